# Optimizing an MI355X kernel written in HIP

```python
import jax, jax.numpy as jnp
from jax import lax
import numpy as np

D_MODEL = 1024
BATCH = 16
SEQ = 2048
DEPTH = 2

CHUNK = 64
D_MIX = D_MODEL
C_CONV = D_MIX // 4
CONV_WIDTH = 31
N_HEADS = 8
HEAD_DIM = 64
D_ATT = N_HEADS * HEAD_DIM
D_Q_LAT = 256
D_KV_LAT = 128
IDX_HEADS = 8
IDX_DIM = 64
TOPK_MAX = 256
Q_BLOCK = 128
C_POOL = D_MIX // 4
POOL_WINDOWS = (2, 4, 8, 16)
POOL_GROUP = C_POOL // 4
N_GROUPS = 4
EXPERTS_PER_GROUP = 8
N_EXPERTS = N_GROUPS * EXPERTS_PER_GROUP
D_EXPERT = 512
MOE_BLOCK = 128
EPS = 1e-6
IN_SPLITS = (C_CONV, C_CONV, D_Q_LAT, D_KV_LAT, IDX_HEADS * IDX_DIM, IDX_DIM, IDX_HEADS, C_POOL)
N_IN = sum(IN_SPLITS)

kernel_name = 'hybrid_chunk_causal_conv_dsa_pool_hmoe'


def _rmsnorm(x, g):
    xf = x.astype(jnp.float32)
    y = xf * lax.rsqrt(jnp.mean(xf * xf, axis=-1, keepdims=True) + EPS)
    return y.astype(x.dtype) * g


def _layernorm(x, g, b):
    xf = x.astype(jnp.float32)
    mu = jnp.mean(xf, axis=-1, keepdims=True)
    var = jnp.mean(jnp.square(xf - mu), axis=-1, keepdims=True)
    return ((xf - mu) * lax.rsqrt(var + EPS)).astype(x.dtype) * g + b


def _conv_module(a_val, a_gate, conv_k, conv_b, ln_g, ln_b):
    u = a_val * jax.nn.sigmoid(a_gate)
    u = lax.conv_general_dilated(
        u, conv_k[:, None, :].astype(u.dtype), window_strides=(1,),
        padding=[(CONV_WIDTH - 1, 0)], dimension_numbers=('NWC', 'WIO', 'NWC'),
        feature_group_count=C_CONV) + conv_b
    return jax.nn.silu(_layernorm(u, ln_g, ln_b))


def _dsa_attention(cq, ckv, qi, ki, wi, q_norm_g, kv_norm_g, w_uq, w_uk, w_uv):
    B, S, _ = ckv.shape
    topk = min(TOPK_MAX, S // 4)
    nb = S // Q_BLOCK
    cq = _rmsnorm(cq, q_norm_g)
    ckv = _rmsnorm(ckv, kv_norm_g)
    q = jnp.einsum('btc,chd->bthd', cq, w_uq)
    q_abs = jnp.einsum('bthd,khd->bthk', q, w_uk)
    qi = qi.reshape(B, S, IDX_HEADS, IDX_DIM)
    key_chunk = jnp.arange(S) // CHUNK
    idx_scale = (IDX_HEADS * IDX_DIM) ** -0.5
    att_scale = HEAD_DIM ** -0.5

    def to_blocks(a):
        return jnp.moveaxis(a.reshape(B, nb, Q_BLOCK, *a.shape[2:]), 1, 0)

    def block(args):
        qa, qib, wib, bi = args
        qchunk = (bi * Q_BLOCK + jnp.arange(Q_BLOCK)) // CHUNK
        allowed = key_chunk[None, :] <= qchunk[:, None]
        rel = jax.nn.relu(jnp.einsum('bqhd,bsd->bqhs', qib, ki).astype(jnp.float32))
        score = jnp.einsum('bqhs,bqh->bqs', rel, wib.astype(jnp.float32)) * idx_scale
        score = jnp.where(allowed[None], score, -jnp.inf)
        _, idx = lax.top_k(score, topk)
        kv_sel = jax.vmap(lambda a, i: a[i])(ckv, idx)
        logits = jnp.einsum('bqhc,bqkc->bqhk', qa, kv_sel).astype(jnp.float32) * att_scale
        valid = (idx // CHUNK) <= qchunk[None, :, None]
        logits = jnp.where(valid[:, :, None, :], logits, -jnp.inf)
        p = jax.nn.softmax(logits, axis=-1).astype(kv_sel.dtype)
        return jnp.einsum('bqhk,bqkc->bqhc', p, kv_sel)

    ctx = lax.map(block, (to_blocks(q_abs), to_blocks(qi), to_blocks(wi), jnp.arange(nb)))
    ctx = jnp.moveaxis(ctx, 0, 1).reshape(B, S, N_HEADS, D_KV_LAT)
    o = jnp.einsum('bthc,chd->bthd', ctx, w_uv)
    return o.reshape(B, S, D_ATT)


def _pool_mixer(u, pool_w, pool_scale):
    B, S, _ = u.shape
    n_pos = jnp.arange(1, S + 1, dtype=jnp.float32)
    outs = []
    for g, w in enumerate(POOL_WINDOWS):
        ug = u[..., g * POOL_GROUP:(g + 1) * POOL_GROUP]
        ugf = ug.astype(jnp.float32)
        cs = jnp.cumsum(ugf, axis=1)
        prev = jnp.pad(cs, ((0, 0), (w, 0), (0, 0)))[:, :S]
        mean = (cs - prev) / jnp.minimum(n_pos, w)[None, :, None]
        outs.append((mean - ugf).astype(u.dtype) @ pool_w[g])
    return jnp.concatenate(outs, axis=-1) * pool_scale


def _hier_moe(h, rg_w, rg_b, re_w, re_b, w1, w3, w2):
    B, S, D = h.shape
    T = B * S
    A = 2 * T
    hf = h.reshape(T, D)
    g_prob = jax.nn.softmax((hf @ rg_w).astype(jnp.float32) + rg_b, axis=-1)
    g_p, g_idx = lax.top_k(g_prob, 1)
    e_logits = jnp.einsum('td,dge->tge', hf, re_w).astype(jnp.float32) + re_b
    e_sel = jnp.take_along_axis(e_logits, g_idx[:, :, None], axis=1)[:, 0]
    e_p, e_idx = lax.top_k(jax.nn.softmax(e_sel, axis=-1), 2)
    e_p = e_p / jnp.sum(e_p, axis=-1, keepdims=True)
    gates = (g_p * e_p).reshape(A)
    a_exp = (g_idx * EXPERTS_PER_GROUP + e_idx).reshape(A).astype(jnp.int32)
    a_tok = jnp.repeat(jnp.arange(T, dtype=jnp.int32), 2)
    order = jnp.argsort(a_exp)
    s_exp = a_exp[order]
    counts = jnp.bincount(a_exp, length=N_EXPERTS)
    starts = jnp.cumsum(counts) - counts
    pcounts = (counts + MOE_BLOCK - 1) // MOE_BLOCK * MOE_BLOCK
    pends = jnp.cumsum(pcounts)
    pstarts = pends - pcounts
    dst = pstarts[s_exp] + jnp.arange(A) - starts[s_exp]
    n_blk = -(-(A + N_EXPERTS * (MOE_BLOCK - 1)) // MOE_BLOCK)
    P = n_blk * MOE_BLOCK
    slot_tok = jnp.zeros((P,), jnp.int32).at[dst].set(a_tok[order])
    slot_gate = jnp.zeros((P,), jnp.float32).at[dst].set(gates[order])
    blk_exp = jnp.minimum(jnp.searchsorted(pends, jnp.arange(n_blk) * MOE_BLOCK, side='right'), N_EXPERTS - 1)

    def run(args):
        tok, e = args
        hb = hf[tok]
        return (jax.nn.silu(hb @ w1[e]) * (hb @ w3[e])) @ w2[e]

    y = lax.map(run, (slot_tok.reshape(n_blk, MOE_BLOCK), blk_exp)).reshape(P, D)
    out = jnp.zeros((T, D), h.dtype).at[slot_tok].add(y * slot_gate[:, None].astype(y.dtype))
    return out.reshape(B, S, D)


def setup_inputs(seed: int = 0) -> dict:
    key = jax.random.key(seed)
    ks = jax.random.split(key, 27)

    def nrm(k, shape, scale):
        return jax.random.normal(k, shape, jnp.float32) * scale

    L = DEPTH
    return {
        'x': nrm(ks[0], (BATCH, SEQ, D_MODEL), 1.0),
        'c': nrm(ks[1], (BATCH, D_MODEL), 1.0),
        'mod_w': nrm(ks[2], (L, D_MODEL, 6 * D_MODEL), 0.5 * D_MODEL ** -0.5),
        'mod_b': nrm(ks[3], (L, 6 * D_MODEL), 0.1),
        'norm1_g': 1.0 + nrm(ks[4], (L, D_MODEL), 0.05),
        'w_in': nrm(ks[5], (L, D_MODEL, N_IN), D_MODEL ** -0.5),
        'conv_k': nrm(ks[6], (L, CONV_WIDTH, C_CONV), CONV_WIDTH ** -0.5),
        'conv_b': nrm(ks[7], (L, C_CONV), 0.02),
        'conv_ln_g': 1.0 + nrm(ks[8], (L, C_CONV), 0.05),
        'conv_ln_b': nrm(ks[9], (L, C_CONV), 0.02),
        'q_norm_g': 1.0 + nrm(ks[10], (L, D_Q_LAT), 0.05),
        'kv_norm_g': 1.0 + nrm(ks[11], (L, D_KV_LAT), 0.05),
        'w_uq': nrm(ks[12], (L, D_Q_LAT, N_HEADS, HEAD_DIM), D_Q_LAT ** -0.5),
        'w_uk': nrm(ks[13], (L, D_KV_LAT, N_HEADS, HEAD_DIM), D_KV_LAT ** -0.5),
        'w_uv': nrm(ks[14], (L, D_KV_LAT, N_HEADS, HEAD_DIM), D_KV_LAT ** -0.5),
        'pool_w': nrm(ks[15], (L, len(POOL_WINDOWS), POOL_GROUP, POOL_GROUP), POOL_GROUP ** -0.5),
        'pool_scale': 1.0 + nrm(ks[16], (L, C_POOL), 0.1),
        'w_out': nrm(ks[17], (L, D_MIX, D_MODEL), D_MIX ** -0.5),
        'norm2_g': 1.0 + nrm(ks[18], (L, D_MODEL), 0.05),
        'router_g_w': nrm(ks[19], (L, D_MODEL, N_GROUPS), D_MODEL ** -0.5),
        'router_g_b': nrm(ks[20], (L, N_GROUPS), 0.01),
        'router_e_w': nrm(ks[21], (L, D_MODEL, N_GROUPS, EXPERTS_PER_GROUP), D_MODEL ** -0.5),
        'router_e_b': nrm(ks[22], (L, N_GROUPS, EXPERTS_PER_GROUP), 0.01),
        'exp_w1': nrm(ks[23], (L, N_EXPERTS, D_MODEL, D_EXPERT), D_MODEL ** -0.5),
        'exp_w3': nrm(ks[24], (L, N_EXPERTS, D_MODEL, D_EXPERT), D_MODEL ** -0.5),
        'exp_w2': nrm(ks[25], (L, N_EXPERTS, D_EXPERT, D_MODEL), D_EXPERT ** -0.5),
        'final_g': 1.0 + nrm(ks[26], (D_MODEL,), 0.05),
    }


def reference(x, c, mod_w, mod_b, norm1_g, w_in, conv_k, conv_b, conv_ln_g, conv_ln_b,
              q_norm_g, kv_norm_g, w_uq, w_uk, w_uv, pool_w, pool_scale, w_out, norm2_g,
              router_g_w, router_g_b, router_e_w, router_e_b, exp_w1, exp_w3, exp_w2, final_g):
    cond = jax.nn.silu(c)
    split_at = np.cumsum(IN_SPLITS)[:-1].tolist()
    for l in range(DEPTH):
        mod = cond @ mod_w[l] + mod_b[l]
        sh1, sc1, g1, sh2, sc2, g2 = [m[:, None, :] for m in jnp.split(mod, 6, axis=-1)]
        h = _rmsnorm(x, norm1_g[l]) * (1 + sc1) + sh1
        z = h @ w_in[l]
        a_val, a_gate, cq, ckv, qi, ki, wi, u_pool = jnp.split(z, split_at, axis=-1)
        y_conv = _conv_module(a_val, a_gate, conv_k[l], conv_b[l], conv_ln_g[l], conv_ln_b[l])
        y_att = _dsa_attention(cq, ckv, qi, ki, wi, q_norm_g[l], kv_norm_g[l], w_uq[l], w_uk[l], w_uv[l])
        y_pool = _pool_mixer(u_pool, pool_w[l], pool_scale[l])
        mix = jnp.concatenate([y_conv, y_att, y_pool], axis=-1) @ w_out[l]
        x = x + g1 * mix
        h = _rmsnorm(x, norm2_g[l]) * (1 + sc2) + sh2
        x = x + g2 * _hier_moe(h, router_g_w[l], router_g_b[l], router_e_w[l], router_e_b[l],
                               exp_w1[l], exp_w3[l], exp_w2[l])
    return _rmsnorm(x, final_g)
```

```cpp
#include <hip/hip_runtime.h>
#include <cstdio>
#include <cstdint>

#ifndef MK_SPLIT
#define MK_SPLIT 1
#endif

#define LAS __attribute__((address_space(3)))
typedef unsigned short bf16_t;
typedef short bf16x8 __attribute__((ext_vector_type(8)));
typedef short bf16x4 __attribute__((ext_vector_type(4)));
typedef float f32x4 __attribute__((ext_vector_type(4)));
typedef float f32x16 __attribute__((ext_vector_type(16)));
typedef unsigned u32x4 __attribute__((ext_vector_type(4)));
typedef unsigned u32x2 __attribute__((ext_vector_type(2)));

constexpr int D = 1024, NB = 16, S = 2048, T = NB * S, DEPTH = 2;
constexpr int NZ = 1792;
constexpr int N_IN = 1736;
constexpr int Z_AVAL = 0, Z_AGATE = 256, Z_CQ = 512, Z_CKV = 768, Z_QI = 896, Z_KI = 1408, Z_WI = 1472, Z_UP = 1480;
constexpr int KMIX = 1536;
constexpr int NEXP = 32, DEXP = 512, MAXTILES = 288, PMAX = MAXTILES * 256;
constexpr float EPS = 1e-6f;
constexpr int SC_PER_B = 4096 * 528;

constexpr size_t MiB = 1u << 20;
constexpr size_t WS_CTL = 0, CTL_ZERO_BYTES = 64 * 1024;
constexpr size_t WS_MOD = 1 * MiB;
constexpr size_t WS_WIN = 2 * MiB;
constexpr size_t WS_WQA = 9 * MiB;
constexpr size_t WS_WMIX = 10 * MiB;
constexpr size_t WS_SMALL = 16 * MiB;
constexpr size_t WS_W13 = 20 * MiB;
constexpr size_t WS_W2 = 84 * MiB;
constexpr size_t WS_Z = 116 * MiB;
constexpr size_t WS_MIXCAT = 228 * MiB;
constexpr size_t WS_H = 324 * MiB;
constexpr size_t WS_CQR = 388 * MiB;
constexpr size_t WS_KVN = 404 * MiB;
constexpr size_t WS_Y = 412 * MiB;
constexpr size_t WS_END = 556 * MiB;
constexpr size_t SM_TOKE = 0;
constexpr size_t SM_TOKG = 256 * 1024;
constexpr size_t SM_RANK = 512 * 1024;
constexpr size_t SM_TSLOT = 768 * 1024;
constexpr size_t SM_STOK = 1024 * 1024;
constexpr size_t SM_SGATE = 1024 * 1024 + 512 * 1024;
constexpr size_t SM_CNT = 2 * 1024 * 1024;
constexpr size_t SM_TEXP = 2 * 1024 * 1024 + 64 * 1024;
constexpr int CW_BAR = 1024;

constexpr int LDS_BYTES = 135168;
constexpr int MISC_OFF = 131072;
constexpr int NPHASE = 22;

__device__ __forceinline__ unsigned cvt_pk_bf16(float lo, float hi) { unsigned r; asm volatile("v_cvt_pk_bf16_f32 %0, %1, %2" : "=v"(r) : "v"(lo), "v"(hi)); return r; }
__device__ __forceinline__ float bf2f(unsigned short b) { return __uint_as_float(((unsigned)b) << 16); }
__device__ __forceinline__ float bflo(unsigned w) { return __uint_as_float(w << 16); }
__device__ __forceinline__ float bfhi(unsigned w) { return __uint_as_float(w & 0xffff0000u); }
__device__ __forceinline__ float wave_sum(float v) {
#pragma unroll
    for (int o = 1; o < 64; o <<= 1) v += __shfl_xor(v, o);
    return v;
}
__device__ __forceinline__ float sigmoidf_(float x) { return 1.0f / (1.0f + __expf(-x)); }
#define LDS_WAIT() asm volatile("s_waitcnt lgkmcnt(0)" ::: "memory")
#define VM_WAIT() asm volatile("s_waitcnt vmcnt(0)" ::: "memory")

#define XB_TMO      128
#define XB_XCNT(j)  (256  + 64 * (j))
#define XB_XSUB(j)  (1280 + 64 * (j))
#define XB_XGEN(j)  (2304 + 64 * (j))
#define XB_TOP      3328
#define XB_TOPGEN   3392
#define XCD_BAR_WORDS 3456
#define XB_SPIN_CAP (1u << 22)

__device__ __forceinline__ unsigned xb_ld(unsigned* p)              { return __hip_atomic_load(p, __ATOMIC_RELAXED, __HIP_MEMORY_SCOPE_AGENT); }
__device__ __forceinline__ unsigned xb_add(unsigned* p, unsigned v) { return __hip_atomic_fetch_add(p, v, __ATOMIC_RELAXED, __HIP_MEMORY_SCOPE_AGENT); }
__device__ __forceinline__ unsigned xb_xcc_id() { return (unsigned)__builtin_amdgcn_s_getreg((3 << 11) | 20) & 0xFu; }
#define XB_SPIN(cond, bar) do { unsigned _sp = 0; while (cond) { __builtin_amdgcn_s_sleep(1); \
    if ((++_sp & 255u) == 0u) { if (xb_ld(&(bar)[XB_TMO])) break; if (_sp > XB_SPIN_CAP) { atomicAdd(&(bar)[XB_TMO], 1u); break; } } } } while (0)

struct XcdBarrier {
    unsigned* bar; unsigned x;
    volatile LAS unsigned* st;
};
__device__ __forceinline__ XcdBarrier xcd_barrier_post(unsigned* bar, volatile LAS unsigned* st) {
    XcdBarrier b; b.bar = bar; b.x = xb_xcc_id(); b.st = st;
    if (threadIdx.x == 0) (void)xb_add(&bar[XB_XCNT(b.x)], 1u);
    return b;
}
__device__ __forceinline__ void xcd_barrier_complete(unsigned* bar, unsigned x, unsigned& nloc, unsigned& nx) {
    const unsigned G = gridDim.x * gridDim.y * gridDim.z;
    unsigned sum, cnt, mine, sp = 0u;
    for (;;) {
        sum = 0u; cnt = 0u; mine = 0u;
#pragma unroll
        for (unsigned j = 0; j < 16; ++j) { const unsigned c = xb_ld(&bar[XB_XCNT(j)]); sum += c; cnt += (c > 0u) ? 1u : 0u; mine = (j == x) ? c : mine; }
        if (sum == G) break;
        __builtin_amdgcn_s_sleep(1);
        if ((++sp & 255u) == 0u) { if (xb_ld(&bar[XB_TMO])) break; if (sp > XB_SPIN_CAP) { atomicAdd(&bar[XB_TMO], 1u); break; } }
    }
    nloc = mine > 0u ? mine : 1u; nx = cnt > 0u ? cnt : 1u;
}
__device__ __forceinline__ void xcd_barrier(const XcdBarrier& b) {
    asm volatile("s_waitcnt vmcnt(0)" ::: "memory");
    __syncthreads();
    if (threadIdx.x == 0) {
        unsigned* bar = b.bar;
        __builtin_amdgcn_s_waitcnt(0);
        unsigned nloc = b.st[0], nx = b.st[1];
        if (nloc == 0u) { xcd_barrier_complete(bar, b.x, nloc, nx); b.st[0] = nloc; b.st[1] = nx; }
        const unsigned old = xb_add(&bar[XB_XSUB(b.x)], 1u);
        const unsigned gen = old / nloc;
        if (old + 1u == (gen + 1u) * nloc) {
            __builtin_amdgcn_fence(__ATOMIC_RELEASE, "agent");
            asm volatile("s_waitcnt vmcnt(0)" ::: "memory");
            const unsigned og = xb_add(&bar[XB_TOP], 1u);
            const unsigned tg = og / nx;
            if (og + 1u == (tg + 1u) * nx) xb_add(&bar[XB_TOPGEN], 1u);
            else XB_SPIN(xb_ld(&bar[XB_TOPGEN]) == tg, bar);
            __builtin_amdgcn_fence(__ATOMIC_ACQUIRE, "agent");
            xb_add(&bar[XB_XGEN(b.x)], 1u);
            asm volatile("s_waitcnt vmcnt(0)" ::: "memory");
        } else {
            XB_SPIN(xb_ld(&bar[XB_XGEN(b.x)]) == gen, bar);
            __builtin_amdgcn_fence(__ATOMIC_ACQUIRE, "agent");
            asm volatile("s_waitcnt vmcnt(0)" ::: "memory");
        }
    }
    __syncthreads();
}

namespace pg8 {
constexpr int BM = 256, BK = 64, HALF = 128, HTB = HALF * BK * 2  , STAGE_BYTES = 8 * HTB, NXCD = 8, WGM = 8;
__host__ __device__ __forceinline__ int lds_byte(int r, int c) { const int st = (r >> 4) * 2 + (c >> 5), rr = r & 15, cc = c & 31, ob = rr * 64 + cc * 2; return st * 1024 + (ob ^ (((ob >> 9) & 1) << 5)); }
__host__ __device__ __forceinline__ void stage_rc(int b, int& R, int& C) { const int st = b / 1024, sb = b % 1024, swz = sb ^ (((sb >> 9) & 1) << 5); R = (st >> 1) * 16 + swz / 64; C = (st & 1) * 32 + (swz % 64) / 2; }
__host__ __device__ __forceinline__ int perm32(int rho) { const int n = rho >> 4, i = rho & 15; return 8 * (i >> 2) + 4 * n + (i & 3); }

struct Unit { int pm, pn; const char* a; const char* b; };

struct StaticOrder {
    const char* A; const char* Bt; int K; const int* rowidx;
    int nM, nN, nwg, G, c;
    __device__ void init(const void* A_, const void* Bt_, int M, int N, int K_, int G_, int c_) { A = (const char*)A_; Bt = (const char*)Bt_; K = K_; rowidx = nullptr; nM = M / BM; nN = N / BM; nwg = nM * nN; G = G_; c = c_; }
    __device__ __forceinline__ bool next(int i, Unit& u) const {
        const long L = (long)i * G + c; if (L >= nwg) return false;
        int wgid = (int)L; { const int q = nwg / NXCD, r = nwg % NXCD, xcd = wgid % NXCD, off = wgid / NXCD; wgid = (xcd < r ? xcd * (q + 1) : r * (q + 1) + (xcd - r) * q) + off; }
        const int nig = WGM * nN, gid = wgid / nig, fm = gid * WGM, gsz = (nM - fm) < WGM ? (nM - fm) : WGM;
        u.pm = fm + ((wgid % nig) % gsz); u.pn = (wgid % nig) / gsz;
        u.a = A + (size_t)u.pm * BM * K * 2; u.b = Bt + (size_t)u.pn * BM * K * 2; return true;
    }
};
struct MoeOrder {
    const char* A; const char* Bt; int K; const int* rowidx;
    const int* tile_exp; int nunits, G, c; size_t bstride;
    __device__ void init(const void* A_, const void* Bt_, int K_, size_t bstride_, const int* rowidx_, const int* tile_exp_, int ntiles, int G_, int c_) {
        A = (const char*)A_; Bt = (const char*)Bt_; K = K_; bstride = bstride_; rowidx = rowidx_; tile_exp = tile_exp_; nunits = ntiles * 4; G = G_; c = c_; }
    __device__ __forceinline__ bool next(int i, Unit& u) const {
        const int L = i * G + c; if (L >= nunits) return false;
        u.pm = L >> 2; u.pn = L & 3; const int e = tile_exp[u.pm];
        u.a = A + (size_t)u.pm * BM * K * 2; u.b = Bt + (size_t)e * bstride + (size_t)u.pn * BM * K * 2; return true;
    }
};

struct EpiBf16 {
    static constexpr bool PERM = true;
    bf16_t* O; int ldc;
    __device__ __forceinline__ void operator()(const f32x4 (&acc)[2][2][4][2], const Unit& u, int wr, int wc, int fr, int fq) const {
        const int row0 = u.pm * BM + wr * 64 + fr, col0 = u.pn * BM + wc * 32 + 8 * fq;
#pragma unroll
        for (int ai = 0; ai < 2; ++ai)
#pragma unroll
            for (int m = 0; m < 4; ++m) { bf16_t* rowp = O + (size_t)(row0 + ai * HALF + m * 16) * ldc + col0;
#pragma unroll
                for (int bj = 0; bj < 2; ++bj) { const f32x4 v0 = acc[ai][bj][m][0], v1 = acc[ai][bj][m][1];
                    u32x4 w; w.x = cvt_pk_bf16(v0[0], v0[1]); w.y = cvt_pk_bf16(v0[2], v0[3]); w.z = cvt_pk_bf16(v1[0], v1[1]); w.w = cvt_pk_bf16(v1[2], v1[3]);
                    *(u32x4*)(rowp + bj * HALF) = w; } }
    }
};
struct EpiMix {
    static constexpr bool PERM = false;
    const float* xin; float* out; const float* gate;
    __device__ __forceinline__ void operator()(const f32x4 (&acc)[2][2][4][2], const Unit& u, int wr, int wc, int fr, int fq) const {
        const int row0 = u.pm * BM + wr * 64 + fr, col0 = u.pn * BM + wc * 32 + 4 * fq;
        const float* gp = gate + (size_t)(u.pm >> 3) * 6144 + col0;
        f32x4 gv[2][2];
#pragma unroll
        for (int bj = 0; bj < 2; ++bj)
#pragma unroll
            for (int n = 0; n < 2; ++n) gv[bj][n] = *(const f32x4*)(gp + bj * HALF + n * 16);
#pragma unroll
        for (int ai = 0; ai < 2; ++ai)
#pragma unroll
            for (int m = 0; m < 4; ++m) { const size_t off = (size_t)(row0 + ai * HALF + m * 16) * D + col0;
#pragma unroll
                for (int bj = 0; bj < 2; ++bj)
#pragma unroll
                    for (int n = 0; n < 2; ++n) { const f32x4 xv = *(const f32x4*)(xin + off + bj * HALF + n * 16);
                        *(f32x4*)(out + off + bj * HALF + n * 16) = xv + gv[bj][n] * acc[ai][bj][m][n]; } }
    }
};
struct EpiAct {
    static constexpr bool PERM = true;
    bf16_t* O;
    __device__ __forceinline__ void operator()(const f32x4 (&acc)[2][2][4][2], const Unit& u, int wr, int wc, int fr, int fq) const {
        const int row0 = u.pm * BM + wr * 64 + fr, col0 = u.pn * 128 + wc * 16 + 4 * fq;
#pragma unroll
        for (int ai = 0; ai < 2; ++ai)
#pragma unroll
            for (int m = 0; m < 4; ++m) { bf16_t* rowp = O + (size_t)(row0 + ai * HALF + m * 16) * DEXP + col0;
#pragma unroll
                for (int bj = 0; bj < 2; ++bj) { const f32x4 a = acc[ai][bj][m][0], b = acc[ai][bj][m][1]; f32x4 r;
#pragma unroll
                    for (int j = 0; j < 4; ++j) r[j] = a[j] * b[j] * __builtin_amdgcn_rcpf(1.0f + __expf(-a[j]));
                    u32x2 w; w.x = cvt_pk_bf16(r[0], r[1]); w.y = cvt_pk_bf16(r[2], r[3]);
                    *(u32x2*)(rowp + bj * 64) = w; } }
    }
};
struct EpiY {
    static constexpr bool PERM = true;
    bf16_t* O; const float* sgate;
    __device__ __forceinline__ void operator()(const f32x4 (&acc)[2][2][4][2], const Unit& u, int wr, int wc, int fr, int fq) const {
        const int row0 = u.pm * BM + wr * 64 + fr, col0 = u.pn * BM + wc * 32 + 8 * fq;
#pragma unroll
        for (int ai = 0; ai < 2; ++ai)
#pragma unroll
            for (int m = 0; m < 4; ++m) { const int row = row0 + ai * HALF + m * 16; const float g = sgate[row]; bf16_t* rowp = O + (size_t)row * D + col0;
#pragma unroll
                for (int bj = 0; bj < 2; ++bj) { const f32x4 v0 = acc[ai][bj][m][0] * g, v1 = acc[ai][bj][m][1] * g;
                    u32x4 w; w.x = cvt_pk_bf16(v0[0], v0[1]); w.y = cvt_pk_bf16(v0[2], v0[3]); w.z = cvt_pk_bf16(v1[0], v1[1]); w.w = cvt_pk_bf16(v1[2], v1[3]);
                    *(u32x4*)(rowp + bj * HALF) = w; } }
    }
};

template <class Epi, class Sched, bool GATHER>
__device__ __forceinline__ void gemm_phase(LAS unsigned char* lds, const Sched& S, const Epi& E) {
    const int tid = threadIdx.x, wid = __builtin_amdgcn_readfirstlane(tid >> 6), lane = tid & 63, wr = wid >> 2, wc = wid & 3, fr = lane & 15, fq = lane >> 4;
    const int K = S.K, nt = K / BK;
    unsigned voffA[2], voffB[2]; int RA[2], CA[2];
#pragma unroll
    for (int i = 0; i < 2; ++i) { int R, C; stage_rc(tid * 16 + i * 8192, R, C); const int Rb = Epi::PERM ? ((R & ~31) + perm32(R & 31)) : R;
        RA[i] = R; CA[i] = C; voffA[i] = (unsigned)(R * K + C) * 2u; voffB[i] = (unsigned)(Rb * K + C) * 2u; }
    const size_t kstep = (size_t)(BK * 2);
    const size_t hstep = (size_t)HALF * K * 2;
    const unsigned ldsw = (unsigned)wid * 1024u;
    const int aoff = lds_byte(wr * 64 + fr, fq * 8), boff = lds_byte(wc * 32 + fr, fq * 8);
#define PG8_SA(b, h) (((b) * 2 + (h)) * HTB)
#define PG8_SB(b, h) ((4 + (b) * 2 + (h)) * HTB)
#define PG8_DMA(bufoff, gptr, i) __builtin_amdgcn_global_load_lds((const unsigned*)(gptr), (LAS unsigned*)(lds + (bufoff) + ldsw + (i) * 8192), 16, 0, 0)
#define PG8_STAGE(bufoff, gbase, voff) do { PG8_DMA(bufoff, (const char*)(gbase) + (voff)[0], 0); PG8_DMA(bufoff, (const char*)(gbase) + (voff)[1], 1); } while (0)
#define PG8_STAGE_A(bufoff, nx, h, kb) do { if constexpr (GATHER) { \
            PG8_DMA(bufoff, S.A + (kb) + ((nx) ? gN[h][0] : gC[h][0]), 0); PG8_DMA(bufoff, S.A + (kb) + ((nx) ? gN[h][1] : gC[h][1]), 1); } \
        else { const char* _b = ((nx) ? nA : cA) + (h) * hstep + (kb); PG8_DMA(bufoff, _b + voffA[0], 0); PG8_DMA(bufoff, _b + voffA[1], 1); } } while (0)
#define PG8_LDA(dst, b, h) do { _Pragma("unroll") for (int m = 0; m < 4; ++m) _Pragma("unroll") for (int k = 0; k < 2; ++k) dst[m][k] = *(const LAS bf16x8*)(lds + PG8_SA(b, h) + aoff + m * 2048 + k * 1024); } while (0)
#define PG8_LDB(dst, b, h) do { _Pragma("unroll") for (int n = 0; n < 2; ++n) _Pragma("unroll") for (int k = 0; k < 2; ++k) dst[n][k] = *(const LAS bf16x8*)(lds + PG8_SB(b, h) + boff + n * 2048 + k * 1024); } while (0)
#define PG8_MMA(ai, bj, At, Bt) do { __builtin_amdgcn_s_setprio(1); _Pragma("unroll") for (int m = 0; m < 4; ++m) _Pragma("unroll") for (int n = 0; n < 2; ++n) _Pragma("unroll") for (int k = 0; k < 2; ++k) \
        acc[ai][bj][m][n] = __builtin_amdgcn_mfma_f32_16x16x32_bf16(Bt[n][k], At[m][k], acc[ai][bj][m][n], 0, 0, 0); __builtin_amdgcn_s_setprio(0); } while (0)
#define PG8_WAIT_V(n) asm volatile("s_waitcnt vmcnt(" #n ")" ::: "memory")
#define PG8_WAIT_L(n) asm volatile("s_waitcnt lgkmcnt(" #n ")" ::: "memory")
#define PG8_BAR __builtin_amdgcn_s_barrier()
#define PG8_SCHED __builtin_amdgcn_sched_barrier(0)
    Unit cur, nxt; int ui = 0;
    if (!S.next(0, cur)) return;
    unsigned gC[2][2] = {{0u, 0u}, {0u, 0u}}, gN[2][2] = {{0u, 0u}, {0u, 0u}};
    if constexpr (GATHER) {
#pragma unroll
        for (int h = 0; h < 2; ++h)
#pragma unroll
            for (int i = 0; i < 2; ++i) gC[h][i] = (unsigned)(S.rowidx[cur.pm * BM + h * HALF + RA[i]] * K + CA[i]) * 2u;
    }
    f32x4 acc[2][2][4][2];
#pragma unroll
    for (int a = 0; a < 2; ++a)
#pragma unroll
        for (int b = 0; b < 2; ++b)
#pragma unroll
            for (int m = 0; m < 4; ++m)
#pragma unroll
                for (int n = 0; n < 2; ++n) acc[a][b][m][n] = (f32x4){0.f, 0.f, 0.f, 0.f};
    bf16x8 At[4][2], B0[2][2], B1[2][2];
    const char* cA = cur.a; const char* cB = cur.b; const char* nA = cA; const char* nB = cB;
    PG8_STAGE(PG8_SB(0, 0), cB, voffB); PG8_STAGE(PG8_SB(0, 1), cB + hstep, voffB); PG8_STAGE_A(PG8_SA(0, 0), false, 0, 0); PG8_STAGE_A(PG8_SA(0, 1), false, 1, 0);
    if (wr == 1) PG8_BAR;
    PG8_WAIT_V(2); PG8_BAR;
    PG8_STAGE(PG8_SB(1, 0), cB + kstep, voffB); PG8_STAGE_A(PG8_SA(1, 0), false, 0, kstep); PG8_STAGE(PG8_SB(1, 1), cB + hstep + kstep, voffB);
    PG8_WAIT_V(6); PG8_BAR;
    for (;;) {
        const bool has_next = S.next(ui + 1, nxt);
        nA = has_next ? nxt.a : cA; nB = has_next ? nxt.b : cB;
        if constexpr (GATHER) {
            const int npm = has_next ? nxt.pm : cur.pm;
#pragma unroll
            for (int h = 0; h < 2; ++h)
#pragma unroll
                for (int i = 0; i < 2; ++i) gN[h][i] = (unsigned)(S.rowidx[npm * BM + h * HALF + RA[i]] * K + CA[i]) * 2u;
        }
        for (int t = 0; t < nt; t += 2) {
            const bool last = (t == nt - 2);
            const size_t k1 = (size_t)(t + 1) * kstep;
            const size_t k2 = last ? 0 : (size_t)(t + 2) * kstep, k3 = k2 + kstep;
            const char* b2 = (last ? nB : cB) + k2; const char* b3 = b2 + kstep;
            PG8_LDB(B0, 0, 0); PG8_LDB(B1, 0, 1); PG8_SCHED; PG8_LDA(At, 0, 0); PG8_STAGE_A(PG8_SA(1, 1), false, 1, k1);
            PG8_WAIT_V(8); PG8_WAIT_L(0); PG8_BAR; PG8_MMA(0, 0, At, B0); PG8_MMA(0, 1, At, B1); PG8_BAR; PG8_SCHED;
            PG8_LDA(At, 0, 1); PG8_STAGE(PG8_SB(0, 0), b2, voffB); PG8_STAGE(PG8_SB(0, 1), b2 + hstep, voffB); PG8_STAGE_A(PG8_SA(0, 0), last, 0, k2);
            PG8_WAIT_V(8); PG8_WAIT_L(0); PG8_BAR; PG8_MMA(1, 0, At, B0); PG8_MMA(1, 1, At, B1); PG8_BAR; PG8_SCHED;
            PG8_LDB(B0, 1, 0); PG8_LDB(B1, 1, 1); PG8_SCHED; PG8_LDA(At, 1, 0); PG8_STAGE_A(PG8_SA(0, 1), last, 1, k2);
            PG8_WAIT_V(8); PG8_WAIT_L(0); PG8_BAR; PG8_MMA(0, 0, At, B0); PG8_MMA(0, 1, At, B1); PG8_BAR; PG8_SCHED;
            PG8_LDA(At, 1, 1); PG8_STAGE(PG8_SB(1, 0), b3, voffB); PG8_STAGE(PG8_SB(1, 1), b3 + hstep, voffB); PG8_STAGE_A(PG8_SA(1, 0), last, 0, k3);
            PG8_WAIT_V(8); PG8_WAIT_L(0); PG8_BAR; PG8_MMA(1, 0, At, B0); PG8_MMA(1, 1, At, B1); PG8_BAR; PG8_SCHED;
        }
        if (wr == 0) PG8_BAR;
        E(acc, cur, wr, wc, fr, fq);
        if (!has_next) break;
#pragma unroll
        for (int a = 0; a < 2; ++a)
#pragma unroll
            for (int b = 0; b < 2; ++b)
#pragma unroll
                for (int m = 0; m < 4; ++m)
#pragma unroll
                    for (int n = 0; n < 2; ++n) acc[a][b][m][n] = (f32x4){0.f, 0.f, 0.f, 0.f};
        cur = nxt; cA = nA; cB = nB; ++ui;
        if constexpr (GATHER) {
#pragma unroll
            for (int h = 0; h < 2; ++h)
#pragma unroll
                for (int i = 0; i < 2; ++i) gC[h][i] = gN[h][i];
        }
        if (wr == 1) PG8_BAR;
    }
    PG8_WAIT_V(0);
    PG8_BAR;
#undef PG8_SA
#undef PG8_SB
#undef PG8_DMA
#undef PG8_STAGE
#undef PG8_STAGE_A
#undef PG8_LDA
#undef PG8_LDB
#undef PG8_MMA
#undef PG8_WAIT_V
#undef PG8_WAIT_L
#undef PG8_BAR
#undef PG8_SCHED
}
}

struct Params { const float* in[27]; float* out; unsigned char* ws; int ph_lo, ph_hi; };
struct Ctx { LAS unsigned char* lds; int tid, lane, wave, vcu, G, gw, NGW; };
enum { I_X = 0, I_C, I_MODW, I_MODB, I_N1G, I_WIN, I_CONVK, I_CONVB, I_CLNG, I_CLNB, I_QNG, I_KVNG, I_WUQ, I_WUK, I_WUV, I_POOLW, I_POOLS, I_WOUT, I_N2G, I_RGW, I_RGB, I_REW, I_REB, I_W1, I_W3, I_W2, I_FG };

template <class RowMap>
__device__ __forceinline__ void tr_item(const float* src, int ldn, int k0, int n0, int nvalid, bf16_t* dst, int ldk, int dk0, RowMap rm, LAS float* scr, int lane) {
#pragma unroll 8
    for (int i = 0; i < 32; ++i) { const int kk = 2 * i + (lane >> 5), n = n0 + (lane & 31); scr[kk * 33 + (lane & 31)] = (n < nvalid) ? src[(size_t)(k0 + kk) * ldn + n] : 0.f; }
    LDS_WAIT();
    const int c = lane & 7;
#pragma unroll
    for (int j = 0; j < 4; ++j) { const int n = (lane >> 3) + 8 * j; const LAS float* s = scr + (8 * c) * 33 + n;
        u32x4 o; o.x = cvt_pk_bf16(s[0 * 33], s[1 * 33]); o.y = cvt_pk_bf16(s[2 * 33], s[3 * 33]); o.z = cvt_pk_bf16(s[4 * 33], s[5 * 33]); o.w = cvt_pk_bf16(s[6 * 33], s[7 * 33]);
        *(u32x4*)(dst + (size_t)rm(n0 + n) * ldk + dk0 + k0 + 8 * c) = o; }
    LDS_WAIT();
}

__device__ __forceinline__ void conv_experts(const Params& p, const Ctx& c, int l) {
    LAS float* scr = (LAS float*)(c.lds + c.wave * 8448);
    bf16_t* W13 = (bf16_t*)(p.ws + WS_W13); bf16_t* W2 = (bf16_t*)(p.ws + WS_W2);
    for (int it = c.gw; it < 3 * 8192; it += c.NGW) {
        const int which = it >> 13, r = it & 8191, e = r >> 8;
        if (which < 2) { const int kb = (r >> 4) & 15, nb = r & 15; const float* src = p.in[which ? I_W3 : I_W1] + (size_t)(l * NEXP + e) * 1024 * 512; const int add = which ? 4 : 0;
            tr_item(src, 512, 64 * kb, 32 * nb, 512, W13 + (size_t)e * 1024 * 1024, 1024, 0, [add](int n) { return 8 * (n >> 2) + (n & 3) + add; }, scr, c.lane); }
        else { const int kb = (r >> 5) & 7, nb = r & 31; const float* src = p.in[I_W2] + (size_t)(l * NEXP + e) * 512 * 1024;
            tr_item(src, 1024, 64 * kb, 32 * nb, 1024, W2 + (size_t)e * 1024 * 512, 512, 0, [](int n) { return n; }, scr, c.lane); }
    }
}

__device__ __forceinline__ void ph_prologue(const Params& p, const Ctx& c) {
    float* mod = (float*)(p.ws + WS_MOD);
    {
        LAS float* cond = (LAS float*)c.lds; LAS float* part = (LAS float*)(c.lds + 65536);
        bool loaded = false;
        for (int item = c.vcu; item < 192; item += c.G) {
            if (!loaded) { for (int i = c.tid; i < NB * D; i += 512) { const float v = p.in[I_C][i]; cond[i] = v / (1.0f + expf(-v)); } __syncthreads(); loaded = true; }
            const int l = item / 96, n0 = (item % 96) * 64;
            const float* W = p.in[I_MODW] + (size_t)l * D * 6144 + n0 + c.lane;
            float acc[NB];
#pragma unroll
            for (int b = 0; b < NB; ++b) acc[b] = 0.f;
            for (int k = c.wave * 128; k < c.wave * 128 + 128; ++k) { const float w = W[(size_t)k * 6144];
#pragma unroll
                for (int b = 0; b < NB; ++b) acc[b] += cond[b * D + k] * w; }
#pragma unroll
            for (int b = 0; b < NB; ++b) part[(c.wave * NB + b) * 64 + c.lane] = acc[b];
            __syncthreads();
            for (int o = c.tid; o < NB * 64; o += 512) { const int b = o >> 6, ln = o & 63; float s = 0.f;
#pragma unroll
                for (int w = 0; w < 8; ++w) s += part[(w * NB + b) * 64 + ln];
                mod[(size_t)(l * NB + b) * 6144 + n0 + ln] = s + p.in[I_MODB][l * 6144 + n0 + ln]; }
            __syncthreads();
        }
        __syncthreads();
    }
    {
        LAS float* scr = (LAS float*)(c.lds + c.wave * 8448);
        constexpr int I_IN = 16 * 56, I_MX = 4 * 32;
        for (int it = c.gw; it < 2 * (I_IN + 2 * I_MX); it += c.NGW) {
            const int l = it / (I_IN + 2 * I_MX); int r = it % (I_IN + 2 * I_MX);
            if (r < I_IN) { const int kb = r / 56, nb = r % 56;
                tr_item(p.in[I_WIN] + (size_t)l * D * N_IN, N_IN, 64 * kb, 32 * nb, N_IN, (bf16_t*)(p.ws + WS_WIN) + (size_t)l * NZ * D, D, 0, [](int n) { return n; }, scr, c.lane); continue; }
            r -= I_IN; const int part = r / I_MX; r %= I_MX; const int kb = r / 32, nb = r % 32;
            tr_item(p.in[I_WOUT] + (size_t)l * D * D + (size_t)(part ? 768 : 0) * D, D, 64 * kb, 32 * nb, D, (bf16_t*)(p.ws + WS_WMIX) + (size_t)l * D * KMIX, KMIX, part ? 1280 : 0, [](int n) { return n; }, scr, c.lane);
        }
    }
    for (int it = c.gw * 64 + c.lane; it < 2 * 131072; it += c.NGW * 64) {
        const int l = it >> 17, r = it & 131071, n = r & 1023, h = (r >> 10) & 7, cb = r >> 13;
        const float* wo = p.in[I_WOUT] + (size_t)l * D * D + (size_t)(256 + 64 * h) * D + n;
        const float* wv = p.in[I_WUV] + (size_t)l * 128 * 512 + (size_t)(8 * cb) * 512 + h * 64;
        float acc[8];
#pragma unroll
        for (int j = 0; j < 8; ++j) acc[j] = 0.f;
        for (int d = 0; d < 64; ++d) { const float w = wo[(size_t)d * D];
#pragma unroll
            for (int j = 0; j < 8; ++j) acc[j] += wv[j * 512 + d] * w; }
        u32x4 o; o.x = cvt_pk_bf16(acc[0], acc[1]); o.y = cvt_pk_bf16(acc[2], acc[3]); o.z = cvt_pk_bf16(acc[4], acc[5]); o.w = cvt_pk_bf16(acc[6], acc[7]);
        *(u32x4*)((bf16_t*)(p.ws + WS_WMIX) + (size_t)l * D * KMIX + (size_t)n * KMIX + 256 + 128 * h + 8 * cb) = o;
    }
    for (int it = c.gw * 64 + c.lane; it < 2 * 32768; it += c.NGW * 64) {
        const int l = it >> 15, r = it & 32767, cb = r & 31, k = (r >> 5) & 127, h = r >> 12;
        const float* uq = p.in[I_WUQ] + (size_t)l * 256 * 512 + (size_t)(8 * cb) * 512 + h * 64;
        const float* uk = p.in[I_WUK] + (size_t)l * 128 * 512 + (size_t)k * 512 + h * 64;
        float acc[8];
#pragma unroll
        for (int j = 0; j < 8; ++j) acc[j] = 0.f;
        for (int d = 0; d < 64; ++d) { const float w = uk[d];
#pragma unroll
            for (int j = 0; j < 8; ++j) acc[j] += uq[j * 512 + d] * w; }
        const float sc = 0.125f * 1.44269504089f;
#pragma unroll
        for (int j = 0; j < 8; ++j) acc[j] *= sc * p.in[I_QNG][l * 256 + 8 * cb + j];
        u32x4 o; o.x = cvt_pk_bf16(acc[0], acc[1]); o.y = cvt_pk_bf16(acc[2], acc[3]); o.z = cvt_pk_bf16(acc[4], acc[5]); o.w = cvt_pk_bf16(acc[6], acc[7]);
        *(u32x4*)((bf16_t*)(p.ws + WS_WQA) + (size_t)l * D * 256 + (size_t)(h * 128 + k) * 256 + 8 * cb) = o;
    }
    conv_experts(p, c, 0);
}

template <int MODE>
__device__ __forceinline__ void ph_norm1(const Params& p, const Ctx& c) {
    const float* mod = (const float*)(p.ws + WS_MOD);
    const bf16_t* Y = (const bf16_t*)(p.ws + WS_Y); const int* tslot = (const int*)(p.ws + WS_SMALL + SM_TSLOT);
    bf16_t* H = (bf16_t*)(p.ws + WS_H);
    for (int m = c.gw; m < T; m += c.NGW) {
        const int b = m >> 11;
        const f32x4* xr = (const f32x4*)((MODE == 0 ? p.in[I_X] : p.out) + (size_t)m * D) + c.lane;
        f32x4 v[4];
#pragma unroll
        for (int j = 0; j < 4; ++j) v[j] = xr[64 * j];
        if (MODE != 0) {
            const int s0 = tslot[2 * m], s1 = tslot[2 * m + 1];
            const u32x2* ya = (const u32x2*)(Y + (size_t)s0 * D) + c.lane; const u32x2* yb = (const u32x2*)(Y + (size_t)s1 * D) + c.lane;
            const f32x4* g2 = (const f32x4*)(mod + (size_t)((MODE - 1) * NB + b) * 6144 + 5120) + c.lane;
#pragma unroll
            for (int j = 0; j < 4; ++j) { const u32x2 a = ya[64 * j], bb = yb[64 * j]; const f32x4 g = g2[64 * j];
                v[j].x += g.x * (bflo(a.x) + bflo(bb.x)); v[j].y += g.y * (bfhi(a.x) + bfhi(bb.x)); v[j].z += g.z * (bflo(a.y) + bflo(bb.y)); v[j].w += g.w * (bfhi(a.y) + bfhi(bb.y)); }
        }
        float ss = 0.f;
#pragma unroll
        for (int j = 0; j < 4; ++j) ss += (v[j].x * v[j].x + v[j].y * v[j].y) + (v[j].z * v[j].z + v[j].w * v[j].w);
        const float r = 1.0f / sqrtf(wave_sum(ss) * (1.0f / D) + EPS);
        if (MODE == 2) {
            const f32x4* fg = (const f32x4*)p.in[I_FG] + c.lane; f32x4* o = (f32x4*)(p.out + (size_t)m * D) + c.lane;
#pragma unroll
            for (int j = 0; j < 4; ++j) o[64 * j] = v[j] * r * fg[64 * j];
        } else {
            if (MODE == 1) { f32x4* o = (f32x4*)(p.out + (size_t)m * D) + c.lane;
#pragma unroll
                for (int j = 0; j < 4; ++j) o[64 * j] = v[j]; }
            const int l = MODE;
            const f32x4* ng = (const f32x4*)(p.in[I_N1G] + l * D) + c.lane;
            const f32x4* sh = (const f32x4*)(mod + (size_t)(l * NB + b) * 6144) + c.lane; const f32x4* sc = (const f32x4*)(mod + (size_t)(l * NB + b) * 6144 + 1024) + c.lane;
            u32x2* o8 = (u32x2*)(H + (size_t)m * D) + c.lane;
#pragma unroll
            for (int j = 0; j < 4; ++j) { const f32x4 hv = v[j] * r * ng[64 * j] * (sc[64 * j] + 1.0f) + sh[64 * j]; u32x2 w; w.x = cvt_pk_bf16(hv.x, hv.y); w.y = cvt_pk_bf16(hv.z, hv.w); o8[64 * j] = w; }
        }
    }
}

__device__ __forceinline__ void ph_postz(const Params& p, const Ctx& c, int l) {
    const bf16_t* Z = (const bf16_t*)(p.ws + WS_Z); bf16_t* MC = (bf16_t*)(p.ws + WS_MIXCAT);
    bf16_t* CQR = (bf16_t*)(p.ws + WS_CQR); bf16_t* KVN = (bf16_t*)(p.ws + WS_KVN);
    LAS float* U = (LAS float*)c.lds;
    const int lane = c.lane, tk0 = c.wave * 8;
    for (int unit = c.vcu; unit < 512; unit += c.G) {
        const int b = unit >> 5, s0 = (unit & 31) * 64, t0 = b * S + s0;
        for (int idx = c.tid; idx < 94 * 64; idx += 512) { const int r = idx >> 6, c4 = idx & 63, s = s0 - 30 + r; f32x4 u = {0.f, 0.f, 0.f, 0.f};
            if (s >= 0) { const bf16_t* zr = Z + (size_t)(b * S + s) * NZ + 4 * c4; const u32x2 a = *(const u32x2*)(zr + Z_AVAL), g = *(const u32x2*)(zr + Z_AGATE);
                u.x = bflo(a.x) * sigmoidf_(bflo(g.x)); u.y = bfhi(a.x) * sigmoidf_(bfhi(g.x)); u.z = bflo(a.y) * sigmoidf_(bflo(g.y)); u.w = bfhi(a.y) * sigmoidf_(bfhi(g.y)); }
            *(LAS f32x4*)(U + r * 256 + 4 * c4) = u; }
        __syncthreads();
        {
            f32x4 acc[8], win[8];
#pragma unroll
            for (int i = 0; i < 8; ++i) { acc[i] = (f32x4){0.f, 0.f, 0.f, 0.f}; win[i] = *(const LAS f32x4*)(U + (tk0 + i) * 256 + 4 * lane); }
            const f32x4* ck = (const f32x4*)(p.in[I_CONVK] + (size_t)l * 31 * 256) + lane;
#pragma unroll
            for (int j = 0; j < 31; ++j) { const f32x4 kj = ck[64 * j];
#pragma unroll
                for (int i = 0; i < 8; ++i) acc[i] += win[i] * kj;
                if (j < 30) {
#pragma unroll
                    for (int i = 0; i < 7; ++i) win[i] = win[i + 1];
                    win[7] = *(const LAS f32x4*)(U + (tk0 + 8 + j) * 256 + 4 * lane); } }
            const f32x4 cb = *((const f32x4*)(p.in[I_CONVB] + l * 256) + lane), lg = *((const f32x4*)(p.in[I_CLNG] + l * 256) + lane), lb = *((const f32x4*)(p.in[I_CLNB] + l * 256) + lane);
#pragma unroll
            for (int i = 0; i < 8; ++i) { const f32x4 v = acc[i] + cb; const float mean = wave_sum((v.x + v.y) + (v.z + v.w)) * (1.0f / 256.0f);
                const f32x4 d = v - mean; const float var = wave_sum((d.x * d.x + d.y * d.y) + (d.z * d.z + d.w * d.w)) * (1.0f / 256.0f);
                const float rs = 1.0f / sqrtf(var + EPS); f32x4 y = d * rs * lg + lb;
                y.x *= sigmoidf_(y.x); y.y *= sigmoidf_(y.y); y.z *= sigmoidf_(y.z); y.w *= sigmoidf_(y.w);
                u32x2 w; w.x = cvt_pk_bf16(y.x, y.y); w.y = cvt_pk_bf16(y.z, y.w);
                *(u32x2*)(MC + (size_t)(t0 + tk0 + i) * KMIX + 4 * lane) = w; }
        }
        __syncthreads();
        for (int idx = c.tid; idx < 79 * 64; idx += 512) { const int r = idx >> 6, c4 = idx & 63, s = s0 - 15 + r; f32x4 u = {0.f, 0.f, 0.f, 0.f};
            if (s >= 0) { const u32x2 a = *(const u32x2*)(Z + (size_t)(b * S + s) * NZ + Z_UP + 4 * c4); u.x = bflo(a.x); u.y = bfhi(a.x); u.z = bflo(a.y); u.w = bfhi(a.y); }
            *(LAS f32x4*)(U + r * 256 + 4 * c4) = u; }
        __syncthreads();
        f32x4 dv[8];
        {
            const int w = 2 << (lane >> 4);
#pragma unroll
            for (int i = 0; i < 8; ++i) { const int r = 15 + tk0 + i, s = s0 + tk0 + i; f32x4 sum = {0.f, 0.f, 0.f, 0.f};
#pragma unroll
                for (int q = 0; q < 16; ++q) { const f32x4 u = *(const LAS f32x4*)(U + (r - q) * 256 + 4 * lane); if (q < w) sum += u; }
                const float cntf = (float)((s + 1) < w ? (s + 1) : w);
                dv[i] = sum / cntf - *(const LAS f32x4*)(U + r * 256 + 4 * lane); }
        }
        __syncthreads();
        {
            LAS float* Dw = U + c.wave * 2048;
#pragma unroll
            for (int i = 0; i < 8; ++i) *(LAS f32x4*)(Dw + i * 256 + 4 * lane) = dv[i];
            LDS_WAIT();
            const int g = lane >> 4, o4 = (lane & 15) * 4;
            const float* pw = p.in[I_POOLW] + (size_t)(l * 4 + g) * 4096 + o4;
            f32x4 out[8];
#pragma unroll
            for (int i = 0; i < 8; ++i) out[i] = (f32x4){0.f, 0.f, 0.f, 0.f};
            for (int ii = 0; ii < 64; ii += 4) {
                const f32x4 w0 = *(const f32x4*)(pw + (ii + 0) * 64), w1 = *(const f32x4*)(pw + (ii + 1) * 64), w2 = *(const f32x4*)(pw + (ii + 2) * 64), w3 = *(const f32x4*)(pw + (ii + 3) * 64);
#pragma unroll
                for (int i = 0; i < 8; ++i) { const f32x4 d = *(const LAS f32x4*)(Dw + i * 256 + 64 * g + ii); out[i] += w0 * d.x + w1 * d.y + w2 * d.z + w3 * d.w; } }
            const f32x4 ps = *((const f32x4*)(p.in[I_POOLS] + l * 256) + lane);
#pragma unroll
            for (int i = 0; i < 8; ++i) { const f32x4 y = out[i] * ps; u32x2 w; w.x = cvt_pk_bf16(y.x, y.y); w.y = cvt_pk_bf16(y.z, y.w);
                *(u32x2*)(MC + (size_t)(t0 + tk0 + i) * KMIX + 1280 + 4 * lane) = w; }
        }
        {
            const float kg0 = p.in[I_KVNG][l * 128 + 2 * lane], kg1 = p.in[I_KVNG][l * 128 + 2 * lane + 1];
#pragma unroll
            for (int i = 0; i < 8; ++i) { const size_t t = (size_t)(t0 + tk0 + i); const bf16_t* zr = Z + t * NZ;
                const u32x2 q = *(const u32x2*)(zr + Z_CQ + 4 * lane); const float q0 = bflo(q.x), q1 = bfhi(q.x), q2 = bflo(q.y), q3 = bfhi(q.y);
                const float rq = 1.0f / sqrtf(wave_sum((q0 * q0 + q1 * q1) + (q2 * q2 + q3 * q3)) * (1.0f / 256.0f) + EPS);
                u32x2 w; w.x = cvt_pk_bf16(q0 * rq, q1 * rq); w.y = cvt_pk_bf16(q2 * rq, q3 * rq); *(u32x2*)(CQR + t * 256 + 4 * lane) = w;
                const unsigned kv = *(const unsigned*)(zr + Z_CKV + 2 * lane); const float k0 = bflo(kv), k1 = bfhi(kv);
                const float rk = 1.0f / sqrtf(wave_sum(k0 * k0 + k1 * k1) * (1.0f / 128.0f) + EPS);
                *(unsigned*)(KVN + t * 128 + 2 * lane) = cvt_pk_bf16(k0 * rk * kg0, k1 * rk * kg1); }
        }
        __syncthreads();
    }
}

__device__ __forceinline__ size_t sc_off(int b, int cq) { return (size_t)b * SC_PER_B + (size_t)2048 * cq * (cq + 1); }
__device__ __forceinline__ void ph_scores(const Params& p, const Ctx& c) {
    const bf16_t* Z = (const bf16_t*)(p.ws + WS_Z); float* SC = (float*)(p.ws + WS_Y);
    const int lane = c.lane, l15 = lane & 15, g = lane >> 4;
    for (int U = c.gw; U < NB * 576; U += c.NGW) {
        const int b = U / 576, u = U % 576;
        int cg = 0; while (8 * (cg + 1) * (cg + 2) <= u) ++cg;
        const int r = u - 8 * cg * (cg + 1), q16 = r / (cg + 1), seg = r % (cg + 1), cq = 4 * cg + (q16 >> 2), q4 = q16 & 3;
        const int n = 64 * (cq + 1), kt0 = seg * 16, kt1 = (kt0 + 16 < 4 * (cq + 1)) ? kt0 + 16 : 4 * (cq + 1);
        const size_t tq = (size_t)b * S + cq * 64 + q4 * 16 + l15;
        const bf16_t* zq = Z + tq * NZ;
        bf16x8 bq[8][2];
#pragma unroll
        for (int h = 0; h < 8; ++h)
#pragma unroll
            for (int s = 0; s < 2; ++s) bq[h][s] = *(const bf16x8*)(zq + Z_QI + h * 64 + 32 * s + 8 * g);
        float wq[8];
        { const u32x4 wv = *(const u32x4*)(zq + Z_WI); const float isc = 0.044194173824159216f;
          wq[0] = bflo(wv.x) * isc; wq[1] = bfhi(wv.x) * isc; wq[2] = bflo(wv.y) * isc; wq[3] = bfhi(wv.y) * isc; wq[4] = bflo(wv.z) * isc; wq[5] = bfhi(wv.z) * isc; wq[6] = bflo(wv.w) * isc; wq[7] = bfhi(wv.w) * isc; }
        float* srow = SC + sc_off(b, cq) + (size_t)(q4 * 16 + l15) * n;
        for (int kt = kt0; kt < kt1; ++kt) {
            const bf16_t* zk = Z + ((size_t)b * S + kt * 16 + l15) * NZ + Z_KI + 8 * g;
            const bf16x8 ak0 = *(const bf16x8*)(zk), ak1 = *(const bf16x8*)(zk + 32);
            f32x4 sc = {0.f, 0.f, 0.f, 0.f};
#pragma unroll
            for (int h = 0; h < 8; ++h) { f32x4 a = {0.f, 0.f, 0.f, 0.f};
                a = __builtin_amdgcn_mfma_f32_16x16x32_bf16(ak0, bq[h][0], a, 0, 0, 0);
                a = __builtin_amdgcn_mfma_f32_16x16x32_bf16(ak1, bq[h][1], a, 0, 0, 0);
#pragma unroll
                for (int i = 0; i < 4; ++i) sc[i] += wq[h] * fmaxf(a[i], 0.f); }
            *(f32x4*)(srow + kt * 16 + 4 * g) = sc;
        }
    }
}

__device__ __forceinline__ unsigned off_b(unsigned row, unsigned ch) { return 256u * row + 16u * (ch ^ (((row & 3) << 2) | ((row >> 2) & 3))); }
__device__ __forceinline__ void ph_attn(const Params& p, const Ctx& c) {
    const float* SC = (const float*)(p.ws + WS_Y); const bf16_t* QA = (const bf16_t*)(p.ws + WS_H); const bf16_t* KVN = (const bf16_t*)(p.ws + WS_KVN);
    bf16_t* MC = (bf16_t*)(p.ws + WS_MIXCAT);
    const int lane = c.lane, g = lane >> 4, hd = lane & 15;
    LAS unsigned char* tile = c.lds + c.wave * 8192;
    LAS unsigned short* lst = (LAS unsigned short*)(c.lds + 65536 + c.wave * 512);
    const unsigned long long ltmask = (1ull << lane) - 1ull;
    const int xg = blockIdx.x & 7, wv = (blockIdx.x >> 3) * 8 + c.wave, nwv = (c.G >> 3) * 8;
    for (int qi = wv; qi < 2 * S; qi += nwv) {
        const int b = xg + 8 * (qi / S), s = qi % S, cq = s >> 6, n = 64 * (cq + 1), nk = n < 256 ? n : 256;
        const size_t t = (size_t)b * S + s;
        if (cq < 4) { for (int i = lane; i < n; i += 64) lst[i] = (unsigned short)i; }
        else {
            const float* srow = SC + sc_off(b, cq) + (size_t)(s & 63) * n;
            unsigned key[32];
#pragma unroll
            for (int j = 0; j < 32; ++j) { key[j] = 0u;
                if (j <= cq) { const float v = srow[64 * j + lane] + 0.0f; const unsigned u = __float_as_uint(v); key[j] = (u & 0x80000000u) ? ~u : (u | 0x80000000u); } }
            unsigned thr = 0u;
            for (int bit = 31; bit >= 0; --bit) { const unsigned cand = thr | (1u << bit); int cnt = 0;
#pragma unroll
                for (int j = 0; j < 32; ++j) cnt += __builtin_popcountll(__ballot(key[j] >= cand));
                if (cnt >= 256) thr = cand; }
            int cgt = 0;
#pragma unroll
            for (int j = 0; j < 32; ++j) cgt += __builtin_popcountll(__ballot(key[j] > thr));
            const int need = 256 - cgt; int base = 0, tb = 0;
#pragma unroll
            for (int j = 0; j < 32; ++j) { if (j <= cq) {
                const bool gt = key[j] > thr, tie = key[j] == thr; const unsigned long long bt = __ballot(tie);
                const int trank = tb + __builtin_popcountll(bt & ltmask); const bool sel = gt || (tie && trank < need);
                const unsigned long long bs = __ballot(sel); const int pos = base + __builtin_popcountll(bs & ltmask);
                if (sel) lst[pos] = (unsigned short)(64 * j + lane);
                base += __builtin_popcountll(bs); tb += __builtin_popcountll(bt); } }
        }
        bf16x8 qf[4];
#pragma unroll
        for (int ks = 0; ks < 4; ++ks) { qf[ks] = (bf16x8){0, 0, 0, 0, 0, 0, 0, 0}; if (hd < 8) qf[ks] = *(const bf16x8*)(QA + t * D + hd * 128 + 32 * ks + 8 * g); }
        float m_run = -INFINITY, l_run = 0.f;
        f32x4 o[8];
#pragma unroll
        for (int ct = 0; ct < 8; ++ct) o[ct] = (f32x4){0.f, 0.f, 0.f, 0.f};
        const char* kvb = (const char*)(KVN + (size_t)b * S * 128);
        for (int kt = 0; kt < nk / 32; ++kt) {
            LDS_WAIT();
            const int myidx = lst[kt * 32 + (lane & 31)];
#pragma unroll
            for (int i = 0; i < 8; ++i) { const int r = 4 * i + g; const int key = __shfl(myidx, r); const unsigned ch = (unsigned)hd ^ (unsigned)(((r & 3) << 2) | ((r >> 2) & 3));
                __builtin_amdgcn_global_load_lds((const unsigned*)(kvb + (size_t)key * 256 + ch * 16), (LAS unsigned*)(tile + i * 1024), 16, 0, 0); }
            VM_WAIT();
            f32x4 sa[2];
#pragma unroll
            for (int rb = 0; rb < 2; ++rb) { sa[rb] = (f32x4){0.f, 0.f, 0.f, 0.f};
#pragma unroll
                for (int ks = 0; ks < 4; ++ks) { const bf16x8 a = *(const LAS bf16x8*)(tile + off_b(16 * rb + hd, 4 * ks + g)); sa[rb] = __builtin_amdgcn_mfma_f32_16x16x32_bf16(a, qf[ks], sa[rb], 0, 0, 0); } }
            float mx = fmaxf(fmaxf(fmaxf(sa[0][0], sa[0][1]), fmaxf(sa[0][2], sa[0][3])), fmaxf(fmaxf(sa[1][0], sa[1][1]), fmaxf(sa[1][2], sa[1][3])));
            mx = fmaxf(mx, __shfl_xor(mx, 16)); mx = fmaxf(mx, __shfl_xor(mx, 32));
            const float m_new = fmaxf(m_run, mx), alpha = exp2f(m_run - m_new);
            float pr[8], ps = 0.f;
#pragma unroll
            for (int j = 0; j < 8; ++j) { pr[j] = exp2f(sa[j >> 2][j & 3] - m_new); ps += pr[j]; }
            l_run = l_run * alpha + ps; m_run = m_new;
            u32x4 pw; pw.x = cvt_pk_bf16(pr[0], pr[1]); pw.y = cvt_pk_bf16(pr[2], pr[3]); pw.z = cvt_pk_bf16(pr[4], pr[5]); pw.w = cvt_pk_bf16(pr[6], pr[7]);
            const bf16x8 pb = __builtin_bit_cast(bf16x8, pw);
            const unsigned q4 = (unsigned)hd >> 2, p4 = (unsigned)hd & 3;
#pragma unroll
            for (int ct = 0; ct < 8; ++ct) {
                o[ct] *= alpha;
                const bf16x4 lo = __builtin_amdgcn_ds_read_tr16_b64_v4i16((LAS bf16x4*)(tile + off_b(4 * g + q4, 2 * ct + (p4 >> 1)) + 8 * (p4 & 1)));
                const bf16x4 hi = __builtin_amdgcn_ds_read_tr16_b64_v4i16((LAS bf16x4*)(tile + off_b(16 + 4 * g + q4, 2 * ct + (p4 >> 1)) + 8 * (p4 & 1)));
                const bf16x8 va = __builtin_shufflevector(lo, hi, 0, 1, 2, 3, 4, 5, 6, 7);
                o[ct] = __builtin_amdgcn_mfma_f32_16x16x32_bf16(va, pb, o[ct], 0, 0, 0);
            }
        }
        float lt = l_run + __shfl_xor(l_run, 16); lt += __shfl_xor(lt, 32);
        const float inv = 1.0f / lt;
        if (hd < 8) {
#pragma unroll
            for (int ct = 0; ct < 8; ++ct) { const f32x4 v = o[ct] * inv; u32x2 w; w.x = cvt_pk_bf16(v.x, v.y); w.y = cvt_pk_bf16(v.z, v.w);
                *(u32x2*)(MC + t * KMIX + 256 + hd * 128 + 16 * ct + 4 * g) = w; }
        }
    }
}

__device__ __forceinline__ void ph_router(const Params& p, const Ctx& c, int l) {
    const float* mod = (const float*)(p.ws + WS_MOD); bf16_t* H = (bf16_t*)(p.ws + WS_H);
    int* toke = (int*)(p.ws + WS_SMALL + SM_TOKE); float* tokg = (float*)(p.ws + WS_SMALL + SM_TOKG); int* rank = (int*)(p.ws + WS_SMALL + SM_RANK); int* cnt = (int*)(p.ws + WS_SMALL + SM_CNT);
    LAS int* le = (LAS int*)c.lds; LAS int* wcnt = le + 256;
    const int lane = c.lane;
    for (int tile = c.vcu; tile < 256; tile += c.G) {
        for (int i = 0; i < 16; ++i) {
            const int tl = c.wave * 16 + i, m = tile * 128 + tl, b = m >> 11;
            const f32x4* xr = (const f32x4*)(p.out + (size_t)m * D) + lane;
            f32x4 v[4]; float ss = 0.f;
#pragma unroll
            for (int j = 0; j < 4; ++j) { v[j] = xr[64 * j]; ss += (v[j].x * v[j].x + v[j].y * v[j].y) + (v[j].z * v[j].z + v[j].w * v[j].w); }
            const float r = 1.0f / sqrtf(wave_sum(ss) * (1.0f / D) + EPS);
            const f32x4* ng = (const f32x4*)(p.in[I_N2G] + l * D) + lane;
            const f32x4* sh = (const f32x4*)(mod + (size_t)(l * NB + b) * 6144 + 3072) + lane; const f32x4* sc = (const f32x4*)(mod + (size_t)(l * NB + b) * 6144 + 4096) + lane;
            u32x2* o8 = (u32x2*)(H + (size_t)m * D) + lane;
            float gl[4] = {0.f, 0.f, 0.f, 0.f};
            const f32x4* rg = (const f32x4*)(p.in[I_RGW] + (size_t)l * D * 4);
#pragma unroll
            for (int j = 0; j < 4; ++j) { v[j] = v[j] * r * ng[64 * j] * (sc[64 * j] + 1.0f) + sh[64 * j];
                u32x2 w; w.x = cvt_pk_bf16(v[j].x, v[j].y); w.y = cvt_pk_bf16(v[j].z, v[j].w); o8[64 * j] = w;
#pragma unroll
                for (int e = 0; e < 4; ++e) { const f32x4 wr = rg[4 * (lane + 64 * j) + e];
                    gl[0] += v[j][e] * wr.x; gl[1] += v[j][e] * wr.y; gl[2] += v[j][e] * wr.z; gl[3] += v[j][e] * wr.w; } }
            int gi = 0; float gmax = -INFINITY;
#pragma unroll
            for (int q = 0; q < 4; ++q) { gl[q] = wave_sum(gl[q]) + p.in[I_RGB][l * 4 + q]; if (gl[q] > gmax) { gmax = gl[q]; gi = q; } }
            float gden = 0.f;
#pragma unroll
            for (int q = 0; q < 4; ++q) gden += expf(gl[q] - gmax);
            const float gp = 1.0f / gden;
            gi = __builtin_amdgcn_readfirstlane(gi);
            float el[8] = {0.f, 0.f, 0.f, 0.f, 0.f, 0.f, 0.f, 0.f};
            const float* re = p.in[I_REW] + (size_t)l * D * 32 + gi * 8;
#pragma unroll
            for (int j = 0; j < 4; ++j)
#pragma unroll
                for (int e = 0; e < 4; ++e) { const float* rr = re + (size_t)(4 * (lane + 64 * j) + e) * 32; const f32x4 w0 = *(const f32x4*)rr, w1 = *(const f32x4*)(rr + 4); const float hv = v[j][e];
                    el[0] += hv * w0.x; el[1] += hv * w0.y; el[2] += hv * w0.z; el[3] += hv * w0.w; el[4] += hv * w1.x; el[5] += hv * w1.y; el[6] += hv * w1.z; el[7] += hv * w1.w; }
            int e0 = 0, e1 = 0; float m0 = -INFINITY, m1 = -INFINITY;
#pragma unroll
            for (int q = 0; q < 8; ++q) el[q] = wave_sum(el[q]) + p.in[I_REB][l * 32 + gi * 8 + q];
#pragma unroll
            for (int q = 0; q < 8; ++q) { if (el[q] > m0) { m1 = m0; e1 = e0; m0 = el[q]; e0 = q; } else if (el[q] > m1) { m1 = el[q]; e1 = q; } }
            const float x1 = expf(m1 - m0), den = 1.0f + x1;
            if (lane == 0) { le[2 * tl] = gi * 8 + e0; le[2 * tl + 1] = gi * 8 + e1; toke[2 * m] = gi * 8 + e0; toke[2 * m + 1] = gi * 8 + e1; tokg[2 * m] = gp / den; tokg[2 * m + 1] = gp * x1 / den; }
        }
        __syncthreads();
        int myrank = 0, mye = 0;
        if (c.tid < 256) { mye = le[c.tid]; const unsigned long long ltmask = (1ull << lane) - 1ull;
            for (int ee = 0; ee < 32; ++ee) { const unsigned long long m = __ballot(mye == ee); if (mye == ee) myrank = __builtin_popcountll(m & ltmask); if (lane == 0) wcnt[c.wave * 32 + ee] = __builtin_popcountll(m); } }
        __syncthreads();
        if (c.tid < 256) { for (int w = 0; w < c.wave; ++w) myrank += wcnt[w * 32 + mye]; rank[tile * 256 + c.tid] = myrank; }
        if (c.tid < 32) cnt[tile * 32 + c.tid] = wcnt[c.tid] + wcnt[32 + c.tid] + wcnt[64 + c.tid] + wcnt[96 + c.tid];
        __syncthreads();
    }
}

__device__ __forceinline__ void ph_dispatch(const Params& p, const Ctx& c) {
    const int* toke = (const int*)(p.ws + WS_SMALL + SM_TOKE); const float* tokg = (const float*)(p.ws + WS_SMALL + SM_TOKG); const int* rank = (const int*)(p.ws + WS_SMALL + SM_RANK); const int* cnt = (const int*)(p.ws + WS_SMALL + SM_CNT);
    int* tslot = (int*)(p.ws + WS_SMALL + SM_TSLOT); int* stok = (int*)(p.ws + WS_SMALL + SM_STOK); float* sgate = (float*)(p.ws + WS_SMALL + SM_SGATE); int* texp = (int*)(p.ws + WS_SMALL + SM_TEXP);
    LAS int* tot = (LAS int*)c.lds; LAS int* pst = tot + 32; LAS int* bse = pst + 33;
    for (int tile = c.vcu; tile < 256; tile += c.G) {
        if (c.tid < 32) { int run = 0, mb = 0; for (int tl = 0; tl < 256; ++tl) { if (tl == tile) mb = run; run += cnt[tl * 32 + c.tid]; } tot[c.tid] = run; bse[c.tid] = mb; }
        __syncthreads();
        if (c.tid == 0) { int a = 0; for (int e = 0; e < 32; ++e) { pst[e] = a; a += ((tot[e] + 255) >> 8) << 8; } pst[32] = a; }
        __syncthreads();
        if (c.tid < 256) { const int a = tile * 256 + c.tid, e = toke[a], slot = pst[e] + bse[e] + rank[a]; stok[slot] = a >> 1; sgate[slot] = tokg[a]; tslot[a] = slot; }
        if (tile == 0) {
            for (int e = 0; e < 32; ++e) { const int pc = pst[e + 1] - pst[e]; for (int r = tot[e] + c.tid; r < pc; r += 512) { stok[pst[e] + r] = 0; sgate[pst[e] + r] = 0.f; } }
            const int ntl = pst[32] >> 8;
            for (int m = c.tid; m < ntl; m += 512) { int e = 0; while (pst[e + 1] <= (m << 8)) ++e; texp[m] = e; }
            if (c.tid == 0) texp[MAXTILES] = ntl;
        }
        __syncthreads();
    }
}

#ifndef PH_ONLY
#define PH_ONLY -1
#endif
#define IN(k) ((PH_ONLY < 0 || PH_ONLY == (k)) && lo <= (k) && (k) < hi)
#define SEAM(k) do { if (IN(k) && IN((k) + 1)) xcd_barrier(bar); } while (0)
template <int l>
__device__ __forceinline__ void run_layer(const Params& p, const Ctx& c, const XcdBarrier& bar, int lo, int hi) {
    bf16_t* Zb = (bf16_t*)(p.ws + WS_Z); bf16_t* Hb = (bf16_t*)(p.ws + WS_H); bf16_t* MCb = (bf16_t*)(p.ws + WS_MIXCAT);
    const float* mod = (const float*)(p.ws + WS_MOD);
    constexpr int P = 1 + 10 * l;
    if (IN(P)) { if (l == 0) ph_norm1<0>(p, c); else { conv_experts(p, c, 1); ph_norm1<1>(p, c); } }
    SEAM(P);
    if (IN(P + 1)) { pg8::StaticOrder So; So.init(Hb, (bf16_t*)(p.ws + WS_WIN) + (size_t)l * NZ * D, T, NZ, D, c.G, (int)blockIdx.x);
        pg8::EpiBf16 E{Zb, NZ}; pg8::gemm_phase<pg8::EpiBf16, pg8::StaticOrder, false>(c.lds, So, E); }
    SEAM(P + 1);
    if (IN(P + 2)) ph_postz(p, c, l);
    SEAM(P + 2);
    if (IN(P + 3)) { pg8::StaticOrder So; So.init((bf16_t*)(p.ws + WS_CQR), (bf16_t*)(p.ws + WS_WQA) + (size_t)l * D * 256, T, D, 256, c.G, (int)blockIdx.x);
        pg8::EpiBf16 E{Hb, D}; pg8::gemm_phase<pg8::EpiBf16, pg8::StaticOrder, false>(c.lds, So, E);
        ph_scores(p, c); }
    SEAM(P + 3);
    if (IN(P + 4)) ph_attn(p, c);
    SEAM(P + 4);
    if (IN(P + 5)) { pg8::StaticOrder So; So.init(MCb, (bf16_t*)(p.ws + WS_WMIX) + (size_t)l * D * KMIX, T, D, KMIX, c.G, (int)blockIdx.x);
        pg8::EpiMix E{l == 0 ? p.in[I_X] : p.out, p.out, mod + (size_t)l * NB * 6144 + 2048}; pg8::gemm_phase<pg8::EpiMix, pg8::StaticOrder, false>(c.lds, So, E); }
    SEAM(P + 5);
    if (IN(P + 6)) ph_router(p, c, l);
    SEAM(P + 6);
    if (IN(P + 7)) ph_dispatch(p, c);
    SEAM(P + 7);
    if (IN(P + 8)) { const int* texp = (const int*)(p.ws + WS_SMALL + SM_TEXP); const int ntl = texp[MAXTILES];
        pg8::MoeOrder Mo; Mo.init(Hb, p.ws + WS_W13, D, (size_t)1024 * 1024 * 2, (const int*)(p.ws + WS_SMALL + SM_STOK), texp, ntl, c.G, c.vcu);
        pg8::EpiAct E{Zb}; pg8::gemm_phase<pg8::EpiAct, pg8::MoeOrder, true>(c.lds, Mo, E); }
    SEAM(P + 8);
    if (IN(P + 9)) { const int* texp = (const int*)(p.ws + WS_SMALL + SM_TEXP); const int ntl = texp[MAXTILES];
        pg8::MoeOrder Mo; Mo.init(Zb, p.ws + WS_W2, DEXP, (size_t)1024 * 512 * 2, nullptr, texp, ntl, c.G, c.vcu);
        pg8::EpiY E{(bf16_t*)(p.ws + WS_Y), (const float*)(p.ws + WS_SMALL + SM_SGATE)}; pg8::gemm_phase<pg8::EpiY, pg8::MoeOrder, false>(c.lds, Mo, E); }
    SEAM(P + 9);
}

__global__ void __launch_bounds__(512, 2) fwd(Params p) {
    extern __shared__ __attribute__((aligned(16))) unsigned char lds_raw[];
    Ctx c;
    c.lds = (LAS unsigned char*)lds_raw;
    c.tid = threadIdx.x; c.lane = c.tid & 63; c.wave = __builtin_amdgcn_readfirstlane(c.tid >> 6);
    c.G = gridDim.x; { const int bx = blockIdx.x; c.vcu = (c.G % 8 == 0) ? (bx % 8) * (c.G / 8) + bx / 8 : bx; }
    c.gw = c.vcu * 8 + c.wave; c.NGW = c.G * 8;
    volatile LAS unsigned* MISC = (volatile LAS unsigned*)(c.lds + MISC_OFF);
    if (c.tid < 64) MISC[c.tid] = 0u;
    __syncthreads();
    unsigned* ctl = (unsigned*)(p.ws + WS_CTL);
    XcdBarrier bar; bar.bar = ctl + CW_BAR; bar.x = 0; bar.st = nullptr;
    const bool multi = (p.ph_hi - p.ph_lo) > 1;
    if (multi) bar = xcd_barrier_post(ctl + CW_BAR, MISC + 8);
    const int lo = p.ph_lo, hi = p.ph_hi;
    if (IN(0)) ph_prologue(p, c);
    SEAM(0);
    run_layer<0>(p, c, bar, lo, hi);
    run_layer<1>(p, c, bar, lo, hi);
    if (IN(21)) ph_norm1<2>(p, c);
#undef IN
#undef SEAM
}

extern "C" void kernel_launch(void* const* d_in, const int* in_sizes, int n_in, void* d_out, int out_size, void* d_ws, size_t ws_size, hipStream_t stream) {
    static int grid = 0;
    if (grid == 0) {
        if (n_in != 27 || out_size != T * D || ws_size < WS_END) { fprintf(stderr, "kernel_launch: unexpected shapes (n_in %d out %d ws %zu, need %zu)\n", n_in, out_size, ws_size, (size_t)WS_END); grid = -1; return; }
        int dev = 0, cus = 0, per_cu = 0;
        if (hipGetDevice(&dev) != hipSuccess || hipDeviceGetAttribute(&cus, hipDeviceAttributeMultiprocessorCount, dev) != hipSuccess) { grid = -1; return; }
        if (hipFuncSetAttribute((const void*)fwd, hipFuncAttributeMaxDynamicSharedMemorySize, LDS_BYTES) != hipSuccess) { fprintf(stderr, "kernel_launch: hipFuncSetAttribute failed\n"); grid = -1; return; }
        if (hipOccupancyMaxActiveBlocksPerMultiprocessor(&per_cu, (const void*)fwd, 512, LDS_BYTES) != hipSuccess || per_cu < 1) { fprintf(stderr, "kernel_launch: occupancy query says %d blocks per CU\n", per_cu); grid = -1; return; }
        (void)hipGetLastError();
        grid = cus;
        if (grid % 8 != 0 || grid > 256) grid = (grid / 8) * 8 > 256 ? 256 : (grid / 8) * 8;
    }
    if (grid <= 0) return;
    (void)hipMemsetAsync((char*)d_ws + WS_CTL, 0, CTL_ZERO_BYTES, stream);
    Params p{};
    for (int i = 0; i < 27; ++i) p.in[i] = (const float*)d_in[i];
    p.out = (float*)d_out; p.ws = (unsigned char*)d_ws;
#if MK_SPLIT
    for (int ph = 0; ph < NPHASE; ++ph) { p.ph_lo = ph; p.ph_hi = ph + 1; hipLaunchKernelGGL(fwd, dim3(grid), dim3(512), LDS_BYTES, stream, p); }
#else
    p.ph_lo = 0; p.ph_hi = NPHASE;
    hipLaunchKernelGGL(fwd, dim3(grid), dim3(512), LDS_BYTES, stream, p);
#endif
}
```

```cpp
#include <hip/hip_runtime.h>
#include <cstdio>
#include <cstdint>

#ifndef MK_SPLIT
#define MK_SPLIT 0
#endif

#define LAS __attribute__((address_space(3)))
typedef unsigned short bf16_t;
typedef short bf16x8 __attribute__((ext_vector_type(8)));
typedef short bf16x4 __attribute__((ext_vector_type(4)));
typedef float f32x4 __attribute__((ext_vector_type(4)));
typedef float f32x16 __attribute__((ext_vector_type(16)));
typedef unsigned u32x4 __attribute__((ext_vector_type(4)));
typedef unsigned u32x2 __attribute__((ext_vector_type(2)));

constexpr int D = 1024, NB = 16, S = 2048, T = NB * S, DEPTH = 2;
constexpr int NZ = 1792;
constexpr int N_IN = 1736;
constexpr int Z_AVAL = 0, Z_AGATE = 256, Z_CQ = 512, Z_CKV = 768, Z_QI = 896, Z_KI = 1408, Z_WI = 1472, Z_UP = 1480;
constexpr int KMIX = 1536;
constexpr int NEXP = 32, DEXP = 512, MAXTILES = 288, PMAX = MAXTILES * 256;
constexpr float EPS = 1e-6f;
constexpr int SC_PER_B = 4096 * 528;

constexpr size_t MiB = 1u << 20;
constexpr size_t WS_CTL = 0, CTL_ZERO_BYTES = 64 * 1024;
constexpr size_t WS_MOD = 1 * MiB;
constexpr size_t WS_WIN = 2 * MiB;
constexpr size_t WS_WQA = 9 * MiB;
constexpr size_t WS_WMIX = 10 * MiB;
constexpr size_t WS_SMALL = 16 * MiB;
constexpr size_t WS_W13 = 20 * MiB;
constexpr size_t WS_W2 = 84 * MiB;
constexpr size_t WS_Z = 116 * MiB;
constexpr size_t WS_MIXCAT = 228 * MiB;
constexpr size_t WS_H = 324 * MiB;
constexpr size_t WS_CQR = 388 * MiB;
constexpr size_t WS_KVN = 404 * MiB;
constexpr size_t WS_Y = 412 * MiB;
constexpr size_t WS_END = 556 * MiB;
constexpr size_t SM_TOKE = 0;
constexpr size_t SM_TOKG = 256 * 1024;
constexpr size_t SM_RANK = 512 * 1024;
constexpr size_t SM_TSLOT = 768 * 1024;
constexpr size_t SM_STOK = 1024 * 1024;
constexpr size_t SM_SGATE = 1024 * 1024 + 512 * 1024;
constexpr size_t SM_CNT = 2 * 1024 * 1024;
constexpr size_t SM_TEXP = 2 * 1024 * 1024 + 64 * 1024;
constexpr int CW_BAR = 1024;

constexpr int LDS_BYTES = 135168;
constexpr int MISC_OFF = 131072;
constexpr int NPHASE = 22;

__device__ __forceinline__ unsigned cvt_pk_bf16(float lo, float hi) { unsigned r; asm volatile("v_cvt_pk_bf16_f32 %0, %1, %2" : "=v"(r) : "v"(lo), "v"(hi)); return r; }
__device__ __forceinline__ float bf2f(unsigned short b) { return __uint_as_float(((unsigned)b) << 16); }
__device__ __forceinline__ float bflo(unsigned w) { return __uint_as_float(w << 16); }
__device__ __forceinline__ float bfhi(unsigned w) { return __uint_as_float(w & 0xffff0000u); }
__device__ __forceinline__ float wave_sum(float v) {
#pragma unroll
    for (int o = 1; o < 64; o <<= 1) v += __shfl_xor(v, o);
    return v;
}
__device__ __forceinline__ float sigmoidf_(float x) { return 1.0f / (1.0f + __expf(-x)); }
#define LDS_WAIT() asm volatile("s_waitcnt lgkmcnt(0)" ::: "memory")
#define VM_WAIT() asm volatile("s_waitcnt vmcnt(0)" ::: "memory")

#define XB_TMO      128
#define XB_XCNT(j)  (256  + 64 * (j))
#define XB_XSUB(j)  (1280 + 64 * (j))
#define XB_XGEN(j)  (2304 + 64 * (j))
#define XB_TOP      3328
#define XB_TOPGEN   3392
#define XCD_BAR_WORDS 3456
#define XB_SPIN_CAP (1u << 22)

__device__ __forceinline__ unsigned xb_ld(unsigned* p)              { return __hip_atomic_load(p, __ATOMIC_RELAXED, __HIP_MEMORY_SCOPE_AGENT); }
__device__ __forceinline__ unsigned xb_add(unsigned* p, unsigned v) { return __hip_atomic_fetch_add(p, v, __ATOMIC_RELAXED, __HIP_MEMORY_SCOPE_AGENT); }
__device__ __forceinline__ unsigned xb_xcc_id() { return (unsigned)__builtin_amdgcn_s_getreg((3 << 11) | 20) & 0xFu; }
#define XB_SPIN(cond, bar) do { unsigned _sp = 0; while (cond) { __builtin_amdgcn_s_sleep(1); \
    if ((++_sp & 255u) == 0u) { if (xb_ld(&(bar)[XB_TMO])) break; if (_sp > XB_SPIN_CAP) { atomicAdd(&(bar)[XB_TMO], 1u); break; } } } } while (0)

struct XcdBarrier {
    unsigned* bar; unsigned x;
    volatile LAS unsigned* st;
};
__device__ __forceinline__ XcdBarrier xcd_barrier_post(unsigned* bar, volatile LAS unsigned* st) {
    XcdBarrier b; b.bar = bar; b.x = xb_xcc_id(); b.st = st;
    if (threadIdx.x == 0) (void)xb_add(&bar[XB_XCNT(b.x)], 1u);
    return b;
}
__device__ __forceinline__ void xcd_barrier_complete(unsigned* bar, unsigned x, unsigned& nloc, unsigned& nx) {
    const unsigned G = gridDim.x * gridDim.y * gridDim.z;
    unsigned sum, cnt, mine, sp = 0u;
    for (;;) {
        sum = 0u; cnt = 0u; mine = 0u;
#pragma unroll
        for (unsigned j = 0; j < 16; ++j) { const unsigned c = xb_ld(&bar[XB_XCNT(j)]); sum += c; cnt += (c > 0u) ? 1u : 0u; mine = (j == x) ? c : mine; }
        if (sum == G) break;
        __builtin_amdgcn_s_sleep(1);
        if ((++sp & 255u) == 0u) { if (xb_ld(&bar[XB_TMO])) break; if (sp > XB_SPIN_CAP) { atomicAdd(&bar[XB_TMO], 1u); break; } }
    }
    nloc = mine > 0u ? mine : 1u; nx = cnt > 0u ? cnt : 1u;
}
__device__ __forceinline__ void xcd_barrier(const XcdBarrier& b) {
    asm volatile("s_waitcnt vmcnt(0)" ::: "memory");
    __syncthreads();
    if (threadIdx.x == 0) {
        unsigned* bar = b.bar;
        __builtin_amdgcn_s_waitcnt(0);
        unsigned nloc = b.st[0], nx = b.st[1];
        if (nloc == 0u) { xcd_barrier_complete(bar, b.x, nloc, nx); b.st[0] = nloc; b.st[1] = nx; }
        const unsigned old = xb_add(&bar[XB_XSUB(b.x)], 1u);
        const unsigned gen = old / nloc;
        if (old + 1u == (gen + 1u) * nloc) {
            __builtin_amdgcn_fence(__ATOMIC_RELEASE, "agent");
            asm volatile("s_waitcnt vmcnt(0)" ::: "memory");
            const unsigned og = xb_add(&bar[XB_TOP], 1u);
            const unsigned tg = og / nx;
            if (og + 1u == (tg + 1u) * nx) xb_add(&bar[XB_TOPGEN], 1u);
            else XB_SPIN(xb_ld(&bar[XB_TOPGEN]) == tg, bar);
            __builtin_amdgcn_fence(__ATOMIC_ACQUIRE, "agent");
            xb_add(&bar[XB_XGEN(b.x)], 1u);
            asm volatile("s_waitcnt vmcnt(0)" ::: "memory");
        } else {
            XB_SPIN(xb_ld(&bar[XB_XGEN(b.x)]) == gen, bar);
            __builtin_amdgcn_fence(__ATOMIC_ACQUIRE, "agent");
            asm volatile("s_waitcnt vmcnt(0)" ::: "memory");
        }
    }
    __syncthreads();
}

namespace pg8 {
constexpr int BM = 256, BK = 64, HALF = 128, HTB = HALF * BK * 2  , STAGE_BYTES = 8 * HTB, NXCD = 8, WGM = 8;
__host__ __device__ __forceinline__ int lds_byte(int r, int c) { const int st = (r >> 4) * 2 + (c >> 5), rr = r & 15, cc = c & 31, ob = rr * 64 + cc * 2; return st * 1024 + (ob ^ (((ob >> 9) & 1) << 5)); }
__host__ __device__ __forceinline__ void stage_rc(int b, int& R, int& C) { const int st = b / 1024, sb = b % 1024, swz = sb ^ (((sb >> 9) & 1) << 5); R = (st >> 1) * 16 + swz / 64; C = (st & 1) * 32 + (swz % 64) / 2; }
__host__ __device__ __forceinline__ int perm32(int rho) { const int n = rho >> 4, i = rho & 15; return 8 * (i >> 2) + 4 * n + (i & 3); }

struct Unit { int pm, pn; const char* a; const char* b; };

struct StaticOrder {
    const char* A; const char* Bt; int K; const int* rowidx;
    int nM, nN, nwg, G, c;
    __device__ void init(const void* A_, const void* Bt_, int M, int N, int K_, int G_, int c_) { A = (const char*)A_; Bt = (const char*)Bt_; K = K_; rowidx = nullptr; nM = M / BM; nN = N / BM; nwg = nM * nN; G = G_; c = c_; }
    __device__ __forceinline__ bool next(int i, Unit& u) const {
        const long L = (long)i * G + c; if (L >= nwg) return false;
        int wgid = (int)L; { const int q = nwg / NXCD, r = nwg % NXCD, xcd = wgid % NXCD, off = wgid / NXCD; wgid = (xcd < r ? xcd * (q + 1) : r * (q + 1) + (xcd - r) * q) + off; }
        const int nig = WGM * nN, gid = wgid / nig, fm = gid * WGM, gsz = (nM - fm) < WGM ? (nM - fm) : WGM;
        u.pm = fm + ((wgid % nig) % gsz); u.pn = (wgid % nig) / gsz;
        u.a = A + (size_t)u.pm * BM * K * 2; u.b = Bt + (size_t)u.pn * BM * K * 2; return true;
    }
};
struct MoeOrder {
    const char* A; const char* Bt; int K; const int* rowidx;
    const int* tile_exp; int nunits, G, c; size_t bstride;
    __device__ void init(const void* A_, const void* Bt_, int K_, size_t bstride_, const int* rowidx_, const int* tile_exp_, int ntiles, int G_, int c_) {
        A = (const char*)A_; Bt = (const char*)Bt_; K = K_; bstride = bstride_; rowidx = rowidx_; tile_exp = tile_exp_; nunits = ntiles * 4; G = G_; c = c_; }
    __device__ __forceinline__ bool next(int i, Unit& u) const {
        const int L = i * G + c; if (L >= nunits) return false;
        u.pm = L >> 2; u.pn = L & 3; const int e = tile_exp[u.pm];
        u.a = A + (size_t)u.pm * BM * K * 2; u.b = Bt + (size_t)e * bstride + (size_t)u.pn * BM * K * 2; return true;
    }
};

struct EpiBf16 {
    static constexpr bool PERM = true;
    bf16_t* O; int ldc;
    __device__ __forceinline__ void operator()(const f32x4 (&acc)[2][2][4][2], const Unit& u, int wr, int wc, int fr, int fq) const {
        const int row0 = u.pm * BM + wr * 64 + fr, col0 = u.pn * BM + wc * 32 + 8 * fq;
#pragma unroll
        for (int ai = 0; ai < 2; ++ai)
#pragma unroll
            for (int m = 0; m < 4; ++m) { bf16_t* rowp = O + (size_t)(row0 + ai * HALF + m * 16) * ldc + col0;
#pragma unroll
                for (int bj = 0; bj < 2; ++bj) { const f32x4 v0 = acc[ai][bj][m][0], v1 = acc[ai][bj][m][1];
                    u32x4 w; w.x = cvt_pk_bf16(v0[0], v0[1]); w.y = cvt_pk_bf16(v0[2], v0[3]); w.z = cvt_pk_bf16(v1[0], v1[1]); w.w = cvt_pk_bf16(v1[2], v1[3]);
                    *(u32x4*)(rowp + bj * HALF) = w; } }
    }
};
struct EpiMix {
    static constexpr bool PERM = false;
    const float* xin; float* out; const float* gate;
    __device__ __forceinline__ void operator()(const f32x4 (&acc)[2][2][4][2], const Unit& u, int wr, int wc, int fr, int fq) const {
        const int row0 = u.pm * BM + wr * 64 + fr, col0 = u.pn * BM + wc * 32 + 4 * fq;
        const float* gp = gate + (size_t)(u.pm >> 3) * 6144 + col0;
        f32x4 gv[2][2];
#pragma unroll
        for (int bj = 0; bj < 2; ++bj)
#pragma unroll
            for (int n = 0; n < 2; ++n) gv[bj][n] = *(const f32x4*)(gp + bj * HALF + n * 16);
#pragma unroll
        for (int ai = 0; ai < 2; ++ai)
#pragma unroll
            for (int m = 0; m < 4; ++m) { const size_t off = (size_t)(row0 + ai * HALF + m * 16) * D + col0;
#pragma unroll
                for (int bj = 0; bj < 2; ++bj)
#pragma unroll
                    for (int n = 0; n < 2; ++n) { const f32x4 xv = *(const f32x4*)(xin + off + bj * HALF + n * 16);
                        *(f32x4*)(out + off + bj * HALF + n * 16) = xv + gv[bj][n] * acc[ai][bj][m][n]; } }
    }
};
struct EpiAct {
    static constexpr bool PERM = true;
    bf16_t* O;
    __device__ __forceinline__ void operator()(const f32x4 (&acc)[2][2][4][2], const Unit& u, int wr, int wc, int fr, int fq) const {
        const int row0 = u.pm * BM + wr * 64 + fr, col0 = u.pn * 128 + wc * 16 + 4 * fq;
#pragma unroll
        for (int ai = 0; ai < 2; ++ai)
#pragma unroll
            for (int m = 0; m < 4; ++m) { bf16_t* rowp = O + (size_t)(row0 + ai * HALF + m * 16) * DEXP + col0;
#pragma unroll
                for (int bj = 0; bj < 2; ++bj) { const f32x4 a = acc[ai][bj][m][0], b = acc[ai][bj][m][1]; f32x4 r;
#pragma unroll
                    for (int j = 0; j < 4; ++j) r[j] = a[j] * b[j] * __builtin_amdgcn_rcpf(1.0f + __expf(-a[j]));
                    u32x2 w; w.x = cvt_pk_bf16(r[0], r[1]); w.y = cvt_pk_bf16(r[2], r[3]);
                    *(u32x2*)(rowp + bj * 64) = w; } }
    }
};
struct EpiY {
    static constexpr bool PERM = true;
    bf16_t* O; const float* sgate;
    __device__ __forceinline__ void operator()(const f32x4 (&acc)[2][2][4][2], const Unit& u, int wr, int wc, int fr, int fq) const {
        const int row0 = u.pm * BM + wr * 64 + fr, col0 = u.pn * BM + wc * 32 + 8 * fq;
#pragma unroll
        for (int ai = 0; ai < 2; ++ai)
#pragma unroll
            for (int m = 0; m < 4; ++m) { const int row = row0 + ai * HALF + m * 16; const float g = sgate[row]; bf16_t* rowp = O + (size_t)row * D + col0;
#pragma unroll
                for (int bj = 0; bj < 2; ++bj) { const f32x4 v0 = acc[ai][bj][m][0] * g, v1 = acc[ai][bj][m][1] * g;
                    u32x4 w; w.x = cvt_pk_bf16(v0[0], v0[1]); w.y = cvt_pk_bf16(v0[2], v0[3]); w.z = cvt_pk_bf16(v1[0], v1[1]); w.w = cvt_pk_bf16(v1[2], v1[3]);
                    *(u32x4*)(rowp + bj * HALF) = w; } }
    }
};

template <class Epi, class Sched, bool GATHER>
__device__ __forceinline__ void gemm_phase(LAS unsigned char* lds, const Sched& S, const Epi& E) {
    const int tid = threadIdx.x, wid = __builtin_amdgcn_readfirstlane(tid >> 6), lane = tid & 63, wr = wid >> 2, wc = wid & 3, fr = lane & 15, fq = lane >> 4;
    const int K = S.K, nt = K / BK;
    unsigned voffA[2], voffB[2]; int RA[2], CA[2];
#pragma unroll
    for (int i = 0; i < 2; ++i) { int R, C; stage_rc(tid * 16 + i * 8192, R, C); const int Rb = Epi::PERM ? ((R & ~31) + perm32(R & 31)) : R;
        RA[i] = R; CA[i] = C; voffA[i] = (unsigned)(R * K + C) * 2u; voffB[i] = (unsigned)(Rb * K + C) * 2u; }
    const size_t kstep = (size_t)(BK * 2);
    const size_t hstep = (size_t)HALF * K * 2;
    const unsigned ldsw = (unsigned)wid * 1024u;
    const int aoff = lds_byte(wr * 64 + fr, fq * 8), boff = lds_byte(wc * 32 + fr, fq * 8);
#define PG8_SA(b, h) (((b) * 2 + (h)) * HTB)
#define PG8_SB(b, h) ((4 + (b) * 2 + (h)) * HTB)
#define PG8_DMA(bufoff, gptr, i) __builtin_amdgcn_global_load_lds((const unsigned*)(gptr), (LAS unsigned*)(lds + (bufoff) + ldsw + (i) * 8192), 16, 0, 0)
#define PG8_STAGE(bufoff, gbase, voff) do { PG8_DMA(bufoff, (const char*)(gbase) + (voff)[0], 0); PG8_DMA(bufoff, (const char*)(gbase) + (voff)[1], 1); } while (0)
#define PG8_STAGE_A(bufoff, nx, h, kb) do { if constexpr (GATHER) { \
            PG8_DMA(bufoff, S.A + (kb) + ((nx) ? gN[h][0] : gC[h][0]), 0); PG8_DMA(bufoff, S.A + (kb) + ((nx) ? gN[h][1] : gC[h][1]), 1); } \
        else { const char* _b = ((nx) ? nA : cA) + (h) * hstep + (kb); PG8_DMA(bufoff, _b + voffA[0], 0); PG8_DMA(bufoff, _b + voffA[1], 1); } } while (0)
#define PG8_LDA(dst, b, h) do { _Pragma("unroll") for (int m = 0; m < 4; ++m) _Pragma("unroll") for (int k = 0; k < 2; ++k) dst[m][k] = *(const LAS bf16x8*)(lds + PG8_SA(b, h) + aoff + m * 2048 + k * 1024); } while (0)
#define PG8_LDB(dst, b, h) do { _Pragma("unroll") for (int n = 0; n < 2; ++n) _Pragma("unroll") for (int k = 0; k < 2; ++k) dst[n][k] = *(const LAS bf16x8*)(lds + PG8_SB(b, h) + boff + n * 2048 + k * 1024); } while (0)
#define PG8_MMA(ai, bj, At, Bt) do { __builtin_amdgcn_s_setprio(1); _Pragma("unroll") for (int m = 0; m < 4; ++m) _Pragma("unroll") for (int n = 0; n < 2; ++n) _Pragma("unroll") for (int k = 0; k < 2; ++k) \
        acc[ai][bj][m][n] = __builtin_amdgcn_mfma_f32_16x16x32_bf16(Bt[n][k], At[m][k], acc[ai][bj][m][n], 0, 0, 0); __builtin_amdgcn_s_setprio(0); } while (0)
#define PG8_WAIT_V(n) asm volatile("s_waitcnt vmcnt(" #n ")" ::: "memory")
#define PG8_WAIT_L(n) asm volatile("s_waitcnt lgkmcnt(" #n ")" ::: "memory")
#define PG8_BAR __builtin_amdgcn_s_barrier()
#define PG8_SCHED __builtin_amdgcn_sched_barrier(0)
    Unit cur, nxt; int ui = 0;
    if (!S.next(0, cur)) return;
    unsigned gC[2][2] = {{0u, 0u}, {0u, 0u}}, gN[2][2] = {{0u, 0u}, {0u, 0u}};
    if constexpr (GATHER) {
#pragma unroll
        for (int h = 0; h < 2; ++h)
#pragma unroll
            for (int i = 0; i < 2; ++i) gC[h][i] = (unsigned)(S.rowidx[cur.pm * BM + h * HALF + RA[i]] * K + CA[i]) * 2u;
    }
    f32x4 acc[2][2][4][2];
#pragma unroll
    for (int a = 0; a < 2; ++a)
#pragma unroll
        for (int b = 0; b < 2; ++b)
#pragma unroll
            for (int m = 0; m < 4; ++m)
#pragma unroll
                for (int n = 0; n < 2; ++n) acc[a][b][m][n] = (f32x4){0.f, 0.f, 0.f, 0.f};
    bf16x8 At[4][2], B0[2][2], B1[2][2];
    const char* cA = cur.a; const char* cB = cur.b; const char* nA = cA; const char* nB = cB;
    PG8_STAGE(PG8_SB(0, 0), cB, voffB); PG8_STAGE(PG8_SB(0, 1), cB + hstep, voffB); PG8_STAGE_A(PG8_SA(0, 0), false, 0, 0); PG8_STAGE_A(PG8_SA(0, 1), false, 1, 0);
    if (wr == 1) PG8_BAR;
    PG8_WAIT_V(2); PG8_BAR;
    PG8_STAGE(PG8_SB(1, 0), cB + kstep, voffB); PG8_STAGE_A(PG8_SA(1, 0), false, 0, kstep); PG8_STAGE(PG8_SB(1, 1), cB + hstep + kstep, voffB);
    PG8_WAIT_V(6); PG8_BAR;
    for (;;) {
        const bool has_next = S.next(ui + 1, nxt);
        nA = has_next ? nxt.a : cA; nB = has_next ? nxt.b : cB;
        if constexpr (GATHER) {
            const int npm = has_next ? nxt.pm : cur.pm;
#pragma unroll
            for (int h = 0; h < 2; ++h)
#pragma unroll
                for (int i = 0; i < 2; ++i) gN[h][i] = (unsigned)(S.rowidx[npm * BM + h * HALF + RA[i]] * K + CA[i]) * 2u;
        }
        for (int t = 0; t < nt; t += 2) {
            const bool last = (t == nt - 2);
            const size_t k1 = (size_t)(t + 1) * kstep;
            const size_t k2 = last ? 0 : (size_t)(t + 2) * kstep, k3 = k2 + kstep;
            const char* b2 = (last ? nB : cB) + k2; const char* b3 = b2 + kstep;
            PG8_LDB(B0, 0, 0); PG8_LDB(B1, 0, 1); PG8_SCHED; PG8_LDA(At, 0, 0); PG8_STAGE_A(PG8_SA(1, 1), false, 1, k1);
            PG8_WAIT_V(8); PG8_WAIT_L(0); PG8_BAR; PG8_MMA(0, 0, At, B0); PG8_MMA(0, 1, At, B1); PG8_BAR; PG8_SCHED;
            PG8_LDA(At, 0, 1); PG8_STAGE(PG8_SB(0, 0), b2, voffB); PG8_STAGE(PG8_SB(0, 1), b2 + hstep, voffB); PG8_STAGE_A(PG8_SA(0, 0), last, 0, k2);
            PG8_WAIT_V(8); PG8_WAIT_L(0); PG8_BAR; PG8_MMA(1, 0, At, B0); PG8_MMA(1, 1, At, B1); PG8_BAR; PG8_SCHED;
            PG8_LDB(B0, 1, 0); PG8_LDB(B1, 1, 1); PG8_SCHED; PG8_LDA(At, 1, 0); PG8_STAGE_A(PG8_SA(0, 1), last, 1, k2);
            PG8_WAIT_V(8); PG8_WAIT_L(0); PG8_BAR; PG8_MMA(0, 0, At, B0); PG8_MMA(0, 1, At, B1); PG8_BAR; PG8_SCHED;
            PG8_LDA(At, 1, 1); PG8_STAGE(PG8_SB(1, 0), b3, voffB); PG8_STAGE(PG8_SB(1, 1), b3 + hstep, voffB); PG8_STAGE_A(PG8_SA(1, 0), last, 0, k3);
            PG8_WAIT_V(8); PG8_WAIT_L(0); PG8_BAR; PG8_MMA(1, 0, At, B0); PG8_MMA(1, 1, At, B1); PG8_BAR; PG8_SCHED;
        }
        if (wr == 0) PG8_BAR;
        E(acc, cur, wr, wc, fr, fq);
        if (!has_next) break;
#pragma unroll
        for (int a = 0; a < 2; ++a)
#pragma unroll
            for (int b = 0; b < 2; ++b)
#pragma unroll
                for (int m = 0; m < 4; ++m)
#pragma unroll
                    for (int n = 0; n < 2; ++n) acc[a][b][m][n] = (f32x4){0.f, 0.f, 0.f, 0.f};
        cur = nxt; cA = nA; cB = nB; ++ui;
        if constexpr (GATHER) {
#pragma unroll
            for (int h = 0; h < 2; ++h)
#pragma unroll
                for (int i = 0; i < 2; ++i) gC[h][i] = gN[h][i];
        }
        if (wr == 1) PG8_BAR;
    }
    PG8_WAIT_V(0);
    PG8_BAR;
#undef PG8_SA
#undef PG8_SB
#undef PG8_DMA
#undef PG8_STAGE
#undef PG8_STAGE_A
#undef PG8_LDA
#undef PG8_LDB
#undef PG8_MMA
#undef PG8_WAIT_V
#undef PG8_WAIT_L
#undef PG8_BAR
#undef PG8_SCHED
}
}

struct Params { const float* in[27]; float* out; unsigned char* ws; int ph_lo, ph_hi; };
struct Ctx { LAS unsigned char* lds; int tid, lane, wave, vcu, G, gw, NGW; };
enum { I_X = 0, I_C, I_MODW, I_MODB, I_N1G, I_WIN, I_CONVK, I_CONVB, I_CLNG, I_CLNB, I_QNG, I_KVNG, I_WUQ, I_WUK, I_WUV, I_POOLW, I_POOLS, I_WOUT, I_N2G, I_RGW, I_RGB, I_REW, I_REB, I_W1, I_W3, I_W2, I_FG };

template <class RowMap>
__device__ __forceinline__ void tr_item(const float* src, int ldn, int k0, int n0, int nvalid, bf16_t* dst, int ldk, int dk0, RowMap rm, LAS float* scr, int lane) {
#pragma unroll 8
    for (int i = 0; i < 32; ++i) { const int kk = 2 * i + (lane >> 5), n = n0 + (lane & 31); scr[kk * 33 + (lane & 31)] = (n < nvalid) ? src[(size_t)(k0 + kk) * ldn + n] : 0.f; }
    LDS_WAIT();
    const int c = lane & 7;
#pragma unroll
    for (int j = 0; j < 4; ++j) { const int n = (lane >> 3) + 8 * j; const LAS float* s = scr + (8 * c) * 33 + n;
        u32x4 o; o.x = cvt_pk_bf16(s[0 * 33], s[1 * 33]); o.y = cvt_pk_bf16(s[2 * 33], s[3 * 33]); o.z = cvt_pk_bf16(s[4 * 33], s[5 * 33]); o.w = cvt_pk_bf16(s[6 * 33], s[7 * 33]);
        *(u32x4*)(dst + (size_t)rm(n0 + n) * ldk + dk0 + k0 + 8 * c) = o; }
    LDS_WAIT();
}

__device__ __forceinline__ void conv_experts(const Params& p, const Ctx& c, int l) {
    LAS float* scr = (LAS float*)(c.lds + c.wave * 8448);
    bf16_t* W13 = (bf16_t*)(p.ws + WS_W13); bf16_t* W2 = (bf16_t*)(p.ws + WS_W2);
    for (int it = c.gw; it < 3 * 8192; it += c.NGW) {
        const int which = it >> 13, r = it & 8191, e = r >> 8;
        if (which < 2) { const int kb = (r >> 4) & 15, nb = r & 15; const float* src = p.in[which ? I_W3 : I_W1] + (size_t)(l * NEXP + e) * 1024 * 512; const int add = which ? 4 : 0;
            tr_item(src, 512, 64 * kb, 32 * nb, 512, W13 + (size_t)e * 1024 * 1024, 1024, 0, [add](int n) { return 8 * (n >> 2) + (n & 3) + add; }, scr, c.lane); }
        else { const int kb = (r >> 5) & 7, nb = r & 31; const float* src = p.in[I_W2] + (size_t)(l * NEXP + e) * 512 * 1024;
            tr_item(src, 1024, 64 * kb, 32 * nb, 1024, W2 + (size_t)e * 1024 * 512, 512, 0, [](int n) { return n; }, scr, c.lane); }
    }
}

__device__ __forceinline__ void ph_prologue(const Params& p, const Ctx& c) {
    float* mod = (float*)(p.ws + WS_MOD);
    {
        LAS float* cond = (LAS float*)c.lds; LAS float* part = (LAS float*)(c.lds + 65536);
        bool loaded = false;
        for (int item = c.vcu; item < 192; item += c.G) {
            if (!loaded) { for (int i = c.tid; i < NB * D; i += 512) { const float v = p.in[I_C][i]; cond[i] = v / (1.0f + expf(-v)); } __syncthreads(); loaded = true; }
            const int l = item / 96, n0 = (item % 96) * 64;
            const float* W = p.in[I_MODW] + (size_t)l * D * 6144 + n0 + c.lane;
            float acc[NB];
#pragma unroll
            for (int b = 0; b < NB; ++b) acc[b] = 0.f;
            for (int k = c.wave * 128; k < c.wave * 128 + 128; ++k) { const float w = W[(size_t)k * 6144];
#pragma unroll
                for (int b = 0; b < NB; ++b) acc[b] += cond[b * D + k] * w; }
#pragma unroll
            for (int b = 0; b < NB; ++b) part[(c.wave * NB + b) * 64 + c.lane] = acc[b];
            __syncthreads();
            for (int o = c.tid; o < NB * 64; o += 512) { const int b = o >> 6, ln = o & 63; float s = 0.f;
#pragma unroll
                for (int w = 0; w < 8; ++w) s += part[(w * NB + b) * 64 + ln];
                mod[(size_t)(l * NB + b) * 6144 + n0 + ln] = s + p.in[I_MODB][l * 6144 + n0 + ln]; }
            __syncthreads();
        }
        __syncthreads();
    }
    {
        LAS float* scr = (LAS float*)(c.lds + c.wave * 8448);
        constexpr int I_IN = 16 * 56, I_MX = 4 * 32;
        for (int it = c.gw; it < 2 * (I_IN + 2 * I_MX); it += c.NGW) {
            const int l = it / (I_IN + 2 * I_MX); int r = it % (I_IN + 2 * I_MX);
            if (r < I_IN) { const int kb = r / 56, nb = r % 56;
                tr_item(p.in[I_WIN] + (size_t)l * D * N_IN, N_IN, 64 * kb, 32 * nb, N_IN, (bf16_t*)(p.ws + WS_WIN) + (size_t)l * NZ * D, D, 0, [](int n) { return n; }, scr, c.lane); continue; }
            r -= I_IN; const int part = r / I_MX; r %= I_MX; const int kb = r / 32, nb = r % 32;
            tr_item(p.in[I_WOUT] + (size_t)l * D * D + (size_t)(part ? 768 : 0) * D, D, 64 * kb, 32 * nb, D, (bf16_t*)(p.ws + WS_WMIX) + (size_t)l * D * KMIX, KMIX, part ? 1280 : 0, [](int n) { return n; }, scr, c.lane);
        }
    }
    for (int it = c.gw * 64 + c.lane; it < 2 * 131072; it += c.NGW * 64) {
        const int l = it >> 17, r = it & 131071, n = r & 1023, h = (r >> 10) & 7, cb = r >> 13;
        const float* wo = p.in[I_WOUT] + (size_t)l * D * D + (size_t)(256 + 64 * h) * D + n;
        const float* wv = p.in[I_WUV] + (size_t)l * 128 * 512 + (size_t)(8 * cb) * 512 + h * 64;
        float acc[8];
#pragma unroll
        for (int j = 0; j < 8; ++j) acc[j] = 0.f;
        for (int d = 0; d < 64; ++d) { const float w = wo[(size_t)d * D];
#pragma unroll
            for (int j = 0; j < 8; ++j) acc[j] += wv[j * 512 + d] * w; }
        u32x4 o; o.x = cvt_pk_bf16(acc[0], acc[1]); o.y = cvt_pk_bf16(acc[2], acc[3]); o.z = cvt_pk_bf16(acc[4], acc[5]); o.w = cvt_pk_bf16(acc[6], acc[7]);
        *(u32x4*)((bf16_t*)(p.ws + WS_WMIX) + (size_t)l * D * KMIX + (size_t)n * KMIX + 256 + 128 * h + 8 * cb) = o;
    }
    for (int it = c.gw * 64 + c.lane; it < 2 * 32768; it += c.NGW * 64) {
        const int l = it >> 15, r = it & 32767, cb = r & 31, k = (r >> 5) & 127, h = r >> 12;
        const float* uq = p.in[I_WUQ] + (size_t)l * 256 * 512 + (size_t)(8 * cb) * 512 + h * 64;
        const float* uk = p.in[I_WUK] + (size_t)l * 128 * 512 + (size_t)k * 512 + h * 64;
        float acc[8];
#pragma unroll
        for (int j = 0; j < 8; ++j) acc[j] = 0.f;
        for (int d = 0; d < 64; ++d) { const float w = uk[d];
#pragma unroll
            for (int j = 0; j < 8; ++j) acc[j] += uq[j * 512 + d] * w; }
        const float sc = 0.125f * 1.44269504089f;
#pragma unroll
        for (int j = 0; j < 8; ++j) acc[j] *= sc * p.in[I_QNG][l * 256 + 8 * cb + j];
        u32x4 o; o.x = cvt_pk_bf16(acc[0], acc[1]); o.y = cvt_pk_bf16(acc[2], acc[3]); o.z = cvt_pk_bf16(acc[4], acc[5]); o.w = cvt_pk_bf16(acc[6], acc[7]);
        *(u32x4*)((bf16_t*)(p.ws + WS_WQA) + (size_t)l * D * 256 + (size_t)(h * 128 + k) * 256 + 8 * cb) = o;
    }
    conv_experts(p, c, 0);
}

template <int MODE>
__device__ __forceinline__ void ph_norm1(const Params& p, const Ctx& c) {
    const float* mod = (const float*)(p.ws + WS_MOD);
    const bf16_t* Y = (const bf16_t*)(p.ws + WS_Y); const int* tslot = (const int*)(p.ws + WS_SMALL + SM_TSLOT);
    bf16_t* H = (bf16_t*)(p.ws + WS_H);
    for (int m = c.gw; m < T; m += c.NGW) {
        const int b = m >> 11;
        const f32x4* xr = (const f32x4*)((MODE == 0 ? p.in[I_X] : p.out) + (size_t)m * D) + c.lane;
        f32x4 v[4];
#pragma unroll
        for (int j = 0; j < 4; ++j) v[j] = xr[64 * j];
        if (MODE != 0) {
            const int s0 = tslot[2 * m], s1 = tslot[2 * m + 1];
            const u32x2* ya = (const u32x2*)(Y + (size_t)s0 * D) + c.lane; const u32x2* yb = (const u32x2*)(Y + (size_t)s1 * D) + c.lane;
            const f32x4* g2 = (const f32x4*)(mod + (size_t)((MODE - 1) * NB + b) * 6144 + 5120) + c.lane;
#pragma unroll
            for (int j = 0; j < 4; ++j) { const u32x2 a = ya[64 * j], bb = yb[64 * j]; const f32x4 g = g2[64 * j];
                v[j].x += g.x * (bflo(a.x) + bflo(bb.x)); v[j].y += g.y * (bfhi(a.x) + bfhi(bb.x)); v[j].z += g.z * (bflo(a.y) + bflo(bb.y)); v[j].w += g.w * (bfhi(a.y) + bfhi(bb.y)); }
        }
        float ss = 0.f;
#pragma unroll
        for (int j = 0; j < 4; ++j) ss += (v[j].x * v[j].x + v[j].y * v[j].y) + (v[j].z * v[j].z + v[j].w * v[j].w);
        const float r = 1.0f / sqrtf(wave_sum(ss) * (1.0f / D) + EPS);
        if (MODE == 2) {
            const f32x4* fg = (const f32x4*)p.in[I_FG] + c.lane; f32x4* o = (f32x4*)(p.out + (size_t)m * D) + c.lane;
#pragma unroll
            for (int j = 0; j < 4; ++j) o[64 * j] = v[j] * r * fg[64 * j];
        } else {
            if (MODE == 1) { f32x4* o = (f32x4*)(p.out + (size_t)m * D) + c.lane;
#pragma unroll
                for (int j = 0; j < 4; ++j) o[64 * j] = v[j]; }
            const int l = MODE;
            const f32x4* ng = (const f32x4*)(p.in[I_N1G] + l * D) + c.lane;
            const f32x4* sh = (const f32x4*)(mod + (size_t)(l * NB + b) * 6144) + c.lane; const f32x4* sc = (const f32x4*)(mod + (size_t)(l * NB + b) * 6144 + 1024) + c.lane;
            u32x2* o8 = (u32x2*)(H + (size_t)m * D) + c.lane;
#pragma unroll
            for (int j = 0; j < 4; ++j) { const f32x4 hv = v[j] * r * ng[64 * j] * (sc[64 * j] + 1.0f) + sh[64 * j]; u32x2 w; w.x = cvt_pk_bf16(hv.x, hv.y); w.y = cvt_pk_bf16(hv.z, hv.w); o8[64 * j] = w; }
        }
    }
}

__device__ __forceinline__ void ph_postz(const Params& p, const Ctx& c, int l) {
    const bf16_t* Z = (const bf16_t*)(p.ws + WS_Z); bf16_t* MC = (bf16_t*)(p.ws + WS_MIXCAT);
    bf16_t* CQR = (bf16_t*)(p.ws + WS_CQR); bf16_t* KVN = (bf16_t*)(p.ws + WS_KVN);
    LAS float* U = (LAS float*)c.lds;
    const int lane = c.lane, tk0 = c.wave * 8;
    for (int unit = c.vcu; unit < 512; unit += c.G) {
        const int b = unit >> 5, s0 = (unit & 31) * 64, t0 = b * S + s0;
        for (int idx = c.tid; idx < 94 * 64; idx += 512) { const int r = idx >> 6, c4 = idx & 63, s = s0 - 30 + r; f32x4 u = {0.f, 0.f, 0.f, 0.f};
            if (s >= 0) { const bf16_t* zr = Z + (size_t)(b * S + s) * NZ + 4 * c4; const u32x2 a = *(const u32x2*)(zr + Z_AVAL), g = *(const u32x2*)(zr + Z_AGATE);
                u.x = bflo(a.x) * sigmoidf_(bflo(g.x)); u.y = bfhi(a.x) * sigmoidf_(bfhi(g.x)); u.z = bflo(a.y) * sigmoidf_(bflo(g.y)); u.w = bfhi(a.y) * sigmoidf_(bfhi(g.y)); }
            *(LAS f32x4*)(U + r * 256 + 4 * c4) = u; }
        __syncthreads();
        {
            f32x4 acc[8], win[8];
#pragma unroll
            for (int i = 0; i < 8; ++i) { acc[i] = (f32x4){0.f, 0.f, 0.f, 0.f}; win[i] = *(const LAS f32x4*)(U + (tk0 + i) * 256 + 4 * lane); }
            const f32x4* ck = (const f32x4*)(p.in[I_CONVK] + (size_t)l * 31 * 256) + lane;
#pragma unroll
            for (int j = 0; j < 31; ++j) { const f32x4 kj = ck[64 * j];
#pragma unroll
                for (int i = 0; i < 8; ++i) acc[i] += win[i] * kj;
                if (j < 30) {
#pragma unroll
                    for (int i = 0; i < 7; ++i) win[i] = win[i + 1];
                    win[7] = *(const LAS f32x4*)(U + (tk0 + 8 + j) * 256 + 4 * lane); } }
            const f32x4 cb = *((const f32x4*)(p.in[I_CONVB] + l * 256) + lane), lg = *((const f32x4*)(p.in[I_CLNG] + l * 256) + lane), lb = *((const f32x4*)(p.in[I_CLNB] + l * 256) + lane);
#pragma unroll
            for (int i = 0; i < 8; ++i) { const f32x4 v = acc[i] + cb; const float mean = wave_sum((v.x + v.y) + (v.z + v.w)) * (1.0f / 256.0f);
                const f32x4 d = v - mean; const float var = wave_sum((d.x * d.x + d.y * d.y) + (d.z * d.z + d.w * d.w)) * (1.0f / 256.0f);
                const float rs = 1.0f / sqrtf(var + EPS); f32x4 y = d * rs * lg + lb;
                y.x *= sigmoidf_(y.x); y.y *= sigmoidf_(y.y); y.z *= sigmoidf_(y.z); y.w *= sigmoidf_(y.w);
                u32x2 w; w.x = cvt_pk_bf16(y.x, y.y); w.y = cvt_pk_bf16(y.z, y.w);
                *(u32x2*)(MC + (size_t)(t0 + tk0 + i) * KMIX + 4 * lane) = w; }
        }
        __syncthreads();
        for (int idx = c.tid; idx < 79 * 64; idx += 512) { const int r = idx >> 6, c4 = idx & 63, s = s0 - 15 + r; f32x4 u = {0.f, 0.f, 0.f, 0.f};
            if (s >= 0) { const u32x2 a = *(const u32x2*)(Z + (size_t)(b * S + s) * NZ + Z_UP + 4 * c4); u.x = bflo(a.x); u.y = bfhi(a.x); u.z = bflo(a.y); u.w = bfhi(a.y); }
            *(LAS f32x4*)(U + r * 256 + 4 * c4) = u; }
        __syncthreads();
        f32x4 dv[8];
        {
            const int w = 2 << (lane >> 4);
#pragma unroll
            for (int i = 0; i < 8; ++i) { const int r = 15 + tk0 + i, s = s0 + tk0 + i; f32x4 sum = {0.f, 0.f, 0.f, 0.f};
#pragma unroll
                for (int q = 0; q < 16; ++q) { const f32x4 u = *(const LAS f32x4*)(U + (r - q) * 256 + 4 * lane); if (q < w) sum += u; }
                const float cntf = (float)((s + 1) < w ? (s + 1) : w);
                dv[i] = sum / cntf - *(const LAS f32x4*)(U + r * 256 + 4 * lane); }
        }
        __syncthreads();
        {
            LAS float* Dw = U + c.wave * 2048;
#pragma unroll
            for (int i = 0; i < 8; ++i) *(LAS f32x4*)(Dw + i * 256 + 4 * lane) = dv[i];
            LDS_WAIT();
            const int g = lane >> 4, o4 = (lane & 15) * 4;
            const float* pw = p.in[I_POOLW] + (size_t)(l * 4 + g) * 4096 + o4;
            f32x4 out[8];
#pragma unroll
            for (int i = 0; i < 8; ++i) out[i] = (f32x4){0.f, 0.f, 0.f, 0.f};
            for (int ii = 0; ii < 64; ii += 4) {
                const f32x4 w0 = *(const f32x4*)(pw + (ii + 0) * 64), w1 = *(const f32x4*)(pw + (ii + 1) * 64), w2 = *(const f32x4*)(pw + (ii + 2) * 64), w3 = *(const f32x4*)(pw + (ii + 3) * 64);
#pragma unroll
                for (int i = 0; i < 8; ++i) { const f32x4 d = *(const LAS f32x4*)(Dw + i * 256 + 64 * g + ii); out[i] += w0 * d.x + w1 * d.y + w2 * d.z + w3 * d.w; } }
            const f32x4 ps = *((const f32x4*)(p.in[I_POOLS] + l * 256) + lane);
#pragma unroll
            for (int i = 0; i < 8; ++i) { const f32x4 y = out[i] * ps; u32x2 w; w.x = cvt_pk_bf16(y.x, y.y); w.y = cvt_pk_bf16(y.z, y.w);
                *(u32x2*)(MC + (size_t)(t0 + tk0 + i) * KMIX + 1280 + 4 * lane) = w; }
        }
        {
            const float kg0 = p.in[I_KVNG][l * 128 + 2 * lane], kg1 = p.in[I_KVNG][l * 128 + 2 * lane + 1];
#pragma unroll
            for (int i = 0; i < 8; ++i) { const size_t t = (size_t)(t0 + tk0 + i); const bf16_t* zr = Z + t * NZ;
                const u32x2 q = *(const u32x2*)(zr + Z_CQ + 4 * lane); const float q0 = bflo(q.x), q1 = bfhi(q.x), q2 = bflo(q.y), q3 = bfhi(q.y);
                const float rq = 1.0f / sqrtf(wave_sum((q0 * q0 + q1 * q1) + (q2 * q2 + q3 * q3)) * (1.0f / 256.0f) + EPS);
                u32x2 w; w.x = cvt_pk_bf16(q0 * rq, q1 * rq); w.y = cvt_pk_bf16(q2 * rq, q3 * rq); *(u32x2*)(CQR + t * 256 + 4 * lane) = w;
                const unsigned kv = *(const unsigned*)(zr + Z_CKV + 2 * lane); const float k0 = bflo(kv), k1 = bfhi(kv);
                const float rk = 1.0f / sqrtf(wave_sum(k0 * k0 + k1 * k1) * (1.0f / 128.0f) + EPS);
                *(unsigned*)(KVN + t * 128 + 2 * lane) = cvt_pk_bf16(k0 * rk * kg0, k1 * rk * kg1); }
        }
        __syncthreads();
    }
}

__device__ __forceinline__ size_t sc_off(int b, int cq) { return (size_t)b * SC_PER_B + (size_t)2048 * cq * (cq + 1); }
__device__ __forceinline__ void ph_scores(const Params& p, const Ctx& c) {
    const bf16_t* Z = (const bf16_t*)(p.ws + WS_Z); float* SC = (float*)(p.ws + WS_Y);
    const int lane = c.lane, l15 = lane & 15, g = lane >> 4;
    for (int U = c.gw; U < NB * 576; U += c.NGW) {
        const int b = U / 576, u = U % 576;
        int cg = 0; while (8 * (cg + 1) * (cg + 2) <= u) ++cg;
        const int r = u - 8 * cg * (cg + 1), q16 = r / (cg + 1), seg = r % (cg + 1), cq = 4 * cg + (q16 >> 2), q4 = q16 & 3;
        const int n = 64 * (cq + 1), kt0 = seg * 16, kt1 = (kt0 + 16 < 4 * (cq + 1)) ? kt0 + 16 : 4 * (cq + 1);
        const size_t tq = (size_t)b * S + cq * 64 + q4 * 16 + l15;
        const bf16_t* zq = Z + tq * NZ;
        bf16x8 bq[8][2];
#pragma unroll
        for (int h = 0; h < 8; ++h)
#pragma unroll
            for (int s = 0; s < 2; ++s) bq[h][s] = *(const bf16x8*)(zq + Z_QI + h * 64 + 32 * s + 8 * g);
        float wq[8];
        { const u32x4 wv = *(const u32x4*)(zq + Z_WI); const float isc = 0.044194173824159216f;
          wq[0] = bflo(wv.x) * isc; wq[1] = bfhi(wv.x) * isc; wq[2] = bflo(wv.y) * isc; wq[3] = bfhi(wv.y) * isc; wq[4] = bflo(wv.z) * isc; wq[5] = bfhi(wv.z) * isc; wq[6] = bflo(wv.w) * isc; wq[7] = bfhi(wv.w) * isc; }
        float* srow = SC + sc_off(b, cq) + (size_t)(q4 * 16 + l15) * n;
        for (int kt = kt0; kt < kt1; ++kt) {
            const bf16_t* zk = Z + ((size_t)b * S + kt * 16 + l15) * NZ + Z_KI + 8 * g;
            const bf16x8 ak0 = *(const bf16x8*)(zk), ak1 = *(const bf16x8*)(zk + 32);
            f32x4 sc = {0.f, 0.f, 0.f, 0.f};
#pragma unroll
            for (int h = 0; h < 8; ++h) { f32x4 a = {0.f, 0.f, 0.f, 0.f};
                a = __builtin_amdgcn_mfma_f32_16x16x32_bf16(ak0, bq[h][0], a, 0, 0, 0);
                a = __builtin_amdgcn_mfma_f32_16x16x32_bf16(ak1, bq[h][1], a, 0, 0, 0);
#pragma unroll
                for (int i = 0; i < 4; ++i) sc[i] += wq[h] * fmaxf(a[i], 0.f); }
            *(f32x4*)(srow + kt * 16 + 4 * g) = sc;
        }
    }
}

__device__ __forceinline__ unsigned off_b(unsigned row, unsigned ch) { return 256u * row + 16u * (ch ^ (((row & 3) << 2) | ((row >> 2) & 3))); }
__device__ __forceinline__ void ph_attn(const Params& p, const Ctx& c) {
    const float* SC = (const float*)(p.ws + WS_Y); const bf16_t* QA = (const bf16_t*)(p.ws + WS_H); const bf16_t* KVN = (const bf16_t*)(p.ws + WS_KVN);
    bf16_t* MC = (bf16_t*)(p.ws + WS_MIXCAT);
    const int lane = c.lane, g = lane >> 4, hd = lane & 15;
    LAS unsigned char* tile = c.lds + c.wave * 8192;
    LAS unsigned short* lst = (LAS unsigned short*)(c.lds + 65536 + c.wave * 512);
    const unsigned long long ltmask = (1ull << lane) - 1ull;
    const int xg = blockIdx.x & 7, wv = (blockIdx.x >> 3) * 8 + c.wave, nwv = (c.G >> 3) * 8;
    for (int qi = wv; qi < 2 * S; qi += nwv) {
        const int b = xg + 8 * (qi / S), s = qi % S, cq = s >> 6, n = 64 * (cq + 1), nk = n < 256 ? n : 256;
        const size_t t = (size_t)b * S + s;
        if (cq < 4) { for (int i = lane; i < n; i += 64) lst[i] = (unsigned short)i; }
        else {
            const float* srow = SC + sc_off(b, cq) + (size_t)(s & 63) * n;
            unsigned key[32];
#pragma unroll
            for (int j = 0; j < 32; ++j) { key[j] = 0u;
                if (j <= cq) { const float v = srow[64 * j + lane] + 0.0f; const unsigned u = __float_as_uint(v); key[j] = (u & 0x80000000u) ? ~u : (u | 0x80000000u); } }
            unsigned thr = 0u;
            for (int bit = 31; bit >= 0; --bit) { const unsigned cand = thr | (1u << bit); int cnt = 0;
#pragma unroll
                for (int j = 0; j < 32; ++j) cnt += __builtin_popcountll(__ballot(key[j] >= cand));
                if (cnt >= 256) thr = cand; }
            int cgt = 0;
#pragma unroll
            for (int j = 0; j < 32; ++j) cgt += __builtin_popcountll(__ballot(key[j] > thr));
            const int need = 256 - cgt; int base = 0, tb = 0;
#pragma unroll
            for (int j = 0; j < 32; ++j) { if (j <= cq) {
                const bool gt = key[j] > thr, tie = key[j] == thr; const unsigned long long bt = __ballot(tie);
                const int trank = tb + __builtin_popcountll(bt & ltmask); const bool sel = gt || (tie && trank < need);
                const unsigned long long bs = __ballot(sel); const int pos = base + __builtin_popcountll(bs & ltmask);
                if (sel) lst[pos] = (unsigned short)(64 * j + lane);
                base += __builtin_popcountll(bs); tb += __builtin_popcountll(bt); } }
        }
        bf16x8 qf[4];
#pragma unroll
        for (int ks = 0; ks < 4; ++ks) { qf[ks] = (bf16x8){0, 0, 0, 0, 0, 0, 0, 0}; if (hd < 8) qf[ks] = *(const bf16x8*)(QA + t * D + hd * 128 + 32 * ks + 8 * g); }
        float m_run = -INFINITY, l_run = 0.f;
        f32x4 o[8];
#pragma unroll
        for (int ct = 0; ct < 8; ++ct) o[ct] = (f32x4){0.f, 0.f, 0.f, 0.f};
        const char* kvb = (const char*)(KVN + (size_t)b * S * 128);
        for (int kt = 0; kt < nk / 32; ++kt) {
            LDS_WAIT();
            const int myidx = lst[kt * 32 + (lane & 31)];
#pragma unroll
            for (int i = 0; i < 8; ++i) { const int r = 4 * i + g; const int key = __shfl(myidx, r); const unsigned ch = (unsigned)hd ^ (unsigned)(((r & 3) << 2) | ((r >> 2) & 3));
                __builtin_amdgcn_global_load_lds((const unsigned*)(kvb + (size_t)key * 256 + ch * 16), (LAS unsigned*)(tile + i * 1024), 16, 0, 0); }
            VM_WAIT();
            f32x4 sa[2];
#pragma unroll
            for (int rb = 0; rb < 2; ++rb) { sa[rb] = (f32x4){0.f, 0.f, 0.f, 0.f};
#pragma unroll
                for (int ks = 0; ks < 4; ++ks) { const bf16x8 a = *(const LAS bf16x8*)(tile + off_b(16 * rb + hd, 4 * ks + g)); sa[rb] = __builtin_amdgcn_mfma_f32_16x16x32_bf16(a, qf[ks], sa[rb], 0, 0, 0); } }
            float mx = fmaxf(fmaxf(fmaxf(sa[0][0], sa[0][1]), fmaxf(sa[0][2], sa[0][3])), fmaxf(fmaxf(sa[1][0], sa[1][1]), fmaxf(sa[1][2], sa[1][3])));
            mx = fmaxf(mx, __shfl_xor(mx, 16)); mx = fmaxf(mx, __shfl_xor(mx, 32));
            const float m_new = fmaxf(m_run, mx), alpha = exp2f(m_run - m_new);
            float pr[8], ps = 0.f;
#pragma unroll
            for (int j = 0; j < 8; ++j) { pr[j] = exp2f(sa[j >> 2][j & 3] - m_new); ps += pr[j]; }
            l_run = l_run * alpha + ps; m_run = m_new;
            u32x4 pw; pw.x = cvt_pk_bf16(pr[0], pr[1]); pw.y = cvt_pk_bf16(pr[2], pr[3]); pw.z = cvt_pk_bf16(pr[4], pr[5]); pw.w = cvt_pk_bf16(pr[6], pr[7]);
            const bf16x8 pb = __builtin_bit_cast(bf16x8, pw);
            const unsigned q4 = (unsigned)hd >> 2, p4 = (unsigned)hd & 3;
#pragma unroll
            for (int ct = 0; ct < 8; ++ct) {
                o[ct] *= alpha;
                const bf16x4 lo = __builtin_amdgcn_ds_read_tr16_b64_v4i16((LAS bf16x4*)(tile + off_b(4 * g + q4, 2 * ct + (p4 >> 1)) + 8 * (p4 & 1)));
                const bf16x4 hi = __builtin_amdgcn_ds_read_tr16_b64_v4i16((LAS bf16x4*)(tile + off_b(16 + 4 * g + q4, 2 * ct + (p4 >> 1)) + 8 * (p4 & 1)));
                const bf16x8 va = __builtin_shufflevector(lo, hi, 0, 1, 2, 3, 4, 5, 6, 7);
                o[ct] = __builtin_amdgcn_mfma_f32_16x16x32_bf16(va, pb, o[ct], 0, 0, 0);
            }
        }
        float lt = l_run + __shfl_xor(l_run, 16); lt += __shfl_xor(lt, 32);
        const float inv = 1.0f / lt;
        if (hd < 8) {
#pragma unroll
            for (int ct = 0; ct < 8; ++ct) { const f32x4 v = o[ct] * inv; u32x2 w; w.x = cvt_pk_bf16(v.x, v.y); w.y = cvt_pk_bf16(v.z, v.w);
                *(u32x2*)(MC + t * KMIX + 256 + hd * 128 + 16 * ct + 4 * g) = w; }
        }
    }
}

__device__ __forceinline__ void ph_router(const Params& p, const Ctx& c, int l) {
    const float* mod = (const float*)(p.ws + WS_MOD); bf16_t* H = (bf16_t*)(p.ws + WS_H);
    int* toke = (int*)(p.ws + WS_SMALL + SM_TOKE); float* tokg = (float*)(p.ws + WS_SMALL + SM_TOKG); int* rank = (int*)(p.ws + WS_SMALL + SM_RANK); int* cnt = (int*)(p.ws + WS_SMALL + SM_CNT);
    LAS int* le = (LAS int*)c.lds; LAS int* wcnt = le + 256;
    const int lane = c.lane;
    for (int tile = c.vcu; tile < 256; tile += c.G) {
        for (int i = 0; i < 16; ++i) {
            const int tl = c.wave * 16 + i, m = tile * 128 + tl, b = m >> 11;
            const f32x4* xr = (const f32x4*)(p.out + (size_t)m * D) + lane;
            f32x4 v[4]; float ss = 0.f;
#pragma unroll
            for (int j = 0; j < 4; ++j) { v[j] = xr[64 * j]; ss += (v[j].x * v[j].x + v[j].y * v[j].y) + (v[j].z * v[j].z + v[j].w * v[j].w); }
            const float r = 1.0f / sqrtf(wave_sum(ss) * (1.0f / D) + EPS);
            const f32x4* ng = (const f32x4*)(p.in[I_N2G] + l * D) + lane;
            const f32x4* sh = (const f32x4*)(mod + (size_t)(l * NB + b) * 6144 + 3072) + lane; const f32x4* sc = (const f32x4*)(mod + (size_t)(l * NB + b) * 6144 + 4096) + lane;
            u32x2* o8 = (u32x2*)(H + (size_t)m * D) + lane;
            float gl[4] = {0.f, 0.f, 0.f, 0.f};
            const f32x4* rg = (const f32x4*)(p.in[I_RGW] + (size_t)l * D * 4);
#pragma unroll
            for (int j = 0; j < 4; ++j) { v[j] = v[j] * r * ng[64 * j] * (sc[64 * j] + 1.0f) + sh[64 * j];
                u32x2 w; w.x = cvt_pk_bf16(v[j].x, v[j].y); w.y = cvt_pk_bf16(v[j].z, v[j].w); o8[64 * j] = w;
#pragma unroll
                for (int e = 0; e < 4; ++e) { const f32x4 wr = rg[4 * (lane + 64 * j) + e];
                    gl[0] += v[j][e] * wr.x; gl[1] += v[j][e] * wr.y; gl[2] += v[j][e] * wr.z; gl[3] += v[j][e] * wr.w; } }
            int gi = 0; float gmax = -INFINITY;
#pragma unroll
            for (int q = 0; q < 4; ++q) { gl[q] = wave_sum(gl[q]) + p.in[I_RGB][l * 4 + q]; if (gl[q] > gmax) { gmax = gl[q]; gi = q; } }
            float gden = 0.f;
#pragma unroll
            for (int q = 0; q < 4; ++q) gden += expf(gl[q] - gmax);
            const float gp = 1.0f / gden;
            gi = __builtin_amdgcn_readfirstlane(gi);
            float el[8] = {0.f, 0.f, 0.f, 0.f, 0.f, 0.f, 0.f, 0.f};
            const float* re = p.in[I_REW] + (size_t)l * D * 32 + gi * 8;
#pragma unroll
            for (int j = 0; j < 4; ++j)
#pragma unroll
                for (int e = 0; e < 4; ++e) { const float* rr = re + (size_t)(4 * (lane + 64 * j) + e) * 32; const f32x4 w0 = *(const f32x4*)rr, w1 = *(const f32x4*)(rr + 4); const float hv = v[j][e];
                    el[0] += hv * w0.x; el[1] += hv * w0.y; el[2] += hv * w0.z; el[3] += hv * w0.w; el[4] += hv * w1.x; el[5] += hv * w1.y; el[6] += hv * w1.z; el[7] += hv * w1.w; }
            int e0 = 0, e1 = 0; float m0 = -INFINITY, m1 = -INFINITY;
#pragma unroll
            for (int q = 0; q < 8; ++q) el[q] = wave_sum(el[q]) + p.in[I_REB][l * 32 + gi * 8 + q];
#pragma unroll
            for (int q = 0; q < 8; ++q) { if (el[q] > m0) { m1 = m0; e1 = e0; m0 = el[q]; e0 = q; } else if (el[q] > m1) { m1 = el[q]; e1 = q; } }
            const float x1 = expf(m1 - m0), den = 1.0f + x1;
            if (lane == 0) { le[2 * tl] = gi * 8 + e0; le[2 * tl + 1] = gi * 8 + e1; toke[2 * m] = gi * 8 + e0; toke[2 * m + 1] = gi * 8 + e1; tokg[2 * m] = gp / den; tokg[2 * m + 1] = gp * x1 / den; }
        }
        __syncthreads();
        int myrank = 0, mye = 0;
        if (c.tid < 256) { mye = le[c.tid]; const unsigned long long ltmask = (1ull << lane) - 1ull;
            for (int ee = 0; ee < 32; ++ee) { const unsigned long long m = __ballot(mye == ee); if (mye == ee) myrank = __builtin_popcountll(m & ltmask); if (lane == 0) wcnt[c.wave * 32 + ee] = __builtin_popcountll(m); } }
        __syncthreads();
        if (c.tid < 256) { for (int w = 0; w < c.wave; ++w) myrank += wcnt[w * 32 + mye]; rank[tile * 256 + c.tid] = myrank; }
        if (c.tid < 32) cnt[tile * 32 + c.tid] = wcnt[c.tid] + wcnt[32 + c.tid] + wcnt[64 + c.tid] + wcnt[96 + c.tid];
        __syncthreads();
    }
}

__device__ __forceinline__ void ph_dispatch(const Params& p, const Ctx& c) {
    const int* toke = (const int*)(p.ws + WS_SMALL + SM_TOKE); const float* tokg = (const float*)(p.ws + WS_SMALL + SM_TOKG); const int* rank = (const int*)(p.ws + WS_SMALL + SM_RANK); const int* cnt = (const int*)(p.ws + WS_SMALL + SM_CNT);
    int* tslot = (int*)(p.ws + WS_SMALL + SM_TSLOT); int* stok = (int*)(p.ws + WS_SMALL + SM_STOK); float* sgate = (float*)(p.ws + WS_SMALL + SM_SGATE); int* texp = (int*)(p.ws + WS_SMALL + SM_TEXP);
    LAS int* tot = (LAS int*)c.lds; LAS int* pst = tot + 32; LAS int* bse = pst + 33;
    for (int tile = c.vcu; tile < 256; tile += c.G) {
        if (c.tid < 32) { int run = 0, mb = 0; for (int tl = 0; tl < 256; ++tl) { if (tl == tile) mb = run; run += cnt[tl * 32 + c.tid]; } tot[c.tid] = run; bse[c.tid] = mb; }
        __syncthreads();
        if (c.tid == 0) { int a = 0; for (int e = 0; e < 32; ++e) { pst[e] = a; a += ((tot[e] + 255) >> 8) << 8; } pst[32] = a; }
        __syncthreads();
        if (c.tid < 256) { const int a = tile * 256 + c.tid, e = toke[a], slot = pst[e] + bse[e] + rank[a]; stok[slot] = a >> 1; sgate[slot] = tokg[a]; tslot[a] = slot; }
        if (tile == 0) {
            for (int e = 0; e < 32; ++e) { const int pc = pst[e + 1] - pst[e]; for (int r = tot[e] + c.tid; r < pc; r += 512) { stok[pst[e] + r] = 0; sgate[pst[e] + r] = 0.f; } }
            const int ntl = pst[32] >> 8;
            for (int m = c.tid; m < ntl; m += 512) { int e = 0; while (pst[e + 1] <= (m << 8)) ++e; texp[m] = e; }
            if (c.tid == 0) texp[MAXTILES] = ntl;
        }
        __syncthreads();
    }
}

#ifndef PH_ONLY
#define PH_ONLY -1
#endif
#define IN(k) ((PH_ONLY < 0 || PH_ONLY == (k)) && lo <= (k) && (k) < hi)
#define SEAM(k) do { if (IN(k) && IN((k) + 1)) xcd_barrier(bar); } while (0)
template <int l>
__device__ __forceinline__ void run_layer(const Params& p, const Ctx& c, const XcdBarrier& bar, int lo, int hi) {
    bf16_t* Zb = (bf16_t*)(p.ws + WS_Z); bf16_t* Hb = (bf16_t*)(p.ws + WS_H); bf16_t* MCb = (bf16_t*)(p.ws + WS_MIXCAT);
    const float* mod = (const float*)(p.ws + WS_MOD);
    constexpr int P = 1 + 10 * l;
    if (IN(P)) { if (l == 0) ph_norm1<0>(p, c); else { conv_experts(p, c, 1); ph_norm1<1>(p, c); } }
    SEAM(P);
    if (IN(P + 1)) { pg8::StaticOrder So; So.init(Hb, (bf16_t*)(p.ws + WS_WIN) + (size_t)l * NZ * D, T, NZ, D, c.G, (int)blockIdx.x);
        pg8::EpiBf16 E{Zb, NZ}; pg8::gemm_phase<pg8::EpiBf16, pg8::StaticOrder, false>(c.lds, So, E); }
    SEAM(P + 1);
    if (IN(P + 2)) ph_postz(p, c, l);
    SEAM(P + 2);
    if (IN(P + 3)) { pg8::StaticOrder So; So.init((bf16_t*)(p.ws + WS_CQR), (bf16_t*)(p.ws + WS_WQA) + (size_t)l * D * 256, T, D, 256, c.G, (int)blockIdx.x);
        pg8::EpiBf16 E{Hb, D}; pg8::gemm_phase<pg8::EpiBf16, pg8::StaticOrder, false>(c.lds, So, E);
        ph_scores(p, c); }
    SEAM(P + 3);
    if (IN(P + 4)) ph_attn(p, c);
    SEAM(P + 4);
    if (IN(P + 5)) { pg8::StaticOrder So; So.init(MCb, (bf16_t*)(p.ws + WS_WMIX) + (size_t)l * D * KMIX, T, D, KMIX, c.G, (int)blockIdx.x);
        pg8::EpiMix E{l == 0 ? p.in[I_X] : p.out, p.out, mod + (size_t)l * NB * 6144 + 2048}; pg8::gemm_phase<pg8::EpiMix, pg8::StaticOrder, false>(c.lds, So, E); }
    SEAM(P + 5);
    if (IN(P + 6)) ph_router(p, c, l);
    SEAM(P + 6);
    if (IN(P + 7)) ph_dispatch(p, c);
    SEAM(P + 7);
    if (IN(P + 8)) { const int* texp = (const int*)(p.ws + WS_SMALL + SM_TEXP); const int ntl = texp[MAXTILES];
        pg8::MoeOrder Mo; Mo.init(Hb, p.ws + WS_W13, D, (size_t)1024 * 1024 * 2, (const int*)(p.ws + WS_SMALL + SM_STOK), texp, ntl, c.G, c.vcu);
        pg8::EpiAct E{Zb}; pg8::gemm_phase<pg8::EpiAct, pg8::MoeOrder, true>(c.lds, Mo, E); }
    SEAM(P + 8);
    if (IN(P + 9)) { const int* texp = (const int*)(p.ws + WS_SMALL + SM_TEXP); const int ntl = texp[MAXTILES];
        pg8::MoeOrder Mo; Mo.init(Zb, p.ws + WS_W2, DEXP, (size_t)1024 * 512 * 2, nullptr, texp, ntl, c.G, c.vcu);
        pg8::EpiY E{(bf16_t*)(p.ws + WS_Y), (const float*)(p.ws + WS_SMALL + SM_SGATE)}; pg8::gemm_phase<pg8::EpiY, pg8::MoeOrder, false>(c.lds, Mo, E); }
    SEAM(P + 9);
}

__global__ void __launch_bounds__(512, 2) fwd(Params p) {
    extern __shared__ __attribute__((aligned(16))) unsigned char lds_raw[];
    Ctx c;
    c.lds = (LAS unsigned char*)lds_raw;
    c.tid = threadIdx.x; c.lane = c.tid & 63; c.wave = __builtin_amdgcn_readfirstlane(c.tid >> 6);
    c.G = gridDim.x; { const int bx = blockIdx.x; c.vcu = (c.G % 8 == 0) ? (bx % 8) * (c.G / 8) + bx / 8 : bx; }
    c.gw = c.vcu * 8 + c.wave; c.NGW = c.G * 8;
    volatile LAS unsigned* MISC = (volatile LAS unsigned*)(c.lds + MISC_OFF);
    if (c.tid < 64) MISC[c.tid] = 0u;
    __syncthreads();
    unsigned* ctl = (unsigned*)(p.ws + WS_CTL);
    XcdBarrier bar; bar.bar = ctl + CW_BAR; bar.x = 0; bar.st = nullptr;
    const bool multi = (p.ph_hi - p.ph_lo) > 1;
    if (multi) bar = xcd_barrier_post(ctl + CW_BAR, MISC + 8);
    const int lo = p.ph_lo, hi = p.ph_hi;
    if (IN(0)) ph_prologue(p, c);
    SEAM(0);
    run_layer<0>(p, c, bar, lo, hi);
    run_layer<1>(p, c, bar, lo, hi);
    if (IN(21)) ph_norm1<2>(p, c);
#undef IN
#undef SEAM
}

extern "C" void kernel_launch(void* const* d_in, const int* in_sizes, int n_in, void* d_out, int out_size, void* d_ws, size_t ws_size, hipStream_t stream) {
    static int grid = 0;
    if (grid == 0) {
        if (n_in != 27 || out_size != T * D || ws_size < WS_END) { fprintf(stderr, "kernel_launch: unexpected shapes (n_in %d out %d ws %zu, need %zu)\n", n_in, out_size, ws_size, (size_t)WS_END); grid = -1; return; }
        int dev = 0, cus = 0, per_cu = 0;
        if (hipGetDevice(&dev) != hipSuccess || hipDeviceGetAttribute(&cus, hipDeviceAttributeMultiprocessorCount, dev) != hipSuccess) { grid = -1; return; }
        if (hipFuncSetAttribute((const void*)fwd, hipFuncAttributeMaxDynamicSharedMemorySize, LDS_BYTES) != hipSuccess) { fprintf(stderr, "kernel_launch: hipFuncSetAttribute failed\n"); grid = -1; return; }
        if (hipOccupancyMaxActiveBlocksPerMultiprocessor(&per_cu, (const void*)fwd, 512, LDS_BYTES) != hipSuccess || per_cu < 1) { fprintf(stderr, "kernel_launch: occupancy query says %d blocks per CU\n", per_cu); grid = -1; return; }
        (void)hipGetLastError();
        grid = cus;
        if (grid % 8 != 0 || grid > 256) grid = (grid / 8) * 8 > 256 ? 256 : (grid / 8) * 8;
    }
    if (grid <= 0) return;
    (void)hipMemsetAsync((char*)d_ws + WS_CTL, 0, CTL_ZERO_BYTES, stream);
    Params p{};
    for (int i = 0; i < 27; ++i) p.in[i] = (const float*)d_in[i];
    p.out = (float*)d_out; p.ws = (unsigned char*)d_ws;
#if MK_SPLIT
    for (int ph = 0; ph < NPHASE; ++ph) { p.ph_lo = ph; p.ph_hi = ph + 1; hipLaunchKernelGGL(fwd, dim3(grid), dim3(512), LDS_BYTES, stream, p); }
#else
    p.ph_lo = 0; p.ph_hi = NPHASE;
    hipLaunchKernelGGL(fwd, dim3(grid), dim3(512), LDS_BYTES, stream, p);
#endif
}
```

```cpp
#include <hip/hip_runtime.h>
#include <cstdio>
#include <cstdint>

#ifndef MK_SPLIT
#define MK_SPLIT 0
#endif

#define LAS __attribute__((address_space(3)))
typedef unsigned short bf16_t;
typedef short bf16x8 __attribute__((ext_vector_type(8)));
typedef short bf16x4 __attribute__((ext_vector_type(4)));
typedef float f32x4 __attribute__((ext_vector_type(4)));
typedef float f32x16 __attribute__((ext_vector_type(16)));
typedef unsigned u32x4 __attribute__((ext_vector_type(4)));
typedef unsigned u32x2 __attribute__((ext_vector_type(2)));

constexpr int D = 1024, NB = 16, S = 2048, T = NB * S, DEPTH = 2;
constexpr int NZ = 1792;
constexpr int N_IN = 1736;
constexpr int Z_AVAL = 0, Z_AGATE = 256, Z_CQ = 512, Z_CKV = 768, Z_QI = 896, Z_KI = 1408, Z_WI = 1472, Z_UP = 1480;
constexpr int KMIX = 1536;
constexpr int NEXP = 32, DEXP = 512, MAXTILES = 288, PMAX = MAXTILES * 256;
constexpr float EPS = 1e-6f;
constexpr int SC_PER_B = 4096 * 528;

constexpr size_t MiB = 1u << 20;
constexpr size_t WS_CTL = 0, CTL_ZERO_BYTES = 64 * 1024;
constexpr size_t WS_MOD = 1 * MiB;
constexpr size_t WS_WIN = 2 * MiB;
constexpr size_t WS_WQA = 9 * MiB;
constexpr size_t WS_WMIX = 10 * MiB;
constexpr size_t WS_SMALL = 16 * MiB;
constexpr size_t WS_W13 = 20 * MiB;
constexpr size_t WS_W2 = 84 * MiB;
constexpr size_t WS_Z = 116 * MiB;
constexpr size_t WS_MIXCAT = 228 * MiB;
constexpr size_t WS_H = 324 * MiB;
constexpr size_t WS_CQR = 388 * MiB;
constexpr size_t WS_KVN = 404 * MiB;
constexpr size_t WS_Y = 412 * MiB;
constexpr size_t WS_END = 556 * MiB;
constexpr size_t SM_TOKE = 0;
constexpr size_t SM_TOKG = 256 * 1024;
constexpr size_t SM_RANK = 512 * 1024;
constexpr size_t SM_TSLOT = 768 * 1024;
constexpr size_t SM_STOK = 1024 * 1024;
constexpr size_t SM_SGATE = 1024 * 1024 + 512 * 1024;
constexpr size_t SM_CNT = 2 * 1024 * 1024;
constexpr size_t SM_TEXP = 2 * 1024 * 1024 + 64 * 1024;
constexpr size_t SM_REW2 = 2 * 1024 * 1024 + 512 * 1024;
constexpr int CW_BAR = 1024;

constexpr int LDS_BYTES = 139264;
constexpr int LIST_OFF = 131072;
constexpr int MISC_OFF = 138240;
constexpr int NPHASE = 22;

__device__ __forceinline__ unsigned cvt_pk_bf16(float lo, float hi) { unsigned r; asm volatile("v_cvt_pk_bf16_f32 %0, %1, %2" : "=v"(r) : "v"(lo), "v"(hi)); return r; }
__device__ __forceinline__ float bf2f(unsigned short b) { return __uint_as_float(((unsigned)b) << 16); }
__device__ __forceinline__ float bflo(unsigned w) { return __uint_as_float(w << 16); }
__device__ __forceinline__ float bfhi(unsigned w) { return __uint_as_float(w & 0xffff0000u); }
__device__ __forceinline__ float wave_sum(float v) {
#pragma unroll
    for (int o = 1; o < 64; o <<= 1) v += __shfl_xor(v, o);
    return v;
}
__device__ __forceinline__ float sigmoidf_(float x) { return 1.0f / (1.0f + __expf(-x)); }
#define LDS_WAIT() asm volatile("s_waitcnt lgkmcnt(0)" ::: "memory")
#define VM_WAIT() asm volatile("s_waitcnt vmcnt(0)" ::: "memory")

#define XB_TMO      128
#define XB_XCNT(j)  (256  + 64 * (j))
#define XB_XSUB(j)  (1280 + 64 * (j))
#define XB_XGEN(j)  (2304 + 64 * (j))
#define XB_TOP      3328
#define XB_TOPGEN   3392
#define XCD_BAR_WORDS 3456
#define XB_SPIN_CAP (1u << 22)

__device__ __forceinline__ unsigned xb_ld(unsigned* p)              { return __hip_atomic_load(p, __ATOMIC_RELAXED, __HIP_MEMORY_SCOPE_AGENT); }
__device__ __forceinline__ unsigned xb_add(unsigned* p, unsigned v) { return __hip_atomic_fetch_add(p, v, __ATOMIC_RELAXED, __HIP_MEMORY_SCOPE_AGENT); }
__device__ __forceinline__ unsigned xb_xcc_id() { return (unsigned)__builtin_amdgcn_s_getreg((3 << 11) | 20) & 0xFu; }
#define XB_SPIN(cond, bar) do { unsigned _sp = 0; while (cond) { __builtin_amdgcn_s_sleep(1); \
    if ((++_sp & 255u) == 0u) { if (xb_ld(&(bar)[XB_TMO])) break; if (_sp > XB_SPIN_CAP) { atomicAdd(&(bar)[XB_TMO], 1u); break; } } } } while (0)

struct XcdBarrier {
    unsigned* bar; unsigned x;
    volatile LAS unsigned* st;
};
__device__ __forceinline__ XcdBarrier xcd_barrier_post(unsigned* bar, volatile LAS unsigned* st) {
    XcdBarrier b; b.bar = bar; b.x = xb_xcc_id(); b.st = st;
    if (threadIdx.x == 0) (void)xb_add(&bar[XB_XCNT(b.x)], 1u);
    return b;
}
__device__ __forceinline__ void xcd_barrier_complete(unsigned* bar, unsigned x, unsigned& nloc, unsigned& nx) {
    const unsigned G = gridDim.x * gridDim.y * gridDim.z;
    unsigned sum, cnt, mine, sp = 0u;
    for (;;) {
        sum = 0u; cnt = 0u; mine = 0u;
#pragma unroll
        for (unsigned j = 0; j < 16; ++j) { const unsigned c = xb_ld(&bar[XB_XCNT(j)]); sum += c; cnt += (c > 0u) ? 1u : 0u; mine = (j == x) ? c : mine; }
        if (sum == G) break;
        __builtin_amdgcn_s_sleep(1);
        if ((++sp & 255u) == 0u) { if (xb_ld(&bar[XB_TMO])) break; if (sp > XB_SPIN_CAP) { atomicAdd(&bar[XB_TMO], 1u); break; } }
    }
    nloc = mine > 0u ? mine : 1u; nx = cnt > 0u ? cnt : 1u;
}
__device__ __forceinline__ void xcd_barrier(const XcdBarrier& b) {
    asm volatile("s_waitcnt vmcnt(0)" ::: "memory");
    __syncthreads();
    if (threadIdx.x == 0) {
        unsigned* bar = b.bar;
        __builtin_amdgcn_s_waitcnt(0);
        unsigned nloc = b.st[0], nx = b.st[1];
        if (nloc == 0u) { xcd_barrier_complete(bar, b.x, nloc, nx); b.st[0] = nloc; b.st[1] = nx; }
        const unsigned old = xb_add(&bar[XB_XSUB(b.x)], 1u);
        const unsigned gen = old / nloc;
        if (old + 1u == (gen + 1u) * nloc) {
            __builtin_amdgcn_fence(__ATOMIC_RELEASE, "agent");
            asm volatile("s_waitcnt vmcnt(0)" ::: "memory");
            const unsigned og = xb_add(&bar[XB_TOP], 1u);
            const unsigned tg = og / nx;
            if (og + 1u == (tg + 1u) * nx) xb_add(&bar[XB_TOPGEN], 1u);
            else XB_SPIN(xb_ld(&bar[XB_TOPGEN]) == tg, bar);
            __builtin_amdgcn_fence(__ATOMIC_ACQUIRE, "agent");
            xb_add(&bar[XB_XGEN(b.x)], 1u);
            asm volatile("s_waitcnt vmcnt(0)" ::: "memory");
        } else {
            XB_SPIN(xb_ld(&bar[XB_XGEN(b.x)]) == gen, bar);
            __builtin_amdgcn_fence(__ATOMIC_ACQUIRE, "agent");
            asm volatile("s_waitcnt vmcnt(0)" ::: "memory");
        }
    }
    __syncthreads();
}

namespace pg8 {
constexpr int BM = 256, BK = 64, HALF = 128, HTB = HALF * BK * 2  , STAGE_BYTES = 8 * HTB, NXCD = 8, WGM = 8;
__host__ __device__ __forceinline__ int lds_byte(int r, int c) { const int st = (r >> 4) * 2 + (c >> 5), rr = r & 15, cc = c & 31, ob = rr * 64 + cc * 2; return st * 1024 + (ob ^ (((ob >> 9) & 1) << 5)); }
__host__ __device__ __forceinline__ void stage_rc(int b, int& R, int& C) { const int st = b / 1024, sb = b % 1024, swz = sb ^ (((sb >> 9) & 1) << 5); R = (st >> 1) * 16 + swz / 64; C = (st & 1) * 32 + (swz % 64) / 2; }
__host__ __device__ __forceinline__ int perm32(int rho) { const int n = rho >> 4, i = rho & 15; return 8 * (i >> 2) + 4 * n + (i & 3); }

struct Unit { int pm, pn; const char* a; const char* b; };

struct StaticOrder {
    const char* A; const char* Bt; int K; const int* rowidx;
    int nM, nN, nwg, G, c;
    __device__ void init(const void* A_, const void* Bt_, int M, int N, int K_, int G_, int c_) { A = (const char*)A_; Bt = (const char*)Bt_; K = K_; rowidx = nullptr; nM = M / BM; nN = N / BM; nwg = nM * nN; G = G_; c = c_; }
    __device__ __forceinline__ bool next(int i, Unit& u) const {
        const long L = (long)i * G + c; if (L >= nwg) return false;
        int wgid = (int)L; { const int q = nwg / NXCD, r = nwg % NXCD, xcd = wgid % NXCD, off = wgid / NXCD; wgid = (xcd < r ? xcd * (q + 1) : r * (q + 1) + (xcd - r) * q) + off; }
        const int nig = WGM * nN, gid = wgid / nig, fm = gid * WGM, gsz = (nM - fm) < WGM ? (nM - fm) : WGM;
        u.pm = fm + ((wgid % nig) % gsz); u.pn = (wgid % nig) / gsz;
        u.a = A + (size_t)u.pm * BM * K * 2; u.b = Bt + (size_t)u.pn * BM * K * 2; return true;
    }
};
struct MoeOrder {
    const char* A; const char* Bt; int K; const int* rowidx;
    const int* tile_exp; int nunits, G, c; size_t bstride;
    __device__ void init(const void* A_, const void* Bt_, int K_, size_t bstride_, const int* rowidx_, const int* tile_exp_, int ntiles, int G_, int c_) {
        A = (const char*)A_; Bt = (const char*)Bt_; K = K_; bstride = bstride_; rowidx = rowidx_; tile_exp = tile_exp_; nunits = ntiles * 4; G = G_; c = c_; }
    __device__ __forceinline__ bool next(int i, Unit& u) const {
        const int L = i * G + c; if (L >= nunits) return false;
        u.pm = L >> 2; u.pn = L & 3; const int e = tile_exp[u.pm];
        u.a = A + (size_t)u.pm * BM * K * 2; u.b = Bt + (size_t)e * bstride + (size_t)u.pn * BM * K * 2; return true;
    }
};

struct EpiBf16 {
    static constexpr bool PERM = true;
    bf16_t* O; int ldc;
    __device__ __forceinline__ void operator()(const f32x4 (&acc)[2][2][4][2], const Unit& u, int wr, int wc, int fr, int fq) const {
        const int row0 = u.pm * BM + wr * 64 + fr, col0 = u.pn * BM + wc * 32 + 8 * fq;
#pragma unroll
        for (int ai = 0; ai < 2; ++ai)
#pragma unroll
            for (int m = 0; m < 4; ++m) { bf16_t* rowp = O + (size_t)(row0 + ai * HALF + m * 16) * ldc + col0;
#pragma unroll
                for (int bj = 0; bj < 2; ++bj) { const f32x4 v0 = acc[ai][bj][m][0], v1 = acc[ai][bj][m][1];
                    u32x4 w; w.x = cvt_pk_bf16(v0[0], v0[1]); w.y = cvt_pk_bf16(v0[2], v0[3]); w.z = cvt_pk_bf16(v1[0], v1[1]); w.w = cvt_pk_bf16(v1[2], v1[3]);
                    *(u32x4*)(rowp + bj * HALF) = w; } }
    }
};
struct EpiMix {
    static constexpr bool PERM = false;
    const float* xin; float* out; const float* gate;
    __device__ __forceinline__ void operator()(const f32x4 (&acc)[2][2][4][2], const Unit& u, int wr, int wc, int fr, int fq) const {
        const int row0 = u.pm * BM + wr * 64 + fr, col0 = u.pn * BM + wc * 32 + 4 * fq;
        const float* gp = gate + (size_t)(u.pm >> 3) * 6144 + col0;
        f32x4 gv[2][2];
#pragma unroll
        for (int bj = 0; bj < 2; ++bj)
#pragma unroll
            for (int n = 0; n < 2; ++n) gv[bj][n] = *(const f32x4*)(gp + bj * HALF + n * 16);
#pragma unroll
        for (int ai = 0; ai < 2; ++ai)
#pragma unroll
            for (int m = 0; m < 4; ++m) { const size_t off = (size_t)(row0 + ai * HALF + m * 16) * D + col0;
#pragma unroll
                for (int bj = 0; bj < 2; ++bj)
#pragma unroll
                    for (int n = 0; n < 2; ++n) { const f32x4 xv = *(const f32x4*)(xin + off + bj * HALF + n * 16);
                        *(f32x4*)(out + off + bj * HALF + n * 16) = xv + gv[bj][n] * acc[ai][bj][m][n]; } }
    }
};
struct EpiAct {
    static constexpr bool PERM = true;
    bf16_t* O;
    __device__ __forceinline__ void operator()(const f32x4 (&acc)[2][2][4][2], const Unit& u, int wr, int wc, int fr, int fq) const {
        const int row0 = u.pm * BM + wr * 64 + fr, col0 = u.pn * 128 + wc * 16 + 4 * fq;
#pragma unroll
        for (int ai = 0; ai < 2; ++ai)
#pragma unroll
            for (int m = 0; m < 4; ++m) { bf16_t* rowp = O + (size_t)(row0 + ai * HALF + m * 16) * DEXP + col0;
#pragma unroll
                for (int bj = 0; bj < 2; ++bj) { const f32x4 a = acc[ai][bj][m][0], b = acc[ai][bj][m][1]; f32x4 r;
#pragma unroll
                    for (int j = 0; j < 4; ++j) r[j] = a[j] * b[j] * __builtin_amdgcn_rcpf(1.0f + __expf(-a[j]));
                    u32x2 w; w.x = cvt_pk_bf16(r[0], r[1]); w.y = cvt_pk_bf16(r[2], r[3]);
                    *(u32x2*)(rowp + bj * 64) = w; } }
    }
};
struct EpiY {
    static constexpr bool PERM = true;
    bf16_t* O; const float* sgate;
    __device__ __forceinline__ void operator()(const f32x4 (&acc)[2][2][4][2], const Unit& u, int wr, int wc, int fr, int fq) const {
        const int row0 = u.pm * BM + wr * 64 + fr, col0 = u.pn * BM + wc * 32 + 8 * fq;
#pragma unroll
        for (int ai = 0; ai < 2; ++ai)
#pragma unroll
            for (int m = 0; m < 4; ++m) { const int row = row0 + ai * HALF + m * 16; const float g = sgate[row]; bf16_t* rowp = O + (size_t)row * D + col0;
#pragma unroll
                for (int bj = 0; bj < 2; ++bj) { const f32x4 v0 = acc[ai][bj][m][0] * g, v1 = acc[ai][bj][m][1] * g;
                    u32x4 w; w.x = cvt_pk_bf16(v0[0], v0[1]); w.y = cvt_pk_bf16(v0[2], v0[3]); w.z = cvt_pk_bf16(v1[0], v1[1]); w.w = cvt_pk_bf16(v1[2], v1[3]);
                    *(u32x4*)(rowp + bj * HALF) = w; } }
    }
};

template <class Epi, class Sched, bool GATHER>
__device__ __forceinline__ void gemm_phase(LAS unsigned char* lds, const Sched& S, const Epi& E) {
    const int tid = threadIdx.x, wid = __builtin_amdgcn_readfirstlane(tid >> 6), lane = tid & 63, wr = wid >> 2, wc = wid & 3, fr = lane & 15, fq = lane >> 4;
    const int K = S.K, nt = K / BK;
    unsigned voffA[2], voffB[2]; int RA[2], CA[2];
#pragma unroll
    for (int i = 0; i < 2; ++i) { int R, C; stage_rc(tid * 16 + i * 8192, R, C); const int Rb = Epi::PERM ? ((R & ~31) + perm32(R & 31)) : R;
        RA[i] = R; CA[i] = C; voffA[i] = (unsigned)(R * K + C) * 2u; voffB[i] = (unsigned)(Rb * K + C) * 2u; }
    const size_t kstep = (size_t)(BK * 2);
    const size_t hstep = (size_t)HALF * K * 2;
    const unsigned ldsw = (unsigned)wid * 1024u;
    const int aoff = lds_byte(wr * 64 + fr, fq * 8), boff = lds_byte(wc * 32 + fr, fq * 8);
#define PG8_SA(b, h) (((b) * 2 + (h)) * HTB)
#define PG8_SB(b, h) ((4 + (b) * 2 + (h)) * HTB)
#define PG8_DMA(bufoff, gptr, i) __builtin_amdgcn_global_load_lds((const unsigned*)(gptr), (LAS unsigned*)(lds + (bufoff) + ldsw + (i) * 8192), 16, 0, 0)
#define PG8_STAGE(bufoff, gbase, voff) do { PG8_DMA(bufoff, (const char*)(gbase) + (voff)[0], 0); PG8_DMA(bufoff, (const char*)(gbase) + (voff)[1], 1); } while (0)
#define PG8_STAGE_A(bufoff, nx, h, kb) do { if constexpr (GATHER) { \
            PG8_DMA(bufoff, S.A + (kb) + ((nx) ? gN[h][0] : gC[h][0]), 0); PG8_DMA(bufoff, S.A + (kb) + ((nx) ? gN[h][1] : gC[h][1]), 1); } \
        else { const char* _b = ((nx) ? nA : cA) + (h) * hstep + (kb); PG8_DMA(bufoff, _b + voffA[0], 0); PG8_DMA(bufoff, _b + voffA[1], 1); } } while (0)
#define PG8_LDA(dst, b, h) do { _Pragma("unroll") for (int m = 0; m < 4; ++m) _Pragma("unroll") for (int k = 0; k < 2; ++k) dst[m][k] = *(const LAS bf16x8*)(lds + PG8_SA(b, h) + aoff + m * 2048 + k * 1024); } while (0)
#define PG8_LDB(dst, b, h) do { _Pragma("unroll") for (int n = 0; n < 2; ++n) _Pragma("unroll") for (int k = 0; k < 2; ++k) dst[n][k] = *(const LAS bf16x8*)(lds + PG8_SB(b, h) + boff + n * 2048 + k * 1024); } while (0)
#define PG8_MMA(ai, bj, At, Bt) do { __builtin_amdgcn_s_setprio(1); _Pragma("unroll") for (int m = 0; m < 4; ++m) _Pragma("unroll") for (int n = 0; n < 2; ++n) _Pragma("unroll") for (int k = 0; k < 2; ++k) \
        acc[ai][bj][m][n] = __builtin_amdgcn_mfma_f32_16x16x32_bf16(Bt[n][k], At[m][k], acc[ai][bj][m][n], 0, 0, 0); __builtin_amdgcn_s_setprio(0); } while (0)
#define PG8_WAIT_V(n) asm volatile("s_waitcnt vmcnt(" #n ")" ::: "memory")
#define PG8_WAIT_L(n) asm volatile("s_waitcnt lgkmcnt(" #n ")" ::: "memory")
#define PG8_BAR __builtin_amdgcn_s_barrier()
#define PG8_SCHED __builtin_amdgcn_sched_barrier(0)
    Unit cur, nxt; int ui = 0;
    if (!S.next(0, cur)) return;
    unsigned gC[2][2] = {{0u, 0u}, {0u, 0u}}, gN[2][2] = {{0u, 0u}, {0u, 0u}};
    if constexpr (GATHER) {
#pragma unroll
        for (int h = 0; h < 2; ++h)
#pragma unroll
            for (int i = 0; i < 2; ++i) gC[h][i] = (unsigned)(S.rowidx[cur.pm * BM + h * HALF + RA[i]] * K + CA[i]) * 2u;
    }
    f32x4 acc[2][2][4][2];
#pragma unroll
    for (int a = 0; a < 2; ++a)
#pragma unroll
        for (int b = 0; b < 2; ++b)
#pragma unroll
            for (int m = 0; m < 4; ++m)
#pragma unroll
                for (int n = 0; n < 2; ++n) acc[a][b][m][n] = (f32x4){0.f, 0.f, 0.f, 0.f};
    bf16x8 At[4][2], B0[2][2], B1[2][2];
    const char* cA = cur.a; const char* cB = cur.b; const char* nA = cA; const char* nB = cB;
    PG8_STAGE(PG8_SB(0, 0), cB, voffB); PG8_STAGE(PG8_SB(0, 1), cB + hstep, voffB); PG8_STAGE_A(PG8_SA(0, 0), false, 0, 0); PG8_STAGE_A(PG8_SA(0, 1), false, 1, 0);
    if (wr == 1) PG8_BAR;
    PG8_WAIT_V(2); PG8_BAR;
    PG8_STAGE(PG8_SB(1, 0), cB + kstep, voffB); PG8_STAGE_A(PG8_SA(1, 0), false, 0, kstep); PG8_STAGE(PG8_SB(1, 1), cB + hstep + kstep, voffB);
    PG8_WAIT_V(6); PG8_BAR;
    for (;;) {
        const bool has_next = S.next(ui + 1, nxt);
        nA = has_next ? nxt.a : cA; nB = has_next ? nxt.b : cB;
        if constexpr (GATHER) {
            const int npm = has_next ? nxt.pm : cur.pm;
#pragma unroll
            for (int h = 0; h < 2; ++h)
#pragma unroll
                for (int i = 0; i < 2; ++i) gN[h][i] = (unsigned)(S.rowidx[npm * BM + h * HALF + RA[i]] * K + CA[i]) * 2u;
        }
        for (int t = 0; t < nt; t += 2) {
            const bool last = (t == nt - 2);
            const size_t k1 = (size_t)(t + 1) * kstep;
            const size_t k2 = last ? 0 : (size_t)(t + 2) * kstep, k3 = k2 + kstep;
            const char* b2 = (last ? nB : cB) + k2; const char* b3 = b2 + kstep;
            PG8_LDB(B0, 0, 0); PG8_LDB(B1, 0, 1); PG8_SCHED; PG8_LDA(At, 0, 0); PG8_STAGE_A(PG8_SA(1, 1), false, 1, k1);
            PG8_WAIT_V(8); PG8_WAIT_L(0); PG8_BAR; PG8_MMA(0, 0, At, B0); PG8_MMA(0, 1, At, B1); PG8_BAR; PG8_SCHED;
            PG8_LDA(At, 0, 1); PG8_STAGE(PG8_SB(0, 0), b2, voffB); PG8_STAGE(PG8_SB(0, 1), b2 + hstep, voffB); PG8_STAGE_A(PG8_SA(0, 0), last, 0, k2);
            PG8_WAIT_V(8); PG8_WAIT_L(0); PG8_BAR; PG8_MMA(1, 0, At, B0); PG8_MMA(1, 1, At, B1); PG8_BAR; PG8_SCHED;
            PG8_LDB(B0, 1, 0); PG8_LDB(B1, 1, 1); PG8_SCHED; PG8_LDA(At, 1, 0); PG8_STAGE_A(PG8_SA(0, 1), last, 1, k2);
            PG8_WAIT_V(8); PG8_WAIT_L(0); PG8_BAR; PG8_MMA(0, 0, At, B0); PG8_MMA(0, 1, At, B1); PG8_BAR; PG8_SCHED;
            PG8_LDA(At, 1, 1); PG8_STAGE(PG8_SB(1, 0), b3, voffB); PG8_STAGE(PG8_SB(1, 1), b3 + hstep, voffB); PG8_STAGE_A(PG8_SA(1, 0), last, 0, k3);
            PG8_WAIT_V(8); PG8_WAIT_L(0); PG8_BAR; PG8_MMA(1, 0, At, B0); PG8_MMA(1, 1, At, B1); PG8_BAR; PG8_SCHED;
        }
        if (wr == 0) PG8_BAR;
        E(acc, cur, wr, wc, fr, fq);
        if (!has_next) break;
#pragma unroll
        for (int a = 0; a < 2; ++a)
#pragma unroll
            for (int b = 0; b < 2; ++b)
#pragma unroll
                for (int m = 0; m < 4; ++m)
#pragma unroll
                    for (int n = 0; n < 2; ++n) acc[a][b][m][n] = (f32x4){0.f, 0.f, 0.f, 0.f};
        cur = nxt; cA = nA; cB = nB; ++ui;
        if constexpr (GATHER) {
#pragma unroll
            for (int h = 0; h < 2; ++h)
#pragma unroll
                for (int i = 0; i < 2; ++i) gC[h][i] = gN[h][i];
        }
        if (wr == 1) PG8_BAR;
    }
    PG8_WAIT_V(0);
    PG8_BAR;
#undef PG8_SA
#undef PG8_SB
#undef PG8_DMA
#undef PG8_STAGE
#undef PG8_STAGE_A
#undef PG8_LDA
#undef PG8_LDB
#undef PG8_MMA
#undef PG8_WAIT_V
#undef PG8_WAIT_L
#undef PG8_BAR
#undef PG8_SCHED
}
}

struct Params { const float* in[27]; float* out; unsigned char* ws; int ph_lo, ph_hi; };
struct Ctx { LAS unsigned char* lds; int tid, lane, wave, vcu, G, gw, NGW; };
enum { I_X = 0, I_C, I_MODW, I_MODB, I_N1G, I_WIN, I_CONVK, I_CONVB, I_CLNG, I_CLNB, I_QNG, I_KVNG, I_WUQ, I_WUK, I_WUV, I_POOLW, I_POOLS, I_WOUT, I_N2G, I_RGW, I_RGB, I_REW, I_REB, I_W1, I_W3, I_W2, I_FG };

template <class RowMap>
__device__ __forceinline__ void tr_item(const float* src, int ldn, int k0, int n0, int nvalid, bf16_t* dst, int ldk, int dk0, RowMap rm, LAS float* scr, int lane) {
#pragma unroll 8
    for (int i = 0; i < 32; ++i) { const int kk = 2 * i + (lane >> 5), n = n0 + (lane & 31); scr[kk * 33 + (lane & 31)] = (n < nvalid) ? src[(size_t)(k0 + kk) * ldn + n] : 0.f; }
    LDS_WAIT();
    const int c = lane & 7;
#pragma unroll
    for (int j = 0; j < 4; ++j) { const int n = (lane >> 3) + 8 * j; const LAS float* s = scr + (8 * c) * 33 + n;
        u32x4 o; o.x = cvt_pk_bf16(s[0 * 33], s[1 * 33]); o.y = cvt_pk_bf16(s[2 * 33], s[3 * 33]); o.z = cvt_pk_bf16(s[4 * 33], s[5 * 33]); o.w = cvt_pk_bf16(s[6 * 33], s[7 * 33]);
        *(u32x4*)(dst + (size_t)rm(n0 + n) * ldk + dk0 + k0 + 8 * c) = o; }
    LDS_WAIT();
}

__device__ __forceinline__ void conv_experts(const Params& p, const Ctx& c, int l) {
    LAS float* scr = (LAS float*)(c.lds + c.wave * 8448);
    bf16_t* W13 = (bf16_t*)(p.ws + WS_W13); bf16_t* W2 = (bf16_t*)(p.ws + WS_W2);
    for (int it = c.gw; it < 3 * 8192; it += c.NGW) {
        const int which = it >> 13, r = it & 8191, e = r >> 8;
        if (which < 2) { const int kb = (r >> 4) & 15, nb = r & 15; const float* src = p.in[which ? I_W3 : I_W1] + (size_t)(l * NEXP + e) * 1024 * 512; const int add = which ? 4 : 0;
            tr_item(src, 512, 64 * kb, 32 * nb, 512, W13 + (size_t)e * 1024 * 1024, 1024, 0, [add](int n) { return 8 * (n >> 2) + (n & 3) + add; }, scr, c.lane); }
        else { const int kb = (r >> 5) & 7, nb = r & 31; const float* src = p.in[I_W2] + (size_t)(l * NEXP + e) * 512 * 1024;
            tr_item(src, 1024, 64 * kb, 32 * nb, 1024, W2 + (size_t)e * 1024 * 512, 512, 0, [](int n) { return n; }, scr, c.lane); }
    }
}

__device__ __forceinline__ void ph_prologue(const Params& p, const Ctx& c) {
    float* mod = (float*)(p.ws + WS_MOD);
    {
        LAS float* cond = (LAS float*)c.lds; LAS float* part = (LAS float*)(c.lds + 65536);
        bool loaded = false;
        for (int item = c.vcu; item < 192; item += c.G) {
            if (!loaded) { for (int i = c.tid; i < NB * D; i += 512) { const float v = p.in[I_C][i]; cond[i] = v / (1.0f + expf(-v)); } __syncthreads(); loaded = true; }
            const int l = item / 96, n0 = (item % 96) * 64;
            const float* W = p.in[I_MODW] + (size_t)l * D * 6144 + n0 + c.lane;
            float acc[NB];
#pragma unroll
            for (int b = 0; b < NB; ++b) acc[b] = 0.f;
            for (int k = c.wave * 128; k < c.wave * 128 + 128; ++k) { const float w = W[(size_t)k * 6144];
#pragma unroll
                for (int b = 0; b < NB; ++b) acc[b] += cond[b * D + k] * w; }
#pragma unroll
            for (int b = 0; b < NB; ++b) part[(c.wave * NB + b) * 64 + c.lane] = acc[b];
            __syncthreads();
            for (int o = c.tid; o < NB * 64; o += 512) { const int b = o >> 6, ln = o & 63; float s = 0.f;
#pragma unroll
                for (int w = 0; w < 8; ++w) s += part[(w * NB + b) * 64 + ln];
                mod[(size_t)(l * NB + b) * 6144 + n0 + ln] = s + p.in[I_MODB][l * 6144 + n0 + ln]; }
            __syncthreads();
        }
        __syncthreads();
    }
    {
        LAS float* scr = (LAS float*)(c.lds + c.wave * 8448);
        constexpr int I_IN = 16 * 56, I_MX = 4 * 32;
        for (int it = c.gw; it < 2 * (I_IN + 2 * I_MX); it += c.NGW) {
            const int l = it / (I_IN + 2 * I_MX); int r = it % (I_IN + 2 * I_MX);
            if (r < I_IN) { const int kb = r / 56, nb = r % 56;
                tr_item(p.in[I_WIN] + (size_t)l * D * N_IN, N_IN, 64 * kb, 32 * nb, N_IN, (bf16_t*)(p.ws + WS_WIN) + (size_t)l * NZ * D, D, 0, [](int n) { return n; }, scr, c.lane); continue; }
            r -= I_IN; const int part = r / I_MX; r %= I_MX; const int kb = r / 32, nb = r % 32;
            tr_item(p.in[I_WOUT] + (size_t)l * D * D + (size_t)(part ? 768 : 0) * D, D, 64 * kb, 32 * nb, D, (bf16_t*)(p.ws + WS_WMIX) + (size_t)l * D * KMIX, KMIX, part ? 1280 : 0, [](int n) { return n; }, scr, c.lane);
        }
    }
    for (int it = c.gw * 64 + c.lane; it < 2 * 131072; it += c.NGW * 64) {
        const int l = it >> 17, r = it & 131071, n = r & 1023, h = (r >> 10) & 7, cb = r >> 13;
        const float* wo = p.in[I_WOUT] + (size_t)l * D * D + (size_t)(256 + 64 * h) * D + n;
        const float* wv = p.in[I_WUV] + (size_t)l * 128 * 512 + (size_t)(8 * cb) * 512 + h * 64;
        float acc[8];
#pragma unroll
        for (int j = 0; j < 8; ++j) acc[j] = 0.f;
        for (int d = 0; d < 64; ++d) { const float w = wo[(size_t)d * D];
#pragma unroll
            for (int j = 0; j < 8; ++j) acc[j] += wv[j * 512 + d] * w; }
        u32x4 o; o.x = cvt_pk_bf16(acc[0], acc[1]); o.y = cvt_pk_bf16(acc[2], acc[3]); o.z = cvt_pk_bf16(acc[4], acc[5]); o.w = cvt_pk_bf16(acc[6], acc[7]);
        *(u32x4*)((bf16_t*)(p.ws + WS_WMIX) + (size_t)l * D * KMIX + (size_t)n * KMIX + 256 + 128 * h + 8 * cb) = o;
    }
    for (int it = c.gw * 64 + c.lane; it < 2 * 32768; it += c.NGW * 64) {
        const int l = it >> 15, r = it & 32767, cb = r & 31, k = (r >> 5) & 127, h = r >> 12;
        const float* uq = p.in[I_WUQ] + (size_t)l * 256 * 512 + (size_t)(8 * cb) * 512 + h * 64;
        const float* uk = p.in[I_WUK] + (size_t)l * 128 * 512 + (size_t)k * 512 + h * 64;
        float acc[8];
#pragma unroll
        for (int j = 0; j < 8; ++j) acc[j] = 0.f;
        for (int d = 0; d < 64; ++d) { const float w = uk[d];
#pragma unroll
            for (int j = 0; j < 8; ++j) acc[j] += uq[j * 512 + d] * w; }
        const float sc = 0.125f * 1.44269504089f;
#pragma unroll
        for (int j = 0; j < 8; ++j) acc[j] *= sc * p.in[I_QNG][l * 256 + 8 * cb + j];
        u32x4 o; o.x = cvt_pk_bf16(acc[0], acc[1]); o.y = cvt_pk_bf16(acc[2], acc[3]); o.z = cvt_pk_bf16(acc[4], acc[5]); o.w = cvt_pk_bf16(acc[6], acc[7]);
        *(u32x4*)((bf16_t*)(p.ws + WS_WQA) + (size_t)l * D * 256 + (size_t)(h * 128 + k) * 256 + 8 * cb) = o;
    }
    for (int it = c.gw * 64 + c.lane; it < 2 * 1024 * 32; it += c.NGW * 64) {
        const int l = it >> 15, r = it & 32767, k = r >> 5, g = (r >> 3) & 3, e = r & 7;
        ((float*)(p.ws + WS_SMALL + SM_REW2))[((size_t)(l * 4 + g) * 1024 + k) * 8 + e] = p.in[I_REW][(size_t)l * D * 32 + r];
    }
    conv_experts(p, c, 0);
}

template <int MODE>
__device__ __forceinline__ void ph_norm1(const Params& p, const Ctx& c) {
    const float* mod = (const float*)(p.ws + WS_MOD);
    const bf16_t* Y = (const bf16_t*)(p.ws + WS_Y); const int* tslot = (const int*)(p.ws + WS_SMALL + SM_TSLOT);
    bf16_t* H = (bf16_t*)(p.ws + WS_H);
    for (int m = c.gw; m < T; m += c.NGW) {
        const int b = m >> 11;
        const f32x4* xr = (const f32x4*)((MODE == 0 ? p.in[I_X] : p.out) + (size_t)m * D) + c.lane;
        f32x4 v[4];
#pragma unroll
        for (int j = 0; j < 4; ++j) v[j] = xr[64 * j];
        if (MODE != 0) {
            const int s0 = tslot[2 * m], s1 = tslot[2 * m + 1];
            const u32x2* ya = (const u32x2*)(Y + (size_t)s0 * D) + c.lane; const u32x2* yb = (const u32x2*)(Y + (size_t)s1 * D) + c.lane;
            const f32x4* g2 = (const f32x4*)(mod + (size_t)((MODE - 1) * NB + b) * 6144 + 5120) + c.lane;
#pragma unroll
            for (int j = 0; j < 4; ++j) { const u32x2 a = ya[64 * j], bb = yb[64 * j]; const f32x4 g = g2[64 * j];
                v[j].x += g.x * (bflo(a.x) + bflo(bb.x)); v[j].y += g.y * (bfhi(a.x) + bfhi(bb.x)); v[j].z += g.z * (bflo(a.y) + bflo(bb.y)); v[j].w += g.w * (bfhi(a.y) + bfhi(bb.y)); }
        }
        float ss = 0.f;
#pragma unroll
        for (int j = 0; j < 4; ++j) ss += (v[j].x * v[j].x + v[j].y * v[j].y) + (v[j].z * v[j].z + v[j].w * v[j].w);
        const float r = 1.0f / sqrtf(wave_sum(ss) * (1.0f / D) + EPS);
        if (MODE == 2) {
            const f32x4* fg = (const f32x4*)p.in[I_FG] + c.lane; f32x4* o = (f32x4*)(p.out + (size_t)m * D) + c.lane;
#pragma unroll
            for (int j = 0; j < 4; ++j) o[64 * j] = v[j] * r * fg[64 * j];
        } else {
            if (MODE == 1) { f32x4* o = (f32x4*)(p.out + (size_t)m * D) + c.lane;
#pragma unroll
                for (int j = 0; j < 4; ++j) o[64 * j] = v[j]; }
            const int l = MODE;
            const f32x4* ng = (const f32x4*)(p.in[I_N1G] + l * D) + c.lane;
            const f32x4* sh = (const f32x4*)(mod + (size_t)(l * NB + b) * 6144) + c.lane; const f32x4* sc = (const f32x4*)(mod + (size_t)(l * NB + b) * 6144 + 1024) + c.lane;
            u32x2* o8 = (u32x2*)(H + (size_t)m * D) + c.lane;
#pragma unroll
            for (int j = 0; j < 4; ++j) { const f32x4 hv = v[j] * r * ng[64 * j] * (sc[64 * j] + 1.0f) + sh[64 * j]; u32x2 w; w.x = cvt_pk_bf16(hv.x, hv.y); w.y = cvt_pk_bf16(hv.z, hv.w); o8[64 * j] = w; }
        }
    }
}

__device__ __forceinline__ void ph_postz(const Params& p, const Ctx& c, int l) {
    const bf16_t* Z = (const bf16_t*)(p.ws + WS_Z); bf16_t* MC = (bf16_t*)(p.ws + WS_MIXCAT);
    bf16_t* CQR = (bf16_t*)(p.ws + WS_CQR); bf16_t* KVN = (bf16_t*)(p.ws + WS_KVN);
    LAS float* U = (LAS float*)c.lds;
    const int lane = c.lane, tk0 = c.wave * 8;
    for (int unit = c.vcu; unit < 512; unit += c.G) {
        const int b = unit >> 5, s0 = (unit & 31) * 64, t0 = b * S + s0;
        for (int idx = c.tid; idx < 94 * 64; idx += 512) { const int r = idx >> 6, c4 = idx & 63, s = s0 - 30 + r; f32x4 u = {0.f, 0.f, 0.f, 0.f};
            if (s >= 0) { const bf16_t* zr = Z + (size_t)(b * S + s) * NZ + 4 * c4; const u32x2 a = *(const u32x2*)(zr + Z_AVAL), g = *(const u32x2*)(zr + Z_AGATE);
                u.x = bflo(a.x) * sigmoidf_(bflo(g.x)); u.y = bfhi(a.x) * sigmoidf_(bfhi(g.x)); u.z = bflo(a.y) * sigmoidf_(bflo(g.y)); u.w = bfhi(a.y) * sigmoidf_(bfhi(g.y)); }
            *(LAS f32x4*)(U + r * 256 + 4 * c4) = u; }
        __syncthreads();
        {
            f32x4 acc[8], win[8];
#pragma unroll
            for (int i = 0; i < 8; ++i) { acc[i] = (f32x4){0.f, 0.f, 0.f, 0.f}; win[i] = *(const LAS f32x4*)(U + (tk0 + i) * 256 + 4 * lane); }
            const f32x4* ck = (const f32x4*)(p.in[I_CONVK] + (size_t)l * 31 * 256) + lane;
#pragma unroll
            for (int j = 0; j < 31; ++j) { const f32x4 kj = ck[64 * j];
#pragma unroll
                for (int i = 0; i < 8; ++i) acc[i] += win[i] * kj;
                if (j < 30) {
#pragma unroll
                    for (int i = 0; i < 7; ++i) win[i] = win[i + 1];
                    win[7] = *(const LAS f32x4*)(U + (tk0 + 8 + j) * 256 + 4 * lane); } }
            const f32x4 cb = *((const f32x4*)(p.in[I_CONVB] + l * 256) + lane), lg = *((const f32x4*)(p.in[I_CLNG] + l * 256) + lane), lb = *((const f32x4*)(p.in[I_CLNB] + l * 256) + lane);
#pragma unroll
            for (int i = 0; i < 8; ++i) { const f32x4 v = acc[i] + cb; const float mean = wave_sum((v.x + v.y) + (v.z + v.w)) * (1.0f / 256.0f);
                const f32x4 d = v - mean; const float var = wave_sum((d.x * d.x + d.y * d.y) + (d.z * d.z + d.w * d.w)) * (1.0f / 256.0f);
                const float rs = 1.0f / sqrtf(var + EPS); f32x4 y = d * rs * lg + lb;
                y.x *= sigmoidf_(y.x); y.y *= sigmoidf_(y.y); y.z *= sigmoidf_(y.z); y.w *= sigmoidf_(y.w);
                u32x2 w; w.x = cvt_pk_bf16(y.x, y.y); w.y = cvt_pk_bf16(y.z, y.w);
                *(u32x2*)(MC + (size_t)(t0 + tk0 + i) * KMIX + 4 * lane) = w; }
        }
        __syncthreads();
        for (int idx = c.tid; idx < 79 * 64; idx += 512) { const int r = idx >> 6, c4 = idx & 63, s = s0 - 15 + r; f32x4 u = {0.f, 0.f, 0.f, 0.f};
            if (s >= 0) { const u32x2 a = *(const u32x2*)(Z + (size_t)(b * S + s) * NZ + Z_UP + 4 * c4); u.x = bflo(a.x); u.y = bfhi(a.x); u.z = bflo(a.y); u.w = bfhi(a.y); }
            *(LAS f32x4*)(U + r * 256 + 4 * c4) = u; }
        __syncthreads();
        f32x4 dv[8];
        {
            const int w = 2 << (lane >> 4);
#pragma unroll
            for (int i = 0; i < 8; ++i) { const int r = 15 + tk0 + i, s = s0 + tk0 + i; f32x4 sum = {0.f, 0.f, 0.f, 0.f};
#pragma unroll
                for (int q = 0; q < 16; ++q) { const f32x4 u = *(const LAS f32x4*)(U + (r - q) * 256 + 4 * lane); if (q < w) sum += u; }
                const float cntf = (float)((s + 1) < w ? (s + 1) : w);
                dv[i] = sum / cntf - *(const LAS f32x4*)(U + r * 256 + 4 * lane); }
        }
        __syncthreads();
        {
            LAS float* Dw = U + c.wave * 2048;
#pragma unroll
            for (int i = 0; i < 8; ++i) *(LAS f32x4*)(Dw + i * 256 + 4 * lane) = dv[i];
            LDS_WAIT();
            const int g = lane >> 4, o4 = (lane & 15) * 4;
            const float* pw = p.in[I_POOLW] + (size_t)(l * 4 + g) * 4096 + o4;
            f32x4 out[8];
#pragma unroll
            for (int i = 0; i < 8; ++i) out[i] = (f32x4){0.f, 0.f, 0.f, 0.f};
            for (int ii = 0; ii < 64; ii += 4) {
                const f32x4 w0 = *(const f32x4*)(pw + (ii + 0) * 64), w1 = *(const f32x4*)(pw + (ii + 1) * 64), w2 = *(const f32x4*)(pw + (ii + 2) * 64), w3 = *(const f32x4*)(pw + (ii + 3) * 64);
#pragma unroll
                for (int i = 0; i < 8; ++i) { const f32x4 d = *(const LAS f32x4*)(Dw + i * 256 + 64 * g + ii); out[i] += w0 * d.x + w1 * d.y + w2 * d.z + w3 * d.w; } }
            const f32x4 ps = *((const f32x4*)(p.in[I_POOLS] + l * 256) + lane);
#pragma unroll
            for (int i = 0; i < 8; ++i) { const f32x4 y = out[i] * ps; u32x2 w; w.x = cvt_pk_bf16(y.x, y.y); w.y = cvt_pk_bf16(y.z, y.w);
                *(u32x2*)(MC + (size_t)(t0 + tk0 + i) * KMIX + 1280 + 4 * lane) = w; }
        }
        {
            const float kg0 = p.in[I_KVNG][l * 128 + 2 * lane], kg1 = p.in[I_KVNG][l * 128 + 2 * lane + 1];
#pragma unroll
            for (int i = 0; i < 8; ++i) { const size_t t = (size_t)(t0 + tk0 + i); const bf16_t* zr = Z + t * NZ;
                const u32x2 q = *(const u32x2*)(zr + Z_CQ + 4 * lane); const float q0 = bflo(q.x), q1 = bfhi(q.x), q2 = bflo(q.y), q3 = bfhi(q.y);
                const float rq = 1.0f / sqrtf(wave_sum((q0 * q0 + q1 * q1) + (q2 * q2 + q3 * q3)) * (1.0f / 256.0f) + EPS);
                u32x2 w; w.x = cvt_pk_bf16(q0 * rq, q1 * rq); w.y = cvt_pk_bf16(q2 * rq, q3 * rq); *(u32x2*)(CQR + t * 256 + 4 * lane) = w;
                const unsigned kv = *(const unsigned*)(zr + Z_CKV + 2 * lane); const float k0 = bflo(kv), k1 = bfhi(kv);
                const float rk = 1.0f / sqrtf(wave_sum(k0 * k0 + k1 * k1) * (1.0f / 128.0f) + EPS);
                *(unsigned*)(KVN + t * 128 + 2 * lane) = cvt_pk_bf16(k0 * rk * kg0, k1 * rk * kg1); }
        }
        __syncthreads();
    }
}

__device__ __forceinline__ size_t sc_off(int b, int cq) { return (size_t)b * SC_PER_B + (size_t)2048 * cq * (cq + 1); }
__device__ __forceinline__ void ph_scores(const Params& p, const Ctx& c) {
    const bf16_t* Z = (const bf16_t*)(p.ws + WS_Z); float* SC = (float*)(p.ws + WS_Y);
    const int lane = c.lane, l15 = lane & 15, g = lane >> 4;
    for (int U = c.gw; U < NB * 576; U += c.NGW) {
        const int b = U / 576, u = U % 576;
        int cg = 0; while (8 * (cg + 1) * (cg + 2) <= u) ++cg;
        const int r = u - 8 * cg * (cg + 1), q16 = r / (cg + 1), seg = r % (cg + 1), cq = 4 * cg + (q16 >> 2), q4 = q16 & 3;
        const int n = 64 * (cq + 1), kt0 = seg * 16, kt1 = (kt0 + 16 < 4 * (cq + 1)) ? kt0 + 16 : 4 * (cq + 1);
        const size_t tq = (size_t)b * S + cq * 64 + q4 * 16 + l15;
        const bf16_t* zq = Z + tq * NZ;
        bf16x8 bq[8][2];
#pragma unroll
        for (int h = 0; h < 8; ++h)
#pragma unroll
            for (int s = 0; s < 2; ++s) bq[h][s] = *(const bf16x8*)(zq + Z_QI + h * 64 + 32 * s + 8 * g);
        float wq[8];
        { const u32x4 wv = *(const u32x4*)(zq + Z_WI); const float isc = 0.044194173824159216f;
          wq[0] = bflo(wv.x) * isc; wq[1] = bfhi(wv.x) * isc; wq[2] = bflo(wv.y) * isc; wq[3] = bfhi(wv.y) * isc; wq[4] = bflo(wv.z) * isc; wq[5] = bfhi(wv.z) * isc; wq[6] = bflo(wv.w) * isc; wq[7] = bfhi(wv.w) * isc; }
        float* srow = SC + sc_off(b, cq) + (size_t)(q4 * 16 + l15) * n;
        const bf16_t* zkb = Z + ((size_t)b * S + l15) * NZ + Z_KI + 8 * g;
        bf16x8 nk0 = *(const bf16x8*)(zkb + (size_t)kt0 * 16 * NZ), nk1 = *(const bf16x8*)(zkb + (size_t)kt0 * 16 * NZ + 32);
        for (int kt = kt0; kt < kt1; ++kt) {
            const bf16x8 ak0 = nk0, ak1 = nk1;
            if (kt + 1 < kt1) { nk0 = *(const bf16x8*)(zkb + (size_t)(kt + 1) * 16 * NZ); nk1 = *(const bf16x8*)(zkb + (size_t)(kt + 1) * 16 * NZ + 32); }
            f32x4 sc = {0.f, 0.f, 0.f, 0.f};
#pragma unroll
            for (int h = 0; h < 8; ++h) { f32x4 a = {0.f, 0.f, 0.f, 0.f};
                a = __builtin_amdgcn_mfma_f32_16x16x32_bf16(ak0, bq[h][0], a, 0, 0, 0);
                a = __builtin_amdgcn_mfma_f32_16x16x32_bf16(ak1, bq[h][1], a, 0, 0, 0);
#pragma unroll
                for (int i = 0; i < 4; ++i) sc[i] += wq[h] * fmaxf(a[i], 0.f); }
            *(f32x4*)(srow + kt * 16 + 4 * g) = sc;
        }
    }
}

__device__ __forceinline__ unsigned off_b(unsigned row, unsigned ch) { return 256u * row + 16u * (ch ^ (((row & 3) << 2) | ((row >> 2) & 3))); }
template <int MODE>
__device__ __forceinline__ void ph_attn(const Params& p, const Ctx& c) {
    const float* SC = (const float*)(p.ws + WS_Y); const bf16_t* QA = (const bf16_t*)(p.ws + WS_H); const bf16_t* KVN = (const bf16_t*)(p.ws + WS_KVN);
    bf16_t* MC = (bf16_t*)(p.ws + WS_MIXCAT);
    const int lane = c.lane, g = lane >> 4, hd = lane & 15;
    LAS unsigned char* tile = c.lds + c.wave * 16384;
    LAS unsigned short* lst = (LAS unsigned short*)(c.lds + LIST_OFF + c.wave * 512);
    const unsigned long long ltmask = (1ull << lane) - 1ull;
    const int xg = blockIdx.x & 7, wv = (blockIdx.x >> 3) * 8 + c.wave, nwv = (c.G >> 3) * 8;
    for (int qi = wv; qi < 2 * S; qi += nwv) {
        const int b = xg + 8 * (qi / S), s = qi % S, cq = s >> 6, n = 64 * (cq + 1), nk = n < 256 ? n : 256;
        const size_t t = (size_t)b * S + s;
        if (cq < 4 || !(MODE & 1)) { for (int i = lane; i < nk; i += 64) lst[i] = (unsigned short)i; }
        else {
            const float* srow = SC + sc_off(b, cq) + (size_t)(s & 63) * n;
            unsigned key[32]; unsigned kmin = 0xffffffffu, kmax = 0u;
            float sv[32];
#pragma unroll
            for (int j = 0; j < 32; ++j) sv[j] = srow[64 * (j <= cq ? j : cq) + lane];
#pragma unroll
            for (int j = 0; j < 32; ++j) { const unsigned u = __float_as_uint(sv[j] + 0.0f); const unsigned k = (u & 0x80000000u) ? ~u : (u | 0x80000000u);
                key[j] = (j <= cq) ? k : 0u; kmin = (j <= cq && k < kmin) ? k : kmin; kmax = (j <= cq && k > kmax) ? k : kmax; }
#pragma unroll
            for (int o = 1; o < 64; o <<= 1) { const unsigned a = __shfl_xor(kmin, o), bb = __shfl_xor(kmax, o); kmin = a < kmin ? a : kmin; kmax = bb > kmax ? bb : kmax; }
            unsigned lo = __builtin_amdgcn_readfirstlane(kmin), hi = __builtin_amdgcn_readfirstlane(kmax); int c_lo = n, c_hi = 0; int it = 0;
            unsigned thr = 0u; int need = 0; bool done = false;
            while (lo < hi && (c_lo - c_hi) > 64) {
                unsigned mid;
                if (it < 20) {
                    const float lo_v = __uint_as_float((lo & 0x80000000u) ? (lo ^ 0x80000000u) : ~lo), hi_v = __uint_as_float((hi & 0x80000000u) ? (hi ^ 0x80000000u) : ~hi);
                    const float f = (it & 1) ? 0.5f : (float)(c_lo - 256) / (float)(c_lo - c_hi);
                    const float mid_v = lo_v + (hi_v - lo_v) * f + 0.0f;
                    const unsigned mu = __float_as_uint(mid_v); mid = (mu & 0x80000000u) ? ~mu : (mu | 0x80000000u);
                } else mid = lo + ((hi - lo) >> 1) + 1u;
                mid = mid > lo ? mid : lo + 1u; mid = mid < hi ? mid : hi;
                int cnt = 0;
#pragma unroll
                for (int jb = 0; jb < 4; ++jb) if (8 * jb <= cq) {
                    unsigned long long bm[8];
#pragma unroll
                    for (int j = 0; j < 8; ++j) bm[j] = __ballot(key[8 * jb + j] >= mid);
#pragma unroll
                    for (int j = 0; j < 8; ++j) cnt += __builtin_popcountll(bm[j]); }
                if (cnt >= 256) { lo = mid; c_lo = cnt; if (cnt == 256) { thr = mid; need = 1 << 20; done = true; break; } } else { hi = mid - 1u; c_hi = cnt; }
                ++it;
            }
            if (!done) {
                if (lo == hi) {
                    thr = lo; int cgt = 0;
#pragma unroll
                    for (int j = 0; j < 32; ++j) cgt += __builtin_popcountll(__ballot(key[j] > thr));
                    need = 256 - cgt;
                } else {
                    LAS unsigned* cand = (LAS unsigned*)lst; int base = 0;
#pragma unroll
                    for (int j = 0; j < 32; ++j) { const bool isc = key[j] >= lo && key[j] <= hi; const unsigned long long bc = __ballot(isc);
                        if (isc) cand[base + __builtin_popcountll(bc & ltmask)] = key[j]; base += __builtin_popcountll(bc); }
                    const int m = base;
                    const unsigned ck = lane < m ? cand[lane] : 0u;
                    int gt = 0, ge = 0;
                    for (int q = 0; q < m; ++q) { const unsigned v = (unsigned)__builtin_amdgcn_readlane((int)ck, q); gt += v > ck; ge += v >= ck; }
                    const int r = 256 - c_hi;
                    const unsigned long long hit = __ballot(lane < m && gt < r && r <= ge);
                    const int src = __builtin_ctzll(hit);
                    thr = __shfl(ck, src); need = r - __shfl(gt, src);
                }
            }
            asm volatile("" ::: "memory");
            {
                int base = 0, tb = 0;
#pragma unroll
                for (int jb = 0; jb < 4; ++jb) if (8 * jb <= cq) {
#pragma unroll
                    for (int j = 8 * jb; j < 8 * jb + 8; ++j) {
                        const bool gt = key[j] > thr, tie = key[j] == thr; const unsigned long long bt = __ballot(tie);
                        const int trank = tb + __builtin_popcountll(bt & ltmask); const bool sel = gt || (tie && trank < need);
                        const unsigned long long bs = __ballot(sel); const int pos = base + __builtin_popcountll(bs & ltmask);
                        if (sel && pos < 256) lst[pos] = (unsigned short)(64 * j + lane);
                        base += __builtin_popcountll(bs); tb += __builtin_popcountll(bt); } }
            }
        }
        bf16x8 qf[4];
#pragma unroll
        for (int ks = 0; ks < 4; ++ks) { qf[ks] = (bf16x8){0, 0, 0, 0, 0, 0, 0, 0}; if (hd < 8) qf[ks] = *(const bf16x8*)(QA + t * D + hd * 128 + 32 * ks + 8 * g); }
        float m_ref = -INFINITY, l_run = 0.f;
        f32x4 o[8];
#pragma unroll
        for (int ct = 0; ct < 8; ++ct) o[ct] = (f32x4){0.f, 0.f, 0.f, 0.f};
        const char* kvb = (const char*)(KVN + (size_t)b * S * 128);
        const int ntile = nk >> 5;
        LDS_WAIT();
#define ATT_ISSUE(kt_, buf_) do { _Pragma("unroll") for (int i = 0; i < 8; ++i) { const int r = 4 * i + g; const unsigned key_ = lst[(kt_) * 32 + r]; \
            const unsigned ch = (unsigned)hd ^ (unsigned)(((r & 3) << 2) | ((r >> 2) & 3)); \
            if (MODE & 2) __builtin_amdgcn_global_load_lds((const unsigned*)(kvb + key_ * 256u + ch * 16u), (LAS unsigned*)(tile + (buf_) * 8192 + i * 1024), 16, 0, 0); } } while (0)
        ATT_ISSUE(0, 0);
        for (int kt = 0; kt < ntile; ++kt) {
            LAS unsigned char* tb_ = tile + (kt & 1) * 8192;
            if (kt + 1 < ntile) { ATT_ISSUE(kt + 1, (kt + 1) & 1); asm volatile("s_waitcnt vmcnt(8)" ::: "memory"); }
            else asm volatile("s_waitcnt vmcnt(0)" ::: "memory");
            if (!(MODE & 4)) continue;
            f32x4 sa[2];
#pragma unroll
            for (int rb = 0; rb < 2; ++rb) { sa[rb] = (f32x4){0.f, 0.f, 0.f, 0.f};
#pragma unroll
                for (int ks = 0; ks < 4; ++ks) { const bf16x8 a = *(const LAS bf16x8*)(tb_ + off_b(16 * rb + hd, 4 * ks + g)); sa[rb] = __builtin_amdgcn_mfma_f32_16x16x32_bf16(a, qf[ks], sa[rb], 0, 0, 0); } }
            float mx = fmaxf(fmaxf(fmaxf(sa[0][0], sa[0][1]), fmaxf(sa[0][2], sa[0][3])), fmaxf(fmaxf(sa[1][0], sa[1][1]), fmaxf(sa[1][2], sa[1][3])));
            mx = fmaxf(mx, __shfl_xor(mx, 16)); mx = fmaxf(mx, __shfl_xor(mx, 32));
            if (__ballot(mx > m_ref + 40.0f) != 0ull) {
                const float m_new = fmaxf(m_ref, mx), alpha = exp2f(m_ref - m_new);
                l_run *= alpha; m_ref = m_new;
#pragma unroll
                for (int ct = 0; ct < 8; ++ct) o[ct] *= alpha;
            }
            float pr[8], ps = 0.f;
#pragma unroll
            for (int j = 0; j < 8; ++j) { pr[j] = exp2f(sa[j >> 2][j & 3] - m_ref); ps += pr[j]; }
            l_run += ps;
            u32x4 pw; pw.x = cvt_pk_bf16(pr[0], pr[1]); pw.y = cvt_pk_bf16(pr[2], pr[3]); pw.z = cvt_pk_bf16(pr[4], pr[5]); pw.w = cvt_pk_bf16(pr[6], pr[7]);
            const bf16x8 pb = __builtin_bit_cast(bf16x8, pw);
            const unsigned q4 = (unsigned)hd >> 2, p4 = (unsigned)hd & 3;
#pragma unroll
            for (int ct = 0; ct < 8; ++ct) {
                const bf16x4 vlo = __builtin_amdgcn_ds_read_tr16_b64_v4i16((LAS bf16x4*)(tb_ + off_b(4 * g + q4, 2 * ct + (p4 >> 1)) + 8 * (p4 & 1)));
                const bf16x4 vhi = __builtin_amdgcn_ds_read_tr16_b64_v4i16((LAS bf16x4*)(tb_ + off_b(16 + 4 * g + q4, 2 * ct + (p4 >> 1)) + 8 * (p4 & 1)));
                const bf16x8 va = __builtin_shufflevector(vlo, vhi, 0, 1, 2, 3, 4, 5, 6, 7);
                o[ct] = __builtin_amdgcn_mfma_f32_16x16x32_bf16(va, pb, o[ct], 0, 0, 0);
            }
            LDS_WAIT();
        }
#undef ATT_ISSUE
        float lt = l_run + __shfl_xor(l_run, 16); lt += __shfl_xor(lt, 32);
        const float inv = 1.0f / lt;
        if (hd < 8 && ((MODE & 8) || lt == 12345.678f)) {
#pragma unroll
            for (int ct = 0; ct < 8; ++ct) { const f32x4 v = o[ct] * inv; u32x2 w; w.x = cvt_pk_bf16(v.x, v.y); w.y = cvt_pk_bf16(v.z, v.w);
                *(u32x2*)(MC + t * KMIX + 256 + hd * 128 + 16 * ct + 4 * g) = w; }
        }
    }
}

__device__ __forceinline__ void ph_router(const Params& p, const Ctx& c, int l) {
    const float* mod = (const float*)(p.ws + WS_MOD); bf16_t* H = (bf16_t*)(p.ws + WS_H);
    int* toke = (int*)(p.ws + WS_SMALL + SM_TOKE); float* tokg = (float*)(p.ws + WS_SMALL + SM_TOKG); int* rank = (int*)(p.ws + WS_SMALL + SM_RANK); int* cnt = (int*)(p.ws + WS_SMALL + SM_CNT);
    LAS int* le = (LAS int*)c.lds; LAS int* wcnt = le + 256;
    const int lane = c.lane;
    for (int tile = c.vcu; tile < 256; tile += c.G) {
        for (int i = 0; i < 16; ++i) {
            const int tl = c.wave * 16 + i, m = tile * 128 + tl, b = m >> 11;
            const f32x4* xr = (const f32x4*)(p.out + (size_t)m * D) + lane;
            f32x4 v[4]; float ss = 0.f;
#pragma unroll
            for (int j = 0; j < 4; ++j) { v[j] = xr[64 * j]; ss += (v[j].x * v[j].x + v[j].y * v[j].y) + (v[j].z * v[j].z + v[j].w * v[j].w); }
            const float r = 1.0f / sqrtf(wave_sum(ss) * (1.0f / D) + EPS);
            const f32x4* ng = (const f32x4*)(p.in[I_N2G] + l * D) + lane;
            const f32x4* sh = (const f32x4*)(mod + (size_t)(l * NB + b) * 6144 + 3072) + lane; const f32x4* sc = (const f32x4*)(mod + (size_t)(l * NB + b) * 6144 + 4096) + lane;
            u32x2* o8 = (u32x2*)(H + (size_t)m * D) + lane;
            float gl[4] = {0.f, 0.f, 0.f, 0.f};
            const f32x4* rg = (const f32x4*)(p.in[I_RGW] + (size_t)l * D * 4);
#pragma unroll
            for (int j = 0; j < 4; ++j) { v[j] = v[j] * r * ng[64 * j] * (sc[64 * j] + 1.0f) + sh[64 * j];
                u32x2 w; w.x = cvt_pk_bf16(v[j].x, v[j].y); w.y = cvt_pk_bf16(v[j].z, v[j].w); o8[64 * j] = w;
#pragma unroll
                for (int e = 0; e < 4; ++e) { const f32x4 wr = rg[4 * (lane + 64 * j) + e];
                    gl[0] += v[j][e] * wr.x; gl[1] += v[j][e] * wr.y; gl[2] += v[j][e] * wr.z; gl[3] += v[j][e] * wr.w; } }
            { const bool h16 = lane & 16, h8 = lane & 8;
              float c0 = (h16 ? gl[2] : gl[0]) + __shfl_xor(h16 ? gl[0] : gl[2], 16), c1 = (h16 ? gl[3] : gl[1]) + __shfl_xor(h16 ? gl[1] : gl[3], 16);
              float d = (h8 ? c1 : c0) + __shfl_xor(h8 ? c0 : c1, 8);
              d += __shfl_xor(d, 4); d += __shfl_xor(d, 2); d += __shfl_xor(d, 1); d += __shfl_xor(d, 32);
#pragma unroll
              for (int q = 0; q < 4; ++q) gl[q] = __shfl(d, 8 * (q & 1) + 16 * (q >> 1)) + p.in[I_RGB][l * 4 + q]; }
            int gi = 0; float gmax = -INFINITY;
#pragma unroll
            for (int q = 0; q < 4; ++q) { if (gl[q] > gmax) { gmax = gl[q]; gi = q; } }
            float gden = 0.f;
#pragma unroll
            for (int q = 0; q < 4; ++q) gden += expf(gl[q] - gmax);
            const float gp = 1.0f / gden;
            gi = __builtin_amdgcn_readfirstlane(gi);
            float el[8] = {0.f, 0.f, 0.f, 0.f, 0.f, 0.f, 0.f, 0.f};
            const float* re = (const float*)(p.ws + WS_SMALL + SM_REW2) + (size_t)(l * 4 + gi) * 1024 * 8;
#pragma unroll
            for (int j = 0; j < 4; ++j)
#pragma unroll
                for (int e = 0; e < 4; ++e) { const float* rr = re + (size_t)(4 * (lane + 64 * j) + e) * 8; const f32x4 w0 = *(const f32x4*)rr, w1 = *(const f32x4*)(rr + 4); const float hv = v[j][e];
                    el[0] += hv * w0.x; el[1] += hv * w0.y; el[2] += hv * w0.z; el[3] += hv * w0.w; el[4] += hv * w1.x; el[5] += hv * w1.y; el[6] += hv * w1.z; el[7] += hv * w1.w; }
            { const bool h32 = lane & 32, h16 = lane & 16, h8 = lane & 8;
              float b0 = (h32 ? el[4] : el[0]) + __shfl_xor(h32 ? el[0] : el[4], 32), b1 = (h32 ? el[5] : el[1]) + __shfl_xor(h32 ? el[1] : el[5], 32);
              float b2 = (h32 ? el[6] : el[2]) + __shfl_xor(h32 ? el[2] : el[6], 32), b3 = (h32 ? el[7] : el[3]) + __shfl_xor(h32 ? el[3] : el[7], 32);
              float c0 = (h16 ? b2 : b0) + __shfl_xor(h16 ? b0 : b2, 16), c1 = (h16 ? b3 : b1) + __shfl_xor(h16 ? b1 : b3, 16);
              float d = (h8 ? c1 : c0) + __shfl_xor(h8 ? c0 : c1, 8);
              d += __shfl_xor(d, 4); d += __shfl_xor(d, 2); d += __shfl_xor(d, 1);
#pragma unroll
              for (int q = 0; q < 8; ++q) el[q] = __shfl(d, 8 * (q & 1) + 16 * ((q >> 1) & 1) + 32 * (q >> 2)) + p.in[I_REB][l * 32 + gi * 8 + q]; }
            int e0 = 0, e1 = 0; float m0 = -INFINITY, m1 = -INFINITY;
#pragma unroll
            for (int q = 0; q < 8; ++q) { if (el[q] > m0) { m1 = m0; e1 = e0; m0 = el[q]; e0 = q; } else if (el[q] > m1) { m1 = el[q]; e1 = q; } }
            const float x1 = expf(m1 - m0), den = 1.0f + x1;
            if (lane == 0) { le[2 * tl] = gi * 8 + e0; le[2 * tl + 1] = gi * 8 + e1; toke[2 * m] = gi * 8 + e0; toke[2 * m + 1] = gi * 8 + e1; tokg[2 * m] = gp / den; tokg[2 * m + 1] = gp * x1 / den; }
        }
        __syncthreads();
        int myrank = 0, mye = 0;
        if (c.tid < 256) { mye = le[c.tid]; const unsigned long long ltmask = (1ull << lane) - 1ull;
            for (int ee = 0; ee < 32; ++ee) { const unsigned long long m = __ballot(mye == ee); if (mye == ee) myrank = __builtin_popcountll(m & ltmask); if (lane == 0) wcnt[c.wave * 32 + ee] = __builtin_popcountll(m); } }
        __syncthreads();
        if (c.tid < 256) { for (int w = 0; w < c.wave; ++w) myrank += wcnt[w * 32 + mye]; rank[tile * 256 + c.tid] = myrank; }
        if (c.tid < 32) cnt[tile * 32 + c.tid] = wcnt[c.tid] + wcnt[32 + c.tid] + wcnt[64 + c.tid] + wcnt[96 + c.tid];
        __syncthreads();
    }
}

__device__ __forceinline__ void ph_dispatch(const Params& p, const Ctx& c) {
    const int* toke = (const int*)(p.ws + WS_SMALL + SM_TOKE); const float* tokg = (const float*)(p.ws + WS_SMALL + SM_TOKG); const int* rank = (const int*)(p.ws + WS_SMALL + SM_RANK); const int* cnt = (const int*)(p.ws + WS_SMALL + SM_CNT);
    int* tslot = (int*)(p.ws + WS_SMALL + SM_TSLOT); int* stok = (int*)(p.ws + WS_SMALL + SM_STOK); float* sgate = (float*)(p.ws + WS_SMALL + SM_SGATE); int* texp = (int*)(p.ws + WS_SMALL + SM_TEXP);
    LAS int* tot = (LAS int*)c.lds; LAS int* pst = tot + 32; LAS int* bse = pst + 33;
    for (int tile = c.vcu; tile < 256; tile += c.G) {
        if (c.tid < 32) { int run = 0, mb = 0; for (int tl = 0; tl < 256; ++tl) { if (tl == tile) mb = run; run += cnt[tl * 32 + c.tid]; } tot[c.tid] = run; bse[c.tid] = mb; }
        __syncthreads();
        if (c.tid == 0) { int a = 0; for (int e = 0; e < 32; ++e) { pst[e] = a; a += ((tot[e] + 255) >> 8) << 8; } pst[32] = a; }
        __syncthreads();
        if (c.tid < 256) { const int a = tile * 256 + c.tid, e = toke[a], slot = pst[e] + bse[e] + rank[a]; stok[slot] = a >> 1; sgate[slot] = tokg[a]; tslot[a] = slot; }
        if (tile == 0) {
            for (int e = 0; e < 32; ++e) { const int pc = pst[e + 1] - pst[e]; for (int r = tot[e] + c.tid; r < pc; r += 512) { stok[pst[e] + r] = 0; sgate[pst[e] + r] = 0.f; } }
            const int ntl = pst[32] >> 8;
            for (int m = c.tid; m < ntl; m += 512) { int e = 0; while (pst[e + 1] <= (m << 8)) ++e; texp[m] = e; }
            if (c.tid == 0) texp[MAXTILES] = ntl;
        }
        __syncthreads();
    }
}

#ifndef PH_ONLY
#define PH_ONLY -1
#endif
#define IN(k) ((PH_ONLY < 0 || PH_ONLY == (k)) && lo <= (k) && (k) < hi)
#define SEAM(k) do { if (IN(k) && IN((k) + 1)) xcd_barrier(bar); } while (0)
#ifndef REP_MASK
#define REP_MASK 0
#endif
#define REP(id) (((REP_MASK) >> (id)) & 1)
#define BODY(id, cond, ...) do { __VA_ARGS__ if (REP(id) && (cond)) { xcd_barrier(bar); __VA_ARGS__ } } while (0)
template <int l>
__device__ __forceinline__ void run_layer(const Params& p, const Ctx& c, const XcdBarrier& bar, int lo, int hi) {
    bf16_t* Zb = (bf16_t*)(p.ws + WS_Z); bf16_t* Hb = (bf16_t*)(p.ws + WS_H); bf16_t* MCb = (bf16_t*)(p.ws + WS_MIXCAT);
    const float* mod = (const float*)(p.ws + WS_MOD);
    constexpr int P = 1 + 10 * l;
    if (IN(P)) { if (l == 0) { BODY(1, true, ph_norm1<0>(p, c);); } else { BODY(12, true, conv_experts(p, c, 1);); ph_norm1<1>(p, c); } }
    SEAM(P);
    if (IN(P + 1)) { BODY(2, true, { pg8::StaticOrder So; So.init(Hb, (bf16_t*)(p.ws + WS_WIN) + (size_t)l * NZ * D, T, NZ, D, c.G, (int)blockIdx.x);
        pg8::EpiBf16 E{Zb, NZ}; pg8::gemm_phase<pg8::EpiBf16, pg8::StaticOrder, false>(c.lds, So, E); }); }
    SEAM(P + 1);
    if (IN(P + 2)) { BODY(3, true, ph_postz(p, c, l);); }
    SEAM(P + 2);
    if (IN(P + 3)) { BODY(4, true, { pg8::StaticOrder So; So.init((bf16_t*)(p.ws + WS_CQR), (bf16_t*)(p.ws + WS_WQA) + (size_t)l * D * 256, T, D, 256, c.G, (int)blockIdx.x);
        pg8::EpiBf16 E{Hb, D}; pg8::gemm_phase<pg8::EpiBf16, pg8::StaticOrder, false>(c.lds, So, E); });
        BODY(5, true, ph_scores(p, c);); }
    SEAM(P + 3);
#ifndef ATT_PROBE
#define ATT_PROBE 0
#endif
    if (IN(P + 4)) { ph_attn<15>(p, c); if (ATT_PROBE) { xcd_barrier(bar); ph_attn<ATT_PROBE>(p, c); } }
    SEAM(P + 4);
    if (IN(P + 5)) { BODY(7, l == 0, { pg8::StaticOrder So; So.init(MCb, (bf16_t*)(p.ws + WS_WMIX) + (size_t)l * D * KMIX, T, D, KMIX, c.G, (int)blockIdx.x);
        pg8::EpiMix E{l == 0 ? p.in[I_X] : p.out, p.out, mod + (size_t)l * NB * 6144 + 2048}; pg8::gemm_phase<pg8::EpiMix, pg8::StaticOrder, false>(c.lds, So, E); }); }
    SEAM(P + 5);
    if (IN(P + 6)) { BODY(8, true, ph_router(p, c, l);); }
    SEAM(P + 6);
    if (IN(P + 7)) { BODY(9, true, ph_dispatch(p, c);); }
    SEAM(P + 7);
    if (IN(P + 8)) { BODY(10, true, { const int* texp = (const int*)(p.ws + WS_SMALL + SM_TEXP); const int ntl = texp[MAXTILES];
        pg8::MoeOrder Mo; Mo.init(Hb, p.ws + WS_W13, D, (size_t)1024 * 1024 * 2, (const int*)(p.ws + WS_SMALL + SM_STOK), texp, ntl, c.G, c.vcu);
        pg8::EpiAct E{Zb}; pg8::gemm_phase<pg8::EpiAct, pg8::MoeOrder, true>(c.lds, Mo, E); }); }
    SEAM(P + 8);
    if (IN(P + 9)) { BODY(11, true, { const int* texp = (const int*)(p.ws + WS_SMALL + SM_TEXP); const int ntl = texp[MAXTILES];
        pg8::MoeOrder Mo; Mo.init(Zb, p.ws + WS_W2, DEXP, (size_t)1024 * 512 * 2, nullptr, texp, ntl, c.G, c.vcu);
        pg8::EpiY E{(bf16_t*)(p.ws + WS_Y), (const float*)(p.ws + WS_SMALL + SM_SGATE)}; pg8::gemm_phase<pg8::EpiY, pg8::MoeOrder, false>(c.lds, Mo, E); }); }
    SEAM(P + 9);
}

__global__ void __launch_bounds__(512, 2) fwd(Params p) {
    extern __shared__ __attribute__((aligned(16))) unsigned char lds_raw[];
    Ctx c;
    c.lds = (LAS unsigned char*)lds_raw;
    c.tid = threadIdx.x; c.lane = c.tid & 63; c.wave = __builtin_amdgcn_readfirstlane(c.tid >> 6);
    c.G = gridDim.x; { const int bx = blockIdx.x; c.vcu = (c.G % 8 == 0) ? (bx % 8) * (c.G / 8) + bx / 8 : bx; }
    c.gw = c.vcu * 8 + c.wave; c.NGW = c.G * 8;
    volatile LAS unsigned* MISC = (volatile LAS unsigned*)(c.lds + MISC_OFF);
    if (c.tid < 64) MISC[c.tid] = 0u;
    __syncthreads();
    unsigned* ctl = (unsigned*)(p.ws + WS_CTL);
    XcdBarrier bar; bar.bar = ctl + CW_BAR; bar.x = 0; bar.st = nullptr;
    const bool multi = (p.ph_hi - p.ph_lo) > 1;
    if (multi) bar = xcd_barrier_post(ctl + CW_BAR, MISC + 8);
    const int lo = p.ph_lo, hi = p.ph_hi;
    if (IN(0)) { BODY(0, true, ph_prologue(p, c);); }
    SEAM(0);
    run_layer<0>(p, c, bar, lo, hi);
    run_layer<1>(p, c, bar, lo, hi);
    if (IN(21)) ph_norm1<2>(p, c);
#undef IN
#undef SEAM
}

extern "C" void kernel_launch(void* const* d_in, const int* in_sizes, int n_in, void* d_out, int out_size, void* d_ws, size_t ws_size, hipStream_t stream) {
    static int grid = 0;
    if (grid == 0) {
        if (n_in != 27 || out_size != T * D || ws_size < WS_END) { fprintf(stderr, "kernel_launch: unexpected shapes (n_in %d out %d ws %zu, need %zu)\n", n_in, out_size, ws_size, (size_t)WS_END); grid = -1; return; }
        int dev = 0, cus = 0, per_cu = 0;
        if (hipGetDevice(&dev) != hipSuccess || hipDeviceGetAttribute(&cus, hipDeviceAttributeMultiprocessorCount, dev) != hipSuccess) { grid = -1; return; }
        if (hipFuncSetAttribute((const void*)fwd, hipFuncAttributeMaxDynamicSharedMemorySize, LDS_BYTES) != hipSuccess) { fprintf(stderr, "kernel_launch: hipFuncSetAttribute failed\n"); grid = -1; return; }
        if (hipOccupancyMaxActiveBlocksPerMultiprocessor(&per_cu, (const void*)fwd, 512, LDS_BYTES) != hipSuccess || per_cu < 1) { fprintf(stderr, "kernel_launch: occupancy query says %d blocks per CU\n", per_cu); grid = -1; return; }
        (void)hipGetLastError();
        grid = cus;
        if (grid % 8 != 0 || grid > 256) grid = (grid / 8) * 8 > 256 ? 256 : (grid / 8) * 8;
    }
    if (grid <= 0) return;
    (void)hipMemsetAsync((char*)d_ws + WS_CTL, 0, CTL_ZERO_BYTES, stream);
    Params p{};
    for (int i = 0; i < 27; ++i) p.in[i] = (const float*)d_in[i];
    p.out = (float*)d_out; p.ws = (unsigned char*)d_ws;
#if MK_SPLIT
    for (int ph = 0; ph < NPHASE; ++ph) { p.ph_lo = ph; p.ph_hi = ph + 1; hipLaunchKernelGGL(fwd, dim3(grid), dim3(512), LDS_BYTES, stream, p); }
#else
    p.ph_lo = 0; p.ph_hi = NPHASE;
    hipLaunchKernelGGL(fwd, dim3(grid), dim3(512), LDS_BYTES, stream, p);
#endif
}
```

```cpp
#include <hip/hip_runtime.h>
#include <cstdio>
#include <cstdint>

#ifndef MK_SPLIT
#define MK_SPLIT 0
#endif

#define LAS __attribute__((address_space(3)))
typedef unsigned short bf16_t;
typedef short bf16x8 __attribute__((ext_vector_type(8)));
typedef short bf16x4 __attribute__((ext_vector_type(4)));
typedef float f32x4 __attribute__((ext_vector_type(4)));
typedef float f32x16 __attribute__((ext_vector_type(16)));
typedef unsigned u32x4 __attribute__((ext_vector_type(4)));
typedef unsigned u32x2 __attribute__((ext_vector_type(2)));

constexpr int D = 1024, NB = 16, S = 2048, T = NB * S, DEPTH = 2;
constexpr int NZ = 1792;
constexpr int N_IN = 1736;
constexpr int Z_AVAL = 0, Z_AGATE = 256, Z_CQ = 512, Z_CKV = 768, Z_QI = 896, Z_KI = 1408, Z_WI = 1472, Z_UP = 1480;
constexpr int KMIX = 1536;
constexpr int NEXP = 32, DEXP = 512, MAXTILES = 288, PMAX = MAXTILES * 256;
constexpr float EPS = 1e-6f;
constexpr int SC_PER_B = 4096 * 528;

constexpr size_t MiB = 1u << 20;
constexpr size_t WS_CTL = 0, CTL_ZERO_BYTES = 64 * 1024;
constexpr size_t WS_MOD = 1 * MiB;
constexpr size_t WS_WIN = 2 * MiB;
constexpr size_t WS_WQA = 9 * MiB;
constexpr size_t WS_WMIX = 10 * MiB;
constexpr size_t WS_SMALL = 16 * MiB;
constexpr size_t WS_W13 = 20 * MiB;
constexpr size_t WS_W2 = 84 * MiB;
constexpr size_t WS_Z = 116 * MiB;
constexpr size_t WS_MIXCAT = 228 * MiB;
constexpr size_t WS_H = 324 * MiB;
constexpr size_t WS_CQR = 388 * MiB;
constexpr size_t WS_KVN = 404 * MiB;
constexpr size_t WS_Y = 412 * MiB;
constexpr size_t WS_END = 556 * MiB;
constexpr size_t SM_TOKE = 0;
constexpr size_t SM_TOKG = 256 * 1024;
constexpr size_t SM_RANK = 512 * 1024;
constexpr size_t SM_TSLOT = 768 * 1024;
constexpr size_t SM_STOK = 1024 * 1024;
constexpr size_t SM_SGATE = 1024 * 1024 + 512 * 1024;
constexpr size_t SM_CNT = 2 * 1024 * 1024;
constexpr size_t SM_TEXP = 2 * 1024 * 1024 + 64 * 1024;
constexpr size_t SM_REW2 = 2 * 1024 * 1024 + 512 * 1024;
constexpr int CW_BAR = 1024;

constexpr int LDS_BYTES = 139264;
constexpr int LIST_OFF = 131072;
constexpr int MISC_OFF = 138240;
constexpr int NPHASE = 22;

__device__ __forceinline__ unsigned cvt_pk_bf16(float lo, float hi) { unsigned r; asm volatile("v_cvt_pk_bf16_f32 %0, %1, %2" : "=v"(r) : "v"(lo), "v"(hi)); return r; }
__device__ __forceinline__ float bf2f(unsigned short b) { return __uint_as_float(((unsigned)b) << 16); }
__device__ __forceinline__ float bflo(unsigned w) { return __uint_as_float(w << 16); }
__device__ __forceinline__ float bfhi(unsigned w) { return __uint_as_float(w & 0xffff0000u); }
__device__ __forceinline__ float wave_sum(float v) {
#pragma unroll
    for (int o = 1; o < 64; o <<= 1) v += __shfl_xor(v, o);
    return v;
}
__device__ __forceinline__ float sigmoidf_(float x) { return 1.0f / (1.0f + __expf(-x)); }
#define LDS_WAIT() asm volatile("s_waitcnt lgkmcnt(0)" ::: "memory")
#define VM_WAIT() asm volatile("s_waitcnt vmcnt(0)" ::: "memory")

#define XB_TMO      128
#define XB_XCNT(j)  (256  + 64 * (j))
#define XB_XSUB(j)  (1280 + 64 * (j))
#define XB_XGEN(j)  (2304 + 64 * (j))
#define XB_TOP      3328
#define XB_TOPGEN   3392
#define XCD_BAR_WORDS 3456
#define XB_SPIN_CAP (1u << 22)

__device__ __forceinline__ unsigned xb_ld(unsigned* p)              { return __hip_atomic_load(p, __ATOMIC_RELAXED, __HIP_MEMORY_SCOPE_AGENT); }
__device__ __forceinline__ unsigned xb_add(unsigned* p, unsigned v) { return __hip_atomic_fetch_add(p, v, __ATOMIC_RELAXED, __HIP_MEMORY_SCOPE_AGENT); }
__device__ __forceinline__ unsigned xb_xcc_id() { return (unsigned)__builtin_amdgcn_s_getreg((3 << 11) | 20) & 0xFu; }
#define XB_SPIN(cond, bar) do { unsigned _sp = 0; while (cond) { __builtin_amdgcn_s_sleep(1); \
    if ((++_sp & 255u) == 0u) { if (xb_ld(&(bar)[XB_TMO])) break; if (_sp > XB_SPIN_CAP) { atomicAdd(&(bar)[XB_TMO], 1u); break; } } } } while (0)

struct XcdBarrier {
    unsigned* bar; unsigned x;
    volatile LAS unsigned* st;
};
__device__ __forceinline__ XcdBarrier xcd_barrier_post(unsigned* bar, volatile LAS unsigned* st) {
    XcdBarrier b; b.bar = bar; b.x = xb_xcc_id(); b.st = st;
    if (threadIdx.x == 0) (void)xb_add(&bar[XB_XCNT(b.x)], 1u);
    return b;
}
__device__ __forceinline__ void xcd_barrier_complete(unsigned* bar, unsigned x, unsigned& nloc, unsigned& nx) {
    const unsigned G = gridDim.x * gridDim.y * gridDim.z;
    unsigned sum, cnt, mine, sp = 0u;
    for (;;) {
        sum = 0u; cnt = 0u; mine = 0u;
#pragma unroll
        for (unsigned j = 0; j < 16; ++j) { const unsigned c = xb_ld(&bar[XB_XCNT(j)]); sum += c; cnt += (c > 0u) ? 1u : 0u; mine = (j == x) ? c : mine; }
        if (sum == G) break;
        __builtin_amdgcn_s_sleep(1);
        if ((++sp & 255u) == 0u) { if (xb_ld(&bar[XB_TMO])) break; if (sp > XB_SPIN_CAP) { atomicAdd(&bar[XB_TMO], 1u); break; } }
    }
    nloc = mine > 0u ? mine : 1u; nx = cnt > 0u ? cnt : 1u;
}
__device__ __forceinline__ void xcd_barrier(const XcdBarrier& b) {
    asm volatile("s_waitcnt vmcnt(0)" ::: "memory");
    __syncthreads();
    if (threadIdx.x == 0) {
        unsigned* bar = b.bar;
        __builtin_amdgcn_s_waitcnt(0);
        unsigned nloc = b.st[0], nx = b.st[1];
        if (nloc == 0u) { xcd_barrier_complete(bar, b.x, nloc, nx); b.st[0] = nloc; b.st[1] = nx; }
        const unsigned old = xb_add(&bar[XB_XSUB(b.x)], 1u);
        const unsigned gen = old / nloc;
        if (old + 1u == (gen + 1u) * nloc) {
            __builtin_amdgcn_fence(__ATOMIC_RELEASE, "agent");
            asm volatile("s_waitcnt vmcnt(0)" ::: "memory");
            const unsigned og = xb_add(&bar[XB_TOP], 1u);
            const unsigned tg = og / nx;
            if (og + 1u == (tg + 1u) * nx) xb_add(&bar[XB_TOPGEN], 1u);
            else XB_SPIN(xb_ld(&bar[XB_TOPGEN]) == tg, bar);
            __builtin_amdgcn_fence(__ATOMIC_ACQUIRE, "agent");
            xb_add(&bar[XB_XGEN(b.x)], 1u);
            asm volatile("s_waitcnt vmcnt(0)" ::: "memory");
        } else {
            XB_SPIN(xb_ld(&bar[XB_XGEN(b.x)]) == gen, bar);
            __builtin_amdgcn_fence(__ATOMIC_ACQUIRE, "agent");
            asm volatile("s_waitcnt vmcnt(0)" ::: "memory");
        }
    }
    __syncthreads();
}

namespace pg8 {
constexpr int BM = 256, BK = 64, HALF = 128, HTB = HALF * BK * 2  , STAGE_BYTES = 8 * HTB, NXCD = 8, WGM = 8;
__host__ __device__ __forceinline__ int lds_byte(int r, int c) { const int st = (r >> 4) * 2 + (c >> 5), rr = r & 15, cc = c & 31, ob = rr * 64 + cc * 2; return st * 1024 + (ob ^ (((ob >> 9) & 1) << 5)); }
__host__ __device__ __forceinline__ void stage_rc(int b, int& R, int& C) { const int st = b / 1024, sb = b % 1024, swz = sb ^ (((sb >> 9) & 1) << 5); R = (st >> 1) * 16 + swz / 64; C = (st & 1) * 32 + (swz % 64) / 2; }
__host__ __device__ __forceinline__ int perm32(int rho) { const int n = rho >> 4, i = rho & 15; return 8 * (i >> 2) + 4 * n + (i & 3); }

struct Unit { int pm, pn; const char* a; const char* b; };

struct StaticOrder {
    const char* A; const char* Bt; int K; const int* rowidx;
    int nM, nN, nwg, G, c;
    __device__ void init(const void* A_, const void* Bt_, int M, int N, int K_, int G_, int c_) { A = (const char*)A_; Bt = (const char*)Bt_; K = K_; rowidx = nullptr; nM = M / BM; nN = N / BM; nwg = nM * nN; G = G_; c = c_; }
    __device__ __forceinline__ bool next(int i, Unit& u) const {
        const long L = (long)i * G + c; if (L >= nwg) return false;
        int wgid = (int)L; { const int q = nwg / NXCD, r = nwg % NXCD, xcd = wgid % NXCD, off = wgid / NXCD; wgid = (xcd < r ? xcd * (q + 1) : r * (q + 1) + (xcd - r) * q) + off; }
        const int nig = WGM * nN, gid = wgid / nig, fm = gid * WGM, gsz = (nM - fm) < WGM ? (nM - fm) : WGM;
        u.pm = fm + ((wgid % nig) % gsz); u.pn = (wgid % nig) / gsz;
        u.a = A + (size_t)u.pm * BM * K * 2; u.b = Bt + (size_t)u.pn * BM * K * 2; return true;
    }
};
struct MoeOrder {
    const char* A; const char* Bt; int K; const int* rowidx;
    const int* tile_exp; int nunits, G, c; size_t bstride;
    __device__ void init(const void* A_, const void* Bt_, int K_, size_t bstride_, const int* rowidx_, const int* tile_exp_, int ntiles, int G_, int c_) {
        A = (const char*)A_; Bt = (const char*)Bt_; K = K_; bstride = bstride_; rowidx = rowidx_; tile_exp = tile_exp_; nunits = ntiles * 4; G = G_; c = c_; }
    __device__ __forceinline__ bool next(int i, Unit& u) const {
        const int L = i * G + c; if (L >= nunits) return false;
        u.pm = L >> 2; u.pn = L & 3; const int e = tile_exp[u.pm];
        u.a = A + (size_t)u.pm * BM * K * 2; u.b = Bt + (size_t)e * bstride + (size_t)u.pn * BM * K * 2; return true;
    }
};

struct EpiBf16 {
    static constexpr bool PERM = true;
    bf16_t* O; int ldc;
    __device__ __forceinline__ void operator()(const f32x4 (&acc)[2][2][4][2], const Unit& u, int wr, int wc, int fr, int fq) const {
        const int row0 = u.pm * BM + wr * 64 + fr, col0 = u.pn * BM + wc * 32 + 8 * fq;
#pragma unroll
        for (int ai = 0; ai < 2; ++ai)
#pragma unroll
            for (int m = 0; m < 4; ++m) { bf16_t* rowp = O + (size_t)(row0 + ai * HALF + m * 16) * ldc + col0;
#pragma unroll
                for (int bj = 0; bj < 2; ++bj) { const f32x4 v0 = acc[ai][bj][m][0], v1 = acc[ai][bj][m][1];
                    u32x4 w; w.x = cvt_pk_bf16(v0[0], v0[1]); w.y = cvt_pk_bf16(v0[2], v0[3]); w.z = cvt_pk_bf16(v1[0], v1[1]); w.w = cvt_pk_bf16(v1[2], v1[3]);
                    *(u32x4*)(rowp + bj * HALF) = w; } }
    }
};
struct EpiMix {
    static constexpr bool PERM = false;
    const float* xin; float* out; const float* gate;
    __device__ __forceinline__ void operator()(const f32x4 (&acc)[2][2][4][2], const Unit& u, int wr, int wc, int fr, int fq) const {
        const int row0 = u.pm * BM + wr * 64 + fr, col0 = u.pn * BM + wc * 32 + 4 * fq;
        const float* gp = gate + (size_t)(u.pm >> 3) * 6144 + col0;
        f32x4 gv[2][2];
#pragma unroll
        for (int bj = 0; bj < 2; ++bj)
#pragma unroll
            for (int n = 0; n < 2; ++n) gv[bj][n] = *(const f32x4*)(gp + bj * HALF + n * 16);
#pragma unroll
        for (int ai = 0; ai < 2; ++ai)
#pragma unroll
            for (int m = 0; m < 4; ++m) { const size_t off = (size_t)(row0 + ai * HALF + m * 16) * D + col0;
#pragma unroll
                for (int bj = 0; bj < 2; ++bj)
#pragma unroll
                    for (int n = 0; n < 2; ++n) { const f32x4 xv = *(const f32x4*)(xin + off + bj * HALF + n * 16);
                        *(f32x4*)(out + off + bj * HALF + n * 16) = xv + gv[bj][n] * acc[ai][bj][m][n]; } }
    }
};
struct EpiAct {
    static constexpr bool PERM = true;
    bf16_t* O;
    __device__ __forceinline__ void operator()(const f32x4 (&acc)[2][2][4][2], const Unit& u, int wr, int wc, int fr, int fq) const {
        const int row0 = u.pm * BM + wr * 64 + fr, col0 = u.pn * 128 + wc * 16 + 4 * fq;
#pragma unroll
        for (int ai = 0; ai < 2; ++ai)
#pragma unroll
            for (int m = 0; m < 4; ++m) { bf16_t* rowp = O + (size_t)(row0 + ai * HALF + m * 16) * DEXP + col0;
#pragma unroll
                for (int bj = 0; bj < 2; ++bj) { const f32x4 a = acc[ai][bj][m][0], b = acc[ai][bj][m][1]; f32x4 r;
#pragma unroll
                    for (int j = 0; j < 4; ++j) r[j] = a[j] * b[j] * __builtin_amdgcn_rcpf(1.0f + __expf(-a[j]));
                    u32x2 w; w.x = cvt_pk_bf16(r[0], r[1]); w.y = cvt_pk_bf16(r[2], r[3]);
                    *(u32x2*)(rowp + bj * 64) = w; } }
    }
};
struct EpiY {
    static constexpr bool PERM = true;
    bf16_t* O; const float* sgate;
    __device__ __forceinline__ void operator()(const f32x4 (&acc)[2][2][4][2], const Unit& u, int wr, int wc, int fr, int fq) const {
        const int row0 = u.pm * BM + wr * 64 + fr, col0 = u.pn * BM + wc * 32 + 8 * fq;
#pragma unroll
        for (int ai = 0; ai < 2; ++ai)
#pragma unroll
            for (int m = 0; m < 4; ++m) { const int row = row0 + ai * HALF + m * 16; const float g = sgate[row]; bf16_t* rowp = O + (size_t)row * D + col0;
#pragma unroll
                for (int bj = 0; bj < 2; ++bj) { const f32x4 v0 = acc[ai][bj][m][0] * g, v1 = acc[ai][bj][m][1] * g;
                    u32x4 w; w.x = cvt_pk_bf16(v0[0], v0[1]); w.y = cvt_pk_bf16(v0[2], v0[3]); w.z = cvt_pk_bf16(v1[0], v1[1]); w.w = cvt_pk_bf16(v1[2], v1[3]);
                    *(u32x4*)(rowp + bj * HALF) = w; } }
    }
};

template <class Epi, class Sched, bool GATHER>
__device__ __forceinline__ void gemm_phase(LAS unsigned char* lds, const Sched& S, const Epi& E) {
    const int tid = threadIdx.x, wid = __builtin_amdgcn_readfirstlane(tid >> 6), lane = tid & 63, wr = wid >> 2, wc = wid & 3, fr = lane & 15, fq = lane >> 4;
    const int K = S.K, nt = K / BK;
    unsigned voffA[2], voffB[2]; int RA[2], CA[2];
#pragma unroll
    for (int i = 0; i < 2; ++i) { int R, C; stage_rc(tid * 16 + i * 8192, R, C); const int Rb = Epi::PERM ? ((R & ~31) + perm32(R & 31)) : R;
        RA[i] = R; CA[i] = C; voffA[i] = (unsigned)(R * K + C) * 2u; voffB[i] = (unsigned)(Rb * K + C) * 2u; }
    const size_t kstep = (size_t)(BK * 2);
    const size_t hstep = (size_t)HALF * K * 2;
    const unsigned ldsw = (unsigned)wid * 1024u;
    const int aoff = lds_byte(wr * 64 + fr, fq * 8), boff = lds_byte(wc * 32 + fr, fq * 8);
#define PG8_SA(b, h) (((b) * 2 + (h)) * HTB)
#define PG8_SB(b, h) ((4 + (b) * 2 + (h)) * HTB)
#define PG8_DMA(bufoff, gptr, i) __builtin_amdgcn_global_load_lds((const unsigned*)(gptr), (LAS unsigned*)(lds + (bufoff) + ldsw + (i) * 8192), 16, 0, 0)
#define PG8_STAGE(bufoff, gbase, voff) do { PG8_DMA(bufoff, (const char*)(gbase) + (voff)[0], 0); PG8_DMA(bufoff, (const char*)(gbase) + (voff)[1], 1); } while (0)
#define PG8_STAGE_A(bufoff, nx, h, kb) do { if constexpr (GATHER) { \
            PG8_DMA(bufoff, S.A + (kb) + ((nx) ? gN[h][0] : gC[h][0]), 0); PG8_DMA(bufoff, S.A + (kb) + ((nx) ? gN[h][1] : gC[h][1]), 1); } \
        else { const char* _b = ((nx) ? nA : cA) + (h) * hstep + (kb); PG8_DMA(bufoff, _b + voffA[0], 0); PG8_DMA(bufoff, _b + voffA[1], 1); } } while (0)
#define PG8_LDA(dst, b, h) do { _Pragma("unroll") for (int m = 0; m < 4; ++m) _Pragma("unroll") for (int k = 0; k < 2; ++k) dst[m][k] = *(const LAS bf16x8*)(lds + PG8_SA(b, h) + aoff + m * 2048 + k * 1024); } while (0)
#define PG8_LDB(dst, b, h) do { _Pragma("unroll") for (int n = 0; n < 2; ++n) _Pragma("unroll") for (int k = 0; k < 2; ++k) dst[n][k] = *(const LAS bf16x8*)(lds + PG8_SB(b, h) + boff + n * 2048 + k * 1024); } while (0)
#define PG8_MMA(ai, bj, At, Bt) do { __builtin_amdgcn_s_setprio(1); _Pragma("unroll") for (int m = 0; m < 4; ++m) _Pragma("unroll") for (int n = 0; n < 2; ++n) _Pragma("unroll") for (int k = 0; k < 2; ++k) \
        acc[ai][bj][m][n] = __builtin_amdgcn_mfma_f32_16x16x32_bf16(Bt[n][k], At[m][k], acc[ai][bj][m][n], 0, 0, 0); __builtin_amdgcn_s_setprio(0); } while (0)
#define PG8_WAIT_V(n) asm volatile("s_waitcnt vmcnt(" #n ")" ::: "memory")
#define PG8_WAIT_L(n) asm volatile("s_waitcnt lgkmcnt(" #n ")" ::: "memory")
#define PG8_BAR __builtin_amdgcn_s_barrier()
#define PG8_SCHED __builtin_amdgcn_sched_barrier(0)
    Unit cur, nxt; int ui = 0;
    if (!S.next(0, cur)) return;
    unsigned gC[2][2] = {{0u, 0u}, {0u, 0u}}, gN[2][2] = {{0u, 0u}, {0u, 0u}};
    if constexpr (GATHER) {
#pragma unroll
        for (int h = 0; h < 2; ++h)
#pragma unroll
            for (int i = 0; i < 2; ++i) gC[h][i] = (unsigned)(S.rowidx[cur.pm * BM + h * HALF + RA[i]] * K + CA[i]) * 2u;
    }
    f32x4 acc[2][2][4][2];
#pragma unroll
    for (int a = 0; a < 2; ++a)
#pragma unroll
        for (int b = 0; b < 2; ++b)
#pragma unroll
            for (int m = 0; m < 4; ++m)
#pragma unroll
                for (int n = 0; n < 2; ++n) acc[a][b][m][n] = (f32x4){0.f, 0.f, 0.f, 0.f};
    bf16x8 At[4][2], B0[2][2], B1[2][2];
    const char* cA = cur.a; const char* cB = cur.b; const char* nA = cA; const char* nB = cB;
    PG8_STAGE(PG8_SB(0, 0), cB, voffB); PG8_STAGE(PG8_SB(0, 1), cB + hstep, voffB); PG8_STAGE_A(PG8_SA(0, 0), false, 0, 0); PG8_STAGE_A(PG8_SA(0, 1), false, 1, 0);
    if (wr == 1) PG8_BAR;
    PG8_WAIT_V(2); PG8_BAR;
    PG8_STAGE(PG8_SB(1, 0), cB + kstep, voffB); PG8_STAGE_A(PG8_SA(1, 0), false, 0, kstep); PG8_STAGE(PG8_SB(1, 1), cB + hstep + kstep, voffB);
    PG8_WAIT_V(6); PG8_BAR;
    for (;;) {
        const bool has_next = S.next(ui + 1, nxt);
        nA = has_next ? nxt.a : cA; nB = has_next ? nxt.b : cB;
        if constexpr (GATHER) {
            const int npm = has_next ? nxt.pm : cur.pm;
#pragma unroll
            for (int h = 0; h < 2; ++h)
#pragma unroll
                for (int i = 0; i < 2; ++i) gN[h][i] = (unsigned)(S.rowidx[npm * BM + h * HALF + RA[i]] * K + CA[i]) * 2u;
        }
        for (int t = 0; t < nt; t += 2) {
            const bool last = (t == nt - 2);
            const size_t k1 = (size_t)(t + 1) * kstep;
            const size_t k2 = last ? 0 : (size_t)(t + 2) * kstep, k3 = k2 + kstep;
            const char* b2 = (last ? nB : cB) + k2; const char* b3 = b2 + kstep;
            PG8_LDB(B0, 0, 0); PG8_LDB(B1, 0, 1); PG8_SCHED; PG8_LDA(At, 0, 0); PG8_STAGE_A(PG8_SA(1, 1), false, 1, k1);
            PG8_WAIT_V(8); PG8_WAIT_L(0); PG8_BAR; PG8_MMA(0, 0, At, B0); PG8_MMA(0, 1, At, B1); PG8_BAR; PG8_SCHED;
            PG8_LDA(At, 0, 1); PG8_STAGE(PG8_SB(0, 0), b2, voffB); PG8_STAGE(PG8_SB(0, 1), b2 + hstep, voffB); PG8_STAGE_A(PG8_SA(0, 0), last, 0, k2);
            PG8_WAIT_V(8); PG8_WAIT_L(0); PG8_BAR; PG8_MMA(1, 0, At, B0); PG8_MMA(1, 1, At, B1); PG8_BAR; PG8_SCHED;
            PG8_LDB(B0, 1, 0); PG8_LDB(B1, 1, 1); PG8_SCHED; PG8_LDA(At, 1, 0); PG8_STAGE_A(PG8_SA(0, 1), last, 1, k2);
            PG8_WAIT_V(8); PG8_WAIT_L(0); PG8_BAR; PG8_MMA(0, 0, At, B0); PG8_MMA(0, 1, At, B1); PG8_BAR; PG8_SCHED;
            PG8_LDA(At, 1, 1); PG8_STAGE(PG8_SB(1, 0), b3, voffB); PG8_STAGE(PG8_SB(1, 1), b3 + hstep, voffB); PG8_STAGE_A(PG8_SA(1, 0), last, 0, k3);
            PG8_WAIT_V(8); PG8_WAIT_L(0); PG8_BAR; PG8_MMA(1, 0, At, B0); PG8_MMA(1, 1, At, B1); PG8_BAR; PG8_SCHED;
        }
        if (wr == 0) PG8_BAR;
        E(acc, cur, wr, wc, fr, fq);
        if (!has_next) break;
#pragma unroll
        for (int a = 0; a < 2; ++a)
#pragma unroll
            for (int b = 0; b < 2; ++b)
#pragma unroll
                for (int m = 0; m < 4; ++m)
#pragma unroll
                    for (int n = 0; n < 2; ++n) acc[a][b][m][n] = (f32x4){0.f, 0.f, 0.f, 0.f};
        cur = nxt; cA = nA; cB = nB; ++ui;
        if constexpr (GATHER) {
#pragma unroll
            for (int h = 0; h < 2; ++h)
#pragma unroll
                for (int i = 0; i < 2; ++i) gC[h][i] = gN[h][i];
        }
        if (wr == 1) PG8_BAR;
    }
    PG8_WAIT_V(0);
    PG8_BAR;
#undef PG8_SA
#undef PG8_SB
#undef PG8_DMA
#undef PG8_STAGE
#undef PG8_STAGE_A
#undef PG8_LDA
#undef PG8_LDB
#undef PG8_MMA
#undef PG8_WAIT_V
#undef PG8_WAIT_L
#undef PG8_BAR
#undef PG8_SCHED
}
}

struct Params { const float* in[27]; float* out; unsigned char* ws; int ph_lo, ph_hi; };
struct Ctx { LAS unsigned char* lds; int tid, lane, wave, vcu, G, gw, NGW; };
enum { I_X = 0, I_C, I_MODW, I_MODB, I_N1G, I_WIN, I_CONVK, I_CONVB, I_CLNG, I_CLNB, I_QNG, I_KVNG, I_WUQ, I_WUK, I_WUV, I_POOLW, I_POOLS, I_WOUT, I_N2G, I_RGW, I_RGB, I_REW, I_REB, I_W1, I_W3, I_W2, I_FG };

template <class RowMap>
__device__ __forceinline__ void tr_item(const float* src, int ldn, int k0, int n0, int nvalid, bf16_t* dst, int ldk, int dk0, RowMap rm, LAS float* scr, int lane) {
#pragma unroll 8
    for (int i = 0; i < 32; ++i) { const int kk = 2 * i + (lane >> 5), n = n0 + (lane & 31); scr[kk * 33 + (lane & 31)] = (n < nvalid) ? src[(size_t)(k0 + kk) * ldn + n] : 0.f; }
    LDS_WAIT();
    const int c = lane & 7;
#pragma unroll
    for (int j = 0; j < 4; ++j) { const int n = (lane >> 3) + 8 * j; const LAS float* s = scr + (8 * c) * 33 + n;
        u32x4 o; o.x = cvt_pk_bf16(s[0 * 33], s[1 * 33]); o.y = cvt_pk_bf16(s[2 * 33], s[3 * 33]); o.z = cvt_pk_bf16(s[4 * 33], s[5 * 33]); o.w = cvt_pk_bf16(s[6 * 33], s[7 * 33]);
        *(u32x4*)(dst + (size_t)rm(n0 + n) * ldk + dk0 + k0 + 8 * c) = o; }
    LDS_WAIT();
}

__device__ __forceinline__ void conv_experts(const Params& p, const Ctx& c, int l) {
    LAS float* scr = (LAS float*)(c.lds + c.wave * 8448);
    bf16_t* W13 = (bf16_t*)(p.ws + WS_W13); bf16_t* W2 = (bf16_t*)(p.ws + WS_W2);
    for (int it = c.gw; it < 3 * 8192; it += c.NGW) {
        const int which = it >> 13, r = it & 8191, e = r >> 8;
        if (which < 2) { const int kb = (r >> 4) & 15, nb = r & 15; const float* src = p.in[which ? I_W3 : I_W1] + (size_t)(l * NEXP + e) * 1024 * 512; const int add = which ? 4 : 0;
            tr_item(src, 512, 64 * kb, 32 * nb, 512, W13 + (size_t)e * 1024 * 1024, 1024, 0, [add](int n) { return 8 * (n >> 2) + (n & 3) + add; }, scr, c.lane); }
        else { const int kb = (r >> 5) & 7, nb = r & 31; const float* src = p.in[I_W2] + (size_t)(l * NEXP + e) * 512 * 1024;
            tr_item(src, 1024, 64 * kb, 32 * nb, 1024, W2 + (size_t)e * 1024 * 512, 512, 0, [](int n) { return n; }, scr, c.lane); }
    }
}

__device__ __forceinline__ void ph_prologue(const Params& p, const Ctx& c) {
    float* mod = (float*)(p.ws + WS_MOD);
    {
        LAS float* cond = (LAS float*)c.lds; LAS float* part = (LAS float*)(c.lds + 65536);
        bool loaded = false;
        for (int item = c.vcu; item < 192; item += c.G) {
            if (!loaded) { for (int i = c.tid; i < NB * D; i += 512) { const float v = p.in[I_C][i]; cond[i] = v / (1.0f + expf(-v)); } __syncthreads(); loaded = true; }
            const int l = item / 96, n0 = (item % 96) * 64;
            const float* W = p.in[I_MODW] + (size_t)l * D * 6144 + n0 + c.lane;
            float acc[NB];
#pragma unroll
            for (int b = 0; b < NB; ++b) acc[b] = 0.f;
            for (int k = c.wave * 128; k < c.wave * 128 + 128; ++k) { const float w = W[(size_t)k * 6144];
#pragma unroll
                for (int b = 0; b < NB; ++b) acc[b] += cond[b * D + k] * w; }
#pragma unroll
            for (int b = 0; b < NB; ++b) part[(c.wave * NB + b) * 64 + c.lane] = acc[b];
            __syncthreads();
            for (int o = c.tid; o < NB * 64; o += 512) { const int b = o >> 6, ln = o & 63; float s = 0.f;
#pragma unroll
                for (int w = 0; w < 8; ++w) s += part[(w * NB + b) * 64 + ln];
                mod[(size_t)(l * NB + b) * 6144 + n0 + ln] = s + p.in[I_MODB][l * 6144 + n0 + ln]; }
            __syncthreads();
        }
        __syncthreads();
    }
    {
        LAS float* scr = (LAS float*)(c.lds + c.wave * 8448);
        constexpr int I_IN = 16 * 56, I_MX = 4 * 32;
        for (int it = c.gw; it < 2 * (I_IN + 2 * I_MX); it += c.NGW) {
            const int l = it / (I_IN + 2 * I_MX); int r = it % (I_IN + 2 * I_MX);
            if (r < I_IN) { const int kb = r / 56, nb = r % 56;
                tr_item(p.in[I_WIN] + (size_t)l * D * N_IN, N_IN, 64 * kb, 32 * nb, N_IN, (bf16_t*)(p.ws + WS_WIN) + (size_t)l * NZ * D, D, 0, [](int n) { return n; }, scr, c.lane); continue; }
            r -= I_IN; const int part = r / I_MX; r %= I_MX; const int kb = r / 32, nb = r % 32;
            tr_item(p.in[I_WOUT] + (size_t)l * D * D + (size_t)(part ? 768 : 0) * D, D, 64 * kb, 32 * nb, D, (bf16_t*)(p.ws + WS_WMIX) + (size_t)l * D * KMIX, KMIX, part ? 1280 : 0, [](int n) { return n; }, scr, c.lane);
        }
    }
    for (int it = c.gw * 64 + c.lane; it < 2 * 131072; it += c.NGW * 64) {
        const int l = it >> 17, r = it & 131071, n = r & 1023, h = (r >> 10) & 7, cb = r >> 13;
        const float* wo = p.in[I_WOUT] + (size_t)l * D * D + (size_t)(256 + 64 * h) * D + n;
        const float* wv = p.in[I_WUV] + (size_t)l * 128 * 512 + (size_t)(8 * cb) * 512 + h * 64;
        float acc[8];
#pragma unroll
        for (int j = 0; j < 8; ++j) acc[j] = 0.f;
        for (int d = 0; d < 64; ++d) { const float w = wo[(size_t)d * D];
#pragma unroll
            for (int j = 0; j < 8; ++j) acc[j] += wv[j * 512 + d] * w; }
        u32x4 o; o.x = cvt_pk_bf16(acc[0], acc[1]); o.y = cvt_pk_bf16(acc[2], acc[3]); o.z = cvt_pk_bf16(acc[4], acc[5]); o.w = cvt_pk_bf16(acc[6], acc[7]);
        *(u32x4*)((bf16_t*)(p.ws + WS_WMIX) + (size_t)l * D * KMIX + (size_t)n * KMIX + 256 + 128 * h + 8 * cb) = o;
    }
    for (int it = c.gw * 64 + c.lane; it < 2 * 32768; it += c.NGW * 64) {
        const int l = it >> 15, r = it & 32767, cb = r & 31, k = (r >> 5) & 127, h = r >> 12;
        const float* uq = p.in[I_WUQ] + (size_t)l * 256 * 512 + (size_t)(8 * cb) * 512 + h * 64;
        const float* uk = p.in[I_WUK] + (size_t)l * 128 * 512 + (size_t)k * 512 + h * 64;
        float acc[8];
#pragma unroll
        for (int j = 0; j < 8; ++j) acc[j] = 0.f;
        for (int d = 0; d < 64; ++d) { const float w = uk[d];
#pragma unroll
            for (int j = 0; j < 8; ++j) acc[j] += uq[j * 512 + d] * w; }
        const float sc = 0.125f * 1.44269504089f;
#pragma unroll
        for (int j = 0; j < 8; ++j) acc[j] *= sc * p.in[I_QNG][l * 256 + 8 * cb + j];
        u32x4 o; o.x = cvt_pk_bf16(acc[0], acc[1]); o.y = cvt_pk_bf16(acc[2], acc[3]); o.z = cvt_pk_bf16(acc[4], acc[5]); o.w = cvt_pk_bf16(acc[6], acc[7]);
        *(u32x4*)((bf16_t*)(p.ws + WS_WQA) + (size_t)l * D * 256 + (size_t)(h * 128 + k) * 256 + 8 * cb) = o;
    }
    for (int it = c.gw * 64 + c.lane; it < 2 * 1024 * 32; it += c.NGW * 64) {
        const int l = it >> 15, r = it & 32767, k = r >> 5, g = (r >> 3) & 3, e = r & 7;
        ((float*)(p.ws + WS_SMALL + SM_REW2))[((size_t)(l * 4 + g) * 1024 + k) * 8 + e] = p.in[I_REW][(size_t)l * D * 32 + r];
    }
    conv_experts(p, c, 0);
}

template <int MODE>
__device__ __forceinline__ void ph_norm1(const Params& p, const Ctx& c) {
    const float* mod = (const float*)(p.ws + WS_MOD);
    const bf16_t* Y = (const bf16_t*)(p.ws + WS_Y); const int* tslot = (const int*)(p.ws + WS_SMALL + SM_TSLOT);
    bf16_t* H = (bf16_t*)(p.ws + WS_H);
    for (int m = c.gw; m < T; m += c.NGW) {
        const int b = m >> 11;
        const f32x4* xr = (const f32x4*)((MODE == 0 ? p.in[I_X] : p.out) + (size_t)m * D) + c.lane;
        f32x4 v[4];
#pragma unroll
        for (int j = 0; j < 4; ++j) v[j] = xr[64 * j];
        if (MODE != 0) {
            const int s0 = tslot[2 * m], s1 = tslot[2 * m + 1];
            const u32x2* ya = (const u32x2*)(Y + (size_t)s0 * D) + c.lane; const u32x2* yb = (const u32x2*)(Y + (size_t)s1 * D) + c.lane;
            const f32x4* g2 = (const f32x4*)(mod + (size_t)((MODE - 1) * NB + b) * 6144 + 5120) + c.lane;
#pragma unroll
            for (int j = 0; j < 4; ++j) { const u32x2 a = ya[64 * j], bb = yb[64 * j]; const f32x4 g = g2[64 * j];
                v[j].x += g.x * (bflo(a.x) + bflo(bb.x)); v[j].y += g.y * (bfhi(a.x) + bfhi(bb.x)); v[j].z += g.z * (bflo(a.y) + bflo(bb.y)); v[j].w += g.w * (bfhi(a.y) + bfhi(bb.y)); }
        }
        float ss = 0.f;
#pragma unroll
        for (int j = 0; j < 4; ++j) ss += (v[j].x * v[j].x + v[j].y * v[j].y) + (v[j].z * v[j].z + v[j].w * v[j].w);
        const float r = 1.0f / sqrtf(wave_sum(ss) * (1.0f / D) + EPS);
        if (MODE == 2) {
            const f32x4* fg = (const f32x4*)p.in[I_FG] + c.lane; f32x4* o = (f32x4*)(p.out + (size_t)m * D) + c.lane;
#pragma unroll
            for (int j = 0; j < 4; ++j) o[64 * j] = v[j] * r * fg[64 * j];
        } else {
            if (MODE == 1) { f32x4* o = (f32x4*)(p.out + (size_t)m * D) + c.lane;
#pragma unroll
                for (int j = 0; j < 4; ++j) o[64 * j] = v[j]; }
            const int l = MODE;
            const f32x4* ng = (const f32x4*)(p.in[I_N1G] + l * D) + c.lane;
            const f32x4* sh = (const f32x4*)(mod + (size_t)(l * NB + b) * 6144) + c.lane; const f32x4* sc = (const f32x4*)(mod + (size_t)(l * NB + b) * 6144 + 1024) + c.lane;
            u32x2* o8 = (u32x2*)(H + (size_t)m * D) + c.lane;
#pragma unroll
            for (int j = 0; j < 4; ++j) { const f32x4 hv = v[j] * r * ng[64 * j] * (sc[64 * j] + 1.0f) + sh[64 * j]; u32x2 w; w.x = cvt_pk_bf16(hv.x, hv.y); w.y = cvt_pk_bf16(hv.z, hv.w); o8[64 * j] = w; }
        }
    }
}

__device__ __forceinline__ void ph_postz(const Params& p, const Ctx& c, int l) {
    const bf16_t* Z = (const bf16_t*)(p.ws + WS_Z); bf16_t* MC = (bf16_t*)(p.ws + WS_MIXCAT);
    bf16_t* CQR = (bf16_t*)(p.ws + WS_CQR); bf16_t* KVN = (bf16_t*)(p.ws + WS_KVN);
    LAS float* U = (LAS float*)c.lds;
    const int lane = c.lane, tk0 = c.wave * 8;
    for (int unit = c.vcu; unit < 512; unit += c.G) {
        const int b = unit >> 5, s0 = (unit & 31) * 64, t0 = b * S + s0;
        for (int idx = c.tid; idx < 94 * 64; idx += 512) { const int r = idx >> 6, c4 = idx & 63, s = s0 - 30 + r; f32x4 u = {0.f, 0.f, 0.f, 0.f};
            if (s >= 0) { const bf16_t* zr = Z + (size_t)(b * S + s) * NZ + 4 * c4; const u32x2 a = *(const u32x2*)(zr + Z_AVAL), g = *(const u32x2*)(zr + Z_AGATE);
                u.x = bflo(a.x) * sigmoidf_(bflo(g.x)); u.y = bfhi(a.x) * sigmoidf_(bfhi(g.x)); u.z = bflo(a.y) * sigmoidf_(bflo(g.y)); u.w = bfhi(a.y) * sigmoidf_(bfhi(g.y)); }
            *(LAS f32x4*)(U + r * 256 + 4 * c4) = u; }
        __syncthreads();
        {
            f32x4 acc[8], win[8];
#pragma unroll
            for (int i = 0; i < 8; ++i) { acc[i] = (f32x4){0.f, 0.f, 0.f, 0.f}; win[i] = *(const LAS f32x4*)(U + (tk0 + i) * 256 + 4 * lane); }
            const f32x4* ck = (const f32x4*)(p.in[I_CONVK] + (size_t)l * 31 * 256) + lane;
#pragma unroll
            for (int j = 0; j < 31; ++j) { const f32x4 kj = ck[64 * j];
#pragma unroll
                for (int i = 0; i < 8; ++i) acc[i] += win[i] * kj;
                if (j < 30) {
#pragma unroll
                    for (int i = 0; i < 7; ++i) win[i] = win[i + 1];
                    win[7] = *(const LAS f32x4*)(U + (tk0 + 8 + j) * 256 + 4 * lane); } }
            const f32x4 cb = *((const f32x4*)(p.in[I_CONVB] + l * 256) + lane), lg = *((const f32x4*)(p.in[I_CLNG] + l * 256) + lane), lb = *((const f32x4*)(p.in[I_CLNB] + l * 256) + lane);
#pragma unroll
            for (int i = 0; i < 8; ++i) { const f32x4 v = acc[i] + cb; const float mean = wave_sum((v.x + v.y) + (v.z + v.w)) * (1.0f / 256.0f);
                const f32x4 d = v - mean; const float var = wave_sum((d.x * d.x + d.y * d.y) + (d.z * d.z + d.w * d.w)) * (1.0f / 256.0f);
                const float rs = 1.0f / sqrtf(var + EPS); f32x4 y = d * rs * lg + lb;
                y.x *= sigmoidf_(y.x); y.y *= sigmoidf_(y.y); y.z *= sigmoidf_(y.z); y.w *= sigmoidf_(y.w);
                u32x2 w; w.x = cvt_pk_bf16(y.x, y.y); w.y = cvt_pk_bf16(y.z, y.w);
                *(u32x2*)(MC + (size_t)(t0 + tk0 + i) * KMIX + 4 * lane) = w; }
        }
        __syncthreads();
        for (int idx = c.tid; idx < 79 * 64; idx += 512) { const int r = idx >> 6, c4 = idx & 63, s = s0 - 15 + r; f32x4 u = {0.f, 0.f, 0.f, 0.f};
            if (s >= 0) { const u32x2 a = *(const u32x2*)(Z + (size_t)(b * S + s) * NZ + Z_UP + 4 * c4); u.x = bflo(a.x); u.y = bfhi(a.x); u.z = bflo(a.y); u.w = bfhi(a.y); }
            *(LAS f32x4*)(U + r * 256 + 4 * c4) = u; }
        __syncthreads();
        f32x4 dv[8];
        {
            const int w = 2 << (lane >> 4);
#pragma unroll
            for (int i = 0; i < 8; ++i) { const int r = 15 + tk0 + i, s = s0 + tk0 + i; f32x4 sum = {0.f, 0.f, 0.f, 0.f};
#pragma unroll
                for (int q = 0; q < 16; ++q) { const f32x4 u = *(const LAS f32x4*)(U + (r - q) * 256 + 4 * lane); if (q < w) sum += u; }
                const float cntf = (float)((s + 1) < w ? (s + 1) : w);
                dv[i] = sum / cntf - *(const LAS f32x4*)(U + r * 256 + 4 * lane); }
        }
        __syncthreads();
        {
            LAS float* Dw = U + c.wave * 2048;
#pragma unroll
            for (int i = 0; i < 8; ++i) *(LAS f32x4*)(Dw + i * 256 + 4 * lane) = dv[i];
            LDS_WAIT();
            const int g = lane >> 4, o4 = (lane & 15) * 4;
            const float* pw = p.in[I_POOLW] + (size_t)(l * 4 + g) * 4096 + o4;
            f32x4 out[8];
#pragma unroll
            for (int i = 0; i < 8; ++i) out[i] = (f32x4){0.f, 0.f, 0.f, 0.f};
            for (int ii = 0; ii < 64; ii += 4) {
                const f32x4 w0 = *(const f32x4*)(pw + (ii + 0) * 64), w1 = *(const f32x4*)(pw + (ii + 1) * 64), w2 = *(const f32x4*)(pw + (ii + 2) * 64), w3 = *(const f32x4*)(pw + (ii + 3) * 64);
#pragma unroll
                for (int i = 0; i < 8; ++i) { const f32x4 d = *(const LAS f32x4*)(Dw + i * 256 + 64 * g + ii); out[i] += w0 * d.x + w1 * d.y + w2 * d.z + w3 * d.w; } }
            const f32x4 ps = *((const f32x4*)(p.in[I_POOLS] + l * 256) + lane);
#pragma unroll
            for (int i = 0; i < 8; ++i) { const f32x4 y = out[i] * ps; u32x2 w; w.x = cvt_pk_bf16(y.x, y.y); w.y = cvt_pk_bf16(y.z, y.w);
                *(u32x2*)(MC + (size_t)(t0 + tk0 + i) * KMIX + 1280 + 4 * lane) = w; }
        }
        {
            const float kg0 = p.in[I_KVNG][l * 128 + 2 * lane], kg1 = p.in[I_KVNG][l * 128 + 2 * lane + 1];
#pragma unroll
            for (int i = 0; i < 8; ++i) { const size_t t = (size_t)(t0 + tk0 + i); const bf16_t* zr = Z + t * NZ;
                const u32x2 q = *(const u32x2*)(zr + Z_CQ + 4 * lane); const float q0 = bflo(q.x), q1 = bfhi(q.x), q2 = bflo(q.y), q3 = bfhi(q.y);
                const float rq = 1.0f / sqrtf(wave_sum((q0 * q0 + q1 * q1) + (q2 * q2 + q3 * q3)) * (1.0f / 256.0f) + EPS);
                u32x2 w; w.x = cvt_pk_bf16(q0 * rq, q1 * rq); w.y = cvt_pk_bf16(q2 * rq, q3 * rq); *(u32x2*)(CQR + t * 256 + 4 * lane) = w;
                const unsigned kv = *(const unsigned*)(zr + Z_CKV + 2 * lane); const float k0 = bflo(kv), k1 = bfhi(kv);
                const float rk = 1.0f / sqrtf(wave_sum(k0 * k0 + k1 * k1) * (1.0f / 128.0f) + EPS);
                *(unsigned*)(KVN + t * 128 + 2 * lane) = cvt_pk_bf16(k0 * rk * kg0, k1 * rk * kg1); }
        }
        __syncthreads();
    }
}

__device__ __forceinline__ size_t sc_off(int b, int cq) { return (size_t)b * SC_PER_B + (size_t)2048 * cq * (cq + 1); }
__device__ __forceinline__ void ph_scores(const Params& p, const Ctx& c) {
    const bf16_t* Z = (const bf16_t*)(p.ws + WS_Z); float* SC = (float*)(p.ws + WS_Y);
    const int lane = c.lane, l15 = lane & 15, g = lane >> 4;
    for (int U = c.gw; U < NB * 576; U += c.NGW) {
        const int b = U / 576, u = U % 576;
        int cg = 0; while (8 * (cg + 1) * (cg + 2) <= u) ++cg;
        const int r = u - 8 * cg * (cg + 1), q16 = r / (cg + 1), seg = r % (cg + 1), cq = 4 * cg + (q16 >> 2), q4 = q16 & 3;
        const int n = 64 * (cq + 1), kt0 = seg * 16, kt1 = (kt0 + 16 < 4 * (cq + 1)) ? kt0 + 16 : 4 * (cq + 1);
        const size_t tq = (size_t)b * S + cq * 64 + q4 * 16 + l15;
        const bf16_t* zq = Z + tq * NZ;
        bf16x8 bq[8][2];
#pragma unroll
        for (int h = 0; h < 8; ++h)
#pragma unroll
            for (int s = 0; s < 2; ++s) bq[h][s] = *(const bf16x8*)(zq + Z_QI + h * 64 + 32 * s + 8 * g);
        float wq[8];
        { const u32x4 wv = *(const u32x4*)(zq + Z_WI); const float isc = 0.044194173824159216f;
          wq[0] = bflo(wv.x) * isc; wq[1] = bfhi(wv.x) * isc; wq[2] = bflo(wv.y) * isc; wq[3] = bfhi(wv.y) * isc; wq[4] = bflo(wv.z) * isc; wq[5] = bfhi(wv.z) * isc; wq[6] = bflo(wv.w) * isc; wq[7] = bfhi(wv.w) * isc; }
        float* srow = SC + sc_off(b, cq) + (size_t)(q4 * 16 + l15) * n;
        const bf16_t* zkb = Z + ((size_t)b * S + l15) * NZ + Z_KI + 8 * g;
        bf16x8 nk0 = *(const bf16x8*)(zkb + (size_t)kt0 * 16 * NZ), nk1 = *(const bf16x8*)(zkb + (size_t)kt0 * 16 * NZ + 32);
        for (int kt = kt0; kt < kt1; ++kt) {
            const bf16x8 ak0 = nk0, ak1 = nk1;
            if (kt + 1 < kt1) { nk0 = *(const bf16x8*)(zkb + (size_t)(kt + 1) * 16 * NZ); nk1 = *(const bf16x8*)(zkb + (size_t)(kt + 1) * 16 * NZ + 32); }
            f32x4 sc = {0.f, 0.f, 0.f, 0.f};
#pragma unroll
            for (int h = 0; h < 8; ++h) { f32x4 a = {0.f, 0.f, 0.f, 0.f};
                a = __builtin_amdgcn_mfma_f32_16x16x32_bf16(ak0, bq[h][0], a, 0, 0, 0);
                a = __builtin_amdgcn_mfma_f32_16x16x32_bf16(ak1, bq[h][1], a, 0, 0, 0);
#pragma unroll
                for (int i = 0; i < 4; ++i) sc[i] += wq[h] * fmaxf(a[i], 0.f); }
            *(f32x4*)(srow + kt * 16 + 4 * g) = sc;
        }
    }
}

__device__ __forceinline__ unsigned off_b(unsigned row, unsigned ch) { return 256u * row + 16u * (ch ^ (((row & 3) << 2) | ((row >> 2) & 3))); }
template <int MODE>
__device__ __forceinline__ void ph_attn(const Params& p, const Ctx& c) {
    const float* SC = (const float*)(p.ws + WS_Y); const bf16_t* QA = (const bf16_t*)(p.ws + WS_H); const bf16_t* KVN = (const bf16_t*)(p.ws + WS_KVN);
    bf16_t* MC = (bf16_t*)(p.ws + WS_MIXCAT);
    const int lane = c.lane, g = lane >> 4, hd = lane & 15;
    LAS unsigned char* tile = c.lds + c.wave * 16384;
    LAS unsigned short* lst = (LAS unsigned short*)(c.lds + LIST_OFF + c.wave * 512);
    const unsigned long long ltmask = (1ull << lane) - 1ull;
    const int xg = blockIdx.x & 7, wv = (blockIdx.x >> 3) * 8 + c.wave, nwv = (c.G >> 3) * 8;
    for (int qi = wv; qi < 2 * S; qi += nwv) {
        const int b = xg + 8 * (qi / S), s = qi % S, cq = s >> 6, n = 64 * (cq + 1), nk = n < 256 ? n : 256;
        const size_t t = (size_t)b * S + s;
        if (cq < 4 || !(MODE & 1)) { for (int i = lane; i < nk; i += 64) lst[i] = (unsigned short)i; }
        else {
            const float* srow = SC + sc_off(b, cq) + (size_t)(s & 63) * n;
            unsigned key[32]; unsigned kmin = 0xffffffffu, kmax = 0u;
            float sv[32];
#pragma unroll
            for (int j = 0; j < 32; ++j) sv[j] = srow[64 * (j <= cq ? j : cq) + lane];
#pragma unroll
            for (int j = 0; j < 32; ++j) key[j] = 0u;
#pragma unroll
            for (int jb = 0; jb < 4; ++jb) if (8 * jb <= cq) {
#pragma unroll
                for (int j = 8 * jb; j < 8 * jb + 8; ++j) { const unsigned u = __float_as_uint(sv[j] + 0.0f); const unsigned k = (u & 0x80000000u) ? ~u : (u | 0x80000000u);
                    key[j] = (j <= cq) ? k : 0u; kmin = (j <= cq && k < kmin) ? k : kmin; kmax = (j <= cq && k > kmax) ? k : kmax; } }
#pragma unroll
            for (int o = 1; o < 64; o <<= 1) { const unsigned a = __shfl_xor(kmin, o), bb = __shfl_xor(kmax, o); kmin = a < kmin ? a : kmin; kmax = bb > kmax ? bb : kmax; }
            unsigned lo = __builtin_amdgcn_readfirstlane(kmin), hi = __builtin_amdgcn_readfirstlane(kmax); int c_lo = n, c_hi = 0; int it = 0;
            unsigned thr = 0u; int need = 0; bool done = false;
            while (lo < hi && (c_lo - c_hi) > 64) {
                unsigned mid;
                if (it < 20) {
                    const float lo_v = __uint_as_float((lo & 0x80000000u) ? (lo ^ 0x80000000u) : ~lo), hi_v = __uint_as_float((hi & 0x80000000u) ? (hi ^ 0x80000000u) : ~hi);
                    const float f = (it & 1) ? 0.5f : (float)(c_lo - 256) / (float)(c_lo - c_hi);
                    const float mid_v = lo_v + (hi_v - lo_v) * f + 0.0f;
                    const unsigned mu = __float_as_uint(mid_v); mid = (mu & 0x80000000u) ? ~mu : (mu | 0x80000000u);
                } else mid = lo + ((hi - lo) >> 1) + 1u;
                mid = mid > lo ? mid : lo + 1u; mid = mid < hi ? mid : hi;
                int cnt = 0;
#pragma unroll
                for (int jb = 0; jb < 4; ++jb) if (8 * jb <= cq) {
                    unsigned long long bm[8];
#pragma unroll
                    for (int j = 0; j < 8; ++j) bm[j] = __ballot(key[8 * jb + j] >= mid);
#pragma unroll
                    for (int j = 0; j < 8; ++j) cnt += __builtin_popcountll(bm[j]); }
                if (cnt >= 256) { lo = mid; c_lo = cnt; if (cnt == 256) { thr = mid; need = 1 << 20; done = true; break; } } else { hi = mid - 1u; c_hi = cnt; }
                ++it;
            }
            if (!done) {
                if (lo == hi) {
                    thr = lo; int cgt = 0;
#pragma unroll
                    for (int j = 0; j < 32; ++j) cgt += __builtin_popcountll(__ballot(key[j] > thr));
                    need = 256 - cgt;
                } else {
                    LAS unsigned* cand = (LAS unsigned*)lst; int base = 0;
#pragma unroll
                    for (int jb = 0; jb < 4; ++jb) if (8 * jb <= cq) {
#pragma unroll
                        for (int j = 8 * jb; j < 8 * jb + 8; ++j) { const bool isc = key[j] >= lo && key[j] <= hi; const unsigned long long bc = __ballot(isc);
                            if (isc) cand[base + __builtin_popcountll(bc & ltmask)] = key[j]; base += __builtin_popcountll(bc); } }
                    const int m = base;
                    const unsigned ck = lane < m ? cand[lane] : 0u;
                    int gt = 0, ge = 0;
                    for (int q = 0; q < m; ++q) { const unsigned v = (unsigned)__builtin_amdgcn_readlane((int)ck, q); gt += v > ck; ge += v >= ck; }
                    const int r = 256 - c_hi;
                    const unsigned long long hit = __ballot(lane < m && gt < r && r <= ge);
                    const int src = __builtin_ctzll(hit);
                    thr = __shfl(ck, src); need = r - __shfl(gt, src);
                }
            }
            asm volatile("" ::: "memory");
            {
                int base = 0, tb = 0;
#pragma unroll
                for (int jb = 0; jb < 4; ++jb) if (8 * jb <= cq) {
#pragma unroll
                    for (int j = 8 * jb; j < 8 * jb + 8; ++j) {
                        const bool gt = key[j] > thr, tie = key[j] == thr; const unsigned long long bt = __ballot(tie);
                        const int trank = tb + __builtin_popcountll(bt & ltmask); const bool sel = gt || (tie && trank < need);
                        const unsigned long long bs = __ballot(sel); const int pos = base + __builtin_popcountll(bs & ltmask);
                        if (sel && pos < 256) lst[pos] = (unsigned short)(64 * j + lane);
                        base += __builtin_popcountll(bs); tb += __builtin_popcountll(bt); } }
            }
        }
        bf16x8 qf[4];
#pragma unroll
        for (int ks = 0; ks < 4; ++ks) { qf[ks] = (bf16x8){0, 0, 0, 0, 0, 0, 0, 0}; if (hd < 8) qf[ks] = *(const bf16x8*)(QA + t * D + hd * 128 + 32 * ks + 8 * g); }
        float m_ref = -INFINITY, l_run = 0.f;
        f32x4 o[8];
#pragma unroll
        for (int ct = 0; ct < 8; ++ct) o[ct] = (f32x4){0.f, 0.f, 0.f, 0.f};
        const char* kvb = (const char*)(KVN + (size_t)b * S * 128);
        const int ntile = nk >> 5;
        LDS_WAIT();
#define ATT_ISSUE(kt_, buf_) do { _Pragma("unroll") for (int i = 0; i < 8; ++i) { const int r = 4 * i + g; const unsigned key_ = lst[(kt_) * 32 + r]; \
            const unsigned ch = (unsigned)hd ^ (unsigned)(((r & 3) << 2) | ((r >> 2) & 3)); \
            if (MODE & 2) __builtin_amdgcn_global_load_lds((const unsigned*)(kvb + key_ * 256u + ch * 16u), (LAS unsigned*)(tile + (buf_) * 8192 + i * 1024), 16, 0, 0); } } while (0)
        ATT_ISSUE(0, 0);
        for (int kt = 0; kt < ntile; ++kt) {
            LAS unsigned char* tb_ = tile + (kt & 1) * 8192;
            if (kt + 1 < ntile) { ATT_ISSUE(kt + 1, (kt + 1) & 1); asm volatile("s_waitcnt vmcnt(8)" ::: "memory"); }
            else asm volatile("s_waitcnt vmcnt(0)" ::: "memory");
            if (!(MODE & 4)) continue;
            f32x4 sa[2];
#pragma unroll
            for (int rb = 0; rb < 2; ++rb) { sa[rb] = (f32x4){0.f, 0.f, 0.f, 0.f};
#pragma unroll
                for (int ks = 0; ks < 4; ++ks) { const bf16x8 a = *(const LAS bf16x8*)(tb_ + off_b(16 * rb + hd, 4 * ks + g)); sa[rb] = __builtin_amdgcn_mfma_f32_16x16x32_bf16(a, qf[ks], sa[rb], 0, 0, 0); } }
            float mx = fmaxf(fmaxf(fmaxf(sa[0][0], sa[0][1]), fmaxf(sa[0][2], sa[0][3])), fmaxf(fmaxf(sa[1][0], sa[1][1]), fmaxf(sa[1][2], sa[1][3])));
            mx = fmaxf(mx, __shfl_xor(mx, 16)); mx = fmaxf(mx, __shfl_xor(mx, 32));
            if (__ballot(mx > m_ref + 40.0f) != 0ull) {
                const float m_new = fmaxf(m_ref, mx), alpha = __builtin_amdgcn_exp2f(m_ref - m_new);
                l_run *= alpha; m_ref = m_new;
#pragma unroll
                for (int ct = 0; ct < 8; ++ct) o[ct] *= alpha;
            }
            float pr[8], ps = 0.f;
#pragma unroll
            for (int j = 0; j < 8; ++j) { pr[j] = __builtin_amdgcn_exp2f(sa[j >> 2][j & 3] - m_ref); ps += pr[j]; }
            l_run += ps;
            u32x4 pw; pw.x = cvt_pk_bf16(pr[0], pr[1]); pw.y = cvt_pk_bf16(pr[2], pr[3]); pw.z = cvt_pk_bf16(pr[4], pr[5]); pw.w = cvt_pk_bf16(pr[6], pr[7]);
            const bf16x8 pb = __builtin_bit_cast(bf16x8, pw);
            const unsigned q4 = (unsigned)hd >> 2, p4 = (unsigned)hd & 3;
#pragma unroll
            for (int ct = 0; ct < 8; ++ct) {
                const bf16x4 vlo = __builtin_amdgcn_ds_read_tr16_b64_v4i16((LAS bf16x4*)(tb_ + off_b(4 * g + q4, 2 * ct + (p4 >> 1)) + 8 * (p4 & 1)));
                const bf16x4 vhi = __builtin_amdgcn_ds_read_tr16_b64_v4i16((LAS bf16x4*)(tb_ + off_b(16 + 4 * g + q4, 2 * ct + (p4 >> 1)) + 8 * (p4 & 1)));
                const bf16x8 va = __builtin_shufflevector(vlo, vhi, 0, 1, 2, 3, 4, 5, 6, 7);
                o[ct] = __builtin_amdgcn_mfma_f32_16x16x32_bf16(va, pb, o[ct], 0, 0, 0);
            }
            LDS_WAIT();
        }
#undef ATT_ISSUE
        float lt = l_run + __shfl_xor(l_run, 16); lt += __shfl_xor(lt, 32);
        const float inv = 1.0f / lt;
        if (hd < 8 && ((MODE & 8) || lt == 12345.678f)) {
#pragma unroll
            for (int ct = 0; ct < 8; ++ct) { const f32x4 v = o[ct] * inv; u32x2 w; w.x = cvt_pk_bf16(v.x, v.y); w.y = cvt_pk_bf16(v.z, v.w);
                *(u32x2*)(MC + t * KMIX + 256 + hd * 128 + 16 * ct + 4 * g) = w; }
        }
    }
}

#ifndef RT_NT
#define RT_NT 2
#endif
__device__ __forceinline__ void ph_router(const Params& p, const Ctx& c, int l) {
    const float* mod = (const float*)(p.ws + WS_MOD); bf16_t* H = (bf16_t*)(p.ws + WS_H);
    int* toke = (int*)(p.ws + WS_SMALL + SM_TOKE); float* tokg = (float*)(p.ws + WS_SMALL + SM_TOKG); int* rank = (int*)(p.ws + WS_SMALL + SM_RANK); int* cnt = (int*)(p.ws + WS_SMALL + SM_CNT);
    LAS int* le = (LAS int*)c.lds; LAS int* wcnt = le + 256;
    const int lane = c.lane;
    for (int tile = c.vcu; tile < 256; tile += c.G) {
        constexpr int NT = RT_NT;
        const int b = (tile * 128) >> 11;
        const f32x4* ng = (const f32x4*)(p.in[I_N2G] + l * D) + lane;
        const f32x4* sh = (const f32x4*)(mod + (size_t)(l * NB + b) * 6144 + 3072) + lane; const f32x4* sc = (const f32x4*)(mod + (size_t)(l * NB + b) * 6144 + 4096) + lane;
        const f32x4* rg = (const f32x4*)(p.in[I_RGW] + (size_t)l * D * 4);
        f32x4 gm[4], sv[4];
#pragma unroll
        for (int j = 0; j < 4; ++j) { gm[j] = ng[64 * j] * (sc[64 * j] + 1.0f); sv[j] = sh[64 * j]; }
        f32x4 v[NT][4], vn[NT][4];
#pragma unroll
        for (int t = 0; t < NT; ++t)
#pragma unroll
            for (int j = 0; j < 4; ++j) vn[t][j] = ((const f32x4*)(p.out + (size_t)(tile * 128 + c.wave * 16 + t) * D) + lane)[64 * j];
        for (int i = 0; i < 16; i += NT) {
            const int tl0 = c.wave * 16 + i, m0 = tile * 128 + tl0;
            float ss[NT], r[NT], gl[NT][4];
#pragma unroll
            for (int t = 0; t < NT; ++t) { ss[t] = 0.f;
#pragma unroll
                for (int j = 0; j < 4; ++j) { v[t][j] = vn[t][j]; ss[t] += (v[t][j].x * v[t][j].x + v[t][j].y * v[t][j].y) + (v[t][j].z * v[t][j].z + v[t][j].w * v[t][j].w); } }
            if (i + NT < 16) {
#pragma unroll
                for (int t = 0; t < NT; ++t)
#pragma unroll
                    for (int j = 0; j < 4; ++j) vn[t][j] = ((const f32x4*)(p.out + (size_t)(m0 + NT + t) * D) + lane)[64 * j]; }
#pragma unroll
            for (int o = 1; o < 64; o <<= 1)
#pragma unroll
                for (int t = 0; t < NT; ++t) ss[t] += __shfl_xor(ss[t], o);
#pragma unroll
            for (int t = 0; t < NT; ++t) { r[t] = 1.0f / sqrtf(ss[t] * (1.0f / D) + EPS); gl[t][0] = gl[t][1] = gl[t][2] = gl[t][3] = 0.f; }
#pragma unroll
            for (int j = 0; j < 4; ++j) {
#pragma unroll
                for (int t = 0; t < NT; ++t) { v[t][j] = v[t][j] * r[t] * gm[j] + sv[j];
                    u32x2 w; w.x = cvt_pk_bf16(v[t][j].x, v[t][j].y); w.y = cvt_pk_bf16(v[t][j].z, v[t][j].w); ((u32x2*)(H + (size_t)(m0 + t) * D) + lane)[64 * j] = w; }
#pragma unroll
                for (int e = 0; e < 4; ++e) { const f32x4 wr = rg[4 * (lane + 64 * j) + e];
#pragma unroll
                    for (int t = 0; t < NT; ++t) { gl[t][0] += v[t][j][e] * wr.x; gl[t][1] += v[t][j][e] * wr.y; gl[t][2] += v[t][j][e] * wr.z; gl[t][3] += v[t][j][e] * wr.w; } } }
            const bool h32 = lane & 32, h16 = lane & 16, h8 = lane & 8;
            float dg[NT];
#pragma unroll
            for (int t = 0; t < NT; ++t) {
                const float c0 = (h16 ? gl[t][2] : gl[t][0]) + __shfl_xor(h16 ? gl[t][0] : gl[t][2], 16), c1 = (h16 ? gl[t][3] : gl[t][1]) + __shfl_xor(h16 ? gl[t][1] : gl[t][3], 16);
                float d = (h8 ? c1 : c0) + __shfl_xor(h8 ? c0 : c1, 8);
                d += __shfl_xor(d, 4); d += __shfl_xor(d, 2); d += __shfl_xor(d, 1); d += __shfl_xor(d, 32); dg[t] = d; }
            int gi[NT]; float gp[NT];
#pragma unroll
            for (int t = 0; t < NT; ++t) { float gq[4]; int g_ = 0; float gmax = -INFINITY;
#pragma unroll
                for (int q = 0; q < 4; ++q) { gq[q] = __shfl(dg[t], 8 * (q & 1) + 16 * (q >> 1)) + p.in[I_RGB][l * 4 + q]; if (gq[q] > gmax) { gmax = gq[q]; g_ = q; } }
                float gden = 0.f;
#pragma unroll
                for (int q = 0; q < 4; ++q) gden += __expf(gq[q] - gmax);
                gp[t] = 1.0f / gden; gi[t] = __builtin_amdgcn_readfirstlane(g_); }
            float el[NT][8];
#pragma unroll
            for (int t = 0; t < NT; ++t)
#pragma unroll
                for (int q = 0; q < 8; ++q) el[t][q] = 0.f;
#pragma unroll
            for (int j = 0; j < 4; ++j)
#pragma unroll
                for (int e = 0; e < 4; ++e)
#pragma unroll
                    for (int t = 0; t < NT; ++t) { const float* rr = (const float*)(p.ws + WS_SMALL + SM_REW2) + (size_t)(l * 4 + gi[t]) * 1024 * 8 + (size_t)(4 * (lane + 64 * j) + e) * 8;
                        const f32x4 w0 = *(const f32x4*)rr, w1 = *(const f32x4*)(rr + 4); const float hv = v[t][j][e];
                        el[t][0] += hv * w0.x; el[t][1] += hv * w0.y; el[t][2] += hv * w0.z; el[t][3] += hv * w0.w; el[t][4] += hv * w1.x; el[t][5] += hv * w1.y; el[t][6] += hv * w1.z; el[t][7] += hv * w1.w; }
            float de[NT];
#pragma unroll
            for (int t = 0; t < NT; ++t) {
                const float b0 = (h32 ? el[t][4] : el[t][0]) + __shfl_xor(h32 ? el[t][0] : el[t][4], 32), b1 = (h32 ? el[t][5] : el[t][1]) + __shfl_xor(h32 ? el[t][1] : el[t][5], 32);
                const float b2 = (h32 ? el[t][6] : el[t][2]) + __shfl_xor(h32 ? el[t][2] : el[t][6], 32), b3 = (h32 ? el[t][7] : el[t][3]) + __shfl_xor(h32 ? el[t][3] : el[t][7], 32);
                const float c0 = (h16 ? b2 : b0) + __shfl_xor(h16 ? b0 : b2, 16), c1 = (h16 ? b3 : b1) + __shfl_xor(h16 ? b1 : b3, 16);
                float d = (h8 ? c1 : c0) + __shfl_xor(h8 ? c0 : c1, 8);
                d += __shfl_xor(d, 4); d += __shfl_xor(d, 2); d += __shfl_xor(d, 1); de[t] = d; }
#pragma unroll
            for (int t = 0; t < NT; ++t) { float eq[8]; int e0 = 0, e1 = 0; float mx0 = -INFINITY, mx1 = -INFINITY;
#pragma unroll
                for (int q = 0; q < 8; ++q) { eq[q] = __shfl(de[t], 8 * (q & 1) + 16 * ((q >> 1) & 1) + 32 * (q >> 2)) + p.in[I_REB][l * 32 + gi[t] * 8 + q];
                    if (eq[q] > mx0) { mx1 = mx0; e1 = e0; mx0 = eq[q]; e0 = q; } else if (eq[q] > mx1) { mx1 = eq[q]; e1 = q; } }
                const float x1 = __expf(mx1 - mx0), den = 1.0f + x1; const int tl = tl0 + t, m = m0 + t;
                if (lane == 0) { le[2 * tl] = gi[t] * 8 + e0; le[2 * tl + 1] = gi[t] * 8 + e1; toke[2 * m] = gi[t] * 8 + e0; toke[2 * m + 1] = gi[t] * 8 + e1; tokg[2 * m] = gp[t] / den; tokg[2 * m + 1] = gp[t] * x1 / den; } }
        }
        __syncthreads();
        int myrank = 0, mye = 0;
        if (c.tid < 256) { mye = le[c.tid]; const unsigned long long ltmask = (1ull << lane) - 1ull;
            for (int ee = 0; ee < 32; ++ee) { const unsigned long long m = __ballot(mye == ee); if (mye == ee) myrank = __builtin_popcountll(m & ltmask); if (lane == 0) wcnt[c.wave * 32 + ee] = __builtin_popcountll(m); } }
        __syncthreads();
        if (c.tid < 256) { for (int w = 0; w < c.wave; ++w) myrank += wcnt[w * 32 + mye]; rank[tile * 256 + c.tid] = myrank; }
        if (c.tid < 32) cnt[tile * 32 + c.tid] = wcnt[c.tid] + wcnt[32 + c.tid] + wcnt[64 + c.tid] + wcnt[96 + c.tid];
        __syncthreads();
    }
}

__device__ __forceinline__ void ph_dispatch(const Params& p, const Ctx& c) {
    const int* toke = (const int*)(p.ws + WS_SMALL + SM_TOKE); const float* tokg = (const float*)(p.ws + WS_SMALL + SM_TOKG); const int* rank = (const int*)(p.ws + WS_SMALL + SM_RANK); const int* cnt = (const int*)(p.ws + WS_SMALL + SM_CNT);
    int* tslot = (int*)(p.ws + WS_SMALL + SM_TSLOT); int* stok = (int*)(p.ws + WS_SMALL + SM_STOK); float* sgate = (float*)(p.ws + WS_SMALL + SM_SGATE); int* texp = (int*)(p.ws + WS_SMALL + SM_TEXP);
    LAS int* tot = (LAS int*)c.lds; LAS int* pst = tot + 32; LAS int* bse = pst + 33;
    for (int tile = c.vcu; tile < 256; tile += c.G) {
        if (c.tid < 32) { int run = 0, mb = 0; for (int tl = 0; tl < 256; ++tl) { if (tl == tile) mb = run; run += cnt[tl * 32 + c.tid]; } tot[c.tid] = run; bse[c.tid] = mb; }
        __syncthreads();
        if (c.tid == 0) { int a = 0; for (int e = 0; e < 32; ++e) { pst[e] = a; a += ((tot[e] + 255) >> 8) << 8; } pst[32] = a; }
        __syncthreads();
        if (c.tid < 256) { const int a = tile * 256 + c.tid, e = toke[a], slot = pst[e] + bse[e] + rank[a]; stok[slot] = a >> 1; sgate[slot] = tokg[a]; tslot[a] = slot; }
        if (tile == 0) {
            for (int e = 0; e < 32; ++e) { const int pc = pst[e + 1] - pst[e]; for (int r = tot[e] + c.tid; r < pc; r += 512) { stok[pst[e] + r] = 0; sgate[pst[e] + r] = 0.f; } }
            const int ntl = pst[32] >> 8;
            for (int m = c.tid; m < ntl; m += 512) { int e = 0; while (pst[e + 1] <= (m << 8)) ++e; texp[m] = e; }
            if (c.tid == 0) texp[MAXTILES] = ntl;
        }
        __syncthreads();
    }
}

#ifndef PH_ONLY
#define PH_ONLY -1
#endif
#define IN(k) ((PH_ONLY < 0 || PH_ONLY == (k)) && lo <= (k) && (k) < hi)
#define SEAM(k) do { if (IN(k) && IN((k) + 1)) xcd_barrier(bar); } while (0)
#ifndef REP_MASK
#define REP_MASK 0
#endif
#define REP(id) (((REP_MASK) >> (id)) & 1)
#define BODY(id, cond, ...) do { __VA_ARGS__ if (REP(id) && (cond)) { xcd_barrier(bar); __VA_ARGS__ } } while (0)
template <int l>
__device__ __forceinline__ void run_layer(const Params& p, const Ctx& c, const XcdBarrier& bar, int lo, int hi) {
    bf16_t* Zb = (bf16_t*)(p.ws + WS_Z); bf16_t* Hb = (bf16_t*)(p.ws + WS_H); bf16_t* MCb = (bf16_t*)(p.ws + WS_MIXCAT);
    const float* mod = (const float*)(p.ws + WS_MOD);
    constexpr int P = 1 + 10 * l;
    if (IN(P)) { if (l == 0) { BODY(1, true, ph_norm1<0>(p, c);); } else { BODY(12, true, conv_experts(p, c, 1);); ph_norm1<1>(p, c); } }
    SEAM(P);
    if (IN(P + 1)) { BODY(2, true, { pg8::StaticOrder So; So.init(Hb, (bf16_t*)(p.ws + WS_WIN) + (size_t)l * NZ * D, T, NZ, D, c.G, (int)blockIdx.x);
        pg8::EpiBf16 E{Zb, NZ}; pg8::gemm_phase<pg8::EpiBf16, pg8::StaticOrder, false>(c.lds, So, E); }); }
    SEAM(P + 1);
    if (IN(P + 2)) { BODY(3, true, ph_postz(p, c, l);); }
    SEAM(P + 2);
    if (IN(P + 3)) { BODY(4, true, { pg8::StaticOrder So; So.init((bf16_t*)(p.ws + WS_CQR), (bf16_t*)(p.ws + WS_WQA) + (size_t)l * D * 256, T, D, 256, c.G, (int)blockIdx.x);
        pg8::EpiBf16 E{Hb, D}; pg8::gemm_phase<pg8::EpiBf16, pg8::StaticOrder, false>(c.lds, So, E); });
        BODY(5, true, ph_scores(p, c);); }
    SEAM(P + 3);
#ifndef ATT_PROBE
#define ATT_PROBE 0
#endif
    if (IN(P + 4)) { ph_attn<15>(p, c); if (ATT_PROBE) { xcd_barrier(bar); ph_attn<ATT_PROBE>(p, c); } }
    SEAM(P + 4);
    if (IN(P + 5)) { BODY(7, l == 0, { pg8::StaticOrder So; So.init(MCb, (bf16_t*)(p.ws + WS_WMIX) + (size_t)l * D * KMIX, T, D, KMIX, c.G, (int)blockIdx.x);
        pg8::EpiMix E{l == 0 ? p.in[I_X] : p.out, p.out, mod + (size_t)l * NB * 6144 + 2048}; pg8::gemm_phase<pg8::EpiMix, pg8::StaticOrder, false>(c.lds, So, E); }); }
    SEAM(P + 5);
    if (IN(P + 6)) { BODY(8, true, ph_router(p, c, l);); }
    SEAM(P + 6);
    if (IN(P + 7)) { BODY(9, true, ph_dispatch(p, c);); }
    SEAM(P + 7);
    if (IN(P + 8)) { BODY(10, true, { const int* texp = (const int*)(p.ws + WS_SMALL + SM_TEXP); const int ntl = texp[MAXTILES];
        pg8::MoeOrder Mo; Mo.init(Hb, p.ws + WS_W13, D, (size_t)1024 * 1024 * 2, (const int*)(p.ws + WS_SMALL + SM_STOK), texp, ntl, c.G, c.vcu);
        pg8::EpiAct E{Zb}; pg8::gemm_phase<pg8::EpiAct, pg8::MoeOrder, true>(c.lds, Mo, E); }); }
    SEAM(P + 8);
    if (IN(P + 9)) { BODY(11, true, { const int* texp = (const int*)(p.ws + WS_SMALL + SM_TEXP); const int ntl = texp[MAXTILES];
        pg8::MoeOrder Mo; Mo.init(Zb, p.ws + WS_W2, DEXP, (size_t)1024 * 512 * 2, nullptr, texp, ntl, c.G, c.vcu);
        pg8::EpiY E{(bf16_t*)(p.ws + WS_Y), (const float*)(p.ws + WS_SMALL + SM_SGATE)}; pg8::gemm_phase<pg8::EpiY, pg8::MoeOrder, false>(c.lds, Mo, E); }); }
    SEAM(P + 9);
}

__global__ void __launch_bounds__(512, 2) fwd(Params p) {
    extern __shared__ __attribute__((aligned(16))) unsigned char lds_raw[];
    Ctx c;
    c.lds = (LAS unsigned char*)lds_raw;
    c.tid = threadIdx.x; c.lane = c.tid & 63; c.wave = __builtin_amdgcn_readfirstlane(c.tid >> 6);
    c.G = gridDim.x; { const int bx = blockIdx.x; c.vcu = (c.G % 8 == 0) ? (bx % 8) * (c.G / 8) + bx / 8 : bx; }
    c.gw = c.vcu * 8 + c.wave; c.NGW = c.G * 8;
    volatile LAS unsigned* MISC = (volatile LAS unsigned*)(c.lds + MISC_OFF);
    if (c.tid < 64) MISC[c.tid] = 0u;
    __syncthreads();
    unsigned* ctl = (unsigned*)(p.ws + WS_CTL);
    XcdBarrier bar; bar.bar = ctl + CW_BAR; bar.x = 0; bar.st = nullptr;
    const bool multi = (p.ph_hi - p.ph_lo) > 1;
    if (multi) bar = xcd_barrier_post(ctl + CW_BAR, MISC + 8);
    const int lo = p.ph_lo, hi = p.ph_hi;
    if (IN(0)) { BODY(0, true, ph_prologue(p, c);); }
    SEAM(0);
    run_layer<0>(p, c, bar, lo, hi);
    run_layer<1>(p, c, bar, lo, hi);
    if (IN(21)) ph_norm1<2>(p, c);
#undef IN
#undef SEAM
}

extern "C" void kernel_launch(void* const* d_in, const int* in_sizes, int n_in, void* d_out, int out_size, void* d_ws, size_t ws_size, hipStream_t stream) {
    static int grid = 0;
    if (grid == 0) {
        if (n_in != 27 || out_size != T * D || ws_size < WS_END) { fprintf(stderr, "kernel_launch: unexpected shapes (n_in %d out %d ws %zu, need %zu)\n", n_in, out_size, ws_size, (size_t)WS_END); grid = -1; return; }
        int dev = 0, cus = 0, per_cu = 0;
        if (hipGetDevice(&dev) != hipSuccess || hipDeviceGetAttribute(&cus, hipDeviceAttributeMultiprocessorCount, dev) != hipSuccess) { grid = -1; return; }
        if (hipFuncSetAttribute((const void*)fwd, hipFuncAttributeMaxDynamicSharedMemorySize, LDS_BYTES) != hipSuccess) { fprintf(stderr, "kernel_launch: hipFuncSetAttribute failed\n"); grid = -1; return; }
        if (hipOccupancyMaxActiveBlocksPerMultiprocessor(&per_cu, (const void*)fwd, 512, LDS_BYTES) != hipSuccess || per_cu < 1) { fprintf(stderr, "kernel_launch: occupancy query says %d blocks per CU\n", per_cu); grid = -1; return; }
        (void)hipGetLastError();
        grid = cus;
        if (grid % 8 != 0 || grid > 256) grid = (grid / 8) * 8 > 256 ? 256 : (grid / 8) * 8;
    }
    if (grid <= 0) return;
    (void)hipMemsetAsync((char*)d_ws + WS_CTL, 0, CTL_ZERO_BYTES, stream);
    Params p{};
    for (int i = 0; i < 27; ++i) p.in[i] = (const float*)d_in[i];
    p.out = (float*)d_out; p.ws = (unsigned char*)d_ws;
#if MK_SPLIT
    for (int ph = 0; ph < NPHASE; ++ph) { p.ph_lo = ph; p.ph_hi = ph + 1; hipLaunchKernelGGL(fwd, dim3(grid), dim3(512), LDS_BYTES, stream, p); }
#else
    p.ph_lo = 0; p.ph_hi = NPHASE;
    hipLaunchKernelGGL(fwd, dim3(grid), dim3(512), LDS_BYTES, stream, p);
#endif
}
```

```cpp
#include <hip/hip_runtime.h>
#include <cstdio>
#include <cstdint>

#ifndef MK_SPLIT
#define MK_SPLIT 0
#endif

#define LAS __attribute__((address_space(3)))
typedef unsigned short bf16_t;
typedef short bf16x8 __attribute__((ext_vector_type(8)));
typedef short bf16x4 __attribute__((ext_vector_type(4)));
typedef float f32x4 __attribute__((ext_vector_type(4)));
typedef float f32x16 __attribute__((ext_vector_type(16)));
typedef unsigned u32x4 __attribute__((ext_vector_type(4)));
typedef unsigned u32x2 __attribute__((ext_vector_type(2)));

constexpr int D = 1024, NB = 16, S = 2048, T = NB * S, DEPTH = 2;
constexpr int NZ = 1792;
constexpr int N_IN = 1736;
constexpr int Z_AVAL = 0, Z_AGATE = 256, Z_CQ = 512, Z_CKV = 768, Z_QI = 896, Z_KI = 1408, Z_WI = 1472, Z_UP = 1480;
constexpr int KMIX = 1536;
constexpr int NEXP = 32, DEXP = 512, MAXTILES = 288, PMAX = MAXTILES * 256;
constexpr float EPS = 1e-6f;
constexpr int SC_PER_B = 4096 * 528;

constexpr size_t MiB = 1u << 20;
constexpr size_t WS_CTL = 0, CTL_ZERO_BYTES = 64 * 1024;
constexpr size_t WS_MOD = 1 * MiB;
constexpr size_t WS_WIN = 2 * MiB;
constexpr size_t WS_WQA = 9 * MiB;
constexpr size_t WS_WMIX = 10 * MiB;
constexpr size_t WS_SMALL = 16 * MiB;
constexpr size_t WS_W13 = 20 * MiB;
constexpr size_t WS_W2 = 84 * MiB;
constexpr size_t WS_Z = 116 * MiB;
constexpr size_t WS_MIXCAT = 228 * MiB;
constexpr size_t WS_H = 324 * MiB;
constexpr size_t WS_CQR = 388 * MiB;
constexpr size_t WS_KVN = 404 * MiB;
constexpr size_t WS_Y = 412 * MiB;
constexpr size_t WS_END = 556 * MiB;
constexpr size_t SM_TOKE = 0;
constexpr size_t SM_TOKG = 256 * 1024;
constexpr size_t SM_RANK = 512 * 1024;
constexpr size_t SM_TSLOT = 768 * 1024;
constexpr size_t SM_STOK = 1024 * 1024;
constexpr size_t SM_SGATE = 1024 * 1024 + 512 * 1024;
constexpr size_t SM_CNT = 2 * 1024 * 1024;
constexpr size_t SM_TEXP = 2 * 1024 * 1024 + 64 * 1024;
constexpr size_t SM_REW2 = 2 * 1024 * 1024 + 512 * 1024;
constexpr size_t SM_RGW2 = 3 * 1024 * 1024;
constexpr int CW_BAR = 1024;

constexpr int LDS_BYTES = 139264;
constexpr int LIST_OFF = 131072;
constexpr int MISC_OFF = 138240;
constexpr int NPHASE = 22;

__device__ __forceinline__ unsigned cvt_pk_bf16(float lo, float hi) { unsigned r; asm volatile("v_cvt_pk_bf16_f32 %0, %1, %2" : "=v"(r) : "v"(lo), "v"(hi)); return r; }
__device__ __forceinline__ float bf2f(unsigned short b) { return __uint_as_float(((unsigned)b) << 16); }
__device__ __forceinline__ float bflo(unsigned w) { return __uint_as_float(w << 16); }
__device__ __forceinline__ float bfhi(unsigned w) { return __uint_as_float(w & 0xffff0000u); }
__device__ __forceinline__ float wave_sum(float v) {
#pragma unroll
    for (int o = 1; o < 64; o <<= 1) v += __shfl_xor(v, o);
    return v;
}
__device__ __forceinline__ float sigmoidf_(float x) { return 1.0f / (1.0f + __expf(-x)); }
#define LDS_WAIT() asm volatile("s_waitcnt lgkmcnt(0)" ::: "memory")
#define VM_WAIT() asm volatile("s_waitcnt vmcnt(0)" ::: "memory")

#define XB_TMO      128
#define XB_XCNT(j)  (256  + 64 * (j))
#define XB_XSUB(j)  (1280 + 64 * (j))
#define XB_XGEN(j)  (2304 + 64 * (j))
#define XB_TOP      3328
#define XB_TOPGEN   3392
#define XCD_BAR_WORDS 3456
#define XB_SPIN_CAP (1u << 22)

__device__ __forceinline__ unsigned xb_ld(unsigned* p)              { return __hip_atomic_load(p, __ATOMIC_RELAXED, __HIP_MEMORY_SCOPE_AGENT); }
__device__ __forceinline__ unsigned xb_add(unsigned* p, unsigned v) { return __hip_atomic_fetch_add(p, v, __ATOMIC_RELAXED, __HIP_MEMORY_SCOPE_AGENT); }
__device__ __forceinline__ unsigned xb_xcc_id() { return (unsigned)__builtin_amdgcn_s_getreg((3 << 11) | 20) & 0xFu; }
#define XB_SPIN(cond, bar) do { unsigned _sp = 0; while (cond) { __builtin_amdgcn_s_sleep(1); \
    if ((++_sp & 255u) == 0u) { if (xb_ld(&(bar)[XB_TMO])) break; if (_sp > XB_SPIN_CAP) { atomicAdd(&(bar)[XB_TMO], 1u); break; } } } } while (0)

struct XcdBarrier {
    unsigned* bar; unsigned x;
    volatile LAS unsigned* st;
};
__device__ __forceinline__ XcdBarrier xcd_barrier_post(unsigned* bar, volatile LAS unsigned* st) {
    XcdBarrier b; b.bar = bar; b.x = xb_xcc_id(); b.st = st;
    if (threadIdx.x == 0) (void)xb_add(&bar[XB_XCNT(b.x)], 1u);
    return b;
}
__device__ __forceinline__ void xcd_barrier_complete(unsigned* bar, unsigned x, unsigned& nloc, unsigned& nx) {
    const unsigned G = gridDim.x * gridDim.y * gridDim.z;
    unsigned sum, cnt, mine, sp = 0u;
    for (;;) {
        sum = 0u; cnt = 0u; mine = 0u;
#pragma unroll
        for (unsigned j = 0; j < 16; ++j) { const unsigned c = xb_ld(&bar[XB_XCNT(j)]); sum += c; cnt += (c > 0u) ? 1u : 0u; mine = (j == x) ? c : mine; }
        if (sum == G) break;
        __builtin_amdgcn_s_sleep(1);
        if ((++sp & 255u) == 0u) { if (xb_ld(&bar[XB_TMO])) break; if (sp > XB_SPIN_CAP) { atomicAdd(&bar[XB_TMO], 1u); break; } }
    }
    nloc = mine > 0u ? mine : 1u; nx = cnt > 0u ? cnt : 1u;
}
__device__ __forceinline__ void xcd_barrier(const XcdBarrier& b) {
    asm volatile("s_waitcnt vmcnt(0)" ::: "memory");
    __syncthreads();
    if (threadIdx.x == 0) {
        unsigned* bar = b.bar;
        __builtin_amdgcn_s_waitcnt(0);
        unsigned nloc = b.st[0], nx = b.st[1];
        if (nloc == 0u) { xcd_barrier_complete(bar, b.x, nloc, nx); b.st[0] = nloc; b.st[1] = nx; }
        const unsigned old = xb_add(&bar[XB_XSUB(b.x)], 1u);
        const unsigned gen = old / nloc;
        if (old + 1u == (gen + 1u) * nloc) {
            __builtin_amdgcn_fence(__ATOMIC_RELEASE, "agent");
            asm volatile("s_waitcnt vmcnt(0)" ::: "memory");
            const unsigned og = xb_add(&bar[XB_TOP], 1u);
            const unsigned tg = og / nx;
            if (og + 1u == (tg + 1u) * nx) xb_add(&bar[XB_TOPGEN], 1u);
            else XB_SPIN(xb_ld(&bar[XB_TOPGEN]) == tg, bar);
            __builtin_amdgcn_fence(__ATOMIC_ACQUIRE, "agent");
            xb_add(&bar[XB_XGEN(b.x)], 1u);
            asm volatile("s_waitcnt vmcnt(0)" ::: "memory");
        } else {
            XB_SPIN(xb_ld(&bar[XB_XGEN(b.x)]) == gen, bar);
            __builtin_amdgcn_fence(__ATOMIC_ACQUIRE, "agent");
            asm volatile("s_waitcnt vmcnt(0)" ::: "memory");
        }
    }
    __syncthreads();
}

namespace pg8 {
constexpr int BM = 256, BK = 64, HALF = 128, HTB = HALF * BK * 2  , STAGE_BYTES = 8 * HTB, NXCD = 8, WGM = 8;
__host__ __device__ __forceinline__ int lds_byte(int r, int c) { const int st = (r >> 4) * 2 + (c >> 5), rr = r & 15, cc = c & 31, ob = rr * 64 + cc * 2; return st * 1024 + (ob ^ (((ob >> 9) & 1) << 5)); }
__host__ __device__ __forceinline__ void stage_rc(int b, int& R, int& C) { const int st = b / 1024, sb = b % 1024, swz = sb ^ (((sb >> 9) & 1) << 5); R = (st >> 1) * 16 + swz / 64; C = (st & 1) * 32 + (swz % 64) / 2; }
__host__ __device__ __forceinline__ int perm32(int rho) { const int n = rho >> 4, i = rho & 15; return 8 * (i >> 2) + 4 * n + (i & 3); }

struct Unit { int pm, pn; const char* a; const char* b; };

struct StaticOrder {
    const char* A; const char* Bt; int K; const int* rowidx;
    int nM, nN, nwg, G, c;
    __device__ void init(const void* A_, const void* Bt_, int M, int N, int K_, int G_, int c_) { A = (const char*)A_; Bt = (const char*)Bt_; K = K_; rowidx = nullptr; nM = M / BM; nN = N / BM; nwg = nM * nN; G = G_; c = c_; }
    __device__ __forceinline__ bool next(int i, Unit& u) const {
        const long L = (long)i * G + c; if (L >= nwg) return false;
        int wgid = (int)L; { const int q = nwg / NXCD, r = nwg % NXCD, xcd = wgid % NXCD, off = wgid / NXCD; wgid = (xcd < r ? xcd * (q + 1) : r * (q + 1) + (xcd - r) * q) + off; }
        const int nig = WGM * nN, gid = wgid / nig, fm = gid * WGM, gsz = (nM - fm) < WGM ? (nM - fm) : WGM;
        u.pm = fm + ((wgid % nig) % gsz); u.pn = (wgid % nig) / gsz;
        u.a = A + (size_t)u.pm * BM * K * 2; u.b = Bt + (size_t)u.pn * BM * K * 2; return true;
    }
};
struct MoeOrder {
    const char* A; const char* Bt; int K; const int* rowidx;
    const int* tile_exp; int nunits, G, c; size_t bstride;
    __device__ void init(const void* A_, const void* Bt_, int K_, size_t bstride_, const int* rowidx_, const int* tile_exp_, int ntiles, int G_, int c_) {
        A = (const char*)A_; Bt = (const char*)Bt_; K = K_; bstride = bstride_; rowidx = rowidx_; tile_exp = tile_exp_; nunits = ntiles * 4; G = G_; c = c_; }
    __device__ __forceinline__ bool next(int i, Unit& u) const {
        const int L = i * G + c; if (L >= nunits) return false;
        u.pm = L >> 2; u.pn = L & 3; const int e = tile_exp[u.pm];
        u.a = A + (size_t)u.pm * BM * K * 2; u.b = Bt + (size_t)e * bstride + (size_t)u.pn * BM * K * 2; return true;
    }
};

struct EpiBf16 {
    static constexpr bool PERM = true;
    bf16_t* O; int ldc;
    __device__ __forceinline__ void operator()(const f32x4 (&acc)[2][2][4][2], const Unit& u, int wr, int wc, int fr, int fq) const {
        const int row0 = u.pm * BM + wr * 64 + fr, col0 = u.pn * BM + wc * 32 + 8 * fq;
#pragma unroll
        for (int ai = 0; ai < 2; ++ai)
#pragma unroll
            for (int m = 0; m < 4; ++m) { bf16_t* rowp = O + (size_t)(row0 + ai * HALF + m * 16) * ldc + col0;
#pragma unroll
                for (int bj = 0; bj < 2; ++bj) { const f32x4 v0 = acc[ai][bj][m][0], v1 = acc[ai][bj][m][1];
                    u32x4 w; w.x = cvt_pk_bf16(v0[0], v0[1]); w.y = cvt_pk_bf16(v0[2], v0[3]); w.z = cvt_pk_bf16(v1[0], v1[1]); w.w = cvt_pk_bf16(v1[2], v1[3]);
                    *(u32x4*)(rowp + bj * HALF) = w; } }
    }
};
struct EpiMix {
    static constexpr bool PERM = false;
    const float* xin; float* out; const float* gate;
    __device__ __forceinline__ void operator()(const f32x4 (&acc)[2][2][4][2], const Unit& u, int wr, int wc, int fr, int fq) const {
        const int row0 = u.pm * BM + wr * 64 + fr, col0 = u.pn * BM + wc * 32 + 4 * fq;
        const float* gp = gate + (size_t)(u.pm >> 3) * 6144 + col0;
        f32x4 gv[2][2];
#pragma unroll
        for (int bj = 0; bj < 2; ++bj)
#pragma unroll
            for (int n = 0; n < 2; ++n) gv[bj][n] = *(const f32x4*)(gp + bj * HALF + n * 16);
#pragma unroll
        for (int ai = 0; ai < 2; ++ai)
#pragma unroll
            for (int m = 0; m < 4; ++m) { const size_t off = (size_t)(row0 + ai * HALF + m * 16) * D + col0;
#pragma unroll
                for (int bj = 0; bj < 2; ++bj)
#pragma unroll
                    for (int n = 0; n < 2; ++n) { const f32x4 xv = *(const f32x4*)(xin + off + bj * HALF + n * 16);
                        *(f32x4*)(out + off + bj * HALF + n * 16) = xv + gv[bj][n] * acc[ai][bj][m][n]; } }
    }
};
struct EpiAct {
    static constexpr bool PERM = true;
    bf16_t* O;
    __device__ __forceinline__ void operator()(const f32x4 (&acc)[2][2][4][2], const Unit& u, int wr, int wc, int fr, int fq) const {
        const int row0 = u.pm * BM + wr * 64 + fr, col0 = u.pn * 128 + wc * 16 + 4 * fq;
#pragma unroll
        for (int ai = 0; ai < 2; ++ai)
#pragma unroll
            for (int m = 0; m < 4; ++m) { bf16_t* rowp = O + (size_t)(row0 + ai * HALF + m * 16) * DEXP + col0;
#pragma unroll
                for (int bj = 0; bj < 2; ++bj) { const f32x4 a = acc[ai][bj][m][0], b = acc[ai][bj][m][1]; f32x4 r;
#pragma unroll
                    for (int j = 0; j < 4; ++j) r[j] = a[j] * b[j] * __builtin_amdgcn_rcpf(1.0f + __expf(-a[j]));
                    u32x2 w; w.x = cvt_pk_bf16(r[0], r[1]); w.y = cvt_pk_bf16(r[2], r[3]);
                    *(u32x2*)(rowp + bj * 64) = w; } }
    }
};
struct EpiY {
    static constexpr bool PERM = true;
    bf16_t* O; const float* sgate;
    __device__ __forceinline__ void operator()(const f32x4 (&acc)[2][2][4][2], const Unit& u, int wr, int wc, int fr, int fq) const {
        const int row0 = u.pm * BM + wr * 64 + fr, col0 = u.pn * BM + wc * 32 + 8 * fq;
#pragma unroll
        for (int ai = 0; ai < 2; ++ai)
#pragma unroll
            for (int m = 0; m < 4; ++m) { const int row = row0 + ai * HALF + m * 16; const float g = sgate[row]; bf16_t* rowp = O + (size_t)row * D + col0;
#pragma unroll
                for (int bj = 0; bj < 2; ++bj) { const f32x4 v0 = acc[ai][bj][m][0] * g, v1 = acc[ai][bj][m][1] * g;
                    u32x4 w; w.x = cvt_pk_bf16(v0[0], v0[1]); w.y = cvt_pk_bf16(v0[2], v0[3]); w.z = cvt_pk_bf16(v1[0], v1[1]); w.w = cvt_pk_bf16(v1[2], v1[3]);
                    *(u32x4*)(rowp + bj * HALF) = w; } }
    }
};

template <class Epi, class Sched, bool GATHER>
__device__ __forceinline__ void gemm_phase(LAS unsigned char* lds, const Sched& S, const Epi& E) {
    const int tid = threadIdx.x, wid = __builtin_amdgcn_readfirstlane(tid >> 6), lane = tid & 63, wr = wid >> 2, wc = wid & 3, fr = lane & 15, fq = lane >> 4;
    const int K = S.K, nt = K / BK;
    unsigned voffA[2], voffB[2]; int RA[2], CA[2];
#pragma unroll
    for (int i = 0; i < 2; ++i) { int R, C; stage_rc(tid * 16 + i * 8192, R, C); const int Rb = Epi::PERM ? ((R & ~31) + perm32(R & 31)) : R;
        RA[i] = R; CA[i] = C; voffA[i] = (unsigned)(R * K + C) * 2u; voffB[i] = (unsigned)(Rb * K + C) * 2u; }
    const size_t kstep = (size_t)(BK * 2);
    const size_t hstep = (size_t)HALF * K * 2;
    const unsigned ldsw = (unsigned)wid * 1024u;
    const int aoff = lds_byte(wr * 64 + fr, fq * 8), boff = lds_byte(wc * 32 + fr, fq * 8);
#define PG8_SA(b, h) (((b) * 2 + (h)) * HTB)
#define PG8_SB(b, h) ((4 + (b) * 2 + (h)) * HTB)
#define PG8_DMA(bufoff, gptr, i) __builtin_amdgcn_global_load_lds((const unsigned*)(gptr), (LAS unsigned*)(lds + (bufoff) + ldsw + (i) * 8192), 16, 0, 0)
#define PG8_STAGE(bufoff, gbase, voff) do { PG8_DMA(bufoff, (const char*)(gbase) + (voff)[0], 0); PG8_DMA(bufoff, (const char*)(gbase) + (voff)[1], 1); } while (0)
#define PG8_STAGE_A(bufoff, nx, h, kb) do { if constexpr (GATHER) { \
            PG8_DMA(bufoff, S.A + (kb) + ((nx) ? gN[h][0] : gC[h][0]), 0); PG8_DMA(bufoff, S.A + (kb) + ((nx) ? gN[h][1] : gC[h][1]), 1); } \
        else { const char* _b = ((nx) ? nA : cA) + (h) * hstep + (kb); PG8_DMA(bufoff, _b + voffA[0], 0); PG8_DMA(bufoff, _b + voffA[1], 1); } } while (0)
#define PG8_LDA(dst, b, h) do { _Pragma("unroll") for (int m = 0; m < 4; ++m) _Pragma("unroll") for (int k = 0; k < 2; ++k) dst[m][k] = *(const LAS bf16x8*)(lds + PG8_SA(b, h) + aoff + m * 2048 + k * 1024); } while (0)
#define PG8_LDB(dst, b, h) do { _Pragma("unroll") for (int n = 0; n < 2; ++n) _Pragma("unroll") for (int k = 0; k < 2; ++k) dst[n][k] = *(const LAS bf16x8*)(lds + PG8_SB(b, h) + boff + n * 2048 + k * 1024); } while (0)
#define PG8_MMA(ai, bj, At, Bt) do { __builtin_amdgcn_s_setprio(1); _Pragma("unroll") for (int m = 0; m < 4; ++m) _Pragma("unroll") for (int n = 0; n < 2; ++n) _Pragma("unroll") for (int k = 0; k < 2; ++k) \
        acc[ai][bj][m][n] = __builtin_amdgcn_mfma_f32_16x16x32_bf16(Bt[n][k], At[m][k], acc[ai][bj][m][n], 0, 0, 0); __builtin_amdgcn_s_setprio(0); } while (0)
#define PG8_WAIT_V(n) asm volatile("s_waitcnt vmcnt(" #n ")" ::: "memory")
#define PG8_WAIT_L(n) asm volatile("s_waitcnt lgkmcnt(" #n ")" ::: "memory")
#define PG8_BAR __builtin_amdgcn_s_barrier()
#define PG8_SCHED __builtin_amdgcn_sched_barrier(0)
    Unit cur, nxt; int ui = 0;
    if (!S.next(0, cur)) return;
    unsigned gC[2][2] = {{0u, 0u}, {0u, 0u}}, gN[2][2] = {{0u, 0u}, {0u, 0u}};
    if constexpr (GATHER) {
#pragma unroll
        for (int h = 0; h < 2; ++h)
#pragma unroll
            for (int i = 0; i < 2; ++i) gC[h][i] = (unsigned)(S.rowidx[cur.pm * BM + h * HALF + RA[i]] * K + CA[i]) * 2u;
    }
    f32x4 acc[2][2][4][2];
#pragma unroll
    for (int a = 0; a < 2; ++a)
#pragma unroll
        for (int b = 0; b < 2; ++b)
#pragma unroll
            for (int m = 0; m < 4; ++m)
#pragma unroll
                for (int n = 0; n < 2; ++n) acc[a][b][m][n] = (f32x4){0.f, 0.f, 0.f, 0.f};
    bf16x8 At[4][2], B0[2][2], B1[2][2];
    const char* cA = cur.a; const char* cB = cur.b; const char* nA = cA; const char* nB = cB;
    PG8_STAGE(PG8_SB(0, 0), cB, voffB); PG8_STAGE(PG8_SB(0, 1), cB + hstep, voffB); PG8_STAGE_A(PG8_SA(0, 0), false, 0, 0); PG8_STAGE_A(PG8_SA(0, 1), false, 1, 0);
    if (wr == 1) PG8_BAR;
    PG8_WAIT_V(2); PG8_BAR;
    PG8_STAGE(PG8_SB(1, 0), cB + kstep, voffB); PG8_STAGE_A(PG8_SA(1, 0), false, 0, kstep); PG8_STAGE(PG8_SB(1, 1), cB + hstep + kstep, voffB);
    PG8_WAIT_V(6); PG8_BAR;
    for (;;) {
        const bool has_next = S.next(ui + 1, nxt);
        nA = has_next ? nxt.a : cA; nB = has_next ? nxt.b : cB;
        if constexpr (GATHER) {
            const int npm = has_next ? nxt.pm : cur.pm;
#pragma unroll
            for (int h = 0; h < 2; ++h)
#pragma unroll
                for (int i = 0; i < 2; ++i) gN[h][i] = (unsigned)(S.rowidx[npm * BM + h * HALF + RA[i]] * K + CA[i]) * 2u;
        }
        for (int t = 0; t < nt; t += 2) {
            const bool last = (t == nt - 2);
            const size_t k1 = (size_t)(t + 1) * kstep;
            const size_t k2 = last ? 0 : (size_t)(t + 2) * kstep, k3 = k2 + kstep;
            const char* b2 = (last ? nB : cB) + k2; const char* b3 = b2 + kstep;
            PG8_LDB(B0, 0, 0); PG8_LDB(B1, 0, 1); PG8_SCHED; PG8_LDA(At, 0, 0); PG8_STAGE_A(PG8_SA(1, 1), false, 1, k1);
            PG8_WAIT_V(8); PG8_WAIT_L(0); PG8_BAR; PG8_MMA(0, 0, At, B0); PG8_MMA(0, 1, At, B1); PG8_BAR; PG8_SCHED;
            PG8_LDA(At, 0, 1); PG8_STAGE(PG8_SB(0, 0), b2, voffB); PG8_STAGE(PG8_SB(0, 1), b2 + hstep, voffB); PG8_STAGE_A(PG8_SA(0, 0), last, 0, k2);
            PG8_WAIT_V(8); PG8_WAIT_L(0); PG8_BAR; PG8_MMA(1, 0, At, B0); PG8_MMA(1, 1, At, B1); PG8_BAR; PG8_SCHED;
            PG8_LDB(B0, 1, 0); PG8_LDB(B1, 1, 1); PG8_SCHED; PG8_LDA(At, 1, 0); PG8_STAGE_A(PG8_SA(0, 1), last, 1, k2);
            PG8_WAIT_V(8); PG8_WAIT_L(0); PG8_BAR; PG8_MMA(0, 0, At, B0); PG8_MMA(0, 1, At, B1); PG8_BAR; PG8_SCHED;
            PG8_LDA(At, 1, 1); PG8_STAGE(PG8_SB(1, 0), b3, voffB); PG8_STAGE(PG8_SB(1, 1), b3 + hstep, voffB); PG8_STAGE_A(PG8_SA(1, 0), last, 0, k3);
            PG8_WAIT_V(8); PG8_WAIT_L(0); PG8_BAR; PG8_MMA(1, 0, At, B0); PG8_MMA(1, 1, At, B1); PG8_BAR; PG8_SCHED;
        }
        if (wr == 0) PG8_BAR;
        E(acc, cur, wr, wc, fr, fq);
        if (!has_next) break;
#pragma unroll
        for (int a = 0; a < 2; ++a)
#pragma unroll
            for (int b = 0; b < 2; ++b)
#pragma unroll
                for (int m = 0; m < 4; ++m)
#pragma unroll
                    for (int n = 0; n < 2; ++n) acc[a][b][m][n] = (f32x4){0.f, 0.f, 0.f, 0.f};
        cur = nxt; cA = nA; cB = nB; ++ui;
        if constexpr (GATHER) {
#pragma unroll
            for (int h = 0; h < 2; ++h)
#pragma unroll
                for (int i = 0; i < 2; ++i) gC[h][i] = gN[h][i];
        }
        if (wr == 1) PG8_BAR;
    }
    PG8_WAIT_V(0);
    PG8_BAR;
#undef PG8_SA
#undef PG8_SB
#undef PG8_DMA
#undef PG8_STAGE
#undef PG8_STAGE_A
#undef PG8_LDA
#undef PG8_LDB
#undef PG8_MMA
#undef PG8_WAIT_V
#undef PG8_WAIT_L
#undef PG8_BAR
#undef PG8_SCHED
}
}

struct Params { const float* in[27]; float* out; unsigned char* ws; int ph_lo, ph_hi; };
struct Ctx { LAS unsigned char* lds; int tid, lane, wave, vcu, G, gw, NGW; };
enum { I_X = 0, I_C, I_MODW, I_MODB, I_N1G, I_WIN, I_CONVK, I_CONVB, I_CLNG, I_CLNB, I_QNG, I_KVNG, I_WUQ, I_WUK, I_WUV, I_POOLW, I_POOLS, I_WOUT, I_N2G, I_RGW, I_RGB, I_REW, I_REB, I_W1, I_W3, I_W2, I_FG };

template <class RowMap>
__device__ __forceinline__ void tr_item(const float* src, int ldn, int k0, int n0, int nvalid, bf16_t* dst, int ldk, int dk0, RowMap rm, LAS float* scr, int lane) {
#pragma unroll 8
    for (int i = 0; i < 32; ++i) { const int kk = 2 * i + (lane >> 5), n = n0 + (lane & 31); scr[kk * 33 + (lane & 31)] = (n < nvalid) ? src[(size_t)(k0 + kk) * ldn + n] : 0.f; }
    LDS_WAIT();
    const int c = lane & 7;
#pragma unroll
    for (int j = 0; j < 4; ++j) { const int n = (lane >> 3) + 8 * j; const LAS float* s = scr + (8 * c) * 33 + n;
        u32x4 o; o.x = cvt_pk_bf16(s[0 * 33], s[1 * 33]); o.y = cvt_pk_bf16(s[2 * 33], s[3 * 33]); o.z = cvt_pk_bf16(s[4 * 33], s[5 * 33]); o.w = cvt_pk_bf16(s[6 * 33], s[7 * 33]);
        *(u32x4*)(dst + (size_t)rm(n0 + n) * ldk + dk0 + k0 + 8 * c) = o; }
    LDS_WAIT();
}

__device__ __forceinline__ void conv_experts(const Params& p, const Ctx& c, int l) {
    LAS float* scr = (LAS float*)(c.lds + c.wave * 8448);
    bf16_t* W13 = (bf16_t*)(p.ws + WS_W13); bf16_t* W2 = (bf16_t*)(p.ws + WS_W2);
    for (int it = c.gw; it < 3 * 8192; it += c.NGW) {
        const int which = it >> 13, r = it & 8191, e = r >> 8;
        if (which < 2) { const int kb = (r >> 4) & 15, nb = r & 15; const float* src = p.in[which ? I_W3 : I_W1] + (size_t)(l * NEXP + e) * 1024 * 512; const int add = which ? 4 : 0;
            tr_item(src, 512, 64 * kb, 32 * nb, 512, W13 + (size_t)e * 1024 * 1024, 1024, 0, [add](int n) { return 8 * (n >> 2) + (n & 3) + add; }, scr, c.lane); }
        else { const int kb = (r >> 5) & 7, nb = r & 31; const float* src = p.in[I_W2] + (size_t)(l * NEXP + e) * 512 * 1024;
            tr_item(src, 1024, 64 * kb, 32 * nb, 1024, W2 + (size_t)e * 1024 * 512, 512, 0, [](int n) { return n; }, scr, c.lane); }
    }
}

__device__ __forceinline__ void ph_prologue(const Params& p, const Ctx& c) {
    float* mod = (float*)(p.ws + WS_MOD);
    {
        LAS float* cond = (LAS float*)c.lds; LAS float* part = (LAS float*)(c.lds + 65536);
        bool loaded = false;
        for (int item = c.vcu; item < 192; item += c.G) {
            if (!loaded) { for (int i = c.tid; i < NB * D; i += 512) { const float v = p.in[I_C][i]; cond[i] = v / (1.0f + expf(-v)); } __syncthreads(); loaded = true; }
            const int l = item / 96, n0 = (item % 96) * 64;
            const float* W = p.in[I_MODW] + (size_t)l * D * 6144 + n0 + c.lane;
            float acc[NB];
#pragma unroll
            for (int b = 0; b < NB; ++b) acc[b] = 0.f;
            for (int k = c.wave * 128; k < c.wave * 128 + 128; ++k) { const float w = W[(size_t)k * 6144];
#pragma unroll
                for (int b = 0; b < NB; ++b) acc[b] += cond[b * D + k] * w; }
#pragma unroll
            for (int b = 0; b < NB; ++b) part[(c.wave * NB + b) * 64 + c.lane] = acc[b];
            __syncthreads();
            for (int o = c.tid; o < NB * 64; o += 512) { const int b = o >> 6, ln = o & 63; float s = 0.f;
#pragma unroll
                for (int w = 0; w < 8; ++w) s += part[(w * NB + b) * 64 + ln];
                mod[(size_t)(l * NB + b) * 6144 + n0 + ln] = s + p.in[I_MODB][l * 6144 + n0 + ln]; }
            __syncthreads();
        }
        __syncthreads();
    }
    {
        LAS float* scr = (LAS float*)(c.lds + c.wave * 8448);
        constexpr int I_IN = 16 * 56, I_MX = 4 * 32;
        for (int it = c.gw; it < 2 * (I_IN + 2 * I_MX); it += c.NGW) {
            const int l = it / (I_IN + 2 * I_MX); int r = it % (I_IN + 2 * I_MX);
            if (r < I_IN) { const int kb = r / 56, nb = r % 56;
                tr_item(p.in[I_WIN] + (size_t)l * D * N_IN, N_IN, 64 * kb, 32 * nb, N_IN, (bf16_t*)(p.ws + WS_WIN) + (size_t)l * NZ * D, D, 0, [](int n) { return n; }, scr, c.lane); continue; }
            r -= I_IN; const int part = r / I_MX; r %= I_MX; const int kb = r / 32, nb = r % 32;
            tr_item(p.in[I_WOUT] + (size_t)l * D * D + (size_t)(part ? 768 : 0) * D, D, 64 * kb, 32 * nb, D, (bf16_t*)(p.ws + WS_WMIX) + (size_t)l * D * KMIX, KMIX, part ? 1280 : 0, [](int n) { return n; }, scr, c.lane);
        }
    }
    for (int it = c.gw * 64 + c.lane; it < 2 * 131072; it += c.NGW * 64) {
        const int l = it >> 17, r = it & 131071, n = r & 1023, h = (r >> 10) & 7, cb = r >> 13;
        const float* wo = p.in[I_WOUT] + (size_t)l * D * D + (size_t)(256 + 64 * h) * D + n;
        const float* wv = p.in[I_WUV] + (size_t)l * 128 * 512 + (size_t)(8 * cb) * 512 + h * 64;
        float acc[8];
#pragma unroll
        for (int j = 0; j < 8; ++j) acc[j] = 0.f;
        for (int d = 0; d < 64; ++d) { const float w = wo[(size_t)d * D];
#pragma unroll
            for (int j = 0; j < 8; ++j) acc[j] += wv[j * 512 + d] * w; }
        u32x4 o; o.x = cvt_pk_bf16(acc[0], acc[1]); o.y = cvt_pk_bf16(acc[2], acc[3]); o.z = cvt_pk_bf16(acc[4], acc[5]); o.w = cvt_pk_bf16(acc[6], acc[7]);
        *(u32x4*)((bf16_t*)(p.ws + WS_WMIX) + (size_t)l * D * KMIX + (size_t)n * KMIX + 256 + 128 * h + 8 * cb) = o;
    }
    for (int it = c.gw * 64 + c.lane; it < 2 * 32768; it += c.NGW * 64) {
        const int l = it >> 15, r = it & 32767, cb = r & 31, k = (r >> 5) & 127, h = r >> 12;
        const float* uq = p.in[I_WUQ] + (size_t)l * 256 * 512 + (size_t)(8 * cb) * 512 + h * 64;
        const float* uk = p.in[I_WUK] + (size_t)l * 128 * 512 + (size_t)k * 512 + h * 64;
        float acc[8];
#pragma unroll
        for (int j = 0; j < 8; ++j) acc[j] = 0.f;
        for (int d = 0; d < 64; ++d) { const float w = uk[d];
#pragma unroll
            for (int j = 0; j < 8; ++j) acc[j] += uq[j * 512 + d] * w; }
        const float sc = 0.125f * 1.44269504089f;
#pragma unroll
        for (int j = 0; j < 8; ++j) acc[j] *= sc * p.in[I_QNG][l * 256 + 8 * cb + j];
        u32x4 o; o.x = cvt_pk_bf16(acc[0], acc[1]); o.y = cvt_pk_bf16(acc[2], acc[3]); o.z = cvt_pk_bf16(acc[4], acc[5]); o.w = cvt_pk_bf16(acc[6], acc[7]);
        *(u32x4*)((bf16_t*)(p.ws + WS_WQA) + (size_t)l * D * 256 + (size_t)(h * 128 + k) * 256 + 8 * cb) = o;
    }
    for (int it = c.gw * 64 + c.lane; it < 2 * 1024 * 32; it += c.NGW * 64) {
        const int l = it >> 15, r = it & 32767, k = r >> 5, g = (r >> 3) & 3, q = r & 7, e = k & 3, ln = (k >> 2) & 63, j = k >> 8;
        ((float*)(p.ws + WS_SMALL + SM_REW2))[(size_t)(l * 4 + g) * 8192 + (size_t)((((j * 4 + e) * 2 + (q >> 2)) * 64 + ln) * 4) + (q & 3)] = p.in[I_REW][(size_t)l * D * 32 + r];
    }
    for (int it = c.gw * 64 + c.lane; it < 2 * 1024 * 4; it += c.NGW * 64) {
        const int l = it >> 12, r = it & 4095, k = r >> 2, q = r & 3, e = k & 3, ln = (k >> 2) & 63, j = k >> 8;
        ((float*)(p.ws + WS_SMALL + SM_RGW2))[(size_t)l * 4096 + (size_t)(((j * 4 + e) * 64 + ln) * 4) + q] = p.in[I_RGW][(size_t)l * D * 4 + r];
    }
    conv_experts(p, c, 0);
}

template <int MODE>
__device__ __forceinline__ void ph_norm1(const Params& p, const Ctx& c) {
    const float* mod = (const float*)(p.ws + WS_MOD);
    const bf16_t* Y = (const bf16_t*)(p.ws + WS_Y); const int* tslot = (const int*)(p.ws + WS_SMALL + SM_TSLOT);
    bf16_t* H = (bf16_t*)(p.ws + WS_H);
    const float* xsrc = (MODE == 0 ? p.in[I_X] : p.out);
    constexpr int NR = 2;
    const int nrow = T / c.NGW;
    f32x4 vn[NR][4]; u32x2 an[NR][4], bn[NR][4];
    auto load_rows = [&](int r0) {
#pragma unroll
        for (int t = 0; t < NR; ++t) { const int m = c.gw + (r0 + t) * c.NGW;
#pragma unroll
            for (int j = 0; j < 4; ++j) vn[t][j] = ((const f32x4*)(xsrc + (size_t)m * D) + c.lane)[64 * j];
            if (MODE != 0) { const int s0 = tslot[2 * m], s1 = tslot[2 * m + 1];
#pragma unroll
                for (int j = 0; j < 4; ++j) { an[t][j] = ((const u32x2*)(Y + (size_t)s0 * D) + c.lane)[64 * j]; bn[t][j] = ((const u32x2*)(Y + (size_t)s1 * D) + c.lane)[64 * j]; } } } };
    load_rows(0);
    for (int r0 = 0; r0 < nrow; r0 += NR) {
        f32x4 v[NR][4]; u32x2 ya[NR][4], yb[NR][4];
#pragma unroll
        for (int t = 0; t < NR; ++t)
#pragma unroll
            for (int j = 0; j < 4; ++j) { v[t][j] = vn[t][j]; if (MODE != 0) { ya[t][j] = an[t][j]; yb[t][j] = bn[t][j]; } }
        if (r0 + NR < nrow) load_rows(r0 + NR);
#pragma unroll
        for (int t = 0; t < NR; ++t) {
            const int m = c.gw + (r0 + t) * c.NGW, b = m >> 11;
            if (MODE != 0) {
                const f32x4* g2 = (const f32x4*)(mod + (size_t)((MODE - 1) * NB + b) * 6144 + 5120) + c.lane;
#pragma unroll
                for (int j = 0; j < 4; ++j) { const u32x2 a = ya[t][j], bb = yb[t][j]; const f32x4 g = g2[64 * j];
                    v[t][j].x += g.x * (bflo(a.x) + bflo(bb.x)); v[t][j].y += g.y * (bfhi(a.x) + bfhi(bb.x)); v[t][j].z += g.z * (bflo(a.y) + bflo(bb.y)); v[t][j].w += g.w * (bfhi(a.y) + bfhi(bb.y)); }
            }
            float ss = 0.f;
#pragma unroll
            for (int j = 0; j < 4; ++j) ss += (v[t][j].x * v[t][j].x + v[t][j].y * v[t][j].y) + (v[t][j].z * v[t][j].z + v[t][j].w * v[t][j].w);
            const float r = 1.0f / sqrtf(wave_sum(ss) * (1.0f / D) + EPS);
            if (MODE == 2) {
                const f32x4* fg = (const f32x4*)p.in[I_FG] + c.lane; f32x4* o = (f32x4*)(p.out + (size_t)m * D) + c.lane;
#pragma unroll
                for (int j = 0; j < 4; ++j) o[64 * j] = v[t][j] * r * fg[64 * j];
            } else {
                if (MODE == 1) { f32x4* o = (f32x4*)(p.out + (size_t)m * D) + c.lane;
#pragma unroll
                    for (int j = 0; j < 4; ++j) o[64 * j] = v[t][j]; }
                const int l = MODE;
                const f32x4* ng = (const f32x4*)(p.in[I_N1G] + l * D) + c.lane;
                const f32x4* sh = (const f32x4*)(mod + (size_t)(l * NB + b) * 6144) + c.lane; const f32x4* sc = (const f32x4*)(mod + (size_t)(l * NB + b) * 6144 + 1024) + c.lane;
                u32x2* o8 = (u32x2*)(H + (size_t)m * D) + c.lane;
#pragma unroll
                for (int j = 0; j < 4; ++j) { const f32x4 hv = v[t][j] * r * ng[64 * j] * (sc[64 * j] + 1.0f) + sh[64 * j]; u32x2 w; w.x = cvt_pk_bf16(hv.x, hv.y); w.y = cvt_pk_bf16(hv.z, hv.w); o8[64 * j] = w; }
            }
        }
    }
}

__device__ __forceinline__ void ph_postz(const Params& p, const Ctx& c, int l) {
    const bf16_t* Z = (const bf16_t*)(p.ws + WS_Z); bf16_t* MC = (bf16_t*)(p.ws + WS_MIXCAT);
    bf16_t* CQR = (bf16_t*)(p.ws + WS_CQR); bf16_t* KVN = (bf16_t*)(p.ws + WS_KVN);
    LAS float* U = (LAS float*)c.lds;
    const int lane = c.lane, tk0 = c.wave * 8;
    for (int unit = c.vcu; unit < 512; unit += c.G) {
        const int b = unit >> 5, s0 = (unit & 31) * 64, t0 = b * S + s0;
        for (int idx = c.tid; idx < 94 * 64; idx += 512) { const int r = idx >> 6, c4 = idx & 63, s = s0 - 30 + r; f32x4 u = {0.f, 0.f, 0.f, 0.f};
            if (s >= 0) { const bf16_t* zr = Z + (size_t)(b * S + s) * NZ + 4 * c4; const u32x2 a = *(const u32x2*)(zr + Z_AVAL), g = *(const u32x2*)(zr + Z_AGATE);
                u.x = bflo(a.x) * sigmoidf_(bflo(g.x)); u.y = bfhi(a.x) * sigmoidf_(bfhi(g.x)); u.z = bflo(a.y) * sigmoidf_(bflo(g.y)); u.w = bfhi(a.y) * sigmoidf_(bfhi(g.y)); }
            *(LAS f32x4*)(U + r * 256 + 4 * c4) = u; }
        __syncthreads();
        {
            f32x4 acc[8], win[8];
#pragma unroll
            for (int i = 0; i < 8; ++i) { acc[i] = (f32x4){0.f, 0.f, 0.f, 0.f}; win[i] = *(const LAS f32x4*)(U + (tk0 + i) * 256 + 4 * lane); }
            const f32x4* ck = (const f32x4*)(p.in[I_CONVK] + (size_t)l * 31 * 256) + lane;
#pragma unroll
            for (int j = 0; j < 31; ++j) { const f32x4 kj = ck[64 * j];
#pragma unroll
                for (int i = 0; i < 8; ++i) acc[i] += win[i] * kj;
                if (j < 30) {
#pragma unroll
                    for (int i = 0; i < 7; ++i) win[i] = win[i + 1];
                    win[7] = *(const LAS f32x4*)(U + (tk0 + 8 + j) * 256 + 4 * lane); } }
            const f32x4 cb = *((const f32x4*)(p.in[I_CONVB] + l * 256) + lane), lg = *((const f32x4*)(p.in[I_CLNG] + l * 256) + lane), lb = *((const f32x4*)(p.in[I_CLNB] + l * 256) + lane);
#pragma unroll
            for (int i = 0; i < 8; ++i) { const f32x4 v = acc[i] + cb; const float mean = wave_sum((v.x + v.y) + (v.z + v.w)) * (1.0f / 256.0f);
                const f32x4 d = v - mean; const float var = wave_sum((d.x * d.x + d.y * d.y) + (d.z * d.z + d.w * d.w)) * (1.0f / 256.0f);
                const float rs = 1.0f / sqrtf(var + EPS); f32x4 y = d * rs * lg + lb;
                y.x *= sigmoidf_(y.x); y.y *= sigmoidf_(y.y); y.z *= sigmoidf_(y.z); y.w *= sigmoidf_(y.w);
                u32x2 w; w.x = cvt_pk_bf16(y.x, y.y); w.y = cvt_pk_bf16(y.z, y.w);
                *(u32x2*)(MC + (size_t)(t0 + tk0 + i) * KMIX + 4 * lane) = w; }
        }
        __syncthreads();
        for (int idx = c.tid; idx < 79 * 64; idx += 512) { const int r = idx >> 6, c4 = idx & 63, s = s0 - 15 + r; f32x4 u = {0.f, 0.f, 0.f, 0.f};
            if (s >= 0) { const u32x2 a = *(const u32x2*)(Z + (size_t)(b * S + s) * NZ + Z_UP + 4 * c4); u.x = bflo(a.x); u.y = bfhi(a.x); u.z = bflo(a.y); u.w = bfhi(a.y); }
            *(LAS f32x4*)(U + r * 256 + 4 * c4) = u; }
        __syncthreads();
        f32x4 dv[8];
        {
            const int w = 2 << (lane >> 4);
#pragma unroll
            for (int i = 0; i < 8; ++i) { const int r = 15 + tk0 + i, s = s0 + tk0 + i; f32x4 sum = {0.f, 0.f, 0.f, 0.f};
#pragma unroll
                for (int q = 0; q < 16; ++q) { const f32x4 u = *(const LAS f32x4*)(U + (r - q) * 256 + 4 * lane); if (q < w) sum += u; }
                const float cntf = (float)((s + 1) < w ? (s + 1) : w);
                dv[i] = sum / cntf - *(const LAS f32x4*)(U + r * 256 + 4 * lane); }
        }
        __syncthreads();
        {
            LAS float* Dw = U + c.wave * 2048;
#pragma unroll
            for (int i = 0; i < 8; ++i) *(LAS f32x4*)(Dw + i * 256 + 4 * lane) = dv[i];
            LDS_WAIT();
            const int g = lane >> 4, o4 = (lane & 15) * 4;
            const float* pw = p.in[I_POOLW] + (size_t)(l * 4 + g) * 4096 + o4;
            f32x4 out[8];
#pragma unroll
            for (int i = 0; i < 8; ++i) out[i] = (f32x4){0.f, 0.f, 0.f, 0.f};
            for (int ii = 0; ii < 64; ii += 4) {
                const f32x4 w0 = *(const f32x4*)(pw + (ii + 0) * 64), w1 = *(const f32x4*)(pw + (ii + 1) * 64), w2 = *(const f32x4*)(pw + (ii + 2) * 64), w3 = *(const f32x4*)(pw + (ii + 3) * 64);
#pragma unroll
                for (int i = 0; i < 8; ++i) { const f32x4 d = *(const LAS f32x4*)(Dw + i * 256 + 64 * g + ii); out[i] += w0 * d.x + w1 * d.y + w2 * d.z + w3 * d.w; } }
            const f32x4 ps = *((const f32x4*)(p.in[I_POOLS] + l * 256) + lane);
#pragma unroll
            for (int i = 0; i < 8; ++i) { const f32x4 y = out[i] * ps; u32x2 w; w.x = cvt_pk_bf16(y.x, y.y); w.y = cvt_pk_bf16(y.z, y.w);
                *(u32x2*)(MC + (size_t)(t0 + tk0 + i) * KMIX + 1280 + 4 * lane) = w; }
        }
        {
            const float kg0 = p.in[I_KVNG][l * 128 + 2 * lane], kg1 = p.in[I_KVNG][l * 128 + 2 * lane + 1];
#pragma unroll
            for (int i = 0; i < 8; ++i) { const size_t t = (size_t)(t0 + tk0 + i); const bf16_t* zr = Z + t * NZ;
                const u32x2 q = *(const u32x2*)(zr + Z_CQ + 4 * lane); const float q0 = bflo(q.x), q1 = bfhi(q.x), q2 = bflo(q.y), q3 = bfhi(q.y);
                const float rq = 1.0f / sqrtf(wave_sum((q0 * q0 + q1 * q1) + (q2 * q2 + q3 * q3)) * (1.0f / 256.0f) + EPS);
                u32x2 w; w.x = cvt_pk_bf16(q0 * rq, q1 * rq); w.y = cvt_pk_bf16(q2 * rq, q3 * rq); *(u32x2*)(CQR + t * 256 + 4 * lane) = w;
                const unsigned kv = *(const unsigned*)(zr + Z_CKV + 2 * lane); const float k0 = bflo(kv), k1 = bfhi(kv);
                const float rk = 1.0f / sqrtf(wave_sum(k0 * k0 + k1 * k1) * (1.0f / 128.0f) + EPS);
                *(unsigned*)(KVN + t * 128 + 2 * lane) = cvt_pk_bf16(k0 * rk * kg0, k1 * rk * kg1); }
        }
        __syncthreads();
    }
}

__device__ __forceinline__ size_t sc_off(int b, int cq) { return (size_t)b * SC_PER_B + (size_t)2048 * cq * (cq + 1); }
__device__ __forceinline__ void ph_scores(const Params& p, const Ctx& c) {
    const bf16_t* Z = (const bf16_t*)(p.ws + WS_Z); float* SC = (float*)(p.ws + WS_Y);
    const int lane = c.lane, l15 = lane & 15, g = lane >> 4;
    for (int U = c.gw; U < NB * 576; U += c.NGW) {
        const int b = U / 576, u = U % 576;
        int cg = 0; while (8 * (cg + 1) * (cg + 2) <= u) ++cg;
        const int r = u - 8 * cg * (cg + 1), q16 = r / (cg + 1), seg = r % (cg + 1), cq = 4 * cg + (q16 >> 2), q4 = q16 & 3;
        const int n = 64 * (cq + 1), kt0 = seg * 16, kt1 = (kt0 + 16 < 4 * (cq + 1)) ? kt0 + 16 : 4 * (cq + 1);
        const size_t tq = (size_t)b * S + cq * 64 + q4 * 16 + l15;
        const bf16_t* zq = Z + tq * NZ;
        bf16x8 bq[8][2];
#pragma unroll
        for (int h = 0; h < 8; ++h)
#pragma unroll
            for (int s = 0; s < 2; ++s) bq[h][s] = *(const bf16x8*)(zq + Z_QI + h * 64 + 32 * s + 8 * g);
        float wq[8];
        { const u32x4 wv = *(const u32x4*)(zq + Z_WI); const float isc = 0.044194173824159216f;
          wq[0] = bflo(wv.x) * isc; wq[1] = bfhi(wv.x) * isc; wq[2] = bflo(wv.y) * isc; wq[3] = bfhi(wv.y) * isc; wq[4] = bflo(wv.z) * isc; wq[5] = bfhi(wv.z) * isc; wq[6] = bflo(wv.w) * isc; wq[7] = bfhi(wv.w) * isc; }
        float* srow = SC + sc_off(b, cq) + (size_t)(q4 * 16 + l15) * n;
        const bf16_t* zkb = Z + ((size_t)b * S + l15) * NZ + Z_KI + 8 * g;
        bf16x8 nk0 = *(const bf16x8*)(zkb + (size_t)kt0 * 16 * NZ), nk1 = *(const bf16x8*)(zkb + (size_t)kt0 * 16 * NZ + 32);
        for (int kt = kt0; kt < kt1; ++kt) {
            const bf16x8 ak0 = nk0, ak1 = nk1;
            if (kt + 1 < kt1) { nk0 = *(const bf16x8*)(zkb + (size_t)(kt + 1) * 16 * NZ); nk1 = *(const bf16x8*)(zkb + (size_t)(kt + 1) * 16 * NZ + 32); }
            f32x4 sc = {0.f, 0.f, 0.f, 0.f};
#pragma unroll
            for (int h = 0; h < 8; ++h) { f32x4 a = {0.f, 0.f, 0.f, 0.f};
                a = __builtin_amdgcn_mfma_f32_16x16x32_bf16(ak0, bq[h][0], a, 0, 0, 0);
                a = __builtin_amdgcn_mfma_f32_16x16x32_bf16(ak1, bq[h][1], a, 0, 0, 0);
#pragma unroll
                for (int i = 0; i < 4; ++i) sc[i] += wq[h] * fmaxf(a[i], 0.f); }
            *(f32x4*)(srow + kt * 16 + 4 * g) = sc;
        }
    }
}

__device__ __forceinline__ unsigned off_b(unsigned row, unsigned ch) { return 256u * row + 16u * (ch ^ (((row & 3) << 2) | ((row >> 2) & 3))); }
template <int MODE>
__device__ __forceinline__ void ph_attn(const Params& p, const Ctx& c) {
    const float* SC = (const float*)(p.ws + WS_Y); const bf16_t* QA = (const bf16_t*)(p.ws + WS_H); const bf16_t* KVN = (const bf16_t*)(p.ws + WS_KVN);
    bf16_t* MC = (bf16_t*)(p.ws + WS_MIXCAT);
    const int lane = c.lane, g = lane >> 4, hd = lane & 15;
    LAS unsigned char* tile = c.lds + c.wave * 16384;
    LAS unsigned short* lst = (LAS unsigned short*)(c.lds + LIST_OFF + c.wave * 512);
    const unsigned long long ltmask = (1ull << lane) - 1ull;
    const int xg = blockIdx.x & 7, wv = (blockIdx.x >> 3) * 8 + c.wave, nwv = (c.G >> 3) * 8;
    for (int qi = wv; qi < 2 * S; qi += nwv) {
        const int b = xg + 8 * (qi / S), s = qi % S, cq = s >> 6, n = 64 * (cq + 1), nk = n < 256 ? n : 256;
        const size_t t = (size_t)b * S + s;
        if (cq < 4 || !(MODE & 1)) { for (int i = lane; i < nk; i += 64) lst[i] = (unsigned short)i; }
        else {
            const float* srow = SC + sc_off(b, cq) + (size_t)(s & 63) * n;
            unsigned key[32]; unsigned kmin = 0xffffffffu, kmax = 0u;
            float sv[32];
#pragma unroll
            for (int j = 0; j < 32; ++j) sv[j] = srow[64 * (j <= cq ? j : cq) + lane];
#pragma unroll
            for (int j = 0; j < 32; ++j) key[j] = 0u;
#pragma unroll
            for (int jb = 0; jb < 4; ++jb) if (8 * jb <= cq) {
#pragma unroll
                for (int j = 8 * jb; j < 8 * jb + 8; ++j) { const unsigned u = __float_as_uint(sv[j] + 0.0f); const unsigned k = (u & 0x80000000u) ? ~u : (u | 0x80000000u);
                    key[j] = (j <= cq) ? k : 0u; kmin = (j <= cq && k < kmin) ? k : kmin; kmax = (j <= cq && k > kmax) ? k : kmax; } }
#pragma unroll
            for (int o = 1; o < 64; o <<= 1) { const unsigned a = __shfl_xor(kmin, o), bb = __shfl_xor(kmax, o); kmin = a < kmin ? a : kmin; kmax = bb > kmax ? bb : kmax; }
            unsigned lo = __builtin_amdgcn_readfirstlane(kmin), hi = __builtin_amdgcn_readfirstlane(kmax); int c_lo = n, c_hi = 0; int it = 0;
            unsigned thr = 0u; int need = 0; bool done = false;
            while (lo < hi && (c_lo - c_hi) > 64) {
                unsigned mid;
                if (it < 20) {
                    const float lo_v = __uint_as_float((lo & 0x80000000u) ? (lo ^ 0x80000000u) : ~lo), hi_v = __uint_as_float((hi & 0x80000000u) ? (hi ^ 0x80000000u) : ~hi);
                    const float f = (it & 1) ? 0.5f : (float)(c_lo - 256) / (float)(c_lo - c_hi);
                    const float mid_v = lo_v + (hi_v - lo_v) * f + 0.0f;
                    const unsigned mu = __float_as_uint(mid_v); mid = (mu & 0x80000000u) ? ~mu : (mu | 0x80000000u);
                } else mid = lo + ((hi - lo) >> 1) + 1u;
                mid = mid > lo ? mid : lo + 1u; mid = mid < hi ? mid : hi;
                int cnt = 0;
#pragma unroll
                for (int jb = 0; jb < 4; ++jb) if (8 * jb <= cq) {
                    unsigned long long bm[8];
#pragma unroll
                    for (int j = 0; j < 8; ++j) bm[j] = __ballot(key[8 * jb + j] >= mid);
#pragma unroll
                    for (int j = 0; j < 8; ++j) cnt += __builtin_popcountll(bm[j]); }
                if (cnt >= 256) { lo = mid; c_lo = cnt; if (cnt == 256) { thr = mid; need = 1 << 20; done = true; break; } } else { hi = mid - 1u; c_hi = cnt; }
                ++it;
            }
            if (!done) {
                if (lo == hi) {
                    thr = lo; int cgt = 0;
#pragma unroll
                    for (int j = 0; j < 32; ++j) cgt += __builtin_popcountll(__ballot(key[j] > thr));
                    need = 256 - cgt;
                } else {
                    LAS unsigned* cand = (LAS unsigned*)lst; int base = 0;
#pragma unroll
                    for (int jb = 0; jb < 4; ++jb) if (8 * jb <= cq) {
#pragma unroll
                        for (int j = 8 * jb; j < 8 * jb + 8; ++j) { const bool isc = key[j] >= lo && key[j] <= hi; const unsigned long long bc = __ballot(isc);
                            if (isc) cand[base + __builtin_popcountll(bc & ltmask)] = key[j]; base += __builtin_popcountll(bc); } }
                    const int m = base;
                    const unsigned ck = lane < m ? cand[lane] : 0u;
                    int gt = 0, ge = 0;
                    for (int q = 0; q < m; ++q) { const unsigned v = (unsigned)__builtin_amdgcn_readlane((int)ck, q); gt += v > ck; ge += v >= ck; }
                    const int r = 256 - c_hi;
                    const unsigned long long hit = __ballot(lane < m && gt < r && r <= ge);
                    const int src = __builtin_ctzll(hit);
                    thr = __shfl(ck, src); need = r - __shfl(gt, src);
                }
            }
            asm volatile("" ::: "memory");
            {
                int base = 0, tb = 0;
#pragma unroll
                for (int jb = 0; jb < 4; ++jb) if (8 * jb <= cq) {
#pragma unroll
                    for (int j = 8 * jb; j < 8 * jb + 8; ++j) {
                        const bool gt = key[j] > thr, tie = key[j] == thr; const unsigned long long bt = __ballot(tie);
                        const int trank = tb + __builtin_popcountll(bt & ltmask); const bool sel = gt || (tie && trank < need);
                        const unsigned long long bs = __ballot(sel); const int pos = base + __builtin_popcountll(bs & ltmask);
                        if (sel && pos < 256) lst[pos] = (unsigned short)(64 * j + lane);
                        base += __builtin_popcountll(bs); tb += __builtin_popcountll(bt); } }
            }
        }
        bf16x8 qf[4];
#pragma unroll
        for (int ks = 0; ks < 4; ++ks) { qf[ks] = (bf16x8){0, 0, 0, 0, 0, 0, 0, 0}; if (hd < 8) qf[ks] = *(const bf16x8*)(QA + t * D + hd * 128 + 32 * ks + 8 * g); }
        float m_ref = -INFINITY, l_run = 0.f;
        f32x4 o[8];
#pragma unroll
        for (int ct = 0; ct < 8; ++ct) o[ct] = (f32x4){0.f, 0.f, 0.f, 0.f};
        const char* kvb = (const char*)(KVN + (size_t)b * S * 128);
        const int ntile = nk >> 5;
        LDS_WAIT();
#define ATT_ISSUE(kt_, buf_) do { _Pragma("unroll") for (int i = 0; i < 8; ++i) { const int r = 4 * i + g; const unsigned key_ = lst[(kt_) * 32 + r]; \
            const unsigned ch = (unsigned)hd ^ (unsigned)(((r & 3) << 2) | ((r >> 2) & 3)); \
            if (MODE & 2) __builtin_amdgcn_global_load_lds((const unsigned*)(kvb + key_ * 256u + ch * 16u), (LAS unsigned*)(tile + (buf_) * 8192 + i * 1024), 16, 0, 0); } } while (0)
        ATT_ISSUE(0, 0);
        for (int kt = 0; kt < ntile; ++kt) {
            LAS unsigned char* tb_ = tile + (kt & 1) * 8192;
            if (kt + 1 < ntile) { ATT_ISSUE(kt + 1, (kt + 1) & 1); asm volatile("s_waitcnt vmcnt(8)" ::: "memory"); }
            else asm volatile("s_waitcnt vmcnt(0)" ::: "memory");
            if (!(MODE & 4)) continue;
            f32x4 sa[2];
#pragma unroll
            for (int rb = 0; rb < 2; ++rb) { sa[rb] = (f32x4){0.f, 0.f, 0.f, 0.f};
#pragma unroll
                for (int ks = 0; ks < 4; ++ks) { const bf16x8 a = *(const LAS bf16x8*)(tb_ + off_b(16 * rb + hd, 4 * ks + g)); sa[rb] = __builtin_amdgcn_mfma_f32_16x16x32_bf16(a, qf[ks], sa[rb], 0, 0, 0); } }
            float mx = fmaxf(fmaxf(fmaxf(sa[0][0], sa[0][1]), fmaxf(sa[0][2], sa[0][3])), fmaxf(fmaxf(sa[1][0], sa[1][1]), fmaxf(sa[1][2], sa[1][3])));
            mx = fmaxf(mx, __shfl_xor(mx, 16)); mx = fmaxf(mx, __shfl_xor(mx, 32));
            if (__ballot(mx > m_ref + 40.0f) != 0ull) {
                const float m_new = fmaxf(m_ref, mx), alpha = __builtin_amdgcn_exp2f(m_ref - m_new);
                l_run *= alpha; m_ref = m_new;
#pragma unroll
                for (int ct = 0; ct < 8; ++ct) o[ct] *= alpha;
            }
            float pr[8], ps = 0.f;
#pragma unroll
            for (int j = 0; j < 8; ++j) { pr[j] = __builtin_amdgcn_exp2f(sa[j >> 2][j & 3] - m_ref); ps += pr[j]; }
            l_run += ps;
            u32x4 pw; pw.x = cvt_pk_bf16(pr[0], pr[1]); pw.y = cvt_pk_bf16(pr[2], pr[3]); pw.z = cvt_pk_bf16(pr[4], pr[5]); pw.w = cvt_pk_bf16(pr[6], pr[7]);
            const bf16x8 pb = __builtin_bit_cast(bf16x8, pw);
            const unsigned q4 = (unsigned)hd >> 2, p4 = (unsigned)hd & 3;
#pragma unroll
            for (int ct = 0; ct < 8; ++ct) {
                const bf16x4 vlo = __builtin_amdgcn_ds_read_tr16_b64_v4i16((LAS bf16x4*)(tb_ + off_b(4 * g + q4, 2 * ct + (p4 >> 1)) + 8 * (p4 & 1)));
                const bf16x4 vhi = __builtin_amdgcn_ds_read_tr16_b64_v4i16((LAS bf16x4*)(tb_ + off_b(16 + 4 * g + q4, 2 * ct + (p4 >> 1)) + 8 * (p4 & 1)));
                const bf16x8 va = __builtin_shufflevector(vlo, vhi, 0, 1, 2, 3, 4, 5, 6, 7);
                o[ct] = __builtin_amdgcn_mfma_f32_16x16x32_bf16(va, pb, o[ct], 0, 0, 0);
            }
            LDS_WAIT();
        }
#undef ATT_ISSUE
        float lt = l_run + __shfl_xor(l_run, 16); lt += __shfl_xor(lt, 32);
        const float inv = 1.0f / lt;
        if (hd < 8 && ((MODE & 8) || lt == 12345.678f)) {
#pragma unroll
            for (int ct = 0; ct < 8; ++ct) { const f32x4 v = o[ct] * inv; u32x2 w; w.x = cvt_pk_bf16(v.x, v.y); w.y = cvt_pk_bf16(v.z, v.w);
                *(u32x2*)(MC + t * KMIX + 256 + hd * 128 + 16 * ct + 4 * g) = w; }
        }
    }
}

#ifndef RT_NT
#define RT_NT 2
#endif
__device__ __forceinline__ void ph_router(const Params& p, const Ctx& c, int l) {
    const float* mod = (const float*)(p.ws + WS_MOD); bf16_t* H = (bf16_t*)(p.ws + WS_H);
    int* toke = (int*)(p.ws + WS_SMALL + SM_TOKE); float* tokg = (float*)(p.ws + WS_SMALL + SM_TOKG); int* rank = (int*)(p.ws + WS_SMALL + SM_RANK); int* cnt = (int*)(p.ws + WS_SMALL + SM_CNT);
    LAS int* le = (LAS int*)c.lds; LAS int* wcnt = le + 256;
    const int lane = c.lane;
    for (int tile = c.vcu; tile < 256; tile += c.G) {
        constexpr int NT = RT_NT;
        const int b = (tile * 128) >> 11;
        const f32x4* ng = (const f32x4*)(p.in[I_N2G] + l * D) + lane;
        const f32x4* sh = (const f32x4*)(mod + (size_t)(l * NB + b) * 6144 + 3072) + lane; const f32x4* sc = (const f32x4*)(mod + (size_t)(l * NB + b) * 6144 + 4096) + lane;
        const f32x4* rg = (const f32x4*)(p.ws + WS_SMALL + SM_RGW2) + (size_t)l * 1024 + lane;
        f32x4 gm[4], sv[4];
#pragma unroll
        for (int j = 0; j < 4; ++j) { gm[j] = ng[64 * j] * (sc[64 * j] + 1.0f); sv[j] = sh[64 * j]; }
        f32x4 v[NT][4], vn[NT][4];
#pragma unroll
        for (int t = 0; t < NT; ++t)
#pragma unroll
            for (int j = 0; j < 4; ++j) vn[t][j] = ((const f32x4*)(p.out + (size_t)(tile * 128 + c.wave * 16 + t) * D) + lane)[64 * j];
        for (int i = 0; i < 16; i += NT) {
            const int tl0 = c.wave * 16 + i, m0 = tile * 128 + tl0;
            float ss[NT], r[NT], gl[NT][4];
#pragma unroll
            for (int t = 0; t < NT; ++t) { ss[t] = 0.f;
#pragma unroll
                for (int j = 0; j < 4; ++j) { v[t][j] = vn[t][j]; ss[t] += (v[t][j].x * v[t][j].x + v[t][j].y * v[t][j].y) + (v[t][j].z * v[t][j].z + v[t][j].w * v[t][j].w); } }
            if (i + NT < 16) {
#pragma unroll
                for (int t = 0; t < NT; ++t)
#pragma unroll
                    for (int j = 0; j < 4; ++j) vn[t][j] = ((const f32x4*)(p.out + (size_t)(m0 + NT + t) * D) + lane)[64 * j]; }
#pragma unroll
            for (int o = 1; o < 64; o <<= 1)
#pragma unroll
                for (int t = 0; t < NT; ++t) ss[t] += __shfl_xor(ss[t], o);
#pragma unroll
            for (int t = 0; t < NT; ++t) { r[t] = 1.0f / sqrtf(ss[t] * (1.0f / D) + EPS); gl[t][0] = gl[t][1] = gl[t][2] = gl[t][3] = 0.f; }
#pragma unroll
            for (int j = 0; j < 4; ++j) {
#pragma unroll
                for (int t = 0; t < NT; ++t) { v[t][j] = v[t][j] * r[t] * gm[j] + sv[j];
                    u32x2 w; w.x = cvt_pk_bf16(v[t][j].x, v[t][j].y); w.y = cvt_pk_bf16(v[t][j].z, v[t][j].w); ((u32x2*)(H + (size_t)(m0 + t) * D) + lane)[64 * j] = w; }
#pragma unroll
                for (int e = 0; e < 4; ++e) { const f32x4 wr = rg[(j * 4 + e) * 64];
#pragma unroll
                    for (int t = 0; t < NT; ++t) { gl[t][0] += v[t][j][e] * wr.x; gl[t][1] += v[t][j][e] * wr.y; gl[t][2] += v[t][j][e] * wr.z; gl[t][3] += v[t][j][e] * wr.w; } } }
            const bool h32 = lane & 32, h16 = lane & 16, h8 = lane & 8;
            float dg[NT];
#pragma unroll
            for (int t = 0; t < NT; ++t) {
                const float c0 = (h16 ? gl[t][2] : gl[t][0]) + __shfl_xor(h16 ? gl[t][0] : gl[t][2], 16), c1 = (h16 ? gl[t][3] : gl[t][1]) + __shfl_xor(h16 ? gl[t][1] : gl[t][3], 16);
                float d = (h8 ? c1 : c0) + __shfl_xor(h8 ? c0 : c1, 8);
                d += __shfl_xor(d, 4); d += __shfl_xor(d, 2); d += __shfl_xor(d, 1); d += __shfl_xor(d, 32); dg[t] = d; }
            int gi[NT]; float gp[NT];
#pragma unroll
            for (int t = 0; t < NT; ++t) { float gq[4]; int g_ = 0; float gmax = -INFINITY;
#pragma unroll
                for (int q = 0; q < 4; ++q) { gq[q] = __shfl(dg[t], 8 * (q & 1) + 16 * (q >> 1)) + p.in[I_RGB][l * 4 + q]; if (gq[q] > gmax) { gmax = gq[q]; g_ = q; } }
                float gden = 0.f;
#pragma unroll
                for (int q = 0; q < 4; ++q) gden += __expf(gq[q] - gmax);
                gp[t] = 1.0f / gden; gi[t] = __builtin_amdgcn_readfirstlane(g_); }
            float el[NT][8];
#pragma unroll
            for (int t = 0; t < NT; ++t)
#pragma unroll
                for (int q = 0; q < 8; ++q) el[t][q] = 0.f;
#pragma unroll
            for (int j = 0; j < 4; ++j)
#pragma unroll
                for (int e = 0; e < 4; ++e)
#pragma unroll
                    for (int t = 0; t < NT; ++t) { const f32x4* rr = (const f32x4*)(p.ws + WS_SMALL + SM_REW2) + (size_t)(l * 4 + gi[t]) * 2048 + (j * 4 + e) * 128 + lane;
                        const f32x4 w0 = rr[0], w1 = rr[64]; const float hv = v[t][j][e];
                        el[t][0] += hv * w0.x; el[t][1] += hv * w0.y; el[t][2] += hv * w0.z; el[t][3] += hv * w0.w; el[t][4] += hv * w1.x; el[t][5] += hv * w1.y; el[t][6] += hv * w1.z; el[t][7] += hv * w1.w; }
            float de[NT];
#pragma unroll
            for (int t = 0; t < NT; ++t) {
                const float b0 = (h32 ? el[t][4] : el[t][0]) + __shfl_xor(h32 ? el[t][0] : el[t][4], 32), b1 = (h32 ? el[t][5] : el[t][1]) + __shfl_xor(h32 ? el[t][1] : el[t][5], 32);
                const float b2 = (h32 ? el[t][6] : el[t][2]) + __shfl_xor(h32 ? el[t][2] : el[t][6], 32), b3 = (h32 ? el[t][7] : el[t][3]) + __shfl_xor(h32 ? el[t][3] : el[t][7], 32);
                const float c0 = (h16 ? b2 : b0) + __shfl_xor(h16 ? b0 : b2, 16), c1 = (h16 ? b3 : b1) + __shfl_xor(h16 ? b1 : b3, 16);
                float d = (h8 ? c1 : c0) + __shfl_xor(h8 ? c0 : c1, 8);
                d += __shfl_xor(d, 4); d += __shfl_xor(d, 2); d += __shfl_xor(d, 1); de[t] = d; }
#pragma unroll
            for (int t = 0; t < NT; ++t) { float eq[8]; int e0 = 0, e1 = 0; float mx0 = -INFINITY, mx1 = -INFINITY;
#pragma unroll
                for (int q = 0; q < 8; ++q) { eq[q] = __shfl(de[t], 8 * (q & 1) + 16 * ((q >> 1) & 1) + 32 * (q >> 2)) + p.in[I_REB][l * 32 + gi[t] * 8 + q];
                    if (eq[q] > mx0) { mx1 = mx0; e1 = e0; mx0 = eq[q]; e0 = q; } else if (eq[q] > mx1) { mx1 = eq[q]; e1 = q; } }
                const float x1 = __expf(mx1 - mx0), den = 1.0f + x1; const int tl = tl0 + t, m = m0 + t;
                if (lane == 0) { le[2 * tl] = gi[t] * 8 + e0; le[2 * tl + 1] = gi[t] * 8 + e1; toke[2 * m] = gi[t] * 8 + e0; toke[2 * m + 1] = gi[t] * 8 + e1; tokg[2 * m] = gp[t] / den; tokg[2 * m + 1] = gp[t] * x1 / den; } }
        }
        __syncthreads();
        int myrank = 0, mye = 0;
        if (c.tid < 256) { mye = le[c.tid]; const unsigned long long ltmask = (1ull << lane) - 1ull;
            for (int ee = 0; ee < 32; ++ee) { const unsigned long long m = __ballot(mye == ee); if (mye == ee) myrank = __builtin_popcountll(m & ltmask); if (lane == 0) wcnt[c.wave * 32 + ee] = __builtin_popcountll(m); } }
        __syncthreads();
        if (c.tid < 256) { for (int w = 0; w < c.wave; ++w) myrank += wcnt[w * 32 + mye]; rank[tile * 256 + c.tid] = myrank; }
        if (c.tid < 32) cnt[tile * 32 + c.tid] = wcnt[c.tid] + wcnt[32 + c.tid] + wcnt[64 + c.tid] + wcnt[96 + c.tid];
        __syncthreads();
    }
}

__device__ __forceinline__ void ph_dispatch(const Params& p, const Ctx& c) {
    const int* toke = (const int*)(p.ws + WS_SMALL + SM_TOKE); const float* tokg = (const float*)(p.ws + WS_SMALL + SM_TOKG); const int* rank = (const int*)(p.ws + WS_SMALL + SM_RANK); const int* cnt = (const int*)(p.ws + WS_SMALL + SM_CNT);
    int* tslot = (int*)(p.ws + WS_SMALL + SM_TSLOT); int* stok = (int*)(p.ws + WS_SMALL + SM_STOK); float* sgate = (float*)(p.ws + WS_SMALL + SM_SGATE); int* texp = (int*)(p.ws + WS_SMALL + SM_TEXP);
    LAS int* tot = (LAS int*)c.lds; LAS int* pst = tot + 32; LAS int* bse = pst + 33;
    for (int tile = c.vcu; tile < 256; tile += c.G) {
        {
            LAS int* psum = bse + 32; LAS int* pbase = psum + 512;
            const int e = c.tid & 31, part = c.tid >> 5; int v[16]; int run = 0, mb = 0;
#pragma unroll
            for (int q = 0; q < 16; ++q) v[q] = cnt[(part * 16 + q) * 32 + e];
#pragma unroll
            for (int q = 0; q < 16; ++q) { if (part * 16 + q == tile) mb = run; run += v[q]; }
            psum[part * 32 + e] = run; pbase[part * 32 + e] = mb;
            __syncthreads();
            if (c.tid < 32) { int tr = 0, tb2 = 0; const int tp = tile >> 4;
                for (int q = 0; q < 16; ++q) { if (q == tp) tb2 = tr + pbase[q * 32 + c.tid]; tr += psum[q * 32 + c.tid]; }
                tot[c.tid] = tr; bse[c.tid] = tb2; }
        }
        __syncthreads();
        if (c.tid == 0) { int a = 0; for (int e = 0; e < 32; ++e) { pst[e] = a; a += ((tot[e] + 255) >> 8) << 8; } pst[32] = a; }
        __syncthreads();
        if (c.tid < 256) { const int a = tile * 256 + c.tid, e = toke[a], slot = pst[e] + bse[e] + rank[a]; stok[slot] = a >> 1; sgate[slot] = tokg[a]; tslot[a] = slot; }
        if (tile == 0) {
            for (int e = 0; e < 32; ++e) { const int pc = pst[e + 1] - pst[e]; for (int r = tot[e] + c.tid; r < pc; r += 512) { stok[pst[e] + r] = 0; sgate[pst[e] + r] = 0.f; } }
            const int ntl = pst[32] >> 8;
            for (int m = c.tid; m < ntl; m += 512) { int e = 0; while (pst[e + 1] <= (m << 8)) ++e; texp[m] = e; }
            if (c.tid == 0) texp[MAXTILES] = ntl;
        }
        __syncthreads();
    }
}

#ifndef PH_ONLY
#define PH_ONLY -1
#endif
#define IN(k) ((PH_ONLY < 0 || PH_ONLY == (k)) && lo <= (k) && (k) < hi)
#define SEAM(k) do { if (IN(k) && IN((k) + 1)) xcd_barrier(bar); } while (0)
#ifndef REP_MASK
#define REP_MASK 0
#endif
#define REP(id) (((REP_MASK) >> (id)) & 1)
#define BODY(id, cond, ...) do { __VA_ARGS__ if (REP(id) && (cond)) { xcd_barrier(bar); __VA_ARGS__ } } while (0)
template <int l>
__device__ __forceinline__ void run_layer(const Params& p, const Ctx& c, const XcdBarrier& bar, int lo, int hi) {
    bf16_t* Zb = (bf16_t*)(p.ws + WS_Z); bf16_t* Hb = (bf16_t*)(p.ws + WS_H); bf16_t* MCb = (bf16_t*)(p.ws + WS_MIXCAT);
    const float* mod = (const float*)(p.ws + WS_MOD);
    constexpr int P = 1 + 10 * l;
    if (IN(P)) { if (l == 0) { BODY(1, true, ph_norm1<0>(p, c);); } else { BODY(12, true, conv_experts(p, c, 1);); ph_norm1<1>(p, c); } }
    SEAM(P);
    if (IN(P + 1)) { BODY(2, true, { pg8::StaticOrder So; So.init(Hb, (bf16_t*)(p.ws + WS_WIN) + (size_t)l * NZ * D, T, NZ, D, c.G, (int)blockIdx.x);
        pg8::EpiBf16 E{Zb, NZ}; pg8::gemm_phase<pg8::EpiBf16, pg8::StaticOrder, false>(c.lds, So, E); }); }
    SEAM(P + 1);
    if (IN(P + 2)) { BODY(3, true, ph_postz(p, c, l);); }
    SEAM(P + 2);
    if (IN(P + 3)) { BODY(4, true, { pg8::StaticOrder So; So.init((bf16_t*)(p.ws + WS_CQR), (bf16_t*)(p.ws + WS_WQA) + (size_t)l * D * 256, T, D, 256, c.G, (int)blockIdx.x);
        pg8::EpiBf16 E{Hb, D}; pg8::gemm_phase<pg8::EpiBf16, pg8::StaticOrder, false>(c.lds, So, E); });
        BODY(5, true, ph_scores(p, c);); }
    SEAM(P + 3);
#ifndef ATT_PROBE
#define ATT_PROBE 0
#endif
    if (IN(P + 4)) { ph_attn<15>(p, c); if (ATT_PROBE) { xcd_barrier(bar); ph_attn<ATT_PROBE>(p, c); } }
    SEAM(P + 4);
    if (IN(P + 5)) { BODY(7, l == 0, { pg8::StaticOrder So; So.init(MCb, (bf16_t*)(p.ws + WS_WMIX) + (size_t)l * D * KMIX, T, D, KMIX, c.G, (int)blockIdx.x);
        pg8::EpiMix E{l == 0 ? p.in[I_X] : p.out, p.out, mod + (size_t)l * NB * 6144 + 2048}; pg8::gemm_phase<pg8::EpiMix, pg8::StaticOrder, false>(c.lds, So, E); }); }
    SEAM(P + 5);
    if (IN(P + 6)) { BODY(8, true, ph_router(p, c, l);); }
    SEAM(P + 6);
    if (IN(P + 7)) { BODY(9, true, ph_dispatch(p, c);); }
    SEAM(P + 7);
    if (IN(P + 8)) { BODY(10, true, { const int* texp = (const int*)(p.ws + WS_SMALL + SM_TEXP); const int ntl = texp[MAXTILES];
        pg8::MoeOrder Mo; Mo.init(Hb, p.ws + WS_W13, D, (size_t)1024 * 1024 * 2, (const int*)(p.ws + WS_SMALL + SM_STOK), texp, ntl, c.G, c.vcu);
        pg8::EpiAct E{Zb}; pg8::gemm_phase<pg8::EpiAct, pg8::MoeOrder, true>(c.lds, Mo, E); }); }
    SEAM(P + 8);
    if (IN(P + 9)) { BODY(11, true, { const int* texp = (const int*)(p.ws + WS_SMALL + SM_TEXP); const int ntl = texp[MAXTILES];
        pg8::MoeOrder Mo; Mo.init(Zb, p.ws + WS_W2, DEXP, (size_t)1024 * 512 * 2, nullptr, texp, ntl, c.G, c.vcu);
        pg8::EpiY E{(bf16_t*)(p.ws + WS_Y), (const float*)(p.ws + WS_SMALL + SM_SGATE)}; pg8::gemm_phase<pg8::EpiY, pg8::MoeOrder, false>(c.lds, Mo, E); }); }
    SEAM(P + 9);
}

__global__ void __launch_bounds__(512, 2) fwd(Params p) {
    extern __shared__ __attribute__((aligned(16))) unsigned char lds_raw[];
    Ctx c;
    c.lds = (LAS unsigned char*)lds_raw;
    c.tid = threadIdx.x; c.lane = c.tid & 63; c.wave = __builtin_amdgcn_readfirstlane(c.tid >> 6);
    c.G = gridDim.x; { const int bx = blockIdx.x; c.vcu = (c.G % 8 == 0) ? (bx % 8) * (c.G / 8) + bx / 8 : bx; }
    c.gw = c.vcu * 8 + c.wave; c.NGW = c.G * 8;
    volatile LAS unsigned* MISC = (volatile LAS unsigned*)(c.lds + MISC_OFF);
    if (c.tid < 64) MISC[c.tid] = 0u;
    __syncthreads();
    unsigned* ctl = (unsigned*)(p.ws + WS_CTL);
    XcdBarrier bar; bar.bar = ctl + CW_BAR; bar.x = 0; bar.st = nullptr;
    const bool multi = (p.ph_hi - p.ph_lo) > 1;
    if (multi) bar = xcd_barrier_post(ctl + CW_BAR, MISC + 8);
    const int lo = p.ph_lo, hi = p.ph_hi;
    if (IN(0)) { BODY(0, true, ph_prologue(p, c);); }
    SEAM(0);
    run_layer<0>(p, c, bar, lo, hi);
    run_layer<1>(p, c, bar, lo, hi);
    if (IN(21)) ph_norm1<2>(p, c);
#undef IN
#undef SEAM
}

extern "C" void kernel_launch(void* const* d_in, const int* in_sizes, int n_in, void* d_out, int out_size, void* d_ws, size_t ws_size, hipStream_t stream) {
    static int grid = 0;
    if (grid == 0) {
        if (n_in != 27 || out_size != T * D || ws_size < WS_END) { fprintf(stderr, "kernel_launch: unexpected shapes (n_in %d out %d ws %zu, need %zu)\n", n_in, out_size, ws_size, (size_t)WS_END); grid = -1; return; }
        int dev = 0, cus = 0, per_cu = 0;
        if (hipGetDevice(&dev) != hipSuccess || hipDeviceGetAttribute(&cus, hipDeviceAttributeMultiprocessorCount, dev) != hipSuccess) { grid = -1; return; }
        if (hipFuncSetAttribute((const void*)fwd, hipFuncAttributeMaxDynamicSharedMemorySize, LDS_BYTES) != hipSuccess) { fprintf(stderr, "kernel_launch: hipFuncSetAttribute failed\n"); grid = -1; return; }
        if (hipOccupancyMaxActiveBlocksPerMultiprocessor(&per_cu, (const void*)fwd, 512, LDS_BYTES) != hipSuccess || per_cu < 1) { fprintf(stderr, "kernel_launch: occupancy query says %d blocks per CU\n", per_cu); grid = -1; return; }
        (void)hipGetLastError();
        grid = cus;
        if (grid % 8 != 0 || grid > 256) grid = (grid / 8) * 8 > 256 ? 256 : (grid / 8) * 8;
    }
    if (grid <= 0) return;
    (void)hipMemsetAsync((char*)d_ws + WS_CTL, 0, CTL_ZERO_BYTES, stream);
    Params p{};
    for (int i = 0; i < 27; ++i) p.in[i] = (const float*)d_in[i];
    p.out = (float*)d_out; p.ws = (unsigned char*)d_ws;
#if MK_SPLIT
    for (int ph = 0; ph < NPHASE; ++ph) { p.ph_lo = ph; p.ph_hi = ph + 1; hipLaunchKernelGGL(fwd, dim3(grid), dim3(512), LDS_BYTES, stream, p); }
#else
    p.ph_lo = 0; p.ph_hi = NPHASE;
    hipLaunchKernelGGL(fwd, dim3(grid), dim3(512), LDS_BYTES, stream, p);
#endif
}
```

```cpp
#include <hip/hip_runtime.h>
#include <cstdio>
#include <cstdint>

#ifndef MK_SPLIT
#define MK_SPLIT 0
#endif

#define LAS __attribute__((address_space(3)))
typedef unsigned short bf16_t;
typedef short bf16x8 __attribute__((ext_vector_type(8)));
typedef short bf16x4 __attribute__((ext_vector_type(4)));
typedef float f32x4 __attribute__((ext_vector_type(4)));
typedef float f32x16 __attribute__((ext_vector_type(16)));
typedef unsigned u32x4 __attribute__((ext_vector_type(4)));
typedef unsigned u32x2 __attribute__((ext_vector_type(2)));

constexpr int D = 1024, NB = 16, S = 2048, T = NB * S, DEPTH = 2;
constexpr int NZ = 1792;
constexpr int N_IN = 1736;
constexpr int Z_AVAL = 0, Z_AGATE = 256, Z_CQ = 512, Z_CKV = 768, Z_QI = 896, Z_KI = 1408, Z_WI = 1472, Z_UP = 1480;
constexpr int KMIX = 1536;
constexpr int NEXP = 32, DEXP = 512, MAXTILES = 288, PMAX = MAXTILES * 256;
constexpr float EPS = 1e-6f;
constexpr int SC_PER_B = 4096 * 528;

constexpr size_t MiB = 1u << 20;
constexpr size_t WS_CTL = 0, CTL_ZERO_BYTES = 64 * 1024;
constexpr size_t WS_MOD = 1 * MiB;
constexpr size_t WS_WIN = 2 * MiB;
constexpr size_t WS_WQA = 9 * MiB;
constexpr size_t WS_WMIX = 10 * MiB;
constexpr size_t WS_SMALL = 16 * MiB;
constexpr size_t WS_W13 = 20 * MiB;
constexpr size_t WS_W2 = 84 * MiB;
constexpr size_t WS_Z = 116 * MiB;
constexpr size_t WS_MIXCAT = 228 * MiB;
constexpr size_t WS_H = 324 * MiB;
constexpr size_t WS_CQR = 388 * MiB;
constexpr size_t WS_KVN = 404 * MiB;
constexpr size_t WS_Y = 412 * MiB;
constexpr size_t WS_END = 556 * MiB;
constexpr size_t SM_TOKE = 0;
constexpr size_t SM_TOKG = 256 * 1024;
constexpr size_t SM_RANK = 512 * 1024;
constexpr size_t SM_TSLOT = 768 * 1024;
constexpr size_t SM_STOK = 1024 * 1024;
constexpr size_t SM_SGATE = 1024 * 1024 + 512 * 1024;
constexpr size_t SM_CNT = 2 * 1024 * 1024;
constexpr size_t SM_TEXP = 2 * 1024 * 1024 + 64 * 1024;
constexpr size_t SM_REW2 = 2 * 1024 * 1024 + 512 * 1024;
constexpr size_t SM_RGW2 = 3 * 1024 * 1024;
constexpr int CW_BAR = 1024;

constexpr int LDS_BYTES = 139264;
constexpr int LIST_OFF = 131072;
constexpr int MISC_OFF = 138240;
constexpr int NPHASE = 22;

__device__ __forceinline__ unsigned cvt_pk_bf16(float lo, float hi) { unsigned r; asm volatile("v_cvt_pk_bf16_f32 %0, %1, %2" : "=v"(r) : "v"(lo), "v"(hi)); return r; }
__device__ __forceinline__ float bf2f(unsigned short b) { return __uint_as_float(((unsigned)b) << 16); }
__device__ __forceinline__ float bflo(unsigned w) { return __uint_as_float(w << 16); }
__device__ __forceinline__ float bfhi(unsigned w) { return __uint_as_float(w & 0xffff0000u); }
template <int W> __device__ __forceinline__ int lane_xor_i(int iv) {
    int r;
    if constexpr (W == 1) r = __builtin_amdgcn_mov_dpp(iv, 0xB1, 0xF, 0xF, true);
    else if constexpr (W == 2) r = __builtin_amdgcn_mov_dpp(iv, 0x4E, 0xF, 0xF, true);
    else if constexpr (W == 4) { r = __builtin_amdgcn_update_dpp(iv, iv, 0x104, 0xF, 0x5, false);
                                 r = __builtin_amdgcn_update_dpp(r, iv, 0x114, 0xF, 0xA, false); }
    else if constexpr (W == 8) r = __builtin_amdgcn_mov_dpp(iv, 0x128, 0xF, 0xF, true);
    else if constexpr (W == 16) { const auto p = __builtin_amdgcn_permlane16_swap((unsigned)iv, (unsigned)iv, false, false); r = (threadIdx.x & 16) ? (int)p[0] : (int)p[1]; }
    else { const auto p = __builtin_amdgcn_permlane32_swap((unsigned)iv, (unsigned)iv, false, false); r = (threadIdx.x & 32) ? (int)p[0] : (int)p[1]; }
    return r;
}
template <int W> __device__ __forceinline__ float lane_xor(float v) { return __builtin_bit_cast(float, lane_xor_i<W>(__builtin_bit_cast(int, v))); }
template <int W> __device__ __forceinline__ unsigned lane_xor(unsigned v) { return (unsigned)lane_xor_i<W>((int)v); }
__device__ __forceinline__ float wave_sum(float v) {
    v += lane_xor<1>(v); v += lane_xor<2>(v); v += lane_xor<4>(v); v += lane_xor<8>(v); v += lane_xor<16>(v); v += lane_xor<32>(v);
    return v;
}
__device__ __forceinline__ float sigmoidf_(float x) { return 1.0f / (1.0f + __expf(-x)); }
#define LDS_WAIT() asm volatile("s_waitcnt lgkmcnt(0)" ::: "memory")
#define VM_WAIT() asm volatile("s_waitcnt vmcnt(0)" ::: "memory")

#define XB_TMO      128
#define XB_XCNT(j)  (256  + 64 * (j))
#define XB_XSUB(j)  (1280 + 64 * (j))
#define XB_XGEN(j)  (2304 + 64 * (j))
#define XB_TOP      3328
#define XB_TOPGEN   3392
#define XCD_BAR_WORDS 3456
#define XB_SPIN_CAP (1u << 22)

__device__ __forceinline__ unsigned xb_ld(unsigned* p)              { return __hip_atomic_load(p, __ATOMIC_RELAXED, __HIP_MEMORY_SCOPE_AGENT); }
__device__ __forceinline__ unsigned xb_add(unsigned* p, unsigned v) { return __hip_atomic_fetch_add(p, v, __ATOMIC_RELAXED, __HIP_MEMORY_SCOPE_AGENT); }
__device__ __forceinline__ unsigned xb_xcc_id() { return (unsigned)__builtin_amdgcn_s_getreg((3 << 11) | 20) & 0xFu; }
#define XB_SPIN(cond, bar) do { unsigned _sp = 0; while (cond) { __builtin_amdgcn_s_sleep(1); \
    if ((++_sp & 255u) == 0u) { if (xb_ld(&(bar)[XB_TMO])) break; if (_sp > XB_SPIN_CAP) { atomicAdd(&(bar)[XB_TMO], 1u); break; } } } } while (0)

struct XcdBarrier {
    unsigned* bar; unsigned x;
    volatile LAS unsigned* st;
};
__device__ __forceinline__ XcdBarrier xcd_barrier_post(unsigned* bar, volatile LAS unsigned* st) {
    XcdBarrier b; b.bar = bar; b.x = xb_xcc_id(); b.st = st;
    if (threadIdx.x == 0) (void)xb_add(&bar[XB_XCNT(b.x)], 1u);
    return b;
}
__device__ __forceinline__ void xcd_barrier_complete(unsigned* bar, unsigned x, unsigned& nloc, unsigned& nx) {
    const unsigned G = gridDim.x * gridDim.y * gridDim.z;
    unsigned sum, cnt, mine, sp = 0u;
    for (;;) {
        sum = 0u; cnt = 0u; mine = 0u;
#pragma unroll
        for (unsigned j = 0; j < 16; ++j) { const unsigned c = xb_ld(&bar[XB_XCNT(j)]); sum += c; cnt += (c > 0u) ? 1u : 0u; mine = (j == x) ? c : mine; }
        if (sum == G) break;
        __builtin_amdgcn_s_sleep(1);
        if ((++sp & 255u) == 0u) { if (xb_ld(&bar[XB_TMO])) break; if (sp > XB_SPIN_CAP) { atomicAdd(&bar[XB_TMO], 1u); break; } }
    }
    nloc = mine > 0u ? mine : 1u; nx = cnt > 0u ? cnt : 1u;
}
__device__ __forceinline__ void xcd_barrier(const XcdBarrier& b) {
    asm volatile("s_waitcnt vmcnt(0)" ::: "memory");
    __syncthreads();
    if (threadIdx.x == 0) {
        unsigned* bar = b.bar;
        __builtin_amdgcn_s_waitcnt(0);
        unsigned nloc = b.st[0], nx = b.st[1];
        if (nloc == 0u) { xcd_barrier_complete(bar, b.x, nloc, nx); b.st[0] = nloc; b.st[1] = nx; }
        const unsigned old = xb_add(&bar[XB_XSUB(b.x)], 1u);
        const unsigned gen = old / nloc;
        if (old + 1u == (gen + 1u) * nloc) {
            __builtin_amdgcn_fence(__ATOMIC_RELEASE, "agent");
            asm volatile("s_waitcnt vmcnt(0)" ::: "memory");
            const unsigned og = xb_add(&bar[XB_TOP], 1u);
            const unsigned tg = og / nx;
            if (og + 1u == (tg + 1u) * nx) xb_add(&bar[XB_TOPGEN], 1u);
            else XB_SPIN(xb_ld(&bar[XB_TOPGEN]) == tg, bar);
            __builtin_amdgcn_fence(__ATOMIC_ACQUIRE, "agent");
            xb_add(&bar[XB_XGEN(b.x)], 1u);
            asm volatile("s_waitcnt vmcnt(0)" ::: "memory");
        } else {
            XB_SPIN(xb_ld(&bar[XB_XGEN(b.x)]) == gen, bar);
            __builtin_amdgcn_fence(__ATOMIC_ACQUIRE, "agent");
            asm volatile("s_waitcnt vmcnt(0)" ::: "memory");
        }
    }
    __syncthreads();
}

namespace pg8 {
constexpr int BM = 256, BK = 64, HALF = 128, HTB = HALF * BK * 2  , STAGE_BYTES = 8 * HTB, NXCD = 8, WGM = 8;
__host__ __device__ __forceinline__ int lds_byte(int r, int c) { const int st = (r >> 4) * 2 + (c >> 5), rr = r & 15, cc = c & 31, ob = rr * 64 + cc * 2; return st * 1024 + (ob ^ (((ob >> 9) & 1) << 5)); }
__host__ __device__ __forceinline__ void stage_rc(int b, int& R, int& C) { const int st = b / 1024, sb = b % 1024, swz = sb ^ (((sb >> 9) & 1) << 5); R = (st >> 1) * 16 + swz / 64; C = (st & 1) * 32 + (swz % 64) / 2; }
__host__ __device__ __forceinline__ int perm32(int rho) { const int n = rho >> 4, i = rho & 15; return 8 * (i >> 2) + 4 * n + (i & 3); }

struct Unit { int pm, pn; const char* a; const char* b; };

struct StaticOrder {
    const char* A; const char* Bt; int K; const int* rowidx;
    int nM, nN, nwg, G, c;
    __device__ void init(const void* A_, const void* Bt_, int M, int N, int K_, int G_, int c_) { A = (const char*)A_; Bt = (const char*)Bt_; K = K_; rowidx = nullptr; nM = M / BM; nN = N / BM; nwg = nM * nN; G = G_; c = c_; }
    __device__ __forceinline__ bool next(int i, Unit& u) const {
        const long L = (long)i * G + c; if (L >= nwg) return false;
        int wgid = (int)L; { const int q = nwg / NXCD, r = nwg % NXCD, xcd = wgid % NXCD, off = wgid / NXCD; wgid = (xcd < r ? xcd * (q + 1) : r * (q + 1) + (xcd - r) * q) + off; }
        const int nig = WGM * nN, gid = wgid / nig, fm = gid * WGM, gsz = (nM - fm) < WGM ? (nM - fm) : WGM;
        u.pm = fm + ((wgid % nig) % gsz); u.pn = (wgid % nig) / gsz;
        u.a = A + (size_t)u.pm * BM * K * 2; u.b = Bt + (size_t)u.pn * BM * K * 2; return true;
    }
};
struct MoeOrder {
    const char* A; const char* Bt; int K; const int* rowidx;
    const int* tile_exp; int nunits, G, c; size_t bstride;
    __device__ void init(const void* A_, const void* Bt_, int K_, size_t bstride_, const int* rowidx_, const int* tile_exp_, int ntiles, int G_, int c_) {
        A = (const char*)A_; Bt = (const char*)Bt_; K = K_; bstride = bstride_; rowidx = rowidx_; tile_exp = tile_exp_; nunits = ntiles * 4; G = G_; c = c_; }
    __device__ __forceinline__ bool next(int i, Unit& u) const {
        const int L = i * G + c; if (L >= nunits) return false;
        u.pm = L >> 2; u.pn = L & 3; const int e = tile_exp[u.pm];
        u.a = A + (size_t)u.pm * BM * K * 2; u.b = Bt + (size_t)e * bstride + (size_t)u.pn * BM * K * 2; return true;
    }
};

struct EpiBf16 {
    static constexpr bool PERM = true;
    bf16_t* O; int ldc;
    __device__ __forceinline__ void operator()(const f32x4 (&acc)[2][2][4][2], const Unit& u, int wr, int wc, int fr, int fq) const {
        const int row0 = u.pm * BM + wr * 64 + fr, col0 = u.pn * BM + wc * 32 + 8 * fq;
#pragma unroll
        for (int ai = 0; ai < 2; ++ai)
#pragma unroll
            for (int m = 0; m < 4; ++m) { bf16_t* rowp = O + (size_t)(row0 + ai * HALF + m * 16) * ldc + col0;
#pragma unroll
                for (int bj = 0; bj < 2; ++bj) { const f32x4 v0 = acc[ai][bj][m][0], v1 = acc[ai][bj][m][1];
                    u32x4 w; w.x = cvt_pk_bf16(v0[0], v0[1]); w.y = cvt_pk_bf16(v0[2], v0[3]); w.z = cvt_pk_bf16(v1[0], v1[1]); w.w = cvt_pk_bf16(v1[2], v1[3]);
                    *(u32x4*)(rowp + bj * HALF) = w; } }
    }
};
struct EpiMix {
    static constexpr bool PERM = false;
    const float* xin; float* out; const float* gate;
    __device__ __forceinline__ void operator()(const f32x4 (&acc)[2][2][4][2], const Unit& u, int wr, int wc, int fr, int fq) const {
        const int row0 = u.pm * BM + wr * 64 + fr, col0 = u.pn * BM + wc * 32 + 4 * fq;
        const float* gp = gate + (size_t)(u.pm >> 3) * 6144 + col0;
        f32x4 gv[2][2];
#pragma unroll
        for (int bj = 0; bj < 2; ++bj)
#pragma unroll
            for (int n = 0; n < 2; ++n) gv[bj][n] = *(const f32x4*)(gp + bj * HALF + n * 16);
#pragma unroll
        for (int ai = 0; ai < 2; ++ai)
#pragma unroll
            for (int m = 0; m < 4; ++m) { const size_t off = (size_t)(row0 + ai * HALF + m * 16) * D + col0;
#pragma unroll
                for (int bj = 0; bj < 2; ++bj)
#pragma unroll
                    for (int n = 0; n < 2; ++n) { const f32x4 xv = *(const f32x4*)(xin + off + bj * HALF + n * 16);
                        *(f32x4*)(out + off + bj * HALF + n * 16) = xv + gv[bj][n] * acc[ai][bj][m][n]; } }
    }
};
struct EpiAct {
    static constexpr bool PERM = true;
    bf16_t* O;
    __device__ __forceinline__ void operator()(const f32x4 (&acc)[2][2][4][2], const Unit& u, int wr, int wc, int fr, int fq) const {
        const int row0 = u.pm * BM + wr * 64 + fr, col0 = u.pn * 128 + wc * 16 + 4 * fq;
#pragma unroll
        for (int ai = 0; ai < 2; ++ai)
#pragma unroll
            for (int m = 0; m < 4; ++m) { bf16_t* rowp = O + (size_t)(row0 + ai * HALF + m * 16) * DEXP + col0;
#pragma unroll
                for (int bj = 0; bj < 2; ++bj) { const f32x4 a = acc[ai][bj][m][0], b = acc[ai][bj][m][1]; f32x4 r;
#pragma unroll
                    for (int j = 0; j < 4; ++j) r[j] = a[j] * b[j] * __builtin_amdgcn_rcpf(1.0f + __expf(-a[j]));
                    u32x2 w; w.x = cvt_pk_bf16(r[0], r[1]); w.y = cvt_pk_bf16(r[2], r[3]);
                    *(u32x2*)(rowp + bj * 64) = w; } }
    }
};
struct EpiY {
    static constexpr bool PERM = true;
    bf16_t* O; const float* sgate;
    __device__ __forceinline__ void operator()(const f32x4 (&acc)[2][2][4][2], const Unit& u, int wr, int wc, int fr, int fq) const {
        const int row0 = u.pm * BM + wr * 64 + fr, col0 = u.pn * BM + wc * 32 + 8 * fq;
#pragma unroll
        for (int ai = 0; ai < 2; ++ai)
#pragma unroll
            for (int m = 0; m < 4; ++m) { const int row = row0 + ai * HALF + m * 16; const float g = sgate[row]; bf16_t* rowp = O + (size_t)row * D + col0;
#pragma unroll
                for (int bj = 0; bj < 2; ++bj) { const f32x4 v0 = acc[ai][bj][m][0] * g, v1 = acc[ai][bj][m][1] * g;
                    u32x4 w; w.x = cvt_pk_bf16(v0[0], v0[1]); w.y = cvt_pk_bf16(v0[2], v0[3]); w.z = cvt_pk_bf16(v1[0], v1[1]); w.w = cvt_pk_bf16(v1[2], v1[3]);
                    *(u32x4*)(rowp + bj * HALF) = w; } }
    }
};

template <class Epi, class Sched, bool GATHER>
__device__ __forceinline__ void gemm_phase(LAS unsigned char* lds, const Sched& S, const Epi& E) {
    const int tid = threadIdx.x, wid = __builtin_amdgcn_readfirstlane(tid >> 6), lane = tid & 63, wr = wid >> 2, wc = wid & 3, fr = lane & 15, fq = lane >> 4;
    const int K = S.K, nt = K / BK;
    unsigned voffA[2], voffB[2]; int RA[2], CA[2];
#pragma unroll
    for (int i = 0; i < 2; ++i) { int R, C; stage_rc(tid * 16 + i * 8192, R, C); const int Rb = Epi::PERM ? ((R & ~31) + perm32(R & 31)) : R;
        RA[i] = R; CA[i] = C; voffA[i] = (unsigned)(R * K + C) * 2u; voffB[i] = (unsigned)(Rb * K + C) * 2u; }
    const size_t kstep = (size_t)(BK * 2);
    const size_t hstep = (size_t)HALF * K * 2;
    const unsigned ldsw = (unsigned)wid * 1024u;
    const int aoff = lds_byte(wr * 64 + fr, fq * 8), boff = lds_byte(wc * 32 + fr, fq * 8);
#define PG8_SA(b, h) (((b) * 2 + (h)) * HTB)
#define PG8_SB(b, h) ((4 + (b) * 2 + (h)) * HTB)
#define PG8_DMA(bufoff, gptr, i) __builtin_amdgcn_global_load_lds((const unsigned*)(gptr), (LAS unsigned*)(lds + (bufoff) + ldsw + (i) * 8192), 16, 0, 0)
#define PG8_STAGE(bufoff, gbase, voff) do { PG8_DMA(bufoff, (const char*)(gbase) + (voff)[0], 0); PG8_DMA(bufoff, (const char*)(gbase) + (voff)[1], 1); } while (0)
#define PG8_STAGE_A(bufoff, nx, h, kb) do { if constexpr (GATHER) { \
            PG8_DMA(bufoff, S.A + (kb) + ((nx) ? gN[h][0] : gC[h][0]), 0); PG8_DMA(bufoff, S.A + (kb) + ((nx) ? gN[h][1] : gC[h][1]), 1); } \
        else { const char* _b = ((nx) ? nA : cA) + (h) * hstep + (kb); PG8_DMA(bufoff, _b + voffA[0], 0); PG8_DMA(bufoff, _b + voffA[1], 1); } } while (0)
#define PG8_LDA(dst, b, h) do { _Pragma("unroll") for (int m = 0; m < 4; ++m) _Pragma("unroll") for (int k = 0; k < 2; ++k) dst[m][k] = *(const LAS bf16x8*)(lds + PG8_SA(b, h) + aoff + m * 2048 + k * 1024); } while (0)
#define PG8_LDB(dst, b, h) do { _Pragma("unroll") for (int n = 0; n < 2; ++n) _Pragma("unroll") for (int k = 0; k < 2; ++k) dst[n][k] = *(const LAS bf16x8*)(lds + PG8_SB(b, h) + boff + n * 2048 + k * 1024); } while (0)
#define PG8_MMA(ai, bj, At, Bt) do { __builtin_amdgcn_s_setprio(1); _Pragma("unroll") for (int m = 0; m < 4; ++m) _Pragma("unroll") for (int n = 0; n < 2; ++n) _Pragma("unroll") for (int k = 0; k < 2; ++k) \
        acc[ai][bj][m][n] = __builtin_amdgcn_mfma_f32_16x16x32_bf16(Bt[n][k], At[m][k], acc[ai][bj][m][n], 0, 0, 0); __builtin_amdgcn_s_setprio(0); } while (0)
#define PG8_WAIT_V(n) asm volatile("s_waitcnt vmcnt(" #n ")" ::: "memory")
#define PG8_WAIT_L(n) asm volatile("s_waitcnt lgkmcnt(" #n ")" ::: "memory")
#define PG8_BAR __builtin_amdgcn_s_barrier()
#define PG8_SCHED __builtin_amdgcn_sched_barrier(0)
    Unit cur, nxt; int ui = 0;
    if (!S.next(0, cur)) return;
    unsigned gC[2][2] = {{0u, 0u}, {0u, 0u}}, gN[2][2] = {{0u, 0u}, {0u, 0u}};
    if constexpr (GATHER) {
#pragma unroll
        for (int h = 0; h < 2; ++h)
#pragma unroll
            for (int i = 0; i < 2; ++i) gC[h][i] = (unsigned)(S.rowidx[cur.pm * BM + h * HALF + RA[i]] * K + CA[i]) * 2u;
    }
    f32x4 acc[2][2][4][2];
#pragma unroll
    for (int a = 0; a < 2; ++a)
#pragma unroll
        for (int b = 0; b < 2; ++b)
#pragma unroll
            for (int m = 0; m < 4; ++m)
#pragma unroll
                for (int n = 0; n < 2; ++n) acc[a][b][m][n] = (f32x4){0.f, 0.f, 0.f, 0.f};
    bf16x8 At[4][2], B0[2][2], B1[2][2];
    const char* cA = cur.a; const char* cB = cur.b; const char* nA = cA; const char* nB = cB;
    PG8_STAGE(PG8_SB(0, 0), cB, voffB); PG8_STAGE(PG8_SB(0, 1), cB + hstep, voffB); PG8_STAGE_A(PG8_SA(0, 0), false, 0, 0); PG8_STAGE_A(PG8_SA(0, 1), false, 1, 0);
    if (wr == 1) PG8_BAR;
    PG8_WAIT_V(2); PG8_BAR;
    PG8_STAGE(PG8_SB(1, 0), cB + kstep, voffB); PG8_STAGE_A(PG8_SA(1, 0), false, 0, kstep); PG8_STAGE(PG8_SB(1, 1), cB + hstep + kstep, voffB);
    PG8_WAIT_V(6); PG8_BAR;
    for (;;) {
        const bool has_next = S.next(ui + 1, nxt);
        nA = has_next ? nxt.a : cA; nB = has_next ? nxt.b : cB;
        if constexpr (GATHER) {
            const int npm = has_next ? nxt.pm : cur.pm;
#pragma unroll
            for (int h = 0; h < 2; ++h)
#pragma unroll
                for (int i = 0; i < 2; ++i) gN[h][i] = (unsigned)(S.rowidx[npm * BM + h * HALF + RA[i]] * K + CA[i]) * 2u;
        }
        for (int t = 0; t < nt; t += 2) {
            const bool last = (t == nt - 2);
            const size_t k1 = (size_t)(t + 1) * kstep;
            const size_t k2 = last ? 0 : (size_t)(t + 2) * kstep, k3 = k2 + kstep;
            const char* b2 = (last ? nB : cB) + k2; const char* b3 = b2 + kstep;
            PG8_LDB(B0, 0, 0); PG8_LDB(B1, 0, 1); PG8_SCHED; PG8_LDA(At, 0, 0); PG8_STAGE_A(PG8_SA(1, 1), false, 1, k1);
            PG8_WAIT_V(8); PG8_WAIT_L(0); PG8_BAR; PG8_MMA(0, 0, At, B0); PG8_MMA(0, 1, At, B1); PG8_BAR; PG8_SCHED;
            PG8_LDA(At, 0, 1); PG8_STAGE(PG8_SB(0, 0), b2, voffB); PG8_STAGE(PG8_SB(0, 1), b2 + hstep, voffB); PG8_STAGE_A(PG8_SA(0, 0), last, 0, k2);
            PG8_WAIT_V(8); PG8_WAIT_L(0); PG8_BAR; PG8_MMA(1, 0, At, B0); PG8_MMA(1, 1, At, B1); PG8_BAR; PG8_SCHED;
            PG8_LDB(B0, 1, 0); PG8_LDB(B1, 1, 1); PG8_SCHED; PG8_LDA(At, 1, 0); PG8_STAGE_A(PG8_SA(0, 1), last, 1, k2);
            PG8_WAIT_V(8); PG8_WAIT_L(0); PG8_BAR; PG8_MMA(0, 0, At, B0); PG8_MMA(0, 1, At, B1); PG8_BAR; PG8_SCHED;
            PG8_LDA(At, 1, 1); PG8_STAGE(PG8_SB(1, 0), b3, voffB); PG8_STAGE(PG8_SB(1, 1), b3 + hstep, voffB); PG8_STAGE_A(PG8_SA(1, 0), last, 0, k3);
            PG8_WAIT_V(8); PG8_WAIT_L(0); PG8_BAR; PG8_MMA(1, 0, At, B0); PG8_MMA(1, 1, At, B1); PG8_BAR; PG8_SCHED;
        }
        if (wr == 0) PG8_BAR;
        E(acc, cur, wr, wc, fr, fq);
        if (!has_next) break;
#pragma unroll
        for (int a = 0; a < 2; ++a)
#pragma unroll
            for (int b = 0; b < 2; ++b)
#pragma unroll
                for (int m = 0; m < 4; ++m)
#pragma unroll
                    for (int n = 0; n < 2; ++n) acc[a][b][m][n] = (f32x4){0.f, 0.f, 0.f, 0.f};
        cur = nxt; cA = nA; cB = nB; ++ui;
        if constexpr (GATHER) {
#pragma unroll
            for (int h = 0; h < 2; ++h)
#pragma unroll
                for (int i = 0; i < 2; ++i) gC[h][i] = gN[h][i];
        }
        if (wr == 1) PG8_BAR;
    }
    PG8_WAIT_V(0);
    PG8_BAR;
#undef PG8_SA
#undef PG8_SB
#undef PG8_DMA
#undef PG8_STAGE
#undef PG8_STAGE_A
#undef PG8_LDA
#undef PG8_LDB
#undef PG8_MMA
#undef PG8_WAIT_V
#undef PG8_WAIT_L
#undef PG8_BAR
#undef PG8_SCHED
}
}

struct Params { const float* in[27]; float* out; unsigned char* ws; int ph_lo, ph_hi; };
struct Ctx { LAS unsigned char* lds; int tid, lane, wave, vcu, G, gw, NGW; };
enum { I_X = 0, I_C, I_MODW, I_MODB, I_N1G, I_WIN, I_CONVK, I_CONVB, I_CLNG, I_CLNB, I_QNG, I_KVNG, I_WUQ, I_WUK, I_WUV, I_POOLW, I_POOLS, I_WOUT, I_N2G, I_RGW, I_RGB, I_REW, I_REB, I_W1, I_W3, I_W2, I_FG };

template <class RowMap>
__device__ __forceinline__ void tr_item(const float* src, int ldn, int k0, int n0, int nvalid, bf16_t* dst, int ldk, int dk0, RowMap rm, LAS float* scr, int lane) {
#pragma unroll 8
    for (int i = 0; i < 32; ++i) { const int kk = 2 * i + (lane >> 5), n = n0 + (lane & 31); scr[kk * 33 + (lane & 31)] = (n < nvalid) ? src[(size_t)(k0 + kk) * ldn + n] : 0.f; }
    LDS_WAIT();
    const int c = lane & 7;
#pragma unroll
    for (int j = 0; j < 4; ++j) { const int n = (lane >> 3) + 8 * j; const LAS float* s = scr + (8 * c) * 33 + n;
        u32x4 o; o.x = cvt_pk_bf16(s[0 * 33], s[1 * 33]); o.y = cvt_pk_bf16(s[2 * 33], s[3 * 33]); o.z = cvt_pk_bf16(s[4 * 33], s[5 * 33]); o.w = cvt_pk_bf16(s[6 * 33], s[7 * 33]);
        *(u32x4*)(dst + (size_t)rm(n0 + n) * ldk + dk0 + k0 + 8 * c) = o; }
    LDS_WAIT();
}

__device__ __forceinline__ void conv_experts(const Params& p, const Ctx& c, int l) {
    LAS float* scr = (LAS float*)(c.lds + c.wave * 8448);
    bf16_t* W13 = (bf16_t*)(p.ws + WS_W13); bf16_t* W2 = (bf16_t*)(p.ws + WS_W2);
    for (int it = c.gw; it < 3 * 8192; it += c.NGW) {
        const int which = it >> 13, r = it & 8191, e = r >> 8;
        if (which < 2) { const int kb = (r >> 4) & 15, nb = r & 15; const float* src = p.in[which ? I_W3 : I_W1] + (size_t)(l * NEXP + e) * 1024 * 512; const int add = which ? 4 : 0;
            tr_item(src, 512, 64 * kb, 32 * nb, 512, W13 + (size_t)e * 1024 * 1024, 1024, 0, [add](int n) { return 8 * (n >> 2) + (n & 3) + add; }, scr, c.lane); }
        else { const int kb = (r >> 5) & 7, nb = r & 31; const float* src = p.in[I_W2] + (size_t)(l * NEXP + e) * 512 * 1024;
            tr_item(src, 1024, 64 * kb, 32 * nb, 1024, W2 + (size_t)e * 1024 * 512, 512, 0, [](int n) { return n; }, scr, c.lane); }
    }
}

__device__ __forceinline__ void ph_prologue(const Params& p, const Ctx& c) {
    float* mod = (float*)(p.ws + WS_MOD);
    {
        LAS float* cond = (LAS float*)c.lds; LAS float* part = (LAS float*)(c.lds + 65536);
        bool loaded = false;
        for (int item = c.vcu; item < 192; item += c.G) {
            if (!loaded) { for (int i = c.tid; i < NB * D; i += 512) { const float v = p.in[I_C][i]; cond[i] = v / (1.0f + expf(-v)); } __syncthreads(); loaded = true; }
            const int l = item / 96, n0 = (item % 96) * 64;
            const float* W = p.in[I_MODW] + (size_t)l * D * 6144 + n0 + c.lane;
            float acc[NB];
#pragma unroll
            for (int b = 0; b < NB; ++b) acc[b] = 0.f;
            for (int k = c.wave * 128; k < c.wave * 128 + 128; ++k) { const float w = W[(size_t)k * 6144];
#pragma unroll
                for (int b = 0; b < NB; ++b) acc[b] += cond[b * D + k] * w; }
#pragma unroll
            for (int b = 0; b < NB; ++b) part[(c.wave * NB + b) * 64 + c.lane] = acc[b];
            __syncthreads();
            for (int o = c.tid; o < NB * 64; o += 512) { const int b = o >> 6, ln = o & 63; float s = 0.f;
#pragma unroll
                for (int w = 0; w < 8; ++w) s += part[(w * NB + b) * 64 + ln];
                mod[(size_t)(l * NB + b) * 6144 + n0 + ln] = s + p.in[I_MODB][l * 6144 + n0 + ln]; }
            __syncthreads();
        }
        __syncthreads();
    }
    {
        LAS float* scr = (LAS float*)(c.lds + c.wave * 8448);
        constexpr int I_IN = 16 * 56, I_MX = 4 * 32;
        for (int it = c.gw; it < 2 * (I_IN + 2 * I_MX); it += c.NGW) {
            const int l = it / (I_IN + 2 * I_MX); int r = it % (I_IN + 2 * I_MX);
            if (r < I_IN) { const int kb = r / 56, nb = r % 56;
                tr_item(p.in[I_WIN] + (size_t)l * D * N_IN, N_IN, 64 * kb, 32 * nb, N_IN, (bf16_t*)(p.ws + WS_WIN) + (size_t)l * NZ * D, D, 0, [](int n) { return n; }, scr, c.lane); continue; }
            r -= I_IN; const int part = r / I_MX; r %= I_MX; const int kb = r / 32, nb = r % 32;
            tr_item(p.in[I_WOUT] + (size_t)l * D * D + (size_t)(part ? 768 : 0) * D, D, 64 * kb, 32 * nb, D, (bf16_t*)(p.ws + WS_WMIX) + (size_t)l * D * KMIX, KMIX, part ? 1280 : 0, [](int n) { return n; }, scr, c.lane);
        }
    }
    for (int it = c.gw * 64 + c.lane; it < 2 * 131072; it += c.NGW * 64) {
        const int l = it >> 17, r = it & 131071, n = r & 1023, h = (r >> 10) & 7, cb = r >> 13;
        const float* wo = p.in[I_WOUT] + (size_t)l * D * D + (size_t)(256 + 64 * h) * D + n;
        const float* wv = p.in[I_WUV] + (size_t)l * 128 * 512 + (size_t)(8 * cb) * 512 + h * 64;
        float acc[8];
#pragma unroll
        for (int j = 0; j < 8; ++j) acc[j] = 0.f;
        for (int d = 0; d < 64; ++d) { const float w = wo[(size_t)d * D];
#pragma unroll
            for (int j = 0; j < 8; ++j) acc[j] += wv[j * 512 + d] * w; }
        u32x4 o; o.x = cvt_pk_bf16(acc[0], acc[1]); o.y = cvt_pk_bf16(acc[2], acc[3]); o.z = cvt_pk_bf16(acc[4], acc[5]); o.w = cvt_pk_bf16(acc[6], acc[7]);
        *(u32x4*)((bf16_t*)(p.ws + WS_WMIX) + (size_t)l * D * KMIX + (size_t)n * KMIX + 256 + 128 * h + 8 * cb) = o;
    }
    for (int it = c.gw * 64 + c.lane; it < 2 * 32768; it += c.NGW * 64) {
        const int l = it >> 15, r = it & 32767, cb = r & 31, k = (r >> 5) & 127, h = r >> 12;
        const float* uq = p.in[I_WUQ] + (size_t)l * 256 * 512 + (size_t)(8 * cb) * 512 + h * 64;
        const float* uk = p.in[I_WUK] + (size_t)l * 128 * 512 + (size_t)k * 512 + h * 64;
        float acc[8];
#pragma unroll
        for (int j = 0; j < 8; ++j) acc[j] = 0.f;
        for (int d = 0; d < 64; ++d) { const float w = uk[d];
#pragma unroll
            for (int j = 0; j < 8; ++j) acc[j] += uq[j * 512 + d] * w; }
        const float sc = 0.125f * 1.44269504089f;
#pragma unroll
        for (int j = 0; j < 8; ++j) acc[j] *= sc * p.in[I_QNG][l * 256 + 8 * cb + j];
        u32x4 o; o.x = cvt_pk_bf16(acc[0], acc[1]); o.y = cvt_pk_bf16(acc[2], acc[3]); o.z = cvt_pk_bf16(acc[4], acc[5]); o.w = cvt_pk_bf16(acc[6], acc[7]);
        *(u32x4*)((bf16_t*)(p.ws + WS_WQA) + (size_t)l * D * 256 + (size_t)(h * 128 + k) * 256 + 8 * cb) = o;
    }
    for (int it = c.gw * 64 + c.lane; it < 2 * 1024 * 32; it += c.NGW * 64) {
        const int l = it >> 15, r = it & 32767, k = r >> 5, g = (r >> 3) & 3, q = r & 7, e = k & 3, ln = (k >> 2) & 63, j = k >> 8;
        ((float*)(p.ws + WS_SMALL + SM_REW2))[(size_t)(l * 4 + g) * 8192 + (size_t)((((j * 4 + e) * 2 + (q >> 2)) * 64 + ln) * 4) + (q & 3)] = p.in[I_REW][(size_t)l * D * 32 + r];
    }
    for (int it = c.gw * 64 + c.lane; it < 2 * 1024 * 4; it += c.NGW * 64) {
        const int l = it >> 12, r = it & 4095, k = r >> 2, q = r & 3, e = k & 3, ln = (k >> 2) & 63, j = k >> 8;
        ((float*)(p.ws + WS_SMALL + SM_RGW2))[(size_t)l * 4096 + (size_t)(((j * 4 + e) * 64 + ln) * 4) + q] = p.in[I_RGW][(size_t)l * D * 4 + r];
    }
    conv_experts(p, c, 0);
}

template <int MODE>
__device__ __forceinline__ void ph_norm1(const Params& p, const Ctx& c) {
    const float* mod = (const float*)(p.ws + WS_MOD);
    const bf16_t* Y = (const bf16_t*)(p.ws + WS_Y); const int* tslot = (const int*)(p.ws + WS_SMALL + SM_TSLOT);
    bf16_t* H = (bf16_t*)(p.ws + WS_H);
    const float* xsrc = (MODE == 0 ? p.in[I_X] : p.out);
    constexpr int NR = 2;
    const int nrow = T / c.NGW;
    f32x4 vn[NR][4]; u32x2 an[NR][4], bn[NR][4];
    auto load_rows = [&](int r0) {
#pragma unroll
        for (int t = 0; t < NR; ++t) { const int m = c.gw + (r0 + t) * c.NGW;
#pragma unroll
            for (int j = 0; j < 4; ++j) vn[t][j] = ((const f32x4*)(xsrc + (size_t)m * D) + c.lane)[64 * j];
            if (MODE != 0) { const int s0 = tslot[2 * m], s1 = tslot[2 * m + 1];
#pragma unroll
                for (int j = 0; j < 4; ++j) { an[t][j] = ((const u32x2*)(Y + (size_t)s0 * D) + c.lane)[64 * j]; bn[t][j] = ((const u32x2*)(Y + (size_t)s1 * D) + c.lane)[64 * j]; } } } };
    load_rows(0);
    for (int r0 = 0; r0 < nrow; r0 += NR) {
        f32x4 v[NR][4]; u32x2 ya[NR][4], yb[NR][4];
#pragma unroll
        for (int t = 0; t < NR; ++t)
#pragma unroll
            for (int j = 0; j < 4; ++j) { v[t][j] = vn[t][j]; if (MODE != 0) { ya[t][j] = an[t][j]; yb[t][j] = bn[t][j]; } }
        if (r0 + NR < nrow) load_rows(r0 + NR);
#pragma unroll
        for (int t = 0; t < NR; ++t) {
            const int m = c.gw + (r0 + t) * c.NGW, b = m >> 11;
            if (MODE != 0) {
                const f32x4* g2 = (const f32x4*)(mod + (size_t)((MODE - 1) * NB + b) * 6144 + 5120) + c.lane;
#pragma unroll
                for (int j = 0; j < 4; ++j) { const u32x2 a = ya[t][j], bb = yb[t][j]; const f32x4 g = g2[64 * j];
                    v[t][j].x += g.x * (bflo(a.x) + bflo(bb.x)); v[t][j].y += g.y * (bfhi(a.x) + bfhi(bb.x)); v[t][j].z += g.z * (bflo(a.y) + bflo(bb.y)); v[t][j].w += g.w * (bfhi(a.y) + bfhi(bb.y)); }
            }
            float ss = 0.f;
#pragma unroll
            for (int j = 0; j < 4; ++j) ss += (v[t][j].x * v[t][j].x + v[t][j].y * v[t][j].y) + (v[t][j].z * v[t][j].z + v[t][j].w * v[t][j].w);
            const float r = 1.0f / sqrtf(wave_sum(ss) * (1.0f / D) + EPS);
            if (MODE == 2) {
                const f32x4* fg = (const f32x4*)p.in[I_FG] + c.lane; f32x4* o = (f32x4*)(p.out + (size_t)m * D) + c.lane;
#pragma unroll
                for (int j = 0; j < 4; ++j) o[64 * j] = v[t][j] * r * fg[64 * j];
            } else {
                if (MODE == 1) { f32x4* o = (f32x4*)(p.out + (size_t)m * D) + c.lane;
#pragma unroll
                    for (int j = 0; j < 4; ++j) o[64 * j] = v[t][j]; }
                const int l = MODE;
                const f32x4* ng = (const f32x4*)(p.in[I_N1G] + l * D) + c.lane;
                const f32x4* sh = (const f32x4*)(mod + (size_t)(l * NB + b) * 6144) + c.lane; const f32x4* sc = (const f32x4*)(mod + (size_t)(l * NB + b) * 6144 + 1024) + c.lane;
                u32x2* o8 = (u32x2*)(H + (size_t)m * D) + c.lane;
#pragma unroll
                for (int j = 0; j < 4; ++j) { const f32x4 hv = v[t][j] * r * ng[64 * j] * (sc[64 * j] + 1.0f) + sh[64 * j]; u32x2 w; w.x = cvt_pk_bf16(hv.x, hv.y); w.y = cvt_pk_bf16(hv.z, hv.w); o8[64 * j] = w; }
            }
        }
    }
}

__device__ __forceinline__ void ph_postz(const Params& p, const Ctx& c, int l) {
    const bf16_t* Z = (const bf16_t*)(p.ws + WS_Z); bf16_t* MC = (bf16_t*)(p.ws + WS_MIXCAT);
    bf16_t* CQR = (bf16_t*)(p.ws + WS_CQR); bf16_t* KVN = (bf16_t*)(p.ws + WS_KVN);
    LAS float* U = (LAS float*)c.lds;
    const int lane = c.lane, tk0 = c.wave * 8;
    for (int unit = c.vcu; unit < 512; unit += c.G) {
        const int b = unit >> 5, s0 = (unit & 31) * 64, t0 = b * S + s0;
        for (int idx = c.tid; idx < 94 * 64; idx += 512) { const int r = idx >> 6, c4 = idx & 63, s = s0 - 30 + r; f32x4 u = {0.f, 0.f, 0.f, 0.f};
            if (s >= 0) { const bf16_t* zr = Z + (size_t)(b * S + s) * NZ + 4 * c4; const u32x2 a = *(const u32x2*)(zr + Z_AVAL), g = *(const u32x2*)(zr + Z_AGATE);
                u.x = bflo(a.x) * sigmoidf_(bflo(g.x)); u.y = bfhi(a.x) * sigmoidf_(bfhi(g.x)); u.z = bflo(a.y) * sigmoidf_(bflo(g.y)); u.w = bfhi(a.y) * sigmoidf_(bfhi(g.y)); }
            *(LAS f32x4*)(U + r * 256 + 4 * c4) = u; }
        __syncthreads();
        {
            f32x4 acc[8], win[8];
#pragma unroll
            for (int i = 0; i < 8; ++i) { acc[i] = (f32x4){0.f, 0.f, 0.f, 0.f}; win[i] = *(const LAS f32x4*)(U + (tk0 + i) * 256 + 4 * lane); }
            const f32x4* ck = (const f32x4*)(p.in[I_CONVK] + (size_t)l * 31 * 256) + lane;
#pragma unroll
            for (int j = 0; j < 31; ++j) { const f32x4 kj = ck[64 * j];
#pragma unroll
                for (int i = 0; i < 8; ++i) acc[i] += win[i] * kj;
                if (j < 30) {
#pragma unroll
                    for (int i = 0; i < 7; ++i) win[i] = win[i + 1];
                    win[7] = *(const LAS f32x4*)(U + (tk0 + 8 + j) * 256 + 4 * lane); } }
            const f32x4 cb = *((const f32x4*)(p.in[I_CONVB] + l * 256) + lane), lg = *((const f32x4*)(p.in[I_CLNG] + l * 256) + lane), lb = *((const f32x4*)(p.in[I_CLNB] + l * 256) + lane);
#pragma unroll
            for (int i = 0; i < 8; ++i) { const f32x4 v = acc[i] + cb; const float mean = wave_sum((v.x + v.y) + (v.z + v.w)) * (1.0f / 256.0f);
                const f32x4 d = v - mean; const float var = wave_sum((d.x * d.x + d.y * d.y) + (d.z * d.z + d.w * d.w)) * (1.0f / 256.0f);
                const float rs = 1.0f / sqrtf(var + EPS); f32x4 y = d * rs * lg + lb;
                y.x *= sigmoidf_(y.x); y.y *= sigmoidf_(y.y); y.z *= sigmoidf_(y.z); y.w *= sigmoidf_(y.w);
                u32x2 w; w.x = cvt_pk_bf16(y.x, y.y); w.y = cvt_pk_bf16(y.z, y.w);
                *(u32x2*)(MC + (size_t)(t0 + tk0 + i) * KMIX + 4 * lane) = w; }
        }
        __syncthreads();
        for (int idx = c.tid; idx < 79 * 64; idx += 512) { const int r = idx >> 6, c4 = idx & 63, s = s0 - 15 + r; f32x4 u = {0.f, 0.f, 0.f, 0.f};
            if (s >= 0) { const u32x2 a = *(const u32x2*)(Z + (size_t)(b * S + s) * NZ + Z_UP + 4 * c4); u.x = bflo(a.x); u.y = bfhi(a.x); u.z = bflo(a.y); u.w = bfhi(a.y); }
            *(LAS f32x4*)(U + r * 256 + 4 * c4) = u; }
        __syncthreads();
        f32x4 dv[8];
        {
            const int w = 2 << (lane >> 4);
#pragma unroll
            for (int i = 0; i < 8; ++i) { const int r = 15 + tk0 + i, s = s0 + tk0 + i; f32x4 sum = {0.f, 0.f, 0.f, 0.f};
#pragma unroll
                for (int q = 0; q < 16; ++q) { const f32x4 u = *(const LAS f32x4*)(U + (r - q) * 256 + 4 * lane); if (q < w) sum += u; }
                const float cntf = (float)((s + 1) < w ? (s + 1) : w);
                dv[i] = sum / cntf - *(const LAS f32x4*)(U + r * 256 + 4 * lane); }
        }
        __syncthreads();
        {
            LAS float* Dw = U + c.wave * 2048;
#pragma unroll
            for (int i = 0; i < 8; ++i) *(LAS f32x4*)(Dw + i * 256 + 4 * lane) = dv[i];
            LDS_WAIT();
            const int g = lane >> 4, o4 = (lane & 15) * 4;
            const float* pw = p.in[I_POOLW] + (size_t)(l * 4 + g) * 4096 + o4;
            f32x4 out[8];
#pragma unroll
            for (int i = 0; i < 8; ++i) out[i] = (f32x4){0.f, 0.f, 0.f, 0.f};
            for (int ii = 0; ii < 64; ii += 4) {
                const f32x4 w0 = *(const f32x4*)(pw + (ii + 0) * 64), w1 = *(const f32x4*)(pw + (ii + 1) * 64), w2 = *(const f32x4*)(pw + (ii + 2) * 64), w3 = *(const f32x4*)(pw + (ii + 3) * 64);
#pragma unroll
                for (int i = 0; i < 8; ++i) { const f32x4 d = *(const LAS f32x4*)(Dw + i * 256 + 64 * g + ii); out[i] += w0 * d.x + w1 * d.y + w2 * d.z + w3 * d.w; } }
            const f32x4 ps = *((const f32x4*)(p.in[I_POOLS] + l * 256) + lane);
#pragma unroll
            for (int i = 0; i < 8; ++i) { const f32x4 y = out[i] * ps; u32x2 w; w.x = cvt_pk_bf16(y.x, y.y); w.y = cvt_pk_bf16(y.z, y.w);
                *(u32x2*)(MC + (size_t)(t0 + tk0 + i) * KMIX + 1280 + 4 * lane) = w; }
        }
        {
            const float kg0 = p.in[I_KVNG][l * 128 + 2 * lane], kg1 = p.in[I_KVNG][l * 128 + 2 * lane + 1];
#pragma unroll
            for (int i = 0; i < 8; ++i) { const size_t t = (size_t)(t0 + tk0 + i); const bf16_t* zr = Z + t * NZ;
                const u32x2 q = *(const u32x2*)(zr + Z_CQ + 4 * lane); const float q0 = bflo(q.x), q1 = bfhi(q.x), q2 = bflo(q.y), q3 = bfhi(q.y);
                const float rq = 1.0f / sqrtf(wave_sum((q0 * q0 + q1 * q1) + (q2 * q2 + q3 * q3)) * (1.0f / 256.0f) + EPS);
                u32x2 w; w.x = cvt_pk_bf16(q0 * rq, q1 * rq); w.y = cvt_pk_bf16(q2 * rq, q3 * rq); *(u32x2*)(CQR + t * 256 + 4 * lane) = w;
                const unsigned kv = *(const unsigned*)(zr + Z_CKV + 2 * lane); const float k0 = bflo(kv), k1 = bfhi(kv);
                const float rk = 1.0f / sqrtf(wave_sum(k0 * k0 + k1 * k1) * (1.0f / 128.0f) + EPS);
                *(unsigned*)(KVN + t * 128 + 2 * lane) = cvt_pk_bf16(k0 * rk * kg0, k1 * rk * kg1); }
        }
        __syncthreads();
    }
}

__device__ __forceinline__ size_t sc_off(int b, int cq) { return (size_t)b * SC_PER_B + (size_t)2048 * cq * (cq + 1); }
__device__ __forceinline__ void ph_scores(const Params& p, const Ctx& c) {
    const bf16_t* Z = (const bf16_t*)(p.ws + WS_Z); float* SC = (float*)(p.ws + WS_Y);
    const int lane = c.lane, l15 = lane & 15, g = lane >> 4;
    for (int U = c.gw; U < NB * 576; U += c.NGW) {
        const int b = U / 576, u = U % 576;
        int cg = 0; while (8 * (cg + 1) * (cg + 2) <= u) ++cg;
        const int r = u - 8 * cg * (cg + 1), q16 = r / (cg + 1), seg = r % (cg + 1), cq = 4 * cg + (q16 >> 2), q4 = q16 & 3;
        const int n = 64 * (cq + 1), kt0 = seg * 16, kt1 = (kt0 + 16 < 4 * (cq + 1)) ? kt0 + 16 : 4 * (cq + 1);
        const size_t tq = (size_t)b * S + cq * 64 + q4 * 16 + l15;
        const bf16_t* zq = Z + tq * NZ;
        bf16x8 bq[8][2];
#pragma unroll
        for (int h = 0; h < 8; ++h)
#pragma unroll
            for (int s = 0; s < 2; ++s) bq[h][s] = *(const bf16x8*)(zq + Z_QI + h * 64 + 32 * s + 8 * g);
        float wq[8];
        { const u32x4 wv = *(const u32x4*)(zq + Z_WI); const float isc = 0.044194173824159216f;
          wq[0] = bflo(wv.x) * isc; wq[1] = bfhi(wv.x) * isc; wq[2] = bflo(wv.y) * isc; wq[3] = bfhi(wv.y) * isc; wq[4] = bflo(wv.z) * isc; wq[5] = bfhi(wv.z) * isc; wq[6] = bflo(wv.w) * isc; wq[7] = bfhi(wv.w) * isc; }
        float* srow = SC + sc_off(b, cq) + (size_t)(q4 * 16 + l15) * n;
        const bf16_t* zkb = Z + ((size_t)b * S + l15) * NZ + Z_KI + 8 * g;
        bf16x8 nk0 = *(const bf16x8*)(zkb + (size_t)kt0 * 16 * NZ), nk1 = *(const bf16x8*)(zkb + (size_t)kt0 * 16 * NZ + 32);
        for (int kt = kt0; kt < kt1; ++kt) {
            const bf16x8 ak0 = nk0, ak1 = nk1;
            if (kt + 1 < kt1) { nk0 = *(const bf16x8*)(zkb + (size_t)(kt + 1) * 16 * NZ); nk1 = *(const bf16x8*)(zkb + (size_t)(kt + 1) * 16 * NZ + 32); }
            f32x4 sc = {0.f, 0.f, 0.f, 0.f};
#pragma unroll
            for (int h = 0; h < 8; ++h) { f32x4 a = {0.f, 0.f, 0.f, 0.f};
                a = __builtin_amdgcn_mfma_f32_16x16x32_bf16(ak0, bq[h][0], a, 0, 0, 0);
                a = __builtin_amdgcn_mfma_f32_16x16x32_bf16(ak1, bq[h][1], a, 0, 0, 0);
#pragma unroll
                for (int i = 0; i < 4; ++i) sc[i] += wq[h] * fmaxf(a[i], 0.f); }
            *(f32x4*)(srow + kt * 16 + 4 * g) = sc;
        }
    }
}

__device__ __forceinline__ unsigned off_b(unsigned row, unsigned ch) { return 256u * row + 16u * (ch ^ (((row & 3) << 2) | ((row >> 2) & 3))); }
template <int MODE>
__device__ __forceinline__ void ph_attn(const Params& p, const Ctx& c) {
    const float* SC = (const float*)(p.ws + WS_Y); const bf16_t* QA = (const bf16_t*)(p.ws + WS_H); const bf16_t* KVN = (const bf16_t*)(p.ws + WS_KVN);
    bf16_t* MC = (bf16_t*)(p.ws + WS_MIXCAT);
    const int lane = c.lane, g = lane >> 4, hd = lane & 15;
    LAS unsigned char* tile = c.lds + c.wave * 16384;
    LAS unsigned short* lst = (LAS unsigned short*)(c.lds + LIST_OFF + c.wave * 512);
    const unsigned long long ltmask = (1ull << lane) - 1ull;
    const int xg = blockIdx.x & 7, wv = (blockIdx.x >> 3) * 8 + c.wave, nwv = (c.G >> 3) * 8;
    for (int qi = wv; qi < 2 * S; qi += nwv) {
        const int b = xg + 8 * (qi / S), s = qi % S, cq = s >> 6, n = 64 * (cq + 1), nk = n < 256 ? n : 256;
        const size_t t = (size_t)b * S + s;
        if (cq < 4 || !(MODE & 1)) { for (int i = lane; i < nk; i += 64) lst[i] = (unsigned short)i; }
        else {
            const float* srow = SC + sc_off(b, cq) + (size_t)(s & 63) * n;
            unsigned key[32]; unsigned kmin = 0xffffffffu, kmax = 0u;
            float sv[32];
#pragma unroll
            for (int j = 0; j < 32; ++j) sv[j] = srow[64 * (j <= cq ? j : cq) + lane];
#pragma unroll
            for (int j = 0; j < 32; ++j) key[j] = 0u;
#pragma unroll
            for (int jb = 0; jb < 4; ++jb) if (8 * jb <= cq) {
#pragma unroll
                for (int j = 8 * jb; j < 8 * jb + 8; ++j) { const unsigned u = __float_as_uint(sv[j] + 0.0f); const unsigned k = (u & 0x80000000u) ? ~u : (u | 0x80000000u);
                    key[j] = (j <= cq) ? k : 0u; kmin = (j <= cq && k < kmin) ? k : kmin; kmax = (j <= cq && k > kmax) ? k : kmax; } }
#define KMM(W) { const unsigned a = lane_xor<W>(kmin), bb = lane_xor<W>(kmax); kmin = a < kmin ? a : kmin; kmax = bb > kmax ? bb : kmax; }
            KMM(1) KMM(2) KMM(4) KMM(8) KMM(16) KMM(32)
#undef KMM
            unsigned lo = __builtin_amdgcn_readfirstlane(kmin), hi = __builtin_amdgcn_readfirstlane(kmax); int c_lo = n, c_hi = 0; int it = 0;
            unsigned thr = 0u; int need = 0; bool done = false;
            while (lo < hi && (c_lo - c_hi) > 64) {
                unsigned mid;
                if (it < 20) {
                    const float lo_v = __uint_as_float((lo & 0x80000000u) ? (lo ^ 0x80000000u) : ~lo), hi_v = __uint_as_float((hi & 0x80000000u) ? (hi ^ 0x80000000u) : ~hi);
                    const float f = (it & 1) ? 0.5f : (float)(c_lo - 256) / (float)(c_lo - c_hi);
                    const float mid_v = lo_v + (hi_v - lo_v) * f + 0.0f;
                    const unsigned mu = __float_as_uint(mid_v); mid = (mu & 0x80000000u) ? ~mu : (mu | 0x80000000u);
                } else mid = lo + ((hi - lo) >> 1) + 1u;
                mid = mid > lo ? mid : lo + 1u; mid = mid < hi ? mid : hi;
                int cnt = 0;
#pragma unroll
                for (int jb = 0; jb < 4; ++jb) if (8 * jb <= cq) {
                    unsigned long long bm[8];
#pragma unroll
                    for (int j = 0; j < 8; ++j) bm[j] = __ballot(key[8 * jb + j] >= mid);
#pragma unroll
                    for (int j = 0; j < 8; ++j) cnt += __builtin_popcountll(bm[j]); }
                if (cnt >= 256) { lo = mid; c_lo = cnt; if (cnt == 256) { thr = mid; need = 1 << 20; done = true; break; } } else { hi = mid - 1u; c_hi = cnt; }
                ++it;
            }
            if (!done) {
                if (lo == hi) {
                    thr = lo; int cgt = 0;
#pragma unroll
                    for (int j = 0; j < 32; ++j) cgt += __builtin_popcountll(__ballot(key[j] > thr));
                    need = 256 - cgt;
                } else {
                    LAS unsigned* cand = (LAS unsigned*)lst; int base = 0;
#pragma unroll
                    for (int jb = 0; jb < 4; ++jb) if (8 * jb <= cq) {
#pragma unroll
                        for (int j = 8 * jb; j < 8 * jb + 8; ++j) { const bool isc = key[j] >= lo && key[j] <= hi; const unsigned long long bc = __ballot(isc);
                            if (isc) cand[base + __builtin_popcountll(bc & ltmask)] = key[j]; base += __builtin_popcountll(bc); } }
                    const int m = base;
                    const unsigned ck = lane < m ? cand[lane] : 0u;
                    int gt = 0, ge = 0;
                    for (int q = 0; q < m; ++q) { const unsigned v = (unsigned)__builtin_amdgcn_readlane((int)ck, q); gt += v > ck; ge += v >= ck; }
                    const int r = 256 - c_hi;
                    const unsigned long long hit = __ballot(lane < m && gt < r && r <= ge);
                    const int src = __builtin_ctzll(hit);
                    thr = __shfl(ck, src); need = r - __shfl(gt, src);
                }
            }
            asm volatile("" ::: "memory");
            {
                int base = 0, tb = 0;
#pragma unroll
                for (int jb = 0; jb < 4; ++jb) if (8 * jb <= cq) {
#pragma unroll
                    for (int j = 8 * jb; j < 8 * jb + 8; ++j) {
                        const bool gt = key[j] > thr, tie = key[j] == thr; const unsigned long long bt = __ballot(tie);
                        const int trank = tb + __builtin_popcountll(bt & ltmask); const bool sel = gt || (tie && trank < need);
                        const unsigned long long bs = __ballot(sel); const int pos = base + __builtin_popcountll(bs & ltmask);
                        if (sel && pos < 256) lst[pos] = (unsigned short)(64 * j + lane);
                        base += __builtin_popcountll(bs); tb += __builtin_popcountll(bt); } }
            }
        }
        bf16x8 qf[4];
#pragma unroll
        for (int ks = 0; ks < 4; ++ks) { qf[ks] = (bf16x8){0, 0, 0, 0, 0, 0, 0, 0}; if (hd < 8) qf[ks] = *(const bf16x8*)(QA + t * D + hd * 128 + 32 * ks + 8 * g); }
        float m_ref = -INFINITY, l_run = 0.f;
        f32x4 o[8];
#pragma unroll
        for (int ct = 0; ct < 8; ++ct) o[ct] = (f32x4){0.f, 0.f, 0.f, 0.f};
        const char* kvb = (const char*)(KVN + (size_t)b * S * 128);
        const int ntile = nk >> 5;
        LDS_WAIT();
#define ATT_ISSUE(kt_, buf_) do { const u32x4 kq_ = *(const LAS u32x4*)(lst + (kt_) * 32 + 8 * g); _Pragma("unroll") for (int i = 0; i < 8; ++i) { const int r = 4 * i + g; \
            const unsigned key_ = (i & 1) ? (kq_[i >> 1] >> 16) : (kq_[i >> 1] & 0xffffu); \
            const unsigned ch = (unsigned)hd ^ (unsigned)(((r & 3) << 2) | ((r >> 2) & 3)); \
            if (MODE & 2) __builtin_amdgcn_global_load_lds((const unsigned*)(kvb + key_ * 256u + ch * 16u), (LAS unsigned*)(tile + (buf_) * 8192 + i * 1024), 16, 0, 0); } } while (0)
        ATT_ISSUE(0, 0);
        for (int kt = 0; kt < ntile; ++kt) {
            LAS unsigned char* tb_ = tile + (kt & 1) * 8192;
            if (kt + 1 < ntile) { ATT_ISSUE(kt + 1, (kt + 1) & 1); asm volatile("s_waitcnt vmcnt(8)" ::: "memory"); }
            else asm volatile("s_waitcnt vmcnt(0)" ::: "memory");
            if (!(MODE & 4)) continue;
            f32x4 sa[2]; bf16x8 af[2][4];
#pragma unroll
            for (int rb = 0; rb < 2; ++rb)
#pragma unroll
                for (int ks = 0; ks < 4; ++ks) af[rb][ks] = *(const LAS bf16x8*)(tb_ + off_b(16 * rb + hd, 4 * ks + g));
#pragma unroll
            for (int rb = 0; rb < 2; ++rb) { sa[rb] = (f32x4){0.f, 0.f, 0.f, 0.f};
#pragma unroll
                for (int ks = 0; ks < 4; ++ks) sa[rb] = __builtin_amdgcn_mfma_f32_16x16x32_bf16(af[rb][ks], qf[ks], sa[rb], 0, 0, 0); }
            float mx = fmaxf(fmaxf(fmaxf(sa[0][0], sa[0][1]), fmaxf(sa[0][2], sa[0][3])), fmaxf(fmaxf(sa[1][0], sa[1][1]), fmaxf(sa[1][2], sa[1][3])));
            if (__ballot(mx > m_ref + 40.0f) != 0ull) {
                mx = fmaxf(mx, lane_xor<16>(mx)); mx = fmaxf(mx, lane_xor<32>(mx));
                const float m_new = fmaxf(m_ref, mx), alpha = __builtin_amdgcn_exp2f(m_ref - m_new);
                l_run *= alpha; m_ref = m_new;
#pragma unroll
                for (int ct = 0; ct < 8; ++ct) o[ct] *= alpha;
            }
            float pr[8], ps = 0.f;
#pragma unroll
            for (int j = 0; j < 8; ++j) { pr[j] = __builtin_amdgcn_exp2f(sa[j >> 2][j & 3] - m_ref); ps += pr[j]; }
            l_run += ps;
            u32x4 pw; pw.x = cvt_pk_bf16(pr[0], pr[1]); pw.y = cvt_pk_bf16(pr[2], pr[3]); pw.z = cvt_pk_bf16(pr[4], pr[5]); pw.w = cvt_pk_bf16(pr[6], pr[7]);
            const bf16x8 pb = __builtin_bit_cast(bf16x8, pw);
            const unsigned q4 = (unsigned)hd >> 2, p4 = (unsigned)hd & 3;
#pragma unroll
            for (int ct = 0; ct < 8; ++ct) {
                const bf16x4 vlo = __builtin_amdgcn_ds_read_tr16_b64_v4i16((LAS bf16x4*)(tb_ + off_b(4 * g + q4, 2 * ct + (p4 >> 1)) + 8 * (p4 & 1)));
                const bf16x4 vhi = __builtin_amdgcn_ds_read_tr16_b64_v4i16((LAS bf16x4*)(tb_ + off_b(16 + 4 * g + q4, 2 * ct + (p4 >> 1)) + 8 * (p4 & 1)));
                const bf16x8 va = __builtin_shufflevector(vlo, vhi, 0, 1, 2, 3, 4, 5, 6, 7);
                o[ct] = __builtin_amdgcn_mfma_f32_16x16x32_bf16(va, pb, o[ct], 0, 0, 0);
            }
            LDS_WAIT();
        }
#undef ATT_ISSUE
        float lt = l_run + lane_xor<16>(l_run); lt += lane_xor<32>(lt);
        const float inv = 1.0f / lt;
        if (hd < 8 && ((MODE & 8) || lt == 12345.678f)) {
#pragma unroll
            for (int ct = 0; ct < 8; ++ct) { const f32x4 v = o[ct] * inv; u32x2 w; w.x = cvt_pk_bf16(v.x, v.y); w.y = cvt_pk_bf16(v.z, v.w);
                *(u32x2*)(MC + t * KMIX + 256 + hd * 128 + 16 * ct + 4 * g) = w; }
        }
    }
}

#ifndef RT_NT
#define RT_NT 2
#endif
__device__ __forceinline__ void ph_router(const Params& p, const Ctx& c, int l) {
    const float* mod = (const float*)(p.ws + WS_MOD); bf16_t* H = (bf16_t*)(p.ws + WS_H);
    int* toke = (int*)(p.ws + WS_SMALL + SM_TOKE); float* tokg = (float*)(p.ws + WS_SMALL + SM_TOKG); int* rank = (int*)(p.ws + WS_SMALL + SM_RANK); int* cnt = (int*)(p.ws + WS_SMALL + SM_CNT);
    LAS int* le = (LAS int*)c.lds; LAS int* wcnt = le + 256;
    const int lane = c.lane;
    for (int tile = c.vcu; tile < 256; tile += c.G) {
        constexpr int NT = RT_NT;
        const int b = (tile * 128) >> 11;
        const f32x4* ng = (const f32x4*)(p.in[I_N2G] + l * D) + lane;
        const f32x4* sh = (const f32x4*)(mod + (size_t)(l * NB + b) * 6144 + 3072) + lane; const f32x4* sc = (const f32x4*)(mod + (size_t)(l * NB + b) * 6144 + 4096) + lane;
        const f32x4* rg = (const f32x4*)(p.ws + WS_SMALL + SM_RGW2) + (size_t)l * 1024 + lane;
        f32x4 gm[4], sv[4];
#pragma unroll
        for (int j = 0; j < 4; ++j) { gm[j] = ng[64 * j] * (sc[64 * j] + 1.0f); sv[j] = sh[64 * j]; }
        f32x4 v[NT][4], vn[NT][4];
#pragma unroll
        for (int t = 0; t < NT; ++t)
#pragma unroll
            for (int j = 0; j < 4; ++j) vn[t][j] = ((const f32x4*)(p.out + (size_t)(tile * 128 + c.wave * 16 + t) * D) + lane)[64 * j];
        for (int i = 0; i < 16; i += NT) {
            const int tl0 = c.wave * 16 + i, m0 = tile * 128 + tl0;
            float ss[NT], r[NT], gl[NT][4];
#pragma unroll
            for (int t = 0; t < NT; ++t) { ss[t] = 0.f;
#pragma unroll
                for (int j = 0; j < 4; ++j) { v[t][j] = vn[t][j]; ss[t] += (v[t][j].x * v[t][j].x + v[t][j].y * v[t][j].y) + (v[t][j].z * v[t][j].z + v[t][j].w * v[t][j].w); } }
            if (i + NT < 16) {
#pragma unroll
                for (int t = 0; t < NT; ++t)
#pragma unroll
                    for (int j = 0; j < 4; ++j) vn[t][j] = ((const f32x4*)(p.out + (size_t)(m0 + NT + t) * D) + lane)[64 * j]; }
#pragma unroll
            for (int t = 0; t < NT; ++t) ss[t] = wave_sum(ss[t]);
#pragma unroll
            for (int t = 0; t < NT; ++t) { r[t] = 1.0f / sqrtf(ss[t] * (1.0f / D) + EPS); gl[t][0] = gl[t][1] = gl[t][2] = gl[t][3] = 0.f; }
#pragma unroll
            for (int j = 0; j < 4; ++j) {
#pragma unroll
                for (int t = 0; t < NT; ++t) { v[t][j] = v[t][j] * r[t] * gm[j] + sv[j];
                    u32x2 w; w.x = cvt_pk_bf16(v[t][j].x, v[t][j].y); w.y = cvt_pk_bf16(v[t][j].z, v[t][j].w); ((u32x2*)(H + (size_t)(m0 + t) * D) + lane)[64 * j] = w; }
#pragma unroll
                for (int e = 0; e < 4; ++e) { const f32x4 wr = rg[(j * 4 + e) * 64];
#pragma unroll
                    for (int t = 0; t < NT; ++t) { gl[t][0] += v[t][j][e] * wr.x; gl[t][1] += v[t][j][e] * wr.y; gl[t][2] += v[t][j][e] * wr.z; gl[t][3] += v[t][j][e] * wr.w; } } }
            const bool h32 = lane & 32, h16 = lane & 16, h8 = lane & 8;
            float dg[NT];
#pragma unroll
            for (int t = 0; t < NT; ++t) {
                const float c0 = (h16 ? gl[t][2] : gl[t][0]) + lane_xor<16>(h16 ? gl[t][0] : gl[t][2]), c1 = (h16 ? gl[t][3] : gl[t][1]) + lane_xor<16>(h16 ? gl[t][1] : gl[t][3]);
                float d = (h8 ? c1 : c0) + lane_xor<8>(h8 ? c0 : c1);
                d += lane_xor<4>(d); d += lane_xor<2>(d); d += lane_xor<1>(d); d += lane_xor<32>(d); dg[t] = d; }
            int gi[NT]; float gp[NT];
#pragma unroll
            for (int t = 0; t < NT; ++t) { float gq[4]; int g_ = 0; float gmax = -INFINITY;
#pragma unroll
                for (int q = 0; q < 4; ++q) { gq[q] = __shfl(dg[t], 8 * (q & 1) + 16 * (q >> 1)) + p.in[I_RGB][l * 4 + q]; if (gq[q] > gmax) { gmax = gq[q]; g_ = q; } }
                float gden = 0.f;
#pragma unroll
                for (int q = 0; q < 4; ++q) gden += __expf(gq[q] - gmax);
                gp[t] = 1.0f / gden; gi[t] = __builtin_amdgcn_readfirstlane(g_); }
            float el[NT][8];
#pragma unroll
            for (int t = 0; t < NT; ++t)
#pragma unroll
                for (int q = 0; q < 8; ++q) el[t][q] = 0.f;
#pragma unroll
            for (int j = 0; j < 4; ++j)
#pragma unroll
                for (int e = 0; e < 4; ++e)
#pragma unroll
                    for (int t = 0; t < NT; ++t) { const f32x4* rr = (const f32x4*)(p.ws + WS_SMALL + SM_REW2) + (size_t)(l * 4 + gi[t]) * 2048 + (j * 4 + e) * 128 + lane;
                        const f32x4 w0 = rr[0], w1 = rr[64]; const float hv = v[t][j][e];
                        el[t][0] += hv * w0.x; el[t][1] += hv * w0.y; el[t][2] += hv * w0.z; el[t][3] += hv * w0.w; el[t][4] += hv * w1.x; el[t][5] += hv * w1.y; el[t][6] += hv * w1.z; el[t][7] += hv * w1.w; }
            float de[NT];
#pragma unroll
            for (int t = 0; t < NT; ++t) {
                const float b0 = (h32 ? el[t][4] : el[t][0]) + lane_xor<32>(h32 ? el[t][0] : el[t][4]), b1 = (h32 ? el[t][5] : el[t][1]) + lane_xor<32>(h32 ? el[t][1] : el[t][5]);
                const float b2 = (h32 ? el[t][6] : el[t][2]) + lane_xor<32>(h32 ? el[t][2] : el[t][6]), b3 = (h32 ? el[t][7] : el[t][3]) + lane_xor<32>(h32 ? el[t][3] : el[t][7]);
                const float c0 = (h16 ? b2 : b0) + lane_xor<16>(h16 ? b0 : b2), c1 = (h16 ? b3 : b1) + lane_xor<16>(h16 ? b1 : b3);
                float d = (h8 ? c1 : c0) + lane_xor<8>(h8 ? c0 : c1);
                d += lane_xor<4>(d); d += lane_xor<2>(d); d += lane_xor<1>(d); de[t] = d; }
#pragma unroll
            for (int t = 0; t < NT; ++t) { float eq[8]; int e0 = 0, e1 = 0; float mx0 = -INFINITY, mx1 = -INFINITY;
#pragma unroll
                for (int q = 0; q < 8; ++q) { eq[q] = __shfl(de[t], 8 * (q & 1) + 16 * ((q >> 1) & 1) + 32 * (q >> 2)) + p.in[I_REB][l * 32 + gi[t] * 8 + q];
                    if (eq[q] > mx0) { mx1 = mx0; e1 = e0; mx0 = eq[q]; e0 = q; } else if (eq[q] > mx1) { mx1 = eq[q]; e1 = q; } }
                const float x1 = __expf(mx1 - mx0), den = 1.0f + x1; const int tl = tl0 + t, m = m0 + t;
                if (lane == 0) { le[2 * tl] = gi[t] * 8 + e0; le[2 * tl + 1] = gi[t] * 8 + e1; toke[2 * m] = gi[t] * 8 + e0; toke[2 * m + 1] = gi[t] * 8 + e1; tokg[2 * m] = gp[t] / den; tokg[2 * m + 1] = gp[t] * x1 / den; } }
        }
        __syncthreads();
        int myrank = 0, mye = 0;
        if (c.tid < 256) { mye = le[c.tid]; const unsigned long long ltmask = (1ull << lane) - 1ull;
            for (int ee = 0; ee < 32; ++ee) { const unsigned long long m = __ballot(mye == ee); if (mye == ee) myrank = __builtin_popcountll(m & ltmask); if (lane == 0) wcnt[c.wave * 32 + ee] = __builtin_popcountll(m); } }
        __syncthreads();
        if (c.tid < 256) { for (int w = 0; w < c.wave; ++w) myrank += wcnt[w * 32 + mye]; rank[tile * 256 + c.tid] = myrank; }
        if (c.tid < 32) cnt[tile * 32 + c.tid] = wcnt[c.tid] + wcnt[32 + c.tid] + wcnt[64 + c.tid] + wcnt[96 + c.tid];
        __syncthreads();
    }
}

__device__ __forceinline__ void ph_dispatch(const Params& p, const Ctx& c) {
    const int* toke = (const int*)(p.ws + WS_SMALL + SM_TOKE); const float* tokg = (const float*)(p.ws + WS_SMALL + SM_TOKG); const int* rank = (const int*)(p.ws + WS_SMALL + SM_RANK); const int* cnt = (const int*)(p.ws + WS_SMALL + SM_CNT);
    int* tslot = (int*)(p.ws + WS_SMALL + SM_TSLOT); int* stok = (int*)(p.ws + WS_SMALL + SM_STOK); float* sgate = (float*)(p.ws + WS_SMALL + SM_SGATE); int* texp = (int*)(p.ws + WS_SMALL + SM_TEXP);
    LAS int* tot = (LAS int*)c.lds; LAS int* pst = tot + 32; LAS int* bse = pst + 33;
    for (int tile = c.vcu; tile < 256; tile += c.G) {
        {
            LAS int* psum = bse + 32; LAS int* pbase = psum + 512;
            const int e = c.tid & 31, part = c.tid >> 5; int v[16]; int run = 0, mb = 0;
#pragma unroll
            for (int q = 0; q < 16; ++q) v[q] = cnt[(part * 16 + q) * 32 + e];
#pragma unroll
            for (int q = 0; q < 16; ++q) { if (part * 16 + q == tile) mb = run; run += v[q]; }
            psum[part * 32 + e] = run; pbase[part * 32 + e] = mb;
            __syncthreads();
            if (c.tid < 32) { int tr = 0, tb2 = 0; const int tp = tile >> 4;
                for (int q = 0; q < 16; ++q) { if (q == tp) tb2 = tr + pbase[q * 32 + c.tid]; tr += psum[q * 32 + c.tid]; }
                tot[c.tid] = tr; bse[c.tid] = tb2; }
        }
        __syncthreads();
        if (c.tid == 0) { int a = 0; for (int e = 0; e < 32; ++e) { pst[e] = a; a += ((tot[e] + 255) >> 8) << 8; } pst[32] = a; }
        __syncthreads();
        if (c.tid < 256) { const int a = tile * 256 + c.tid, e = toke[a], slot = pst[e] + bse[e] + rank[a]; stok[slot] = a >> 1; sgate[slot] = tokg[a]; tslot[a] = slot; }
        if (tile == 0) {
            for (int e = 0; e < 32; ++e) { const int pc = pst[e + 1] - pst[e]; for (int r = tot[e] + c.tid; r < pc; r += 512) { stok[pst[e] + r] = 0; sgate[pst[e] + r] = 0.f; } }
            const int ntl = pst[32] >> 8;
            for (int m = c.tid; m < ntl; m += 512) { int e = 0; while (pst[e + 1] <= (m << 8)) ++e; texp[m] = e; }
            if (c.tid == 0) texp[MAXTILES] = ntl;
        }
        __syncthreads();
    }
}

#ifndef PH_ONLY
#define PH_ONLY -1
#endif
#define IN(k) ((PH_ONLY < 0 || PH_ONLY == (k)) && lo <= (k) && (k) < hi)
#define SEAM(k) do { if (IN(k) && IN((k) + 1)) xcd_barrier(bar); } while (0)
#ifndef REP_MASK
#define REP_MASK 0
#endif
#define REP(id) (((REP_MASK) >> (id)) & 1)
#define BODY(id, cond, ...) do { __VA_ARGS__ if (REP(id) && (cond)) { xcd_barrier(bar); __VA_ARGS__ } } while (0)
template <int l>
__device__ __forceinline__ void run_layer(const Params& p, const Ctx& c, const XcdBarrier& bar, int lo, int hi) {
    bf16_t* Zb = (bf16_t*)(p.ws + WS_Z); bf16_t* Hb = (bf16_t*)(p.ws + WS_H); bf16_t* MCb = (bf16_t*)(p.ws + WS_MIXCAT);
    const float* mod = (const float*)(p.ws + WS_MOD);
    constexpr int P = 1 + 10 * l;
    if (IN(P)) { if (l == 0) { BODY(1, true, ph_norm1<0>(p, c);); } else { BODY(12, true, conv_experts(p, c, 1);); ph_norm1<1>(p, c); } }
    SEAM(P);
    if (IN(P + 1)) { BODY(2, true, { pg8::StaticOrder So; So.init(Hb, (bf16_t*)(p.ws + WS_WIN) + (size_t)l * NZ * D, T, NZ, D, c.G, (int)blockIdx.x);
        pg8::EpiBf16 E{Zb, NZ}; pg8::gemm_phase<pg8::EpiBf16, pg8::StaticOrder, false>(c.lds, So, E); }); }
    SEAM(P + 1);
    if (IN(P + 2)) { BODY(3, true, ph_postz(p, c, l);); }
    SEAM(P + 2);
    if (IN(P + 3)) { BODY(4, true, { pg8::StaticOrder So; So.init((bf16_t*)(p.ws + WS_CQR), (bf16_t*)(p.ws + WS_WQA) + (size_t)l * D * 256, T, D, 256, c.G, (int)blockIdx.x);
        pg8::EpiBf16 E{Hb, D}; pg8::gemm_phase<pg8::EpiBf16, pg8::StaticOrder, false>(c.lds, So, E); });
        BODY(5, true, ph_scores(p, c);); }
    SEAM(P + 3);
#ifndef ATT_PROBE
#define ATT_PROBE 0
#endif
    if (IN(P + 4)) { ph_attn<15>(p, c); if (ATT_PROBE) { xcd_barrier(bar); ph_attn<ATT_PROBE>(p, c); } }
    SEAM(P + 4);
    if (IN(P + 5)) { BODY(7, l == 0, { pg8::StaticOrder So; So.init(MCb, (bf16_t*)(p.ws + WS_WMIX) + (size_t)l * D * KMIX, T, D, KMIX, c.G, (int)blockIdx.x);
        pg8::EpiMix E{l == 0 ? p.in[I_X] : p.out, p.out, mod + (size_t)l * NB * 6144 + 2048}; pg8::gemm_phase<pg8::EpiMix, pg8::StaticOrder, false>(c.lds, So, E); }); }
    SEAM(P + 5);
    if (IN(P + 6)) { BODY(8, true, ph_router(p, c, l);); }
    SEAM(P + 6);
    if (IN(P + 7)) { BODY(9, true, ph_dispatch(p, c);); }
    SEAM(P + 7);
    if (IN(P + 8)) { BODY(10, true, { const int* texp = (const int*)(p.ws + WS_SMALL + SM_TEXP); const int ntl = texp[MAXTILES];
        pg8::MoeOrder Mo; Mo.init(Hb, p.ws + WS_W13, D, (size_t)1024 * 1024 * 2, (const int*)(p.ws + WS_SMALL + SM_STOK), texp, ntl, c.G, c.vcu);
        pg8::EpiAct E{Zb}; pg8::gemm_phase<pg8::EpiAct, pg8::MoeOrder, true>(c.lds, Mo, E); }); }
    SEAM(P + 8);
    if (IN(P + 9)) { BODY(11, true, { const int* texp = (const int*)(p.ws + WS_SMALL + SM_TEXP); const int ntl = texp[MAXTILES];
        pg8::MoeOrder Mo; Mo.init(Zb, p.ws + WS_W2, DEXP, (size_t)1024 * 512 * 2, nullptr, texp, ntl, c.G, c.vcu);
        pg8::EpiY E{(bf16_t*)(p.ws + WS_Y), (const float*)(p.ws + WS_SMALL + SM_SGATE)}; pg8::gemm_phase<pg8::EpiY, pg8::MoeOrder, false>(c.lds, Mo, E); }); }
    SEAM(P + 9);
}

__global__ void __launch_bounds__(512, 2) fwd(Params p) {
    extern __shared__ __attribute__((aligned(16))) unsigned char lds_raw[];
    Ctx c;
    c.lds = (LAS unsigned char*)lds_raw;
    c.tid = threadIdx.x; c.lane = c.tid & 63; c.wave = __builtin_amdgcn_readfirstlane(c.tid >> 6);
    c.G = gridDim.x; { const int bx = blockIdx.x; c.vcu = (c.G % 8 == 0) ? (bx % 8) * (c.G / 8) + bx / 8 : bx; }
    c.gw = c.vcu * 8 + c.wave; c.NGW = c.G * 8;
    volatile LAS unsigned* MISC = (volatile LAS unsigned*)(c.lds + MISC_OFF);
    if (c.tid < 64) MISC[c.tid] = 0u;
    __syncthreads();
    unsigned* ctl = (unsigned*)(p.ws + WS_CTL);
    XcdBarrier bar; bar.bar = ctl + CW_BAR; bar.x = 0; bar.st = nullptr;
    const bool multi = (p.ph_hi - p.ph_lo) > 1;
    if (multi) bar = xcd_barrier_post(ctl + CW_BAR, MISC + 8);
    const int lo = p.ph_lo, hi = p.ph_hi;
    if (IN(0)) { BODY(0, true, ph_prologue(p, c);); }
    SEAM(0);
    run_layer<0>(p, c, bar, lo, hi);
    run_layer<1>(p, c, bar, lo, hi);
    if (IN(21)) ph_norm1<2>(p, c);
#undef IN
#undef SEAM
}

extern "C" void kernel_launch(void* const* d_in, const int* in_sizes, int n_in, void* d_out, int out_size, void* d_ws, size_t ws_size, hipStream_t stream) {
    static int grid = 0;
    if (grid == 0) {
        if (n_in != 27 || out_size != T * D || ws_size < WS_END) { fprintf(stderr, "kernel_launch: unexpected shapes (n_in %d out %d ws %zu, need %zu)\n", n_in, out_size, ws_size, (size_t)WS_END); grid = -1; return; }
        int dev = 0, cus = 0, per_cu = 0;
        if (hipGetDevice(&dev) != hipSuccess || hipDeviceGetAttribute(&cus, hipDeviceAttributeMultiprocessorCount, dev) != hipSuccess) { grid = -1; return; }
        if (hipFuncSetAttribute((const void*)fwd, hipFuncAttributeMaxDynamicSharedMemorySize, LDS_BYTES) != hipSuccess) { fprintf(stderr, "kernel_launch: hipFuncSetAttribute failed\n"); grid = -1; return; }
        if (hipOccupancyMaxActiveBlocksPerMultiprocessor(&per_cu, (const void*)fwd, 512, LDS_BYTES) != hipSuccess || per_cu < 1) { fprintf(stderr, "kernel_launch: occupancy query says %d blocks per CU\n", per_cu); grid = -1; return; }
        (void)hipGetLastError();
        grid = cus;
        if (grid % 8 != 0 || grid > 256) grid = (grid / 8) * 8 > 256 ? 256 : (grid / 8) * 8;
    }
    if (grid <= 0) return;
    (void)hipMemsetAsync((char*)d_ws + WS_CTL, 0, CTL_ZERO_BYTES, stream);
    Params p{};
    for (int i = 0; i < 27; ++i) p.in[i] = (const float*)d_in[i];
    p.out = (float*)d_out; p.ws = (unsigned char*)d_ws;
#if MK_SPLIT
    for (int ph = 0; ph < NPHASE; ++ph) { p.ph_lo = ph; p.ph_hi = ph + 1; hipLaunchKernelGGL(fwd, dim3(grid), dim3(512), LDS_BYTES, stream, p); }
#else
    p.ph_lo = 0; p.ph_hi = NPHASE;
    hipLaunchKernelGGL(fwd, dim3(grid), dim3(512), LDS_BYTES, stream, p);
#endif
}
```

```cpp
#include <hip/hip_runtime.h>
#include <cstdio>
#include <cstdint>

#ifndef MK_SPLIT
#define MK_SPLIT 0
#endif

#define LAS __attribute__((address_space(3)))
typedef unsigned short bf16_t;
typedef short bf16x8 __attribute__((ext_vector_type(8)));
typedef short bf16x4 __attribute__((ext_vector_type(4)));
typedef float f32x4 __attribute__((ext_vector_type(4)));
typedef float f32x16 __attribute__((ext_vector_type(16)));
typedef unsigned u32x4 __attribute__((ext_vector_type(4)));
typedef unsigned u32x2 __attribute__((ext_vector_type(2)));

constexpr int D = 1024, NB = 16, S = 2048, T = NB * S, DEPTH = 2;
constexpr int NZ = 1792;
constexpr int N_IN = 1736;
constexpr int Z_AVAL = 0, Z_AGATE = 256, Z_CQ = 512, Z_CKV = 768, Z_QI = 896, Z_KI = 1408, Z_WI = 1472, Z_UP = 1480;
constexpr int KMIX = 1536;
constexpr int NEXP = 32, DEXP = 512, MAXTILES = 288, PMAX = MAXTILES * 256;
constexpr float EPS = 1e-6f;
constexpr int SC_PER_B = 4096 * 528;

constexpr size_t MiB = 1u << 20;
constexpr size_t WS_CTL = 0, CTL_ZERO_BYTES = 64 * 1024;
constexpr size_t WS_MOD = 1 * MiB;
constexpr size_t WS_WIN = 2 * MiB;
constexpr size_t WS_WQA = 9 * MiB;
constexpr size_t WS_WMIX = 10 * MiB;
constexpr size_t WS_SMALL = 16 * MiB;
constexpr size_t WS_W13 = 20 * MiB;
constexpr size_t WS_W2 = 84 * MiB;
constexpr size_t WS_Z = 116 * MiB;
constexpr size_t WS_X16 = 228 * MiB;
constexpr size_t WS_H = 324 * MiB;
constexpr size_t WS_CQR = 388 * MiB;
constexpr size_t WS_KVN = 404 * MiB;
constexpr size_t WS_Y = 412 * MiB;
constexpr size_t WS_END = 556 * MiB;
constexpr size_t SM_TOKE = 0;
constexpr size_t SM_TOKG = 256 * 1024;
constexpr size_t SM_RANK = 512 * 1024;
constexpr size_t SM_TSLOT = 768 * 1024;
constexpr size_t SM_STOK = 1024 * 1024;
constexpr size_t SM_SGATE = 1024 * 1024 + 512 * 1024;
constexpr size_t SM_CNT = 2 * 1024 * 1024;
constexpr size_t SM_TEXP = 2 * 1024 * 1024 + 64 * 1024;
constexpr size_t SM_REW2 = 2 * 1024 * 1024 + 512 * 1024;
constexpr size_t SM_RGW2 = 3 * 1024 * 1024;
constexpr int CW_BAR = 1024;

constexpr int LDS_BYTES = 155648;
constexpr int LIST_OFF = 131072;
constexpr int MISC_OFF = 154624;
constexpr int RT_RG_OFF = 131072, RT_LE_OFF = 147456;
constexpr int NPHASE = 22;

__device__ __forceinline__ unsigned cvt_pk_bf16(float lo, float hi) { unsigned r; asm volatile("v_cvt_pk_bf16_f32 %0, %1, %2" : "=v"(r) : "v"(lo), "v"(hi)); return r; }
__device__ __forceinline__ float bf2f(unsigned short b) { return __uint_as_float(((unsigned)b) << 16); }
__device__ __forceinline__ float bflo(unsigned w) { return __uint_as_float(w << 16); }
__device__ __forceinline__ float bfhi(unsigned w) { return __uint_as_float(w & 0xffff0000u); }
template <int W> __device__ __forceinline__ int lane_xor_i(int iv) {
    int r;
    if constexpr (W == 1) r = __builtin_amdgcn_mov_dpp(iv, 0xB1, 0xF, 0xF, true);
    else if constexpr (W == 2) r = __builtin_amdgcn_mov_dpp(iv, 0x4E, 0xF, 0xF, true);
    else if constexpr (W == 4) { r = __builtin_amdgcn_update_dpp(iv, iv, 0x104, 0xF, 0x5, false);
                                 r = __builtin_amdgcn_update_dpp(r, iv, 0x114, 0xF, 0xA, false); }
    else if constexpr (W == 8) r = __builtin_amdgcn_mov_dpp(iv, 0x128, 0xF, 0xF, true);
    else if constexpr (W == 16) { const auto p = __builtin_amdgcn_permlane16_swap((unsigned)iv, (unsigned)iv, false, false); r = (threadIdx.x & 16) ? (int)p[0] : (int)p[1]; }
    else { const auto p = __builtin_amdgcn_permlane32_swap((unsigned)iv, (unsigned)iv, false, false); r = (threadIdx.x & 32) ? (int)p[0] : (int)p[1]; }
    return r;
}
template <int W> __device__ __forceinline__ float lane_xor(float v) { return __builtin_bit_cast(float, lane_xor_i<W>(__builtin_bit_cast(int, v))); }
template <int W> __device__ __forceinline__ unsigned lane_xor(unsigned v) { return (unsigned)lane_xor_i<W>((int)v); }
__device__ __forceinline__ float wave_sum(float v) {
    v += lane_xor<1>(v); v += lane_xor<2>(v); v += lane_xor<4>(v); v += lane_xor<8>(v); v += lane_xor<16>(v); v += lane_xor<32>(v);
    return v;
}
__device__ __forceinline__ float sigmoidf_(float x) { return 1.0f / (1.0f + __expf(-x)); }
#define LDS_WAIT() asm volatile("s_waitcnt lgkmcnt(0)" ::: "memory")
#define VM_WAIT() asm volatile("s_waitcnt vmcnt(0)" ::: "memory")

#define XB_TMO      128
#define XB_XCNT(j)  (256  + 64 * (j))
#define XB_XSUB(j)  (1280 + 64 * (j))
#define XB_XGEN(j)  (2304 + 64 * (j))
#define XB_TOP      3328
#define XB_TOPGEN   3392
#define XCD_BAR_WORDS 3456
#define XB_SPIN_CAP (1u << 22)

__device__ __forceinline__ unsigned xb_ld(unsigned* p)              { return __hip_atomic_load(p, __ATOMIC_RELAXED, __HIP_MEMORY_SCOPE_AGENT); }
__device__ __forceinline__ unsigned xb_add(unsigned* p, unsigned v) { return __hip_atomic_fetch_add(p, v, __ATOMIC_RELAXED, __HIP_MEMORY_SCOPE_AGENT); }
__device__ __forceinline__ unsigned xb_xcc_id() { return (unsigned)__builtin_amdgcn_s_getreg((3 << 11) | 20) & 0xFu; }
#define XB_SPIN(cond, bar) do { unsigned _sp = 0; while (cond) { __builtin_amdgcn_s_sleep(1); \
    if ((++_sp & 255u) == 0u) { if (xb_ld(&(bar)[XB_TMO])) break; if (_sp > XB_SPIN_CAP) { atomicAdd(&(bar)[XB_TMO], 1u); break; } } } } while (0)

struct XcdBarrier {
    unsigned* bar; unsigned x;
    volatile LAS unsigned* st;
};
__device__ __forceinline__ XcdBarrier xcd_barrier_post(unsigned* bar, volatile LAS unsigned* st) {
    XcdBarrier b; b.bar = bar; b.x = xb_xcc_id(); b.st = st;
    if (threadIdx.x == 0) (void)xb_add(&bar[XB_XCNT(b.x)], 1u);
    return b;
}
__device__ __forceinline__ void xcd_barrier_complete(unsigned* bar, unsigned x, unsigned& nloc, unsigned& nx) {
    const unsigned G = gridDim.x * gridDim.y * gridDim.z;
    unsigned sum, cnt, mine, sp = 0u;
    for (;;) {
        sum = 0u; cnt = 0u; mine = 0u;
#pragma unroll
        for (unsigned j = 0; j < 16; ++j) { const unsigned c = xb_ld(&bar[XB_XCNT(j)]); sum += c; cnt += (c > 0u) ? 1u : 0u; mine = (j == x) ? c : mine; }
        if (sum == G) break;
        __builtin_amdgcn_s_sleep(1);
        if ((++sp & 255u) == 0u) { if (xb_ld(&bar[XB_TMO])) break; if (sp > XB_SPIN_CAP) { atomicAdd(&bar[XB_TMO], 1u); break; } }
    }
    nloc = mine > 0u ? mine : 1u; nx = cnt > 0u ? cnt : 1u;
}
__device__ __forceinline__ void xcd_barrier(const XcdBarrier& b) {
    asm volatile("s_waitcnt vmcnt(0)" ::: "memory");
    __syncthreads();
    if (threadIdx.x == 0) {
        unsigned* bar = b.bar;
        __builtin_amdgcn_s_waitcnt(0);
        unsigned nloc = b.st[0], nx = b.st[1];
        if (nloc == 0u) { xcd_barrier_complete(bar, b.x, nloc, nx); b.st[0] = nloc; b.st[1] = nx; }
        const unsigned old = xb_add(&bar[XB_XSUB(b.x)], 1u);
        const unsigned gen = old / nloc;
        if (old + 1u == (gen + 1u) * nloc) {
            __builtin_amdgcn_fence(__ATOMIC_RELEASE, "agent");
            asm volatile("s_waitcnt vmcnt(0)" ::: "memory");
            const unsigned og = xb_add(&bar[XB_TOP], 1u);
            const unsigned tg = og / nx;
            if (og + 1u == (tg + 1u) * nx) xb_add(&bar[XB_TOPGEN], 1u);
            else XB_SPIN(xb_ld(&bar[XB_TOPGEN]) == tg, bar);
            __builtin_amdgcn_fence(__ATOMIC_ACQUIRE, "agent");
            xb_add(&bar[XB_XGEN(b.x)], 1u);
            asm volatile("s_waitcnt vmcnt(0)" ::: "memory");
        } else {
            XB_SPIN(xb_ld(&bar[XB_XGEN(b.x)]) == gen, bar);
            __builtin_amdgcn_fence(__ATOMIC_ACQUIRE, "agent");
            asm volatile("s_waitcnt vmcnt(0)" ::: "memory");
        }
    }
    __syncthreads();
}

namespace pg8 {
constexpr int BM = 256, BK = 64, HALF = 128, HTB = HALF * BK * 2  , STAGE_BYTES = 8 * HTB, NXCD = 8, WGM = 8;
__host__ __device__ __forceinline__ int lds_byte(int r, int c) { const int st = (r >> 4) * 2 + (c >> 5), rr = r & 15, cc = c & 31, ob = rr * 64 + cc * 2; return st * 1024 + (ob ^ (((ob >> 9) & 1) << 5)); }
__host__ __device__ __forceinline__ void stage_rc(int b, int& R, int& C) { const int st = b / 1024, sb = b % 1024, swz = sb ^ (((sb >> 9) & 1) << 5); R = (st >> 1) * 16 + swz / 64; C = (st & 1) * 32 + (swz % 64) / 2; }
__host__ __device__ __forceinline__ int perm32(int rho) { const int n = rho >> 4, i = rho & 15; return 8 * (i >> 2) + 4 * n + (i & 3); }

struct Unit { int pm, pn; const char* a; const char* b; };

struct StaticOrder {
    const char* A; const char* Bt; int K; const int* rowidx;
    int nM, nN, nwg, G, c;
    __device__ void init(const void* A_, const void* Bt_, int M, int N, int K_, int G_, int c_) { A = (const char*)A_; Bt = (const char*)Bt_; K = K_; rowidx = nullptr; nM = M / BM; nN = N / BM; nwg = nM * nN; G = G_; c = c_; }
    __device__ __forceinline__ bool next(int i, Unit& u) const {
        const long L = (long)i * G + c; if (L >= nwg) return false;
        int wgid = (int)L; { const int q = nwg / NXCD, r = nwg % NXCD, xcd = wgid % NXCD, off = wgid / NXCD; wgid = (xcd < r ? xcd * (q + 1) : r * (q + 1) + (xcd - r) * q) + off; }
        const int nig = WGM * nN, gid = wgid / nig, fm = gid * WGM, gsz = (nM - fm) < WGM ? (nM - fm) : WGM;
        u.pm = fm + ((wgid % nig) % gsz); u.pn = (wgid % nig) / gsz;
        u.a = A + (size_t)u.pm * BM * K * 2; u.b = Bt + (size_t)u.pn * BM * K * 2; return true;
    }
};
struct MoeOrder {
    const char* A; const char* Bt; int K; const int* rowidx;
    const int* tile_exp; int nunits, G, c; size_t bstride;
    __device__ void init(const void* A_, const void* Bt_, int K_, size_t bstride_, const int* rowidx_, const int* tile_exp_, int ntiles, int G_, int c_) {
        A = (const char*)A_; Bt = (const char*)Bt_; K = K_; bstride = bstride_; rowidx = rowidx_; tile_exp = tile_exp_; nunits = ntiles * 4; G = G_; c = c_; }
    __device__ __forceinline__ bool next(int i, Unit& u) const {
        const int L = i * G + c; if (L >= nunits) return false;
        u.pm = L >> 2; u.pn = L & 3; const int e = tile_exp[u.pm];
        u.a = A + (size_t)u.pm * BM * K * 2; u.b = Bt + (size_t)e * bstride + (size_t)u.pn * BM * K * 2; return true;
    }
};

struct EpiBf16 {
    static constexpr bool PERM = true;
    bf16_t* O; int ldc;
    __device__ __forceinline__ void operator()(const f32x4 (&acc)[2][2][4][2], const Unit& u, int wr, int wc, int fr, int fq) const {
        const int row0 = u.pm * BM + wr * 64 + fr, col0 = u.pn * BM + wc * 32 + 8 * fq;
#pragma unroll
        for (int ai = 0; ai < 2; ++ai)
#pragma unroll
            for (int m = 0; m < 4; ++m) { bf16_t* rowp = O + (size_t)(row0 + ai * HALF + m * 16) * ldc + col0;
#pragma unroll
                for (int bj = 0; bj < 2; ++bj) { const f32x4 v0 = acc[ai][bj][m][0], v1 = acc[ai][bj][m][1];
                    u32x4 w; w.x = cvt_pk_bf16(v0[0], v0[1]); w.y = cvt_pk_bf16(v0[2], v0[3]); w.z = cvt_pk_bf16(v1[0], v1[1]); w.w = cvt_pk_bf16(v1[2], v1[3]);
                    *(u32x4*)(rowp + bj * HALF) = w; } }
    }
};
struct EpiMix {
    static constexpr bool PERM = true;
    const float* xin32; bf16_t* x16; const float* gate;
    __device__ __forceinline__ void operator()(const f32x4 (&acc)[2][2][4][2], const Unit& u, int wr, int wc, int fr, int fq) const {
        const int row0 = u.pm * BM + wr * 64 + fr, col0 = u.pn * BM + wc * 32 + 8 * fq;
        const float* gp = gate + (size_t)(u.pm >> 3) * 6144 + col0;
        f32x4 gv[2][2];
#pragma unroll
        for (int bj = 0; bj < 2; ++bj)
#pragma unroll
            for (int n = 0; n < 2; ++n) gv[bj][n] = *(const f32x4*)(gp + bj * HALF + 4 * n);
#pragma unroll
        for (int ai = 0; ai < 2; ++ai)
#pragma unroll
            for (int m = 0; m < 4; ++m) { const size_t off = (size_t)(row0 + ai * HALF + m * 16) * D + col0;
#pragma unroll
                for (int bj = 0; bj < 2; ++bj) { f32x4 x0, x1;
                    if (xin32) { x0 = *(const f32x4*)(xin32 + off + bj * HALF); x1 = *(const f32x4*)(xin32 + off + bj * HALF + 4); }
                    else { const u32x4 xv = *(const u32x4*)(x16 + off + bj * HALF); x0 = (f32x4){bflo(xv.x), bfhi(xv.x), bflo(xv.y), bfhi(xv.y)}; x1 = (f32x4){bflo(xv.z), bfhi(xv.z), bflo(xv.w), bfhi(xv.w)}; }
                    const f32x4 v0 = x0 + gv[bj][0] * acc[ai][bj][m][0], v1 = x1 + gv[bj][1] * acc[ai][bj][m][1];
                    u32x4 w; w.x = cvt_pk_bf16(v0[0], v0[1]); w.y = cvt_pk_bf16(v0[2], v0[3]); w.z = cvt_pk_bf16(v1[0], v1[1]); w.w = cvt_pk_bf16(v1[2], v1[3]);
                    *(u32x4*)(x16 + off + bj * HALF) = w; } }
    }
};
struct EpiAct {
    static constexpr bool PERM = true;
    bf16_t* O;
    __device__ __forceinline__ void operator()(const f32x4 (&acc)[2][2][4][2], const Unit& u, int wr, int wc, int fr, int fq) const {
        const int row0 = u.pm * BM + wr * 64 + fr, col0 = u.pn * 128 + wc * 16 + 4 * fq;
#pragma unroll
        for (int ai = 0; ai < 2; ++ai)
#pragma unroll
            for (int m = 0; m < 4; ++m) { bf16_t* rowp = O + (size_t)(row0 + ai * HALF + m * 16) * DEXP + col0;
#pragma unroll
                for (int bj = 0; bj < 2; ++bj) { const f32x4 a = acc[ai][bj][m][0], b = acc[ai][bj][m][1]; f32x4 r;
#pragma unroll
                    for (int j = 0; j < 4; ++j) r[j] = a[j] * b[j] * __builtin_amdgcn_rcpf(1.0f + __expf(-a[j]));
                    u32x2 w; w.x = cvt_pk_bf16(r[0], r[1]); w.y = cvt_pk_bf16(r[2], r[3]);
                    *(u32x2*)(rowp + bj * 64) = w; } }
    }
};
struct EpiY {
    static constexpr bool PERM = true;
    bf16_t* O; const float* sgate;
    __device__ __forceinline__ void operator()(const f32x4 (&acc)[2][2][4][2], const Unit& u, int wr, int wc, int fr, int fq) const {
        const int row0 = u.pm * BM + wr * 64 + fr, col0 = u.pn * BM + wc * 32 + 8 * fq;
#pragma unroll
        for (int ai = 0; ai < 2; ++ai)
#pragma unroll
            for (int m = 0; m < 4; ++m) { const int row = row0 + ai * HALF + m * 16; const float g = sgate[row]; bf16_t* rowp = O + (size_t)row * D + col0;
#pragma unroll
                for (int bj = 0; bj < 2; ++bj) { const f32x4 v0 = acc[ai][bj][m][0] * g, v1 = acc[ai][bj][m][1] * g;
                    u32x4 w; w.x = cvt_pk_bf16(v0[0], v0[1]); w.y = cvt_pk_bf16(v0[2], v0[3]); w.z = cvt_pk_bf16(v1[0], v1[1]); w.w = cvt_pk_bf16(v1[2], v1[3]);
                    *(u32x4*)(rowp + bj * HALF) = w; } }
    }
};

template <class Epi, class Sched, bool GATHER>
__device__ __forceinline__ void gemm_phase(LAS unsigned char* lds, const Sched& S, const Epi& E) {
    const int tid = threadIdx.x, wid = __builtin_amdgcn_readfirstlane(tid >> 6), lane = tid & 63, wr = wid >> 2, wc = wid & 3, fr = lane & 15, fq = lane >> 4;
    const int K = S.K, nt = K / BK;
    unsigned voffA[2], voffB[2]; int RA[2], CA[2];
#pragma unroll
    for (int i = 0; i < 2; ++i) { int R, C; stage_rc(tid * 16 + i * 8192, R, C); const int Rb = Epi::PERM ? ((R & ~31) + perm32(R & 31)) : R;
        RA[i] = R; CA[i] = C; voffA[i] = (unsigned)(R * K + C) * 2u; voffB[i] = (unsigned)(Rb * K + C) * 2u; }
    const size_t kstep = (size_t)(BK * 2);
    const size_t hstep = (size_t)HALF * K * 2;
    const unsigned ldsw = (unsigned)wid * 1024u;
    const int aoff = lds_byte(wr * 64 + fr, fq * 8), boff = lds_byte(wc * 32 + fr, fq * 8);
#define PG8_SA(b, h) (((b) * 2 + (h)) * HTB)
#define PG8_SB(b, h) ((4 + (b) * 2 + (h)) * HTB)
#define PG8_DMA(bufoff, gptr, i) __builtin_amdgcn_global_load_lds((const unsigned*)(gptr), (LAS unsigned*)(lds + (bufoff) + ldsw + (i) * 8192), 16, 0, 0)
#define PG8_STAGE(bufoff, gbase, voff) do { PG8_DMA(bufoff, (const char*)(gbase) + (voff)[0], 0); PG8_DMA(bufoff, (const char*)(gbase) + (voff)[1], 1); } while (0)
#define PG8_STAGE_A(bufoff, nx, h, kb) do { if constexpr (GATHER) { \
            PG8_DMA(bufoff, S.A + (kb) + ((nx) ? gN[h][0] : gC[h][0]), 0); PG8_DMA(bufoff, S.A + (kb) + ((nx) ? gN[h][1] : gC[h][1]), 1); } \
        else { const char* _b = ((nx) ? nA : cA) + (h) * hstep + (kb); PG8_DMA(bufoff, _b + voffA[0], 0); PG8_DMA(bufoff, _b + voffA[1], 1); } } while (0)
#define PG8_LDA(dst, b, h) do { _Pragma("unroll") for (int m = 0; m < 4; ++m) _Pragma("unroll") for (int k = 0; k < 2; ++k) dst[m][k] = *(const LAS bf16x8*)(lds + PG8_SA(b, h) + aoff + m * 2048 + k * 1024); } while (0)
#define PG8_LDB(dst, b, h) do { _Pragma("unroll") for (int n = 0; n < 2; ++n) _Pragma("unroll") for (int k = 0; k < 2; ++k) dst[n][k] = *(const LAS bf16x8*)(lds + PG8_SB(b, h) + boff + n * 2048 + k * 1024); } while (0)
#define PG8_MMA(ai, bj, At, Bt) do { __builtin_amdgcn_s_setprio(1); _Pragma("unroll") for (int m = 0; m < 4; ++m) _Pragma("unroll") for (int n = 0; n < 2; ++n) _Pragma("unroll") for (int k = 0; k < 2; ++k) \
        acc[ai][bj][m][n] = __builtin_amdgcn_mfma_f32_16x16x32_bf16(Bt[n][k], At[m][k], acc[ai][bj][m][n], 0, 0, 0); __builtin_amdgcn_s_setprio(0); } while (0)
#define PG8_WAIT_V(n) asm volatile("s_waitcnt vmcnt(" #n ")" ::: "memory")
#define PG8_WAIT_L(n) asm volatile("s_waitcnt lgkmcnt(" #n ")" ::: "memory")
#define PG8_BAR __builtin_amdgcn_s_barrier()
#define PG8_SCHED __builtin_amdgcn_sched_barrier(0)
    Unit cur, nxt; int ui = 0;
    if (!S.next(0, cur)) return;
    unsigned gC[2][2] = {{0u, 0u}, {0u, 0u}}, gN[2][2] = {{0u, 0u}, {0u, 0u}};
    if constexpr (GATHER) {
#pragma unroll
        for (int h = 0; h < 2; ++h)
#pragma unroll
            for (int i = 0; i < 2; ++i) gC[h][i] = (unsigned)(S.rowidx[cur.pm * BM + h * HALF + RA[i]] * K + CA[i]) * 2u;
    }
    f32x4 acc[2][2][4][2];
#pragma unroll
    for (int a = 0; a < 2; ++a)
#pragma unroll
        for (int b = 0; b < 2; ++b)
#pragma unroll
            for (int m = 0; m < 4; ++m)
#pragma unroll
                for (int n = 0; n < 2; ++n) acc[a][b][m][n] = (f32x4){0.f, 0.f, 0.f, 0.f};
    bf16x8 At[4][2], B0[2][2], B1[2][2];
    const char* cA = cur.a; const char* cB = cur.b; const char* nA = cA; const char* nB = cB;
    PG8_STAGE(PG8_SB(0, 0), cB, voffB); PG8_STAGE(PG8_SB(0, 1), cB + hstep, voffB); PG8_STAGE_A(PG8_SA(0, 0), false, 0, 0); PG8_STAGE_A(PG8_SA(0, 1), false, 1, 0);
    if (wr == 1) PG8_BAR;
    PG8_WAIT_V(2); PG8_BAR;
    PG8_STAGE(PG8_SB(1, 0), cB + kstep, voffB); PG8_STAGE_A(PG8_SA(1, 0), false, 0, kstep); PG8_STAGE(PG8_SB(1, 1), cB + hstep + kstep, voffB);
    PG8_WAIT_V(6); PG8_BAR;
    for (;;) {
        const bool has_next = S.next(ui + 1, nxt);
        nA = has_next ? nxt.a : cA; nB = has_next ? nxt.b : cB;
        if constexpr (GATHER) {
            const int npm = has_next ? nxt.pm : cur.pm;
#pragma unroll
            for (int h = 0; h < 2; ++h)
#pragma unroll
                for (int i = 0; i < 2; ++i) gN[h][i] = (unsigned)(S.rowidx[npm * BM + h * HALF + RA[i]] * K + CA[i]) * 2u;
        }
        for (int t = 0; t < nt; t += 2) {
            const bool last = (t == nt - 2);
            const size_t k1 = (size_t)(t + 1) * kstep;
            const size_t k2 = last ? 0 : (size_t)(t + 2) * kstep, k3 = k2 + kstep;
            const char* b2 = (last ? nB : cB) + k2; const char* b3 = b2 + kstep;
            PG8_LDB(B0, 0, 0); PG8_LDB(B1, 0, 1); PG8_SCHED; PG8_LDA(At, 0, 0); PG8_STAGE_A(PG8_SA(1, 1), false, 1, k1);
            PG8_WAIT_V(8); PG8_WAIT_L(0); PG8_BAR; PG8_MMA(0, 0, At, B0); PG8_MMA(0, 1, At, B1); PG8_BAR; PG8_SCHED;
            PG8_LDA(At, 0, 1); PG8_STAGE(PG8_SB(0, 0), b2, voffB); PG8_STAGE(PG8_SB(0, 1), b2 + hstep, voffB); PG8_STAGE_A(PG8_SA(0, 0), last, 0, k2);
            PG8_WAIT_V(8); PG8_WAIT_L(0); PG8_BAR; PG8_MMA(1, 0, At, B0); PG8_MMA(1, 1, At, B1); PG8_BAR; PG8_SCHED;
            PG8_LDB(B0, 1, 0); PG8_LDB(B1, 1, 1); PG8_SCHED; PG8_LDA(At, 1, 0); PG8_STAGE_A(PG8_SA(0, 1), last, 1, k2);
            PG8_WAIT_V(8); PG8_WAIT_L(0); PG8_BAR; PG8_MMA(0, 0, At, B0); PG8_MMA(0, 1, At, B1); PG8_BAR; PG8_SCHED;
            PG8_LDA(At, 1, 1); PG8_STAGE(PG8_SB(1, 0), b3, voffB); PG8_STAGE(PG8_SB(1, 1), b3 + hstep, voffB); PG8_STAGE_A(PG8_SA(1, 0), last, 0, k3);
            PG8_WAIT_V(8); PG8_WAIT_L(0); PG8_BAR; PG8_MMA(1, 0, At, B0); PG8_MMA(1, 1, At, B1); PG8_BAR; PG8_SCHED;
        }
        if (wr == 0) PG8_BAR;
        E(acc, cur, wr, wc, fr, fq);
        if (!has_next) break;
#pragma unroll
        for (int a = 0; a < 2; ++a)
#pragma unroll
            for (int b = 0; b < 2; ++b)
#pragma unroll
                for (int m = 0; m < 4; ++m)
#pragma unroll
                    for (int n = 0; n < 2; ++n) acc[a][b][m][n] = (f32x4){0.f, 0.f, 0.f, 0.f};
        cur = nxt; cA = nA; cB = nB; ++ui;
        if constexpr (GATHER) {
#pragma unroll
            for (int h = 0; h < 2; ++h)
#pragma unroll
                for (int i = 0; i < 2; ++i) gC[h][i] = gN[h][i];
        }
        if (wr == 1) PG8_BAR;
    }
    PG8_WAIT_V(0);
    PG8_BAR;
#undef PG8_SA
#undef PG8_SB
#undef PG8_DMA
#undef PG8_STAGE
#undef PG8_STAGE_A
#undef PG8_LDA
#undef PG8_LDB
#undef PG8_MMA
#undef PG8_WAIT_V
#undef PG8_WAIT_L
#undef PG8_BAR
#undef PG8_SCHED
}
}

struct Params { const float* in[27]; float* out; unsigned char* ws; int ph_lo, ph_hi; };
struct Ctx { LAS unsigned char* lds; int tid, lane, wave, vcu, G, gw, NGW; };
enum { I_X = 0, I_C, I_MODW, I_MODB, I_N1G, I_WIN, I_CONVK, I_CONVB, I_CLNG, I_CLNB, I_QNG, I_KVNG, I_WUQ, I_WUK, I_WUV, I_POOLW, I_POOLS, I_WOUT, I_N2G, I_RGW, I_RGB, I_REW, I_REB, I_W1, I_W3, I_W2, I_FG };

template <class RowMap>
__device__ __forceinline__ void tr_item(const float* src, int ldn, int k0, int n0, int nvalid, bf16_t* dst, int ldk, int dk0, RowMap rm, LAS float* scr, int lane) {
#pragma unroll 8
    for (int i = 0; i < 32; ++i) { const int kk = 2 * i + (lane >> 5), n = n0 + (lane & 31); scr[kk * 33 + (lane & 31)] = (n < nvalid) ? src[(size_t)(k0 + kk) * ldn + n] : 0.f; }
    LDS_WAIT();
    const int c = lane & 7;
#pragma unroll
    for (int j = 0; j < 4; ++j) { const int n = (lane >> 3) + 8 * j; const LAS float* s = scr + (8 * c) * 33 + n;
        u32x4 o; o.x = cvt_pk_bf16(s[0 * 33], s[1 * 33]); o.y = cvt_pk_bf16(s[2 * 33], s[3 * 33]); o.z = cvt_pk_bf16(s[4 * 33], s[5 * 33]); o.w = cvt_pk_bf16(s[6 * 33], s[7 * 33]);
        *(u32x4*)(dst + (size_t)rm(n0 + n) * ldk + dk0 + k0 + 8 * c) = o; }
    LDS_WAIT();
}

__device__ __forceinline__ void conv_experts(const Params& p, const Ctx& c, int l) {
    LAS float* scr = (LAS float*)(c.lds + c.wave * 8448);
    bf16_t* W13 = (bf16_t*)(p.ws + WS_W13); bf16_t* W2 = (bf16_t*)(p.ws + WS_W2);
    for (int it = c.gw; it < 3 * 8192; it += c.NGW) {
        const int which = it >> 13, r = it & 8191, e = r >> 8;
        if (which < 2) { const int kb = (r >> 4) & 15, nb = r & 15; const float* src = p.in[which ? I_W3 : I_W1] + (size_t)(l * NEXP + e) * 1024 * 512; const int add = which ? 4 : 0;
            tr_item(src, 512, 64 * kb, 32 * nb, 512, W13 + (size_t)e * 1024 * 1024, 1024, 0, [add](int n) { return 8 * (n >> 2) + (n & 3) + add; }, scr, c.lane); }
        else { const int kb = (r >> 5) & 7, nb = r & 31; const float* src = p.in[I_W2] + (size_t)(l * NEXP + e) * 512 * 1024;
            tr_item(src, 1024, 64 * kb, 32 * nb, 1024, W2 + (size_t)e * 1024 * 512, 512, 0, [](int n) { return n; }, scr, c.lane); }
    }
}

__device__ __forceinline__ void cx_issue(const Params& p, int l, int it, int lane, float (&tv)[32]) {
    const int which = it >> 13, r = it & 8191, e = r >> 8;
    const float* src; int ldn, k0, n0;
    if (which < 2) { const int kb = (r >> 4) & 15, nb = r & 15; src = p.in[which ? I_W3 : I_W1] + (size_t)(l * NEXP + e) * 1024 * 512; ldn = 512; k0 = 64 * kb; n0 = 32 * nb; }
    else { const int kb = (r >> 5) & 7, nb = r & 31; src = p.in[I_W2] + (size_t)(l * NEXP + e) * 512 * 1024; ldn = 1024; k0 = 64 * kb; n0 = 32 * nb; }
    const float* s0 = src + (size_t)(k0 + (lane >> 5)) * ldn + n0 + (lane & 31);
#pragma unroll
    for (int i = 0; i < 32; ++i) tv[i] = s0[(size_t)(2 * i) * ldn];
}
__device__ __forceinline__ void cx_finish(const Params& p, int it, int lane, const float (&tv)[32], LAS float* scr) {
    const int which = it >> 13, r = it & 8191, e = r >> 8;
    bf16_t* dst; int ldk, k0, n0, add = 0; bool inter = false;
    if (which < 2) { const int kb = (r >> 4) & 15, nb = r & 15; dst = (bf16_t*)(p.ws + WS_W13) + (size_t)e * 1024 * 1024; ldk = 1024; k0 = 64 * kb; n0 = 32 * nb; add = which ? 4 : 0; inter = true; }
    else { const int kb = (r >> 5) & 7, nb = r & 31; dst = (bf16_t*)(p.ws + WS_W2) + (size_t)e * 1024 * 512; ldk = 512; k0 = 64 * kb; n0 = 32 * nb; }
#pragma unroll
    for (int i = 0; i < 32; ++i) scr[(2 * i + (lane >> 5)) * 33 + (lane & 31)] = tv[i];
    LDS_WAIT();
    const int cc = lane & 7;
#pragma unroll
    for (int j = 0; j < 4; ++j) { const int n = (lane >> 3) + 8 * j; const LAS float* sp = scr + (8 * cc) * 33 + n; const int nn = n0 + n; const int row = inter ? (8 * (nn >> 2) + (nn & 3) + add) : nn;
        u32x4 o; o.x = cvt_pk_bf16(sp[0 * 33], sp[1 * 33]); o.y = cvt_pk_bf16(sp[2 * 33], sp[3 * 33]); o.z = cvt_pk_bf16(sp[4 * 33], sp[5 * 33]); o.w = cvt_pk_bf16(sp[6 * 33], sp[7 * 33]);
        *(u32x4*)(dst + (size_t)row * ldk + k0 + 8 * cc) = o; }
    LDS_WAIT();
}

__device__ __forceinline__ void ph_prologue(const Params& p, const Ctx& c) {
    float* mod = (float*)(p.ws + WS_MOD);
    {
        LAS float* cond = (LAS float*)c.lds; LAS float* part = (LAS float*)(c.lds + 65536);
        bool loaded = false;
        for (int item = c.vcu; item < 192; item += c.G) {
            if (!loaded) { for (int i = c.tid; i < NB * D; i += 512) { const float v = p.in[I_C][i]; cond[i] = v / (1.0f + expf(-v)); } __syncthreads(); loaded = true; }
            const int l = item / 96, n0 = (item % 96) * 64;
            const float* W = p.in[I_MODW] + (size_t)l * D * 6144 + n0 + c.lane;
            float acc[NB];
#pragma unroll
            for (int b = 0; b < NB; ++b) acc[b] = 0.f;
            for (int k = c.wave * 128; k < c.wave * 128 + 128; ++k) { const float w = W[(size_t)k * 6144];
#pragma unroll
                for (int b = 0; b < NB; ++b) acc[b] += cond[b * D + k] * w; }
#pragma unroll
            for (int b = 0; b < NB; ++b) part[(c.wave * NB + b) * 64 + c.lane] = acc[b];
            __syncthreads();
            for (int o = c.tid; o < NB * 64; o += 512) { const int b = o >> 6, ln = o & 63; float s = 0.f;
#pragma unroll
                for (int w = 0; w < 8; ++w) s += part[(w * NB + b) * 64 + ln];
                mod[(size_t)(l * NB + b) * 6144 + n0 + ln] = s + p.in[I_MODB][l * 6144 + n0 + ln]; }
            __syncthreads();
        }
        __syncthreads();
    }
    {
        LAS float* scr = (LAS float*)(c.lds + c.wave * 8448);
        constexpr int I_IN = 16 * 56, I_MX = 4 * 32;
        for (int it = c.gw; it < 2 * (I_IN + 2 * I_MX); it += c.NGW) {
            const int l = it / (I_IN + 2 * I_MX); int r = it % (I_IN + 2 * I_MX);
            if (r < I_IN) { const int kb = r / 56, nb = r % 56;
                tr_item(p.in[I_WIN] + (size_t)l * D * N_IN, N_IN, 64 * kb, 32 * nb, N_IN, (bf16_t*)(p.ws + WS_WIN) + (size_t)l * NZ * D, D, 0, [](int n) { return n; }, scr, c.lane); continue; }
            r -= I_IN; const int part = r / I_MX; r %= I_MX; const int kb = r / 32, nb = r % 32;
            tr_item(p.in[I_WOUT] + (size_t)l * D * D + (size_t)(part ? 768 : 0) * D, D, 64 * kb, 32 * nb, D, (bf16_t*)(p.ws + WS_WMIX) + (size_t)l * D * KMIX, KMIX, part ? 1280 : 0, [](int n) { return n; }, scr, c.lane);
        }
    }
    for (int it = c.gw * 64 + c.lane; it < 2 * 131072; it += c.NGW * 64) {
        const int l = it >> 17, r = it & 131071, n = r & 1023, h = (r >> 10) & 7, cb = r >> 13;
        const float* wo = p.in[I_WOUT] + (size_t)l * D * D + (size_t)(256 + 64 * h) * D + n;
        const float* wv = p.in[I_WUV] + (size_t)l * 128 * 512 + (size_t)(8 * cb) * 512 + h * 64;
        float acc[8];
#pragma unroll
        for (int j = 0; j < 8; ++j) acc[j] = 0.f;
        for (int d = 0; d < 64; ++d) { const float w = wo[(size_t)d * D];
#pragma unroll
            for (int j = 0; j < 8; ++j) acc[j] += wv[j * 512 + d] * w; }
        u32x4 o; o.x = cvt_pk_bf16(acc[0], acc[1]); o.y = cvt_pk_bf16(acc[2], acc[3]); o.z = cvt_pk_bf16(acc[4], acc[5]); o.w = cvt_pk_bf16(acc[6], acc[7]);
        *(u32x4*)((bf16_t*)(p.ws + WS_WMIX) + (size_t)l * D * KMIX + (size_t)n * KMIX + 256 + 128 * h + 8 * cb) = o;
    }
    for (int it = c.gw * 64 + c.lane; it < 2 * 32768; it += c.NGW * 64) {
        const int l = it >> 15, r = it & 32767, cb = r & 31, k = (r >> 5) & 127, h = r >> 12;
        const float* uq = p.in[I_WUQ] + (size_t)l * 256 * 512 + (size_t)(8 * cb) * 512 + h * 64;
        const float* uk = p.in[I_WUK] + (size_t)l * 128 * 512 + (size_t)k * 512 + h * 64;
        float acc[8];
#pragma unroll
        for (int j = 0; j < 8; ++j) acc[j] = 0.f;
        for (int d = 0; d < 64; ++d) { const float w = uk[d];
#pragma unroll
            for (int j = 0; j < 8; ++j) acc[j] += uq[j * 512 + d] * w; }
        const float sc = 0.125f * 1.44269504089f;
#pragma unroll
        for (int j = 0; j < 8; ++j) acc[j] *= sc * p.in[I_QNG][l * 256 + 8 * cb + j];
        u32x4 o; o.x = cvt_pk_bf16(acc[0], acc[1]); o.y = cvt_pk_bf16(acc[2], acc[3]); o.z = cvt_pk_bf16(acc[4], acc[5]); o.w = cvt_pk_bf16(acc[6], acc[7]);
        *(u32x4*)((bf16_t*)(p.ws + WS_WQA) + (size_t)l * D * 256 + (size_t)(h * 128 + k) * 256 + 8 * cb) = o;
    }
    for (int it = c.gw * 64 + c.lane; it < 2 * 1024 * 32; it += c.NGW * 64) {
        const int l = it >> 15, r = it & 32767, k = r >> 5, g = (r >> 3) & 3, q = r & 7, e = k & 3, ln = (k >> 2) & 63, j = k >> 8;
        ((float*)(p.ws + WS_SMALL + SM_REW2))[(size_t)(l * 4 + g) * 8192 + (size_t)((((j * 4 + e) * 2 + (q >> 2)) * 64 + ln) * 4) + (q & 3)] = p.in[I_REW][(size_t)l * D * 32 + r];
    }
    for (int it = c.gw * 64 + c.lane; it < 2 * 1024 * 4; it += c.NGW * 64) {
        const int l = it >> 12, r = it & 4095, k = r >> 2, q = r & 3, e = k & 3, ln = (k >> 2) & 63, j = k >> 8;
        ((float*)(p.ws + WS_SMALL + SM_RGW2))[(size_t)l * 4096 + (size_t)(((j * 4 + e) * 64 + ln) * 4) + q] = p.in[I_RGW][(size_t)l * D * 4 + r];
    }
}

template <int MODE>
__device__ __forceinline__ void ph_norm1(const Params& p, const Ctx& c) {
    const float* mod = (const float*)(p.ws + WS_MOD);
    const bf16_t* Y = (const bf16_t*)(p.ws + WS_Y); const int* tslot = (const int*)(p.ws + WS_SMALL + SM_TSLOT);
    bf16_t* H = (bf16_t*)(p.ws + WS_H); bf16_t* X16 = (bf16_t*)(p.ws + WS_X16);
    constexpr int NR = 2;
    const int nrow = T / c.NGW;
    f32x4 vn[NR][4]; u32x2 xn[NR][4], an[NR][4], bn[NR][4];
    auto load_rows = [&](int r0) {
#pragma unroll
        for (int t = 0; t < NR; ++t) { const int m = c.gw + (r0 + t) * c.NGW;
            if (MODE == 0) {
#pragma unroll
                for (int j = 0; j < 4; ++j) vn[t][j] = ((const f32x4*)(p.in[I_X] + (size_t)m * D) + c.lane)[64 * j];
            } else { const int s0 = tslot[2 * m], s1 = tslot[2 * m + 1];
#pragma unroll
                for (int j = 0; j < 4; ++j) { xn[t][j] = ((const u32x2*)(X16 + (size_t)m * D) + c.lane)[64 * j]; an[t][j] = ((const u32x2*)(Y + (size_t)s0 * D) + c.lane)[64 * j]; bn[t][j] = ((const u32x2*)(Y + (size_t)s1 * D) + c.lane)[64 * j]; } } } };
    load_rows(0);
    for (int r0 = 0; r0 < nrow; r0 += NR) {
        f32x4 v[NR][4]; u32x2 ya[NR][4], yb[NR][4];
#pragma unroll
        for (int t = 0; t < NR; ++t)
#pragma unroll
            for (int j = 0; j < 4; ++j) { if (MODE == 0) v[t][j] = vn[t][j]; else { v[t][j] = (f32x4){bflo(xn[t][j].x), bfhi(xn[t][j].x), bflo(xn[t][j].y), bfhi(xn[t][j].y)}; ya[t][j] = an[t][j]; yb[t][j] = bn[t][j]; } }
        if (r0 + NR < nrow) load_rows(r0 + NR);
#pragma unroll
        for (int t = 0; t < NR; ++t) {
            const int m = c.gw + (r0 + t) * c.NGW, b = m >> 11;
            if (MODE != 0) {
                const f32x4* g2 = (const f32x4*)(mod + (size_t)((MODE - 1) * NB + b) * 6144 + 5120) + c.lane;
#pragma unroll
                for (int j = 0; j < 4; ++j) { const u32x2 a = ya[t][j], bb = yb[t][j]; const f32x4 g = g2[64 * j];
                    v[t][j].x += g.x * (bflo(a.x) + bflo(bb.x)); v[t][j].y += g.y * (bfhi(a.x) + bfhi(bb.x)); v[t][j].z += g.z * (bflo(a.y) + bflo(bb.y)); v[t][j].w += g.w * (bfhi(a.y) + bfhi(bb.y)); }
            }
            float ss = 0.f;
#pragma unroll
            for (int j = 0; j < 4; ++j) ss += (v[t][j].x * v[t][j].x + v[t][j].y * v[t][j].y) + (v[t][j].z * v[t][j].z + v[t][j].w * v[t][j].w);
            const float r = 1.0f / sqrtf(wave_sum(ss) * (1.0f / D) + EPS);
            if (MODE == 2) {
                const f32x4* fg = (const f32x4*)p.in[I_FG] + c.lane; f32x4* o = (f32x4*)(p.out + (size_t)m * D) + c.lane;
#pragma unroll
                for (int j = 0; j < 4; ++j) o[64 * j] = v[t][j] * r * fg[64 * j];
            } else {
                if (MODE == 1) { u32x2* o = (u32x2*)(X16 + (size_t)m * D) + c.lane;
#pragma unroll
                    for (int j = 0; j < 4; ++j) { u32x2 w; w.x = cvt_pk_bf16(v[t][j].x, v[t][j].y); w.y = cvt_pk_bf16(v[t][j].z, v[t][j].w); o[64 * j] = w; } }
                const int l = MODE;
                const f32x4* ng = (const f32x4*)(p.in[I_N1G] + l * D) + c.lane;
                const f32x4* sh = (const f32x4*)(mod + (size_t)(l * NB + b) * 6144) + c.lane; const f32x4* sc = (const f32x4*)(mod + (size_t)(l * NB + b) * 6144 + 1024) + c.lane;
                u32x2* o8 = (u32x2*)(H + (size_t)m * D) + c.lane;
#pragma unroll
                for (int j = 0; j < 4; ++j) { const f32x4 hv = v[t][j] * r * ng[64 * j] * (sc[64 * j] + 1.0f) + sh[64 * j]; u32x2 w; w.x = cvt_pk_bf16(hv.x, hv.y); w.y = cvt_pk_bf16(hv.z, hv.w); o8[64 * j] = w; }
            }
        }
    }
}

__device__ __forceinline__ void ph_postz(const Params& p, const Ctx& c, int l) {
    const bf16_t* Z = (const bf16_t*)(p.ws + WS_Z); bf16_t* MC = (bf16_t*)p.out;
    bf16_t* CQR = (bf16_t*)(p.ws + WS_CQR); bf16_t* KVN = (bf16_t*)(p.ws + WS_KVN);
    LAS float* U = (LAS float*)c.lds;
    const int lane = c.lane, tk0 = c.wave * 8;
    for (int unit = c.vcu; unit < 512; unit += c.G) {
        const int b = unit >> 5, s0 = (unit & 31) * 64, t0 = b * S + s0;
#pragma unroll
        for (int hb = 0; hb < 2; ++hb) {   u32x2 av[6], gv[6];
#pragma unroll
            for (int q = 0; q < 6; ++q) { const int idx = c.tid + 512 * (6 * hb + q), r = idx >> 6, c4 = idx & 63; int s = s0 - 30 + r; s = s < 0 ? 0 : (s > S - 1 ? S - 1 : s);
                const bf16_t* zr = Z + (size_t)(b * S + s) * NZ + 4 * c4; av[q] = *(const u32x2*)(zr + Z_AVAL); gv[q] = *(const u32x2*)(zr + Z_AGATE); }
#pragma unroll
            for (int q = 0; q < 6; ++q) { const int idx = c.tid + 512 * (6 * hb + q), r = idx >> 6, c4 = idx & 63, s = s0 - 30 + r; f32x4 u = {0.f, 0.f, 0.f, 0.f};
                if (s >= 0) { const u32x2 a = av[q], g = gv[q];
                    u.x = bflo(a.x) * sigmoidf_(bflo(g.x)); u.y = bfhi(a.x) * sigmoidf_(bfhi(g.x)); u.z = bflo(a.y) * sigmoidf_(bflo(g.y)); u.w = bfhi(a.y) * sigmoidf_(bfhi(g.y)); }
                if (idx < 94 * 64) *(LAS f32x4*)(U + r * 256 + 4 * c4) = u; }
            asm volatile("" ::: "memory");
        }
        __syncthreads();
        {
            const f32x4* ck = (const f32x4*)(p.in[I_CONVK] + (size_t)l * 31 * 256) + lane;
            const f32x4 cb = *((const f32x4*)(p.in[I_CONVB] + l * 256) + lane), lg = *((const f32x4*)(p.in[I_CLNG] + l * 256) + lane), lb = *((const f32x4*)(p.in[I_CLNB] + l * 256) + lane);
#pragma unroll 1
            for (int hp = 0; hp < 2; ++hp) {
                const int tq = tk0 + 4 * hp;
                f32x4 acc[4], win[4];
#pragma unroll
                for (int i = 0; i < 4; ++i) { acc[i] = (f32x4){0.f, 0.f, 0.f, 0.f}; win[i] = *(const LAS f32x4*)(U + (tq + i) * 256 + 4 * lane); }
#pragma unroll
                for (int j = 0; j < 31; ++j) { const f32x4 kj = ck[64 * j];
#pragma unroll
                    for (int i = 0; i < 4; ++i) acc[i] += win[i] * kj;
                    if (j < 30) {
#pragma unroll
                        for (int i = 0; i < 3; ++i) win[i] = win[i + 1];
                        win[3] = *(const LAS f32x4*)(U + (tq + 4 + j) * 256 + 4 * lane); } }
#pragma unroll
                for (int i = 0; i < 4; ++i) { const f32x4 v = acc[i] + cb; const float mean = wave_sum((v.x + v.y) + (v.z + v.w)) * (1.0f / 256.0f);
                    const f32x4 d = v - mean; const float var = wave_sum((d.x * d.x + d.y * d.y) + (d.z * d.z + d.w * d.w)) * (1.0f / 256.0f);
                    const float rs = 1.0f / sqrtf(var + EPS); f32x4 y = d * rs * lg + lb;
                    y.x *= sigmoidf_(y.x); y.y *= sigmoidf_(y.y); y.z *= sigmoidf_(y.z); y.w *= sigmoidf_(y.w);
                    u32x2 w; w.x = cvt_pk_bf16(y.x, y.y); w.y = cvt_pk_bf16(y.z, y.w);
                    *(u32x2*)(MC + (size_t)(t0 + tq + i) * KMIX + 4 * lane) = w; }
            }
        }
        __syncthreads();
        {   u32x2 av[10];
#pragma unroll
            for (int q = 0; q < 10; ++q) { const int idx = c.tid + 512 * q, r = idx >> 6, c4 = idx & 63; int s = s0 - 15 + r; s = s < 0 ? 0 : (s > S - 1 ? S - 1 : s);
                av[q] = *(const u32x2*)(Z + (size_t)(b * S + s) * NZ + Z_UP + 4 * c4); }
#pragma unroll
            for (int q = 0; q < 10; ++q) { const int idx = c.tid + 512 * q, r = idx >> 6, c4 = idx & 63, s = s0 - 15 + r; f32x4 u = {0.f, 0.f, 0.f, 0.f};
                if (s >= 0) { const u32x2 a = av[q]; u.x = bflo(a.x); u.y = bfhi(a.x); u.z = bflo(a.y); u.w = bfhi(a.y); }
                if (idx < 79 * 64) *(LAS f32x4*)(U + r * 256 + 4 * c4) = u; }
        }
        __syncthreads();
        f32x4 dv[8];
        {
            const int w = 2 << (lane >> 4);
#pragma unroll
            for (int i = 0; i < 8; ++i) { const int r = 15 + tk0 + i, s = s0 + tk0 + i; f32x4 sum = {0.f, 0.f, 0.f, 0.f};
#pragma unroll
                for (int q = 0; q < 16; ++q) { const f32x4 u = *(const LAS f32x4*)(U + (r - q) * 256 + 4 * lane); if (q < w) sum += u; }
                const float cntf = (float)((s + 1) < w ? (s + 1) : w);
                dv[i] = sum / cntf - *(const LAS f32x4*)(U + r * 256 + 4 * lane); }
        }
        __syncthreads();
        {
            LAS float* Dw = U + c.wave * 2048;
#pragma unroll
            for (int i = 0; i < 8; ++i) *(LAS f32x4*)(Dw + i * 256 + 4 * lane) = dv[i];
            LDS_WAIT();
            const int g = lane >> 4, o4 = (lane & 15) * 4;
            const float* pw = p.in[I_POOLW] + (size_t)(l * 4 + g) * 4096 + o4;
            f32x4 out[8];
#pragma unroll
            for (int i = 0; i < 8; ++i) out[i] = (f32x4){0.f, 0.f, 0.f, 0.f};
            for (int ii = 0; ii < 64; ii += 4) {
                asm volatile("" ::: "memory");
                const f32x4 w0 = *(const f32x4*)(pw + (ii + 0) * 64), w1 = *(const f32x4*)(pw + (ii + 1) * 64), w2 = *(const f32x4*)(pw + (ii + 2) * 64), w3 = *(const f32x4*)(pw + (ii + 3) * 64);
#pragma unroll
                for (int i = 0; i < 8; ++i) { const f32x4 d = *(const LAS f32x4*)(Dw + i * 256 + 64 * g + ii); out[i] += w0 * d.x + w1 * d.y + w2 * d.z + w3 * d.w; } }
            const f32x4 ps = *((const f32x4*)(p.in[I_POOLS] + l * 256) + lane);
#pragma unroll
            for (int i = 0; i < 8; ++i) { const f32x4 y = out[i] * ps; u32x2 w; w.x = cvt_pk_bf16(y.x, y.y); w.y = cvt_pk_bf16(y.z, y.w);
                *(u32x2*)(MC + (size_t)(t0 + tk0 + i) * KMIX + 1280 + 4 * lane) = w; }
        }
        asm volatile("" ::: "memory");
        {
            const float kg0 = p.in[I_KVNG][l * 128 + 2 * lane], kg1 = p.in[I_KVNG][l * 128 + 2 * lane + 1];
            u32x2 qv[8]; unsigned kvv[8];
#pragma unroll
            for (int i = 0; i < 8; ++i) { const bf16_t* zr = Z + (size_t)(t0 + tk0 + i) * NZ; qv[i] = *(const u32x2*)(zr + Z_CQ + 4 * lane); kvv[i] = *(const unsigned*)(zr + Z_CKV + 2 * lane); }
#pragma unroll
            for (int i = 0; i < 8; ++i) { const size_t t = (size_t)(t0 + tk0 + i);
                const u32x2 q = qv[i]; const float q0 = bflo(q.x), q1 = bfhi(q.x), q2 = bflo(q.y), q3 = bfhi(q.y);
                const float rq = 1.0f / sqrtf(wave_sum((q0 * q0 + q1 * q1) + (q2 * q2 + q3 * q3)) * (1.0f / 256.0f) + EPS);
                u32x2 w; w.x = cvt_pk_bf16(q0 * rq, q1 * rq); w.y = cvt_pk_bf16(q2 * rq, q3 * rq); *(u32x2*)(CQR + t * 256 + 4 * lane) = w;
                const unsigned kv = kvv[i]; const float k0 = bflo(kv), k1 = bfhi(kv);
                const float rk = 1.0f / sqrtf(wave_sum(k0 * k0 + k1 * k1) * (1.0f / 128.0f) + EPS);
                *(unsigned*)(KVN + t * 128 + 2 * lane) = cvt_pk_bf16(k0 * rk * kg0, k1 * rk * kg1); }
        }
        __syncthreads();
    }
}

__device__ __forceinline__ size_t sc_off(int b, int cq) { return (size_t)b * SC_PER_B + (size_t)2048 * cq * (cq + 1); }
__device__ __forceinline__ void ph_scores(const Params& p, const Ctx& c) {
    const bf16_t* Z = (const bf16_t*)(p.ws + WS_Z); float* SC = (float*)(p.ws + WS_Y);
    const int lane = c.lane, l15 = lane & 15, g = lane >> 4;
    for (int U = c.gw; U < NB * 576; U += c.NGW) {
        const int b = U / 576, u = U % 576;
        int cg = 0; while (8 * (cg + 1) * (cg + 2) <= u) ++cg;
        const int r = u - 8 * cg * (cg + 1), q16 = r / (cg + 1), seg = r % (cg + 1), cq = 4 * cg + (q16 >> 2), q4 = q16 & 3;
        const int n = 64 * (cq + 1), kt0 = seg * 16, kt1 = (kt0 + 16 < 4 * (cq + 1)) ? kt0 + 16 : 4 * (cq + 1);
        const size_t tq = (size_t)b * S + cq * 64 + q4 * 16 + l15;
        const bf16_t* zq = Z + tq * NZ;
        bf16x8 bq[8][2];
#pragma unroll
        for (int h = 0; h < 8; ++h)
#pragma unroll
            for (int s = 0; s < 2; ++s) bq[h][s] = *(const bf16x8*)(zq + Z_QI + h * 64 + 32 * s + 8 * g);
        float wq[8];
        { const u32x4 wv = *(const u32x4*)(zq + Z_WI); const float isc = 0.044194173824159216f;
          wq[0] = bflo(wv.x) * isc; wq[1] = bfhi(wv.x) * isc; wq[2] = bflo(wv.y) * isc; wq[3] = bfhi(wv.y) * isc; wq[4] = bflo(wv.z) * isc; wq[5] = bfhi(wv.z) * isc; wq[6] = bflo(wv.w) * isc; wq[7] = bfhi(wv.w) * isc; }
        float* srow = SC + sc_off(b, cq) + (size_t)(q4 * 16 + l15) * n;
        const bf16_t* zkb = Z + ((size_t)b * S + l15) * NZ + Z_KI + 8 * g;
        bf16x8 nk0 = *(const bf16x8*)(zkb + (size_t)kt0 * 16 * NZ), nk1 = *(const bf16x8*)(zkb + (size_t)kt0 * 16 * NZ + 32);
        for (int kt = kt0; kt < kt1; ++kt) {
            const bf16x8 ak0 = nk0, ak1 = nk1;
            if (kt + 1 < kt1) { nk0 = *(const bf16x8*)(zkb + (size_t)(kt + 1) * 16 * NZ); nk1 = *(const bf16x8*)(zkb + (size_t)(kt + 1) * 16 * NZ + 32); }
            f32x4 sc = {0.f, 0.f, 0.f, 0.f};
#pragma unroll
            for (int h = 0; h < 8; ++h) { f32x4 a = {0.f, 0.f, 0.f, 0.f};
                a = __builtin_amdgcn_mfma_f32_16x16x32_bf16(ak0, bq[h][0], a, 0, 0, 0);
                a = __builtin_amdgcn_mfma_f32_16x16x32_bf16(ak1, bq[h][1], a, 0, 0, 0);
#pragma unroll
                for (int i = 0; i < 4; ++i) sc[i] += wq[h] * fmaxf(a[i], 0.f); }
            *(f32x4*)(srow + kt * 16 + 4 * g) = sc;
        }
    }
}

__device__ __forceinline__ unsigned off_b(unsigned row, unsigned ch) { return 256u * row + 16u * (ch ^ (((row & 3) << 2) | ((row >> 2) & 3))); }
template <int MODE>
__device__ __forceinline__ void ph_attn(const Params& p, const Ctx& c, int l) {
    const float* SC = (const float*)(p.ws + WS_Y); const bf16_t* QA = (const bf16_t*)(p.ws + WS_H); const bf16_t* KVN = (const bf16_t*)(p.ws + WS_KVN);
    bf16_t* MC = (bf16_t*)p.out;
    const int lane = c.lane, g = lane >> 4, hd = lane & 15;
    LAS unsigned char* tile = c.lds + c.wave * 16384;
    LAS unsigned short* lst = (LAS unsigned short*)(c.lds + LIST_OFF + c.wave * 512);
    const unsigned long long ltmask = (1ull << lane) - 1ull;
    const int xg = blockIdx.x & 7, wv = (blockIdx.x >> 3) * 8 + c.wave, nwv = (c.G >> 3) * 8;
    int cxq = 0;
    for (int qi = wv; qi < 2 * S; qi += nwv) {
        const int b = xg + 8 * (qi / S), s = qi % S, cq = s >> 6, n = 64 * (cq + 1), nk = n < 256 ? n : 256;
        const size_t t = (size_t)b * S + s;
        float tv[32]; const int cit = c.gw + c.NGW * cxq; const bool cxv = (MODE & 8) && cit < 3 * 8192;
        if (cxv) cx_issue(p, l, cit, lane, tv);
        if (cq < 4 || !(MODE & 1)) { for (int i = lane; i < nk; i += 64) lst[i] = (unsigned short)i; }
        else {
            const float* srow = SC + sc_off(b, cq) + (size_t)(s & 63) * n;
            unsigned key[32]; unsigned kmin = 0xffffffffu, kmax = 0u;
            float sv[32];
#pragma unroll
            for (int j = 0; j < 32; ++j) sv[j] = srow[64 * (j <= cq ? j : cq) + lane];
#pragma unroll
            for (int j = 0; j < 32; ++j) key[j] = 0u;
#pragma unroll
            for (int jb = 0; jb < 4; ++jb) if (8 * jb <= cq) {
#pragma unroll
                for (int j = 8 * jb; j < 8 * jb + 8; ++j) { const unsigned u = __float_as_uint(sv[j] + 0.0f); const unsigned k = (u & 0x80000000u) ? ~u : (u | 0x80000000u);
                    key[j] = (j <= cq) ? k : 0u; kmin = (j <= cq && k < kmin) ? k : kmin; kmax = (j <= cq && k > kmax) ? k : kmax; } }
#define KMM(W) { const unsigned a = lane_xor<W>(kmin), bb = lane_xor<W>(kmax); kmin = a < kmin ? a : kmin; kmax = bb > kmax ? bb : kmax; }
            KMM(1) KMM(2) KMM(4) KMM(8) KMM(16) KMM(32)
#undef KMM
            unsigned lo = __builtin_amdgcn_readfirstlane(kmin), hi = __builtin_amdgcn_readfirstlane(kmax); int c_lo = n, c_hi = 0; int it = 0;
            unsigned thr = 0u; int need = 0; bool done = false;
            while (lo < hi && (c_lo - c_hi) > 64) {
                unsigned mid;
                if (it < 20) {
                    const float lo_v = __uint_as_float((lo & 0x80000000u) ? (lo ^ 0x80000000u) : ~lo), hi_v = __uint_as_float((hi & 0x80000000u) ? (hi ^ 0x80000000u) : ~hi);
                    const float f = (it & 1) ? 0.5f : (float)(c_lo - 256) / (float)(c_lo - c_hi);
                    const float mid_v = lo_v + (hi_v - lo_v) * f + 0.0f;
                    const unsigned mu = __float_as_uint(mid_v); mid = (mu & 0x80000000u) ? ~mu : (mu | 0x80000000u);
                } else mid = lo + ((hi - lo) >> 1) + 1u;
                mid = mid > lo ? mid : lo + 1u; mid = mid < hi ? mid : hi;
                int cnt = 0;
#pragma unroll
                for (int jb = 0; jb < 4; ++jb) if (8 * jb <= cq) {
                    unsigned long long bm[8];
#pragma unroll
                    for (int j = 0; j < 8; ++j) bm[j] = __ballot(key[8 * jb + j] >= mid);
#pragma unroll
                    for (int j = 0; j < 8; ++j) cnt += __builtin_popcountll(bm[j]); }
                if (cnt >= 256) { lo = mid; c_lo = cnt; if (cnt == 256) { thr = mid; need = 1 << 20; done = true; break; } } else { hi = mid - 1u; c_hi = cnt; }
                ++it;
            }
            if (!done) {
                if (lo == hi) {
                    thr = lo; int cgt = 0;
#pragma unroll
                    for (int j = 0; j < 32; ++j) cgt += __builtin_popcountll(__ballot(key[j] > thr));
                    need = 256 - cgt;
                } else {
                    LAS unsigned* cand = (LAS unsigned*)lst; int base = 0;
#pragma unroll
                    for (int jb = 0; jb < 4; ++jb) if (8 * jb <= cq) {
#pragma unroll
                        for (int j = 8 * jb; j < 8 * jb + 8; ++j) { const bool isc = key[j] >= lo && key[j] <= hi; const unsigned long long bc = __ballot(isc);
                            if (isc) cand[base + __builtin_popcountll(bc & ltmask)] = key[j]; base += __builtin_popcountll(bc); } }
                    const int m = base;
                    const unsigned ck = lane < m ? cand[lane] : 0u;
                    int gt = 0, ge = 0;
                    for (int q = 0; q < m; ++q) { const unsigned v = (unsigned)__builtin_amdgcn_readlane((int)ck, q); gt += v > ck; ge += v >= ck; }
                    const int r = 256 - c_hi;
                    const unsigned long long hit = __ballot(lane < m && gt < r && r <= ge);
                    const int src = __builtin_ctzll(hit);
                    thr = __shfl(ck, src); need = r - __shfl(gt, src);
                }
            }
            asm volatile("" ::: "memory");
            {
                int base = 0, tb = 0;
#pragma unroll
                for (int jb = 0; jb < 4; ++jb) if (8 * jb <= cq) {
#pragma unroll
                    for (int j = 8 * jb; j < 8 * jb + 8; ++j) {
                        const bool gt = key[j] > thr, tie = key[j] == thr; const unsigned long long bt = __ballot(tie);
                        const int trank = tb + __builtin_popcountll(bt & ltmask); const bool sel = gt || (tie && trank < need);
                        const unsigned long long bs = __ballot(sel); const int pos = base + __builtin_popcountll(bs & ltmask);
                        if (sel && pos < 256) lst[pos] = (unsigned short)(64 * j + lane);
                        base += __builtin_popcountll(bs); tb += __builtin_popcountll(bt); } }
            }
        }
        bf16x8 qf[4];
#pragma unroll
        for (int ks = 0; ks < 4; ++ks) { qf[ks] = (bf16x8){0, 0, 0, 0, 0, 0, 0, 0}; if (hd < 8) qf[ks] = *(const bf16x8*)(QA + t * D + hd * 128 + 32 * ks + 8 * g); }
        float m_ref = -INFINITY, l_run = 0.f;
        f32x4 o[8];
#pragma unroll
        for (int ct = 0; ct < 8; ++ct) o[ct] = (f32x4){0.f, 0.f, 0.f, 0.f};
        const char* kvb = (const char*)(KVN + (size_t)b * S * 128);
        const int ntile = nk >> 5;
        LDS_WAIT();
#define ATT_ISSUE(kt_, buf_) do { const u32x4 kq_ = *(const LAS u32x4*)(lst + (kt_) * 32 + 8 * g); _Pragma("unroll") for (int i = 0; i < 8; ++i) { const int r = 4 * i + g; \
            const unsigned key_ = (i & 1) ? (kq_[i >> 1] >> 16) : (kq_[i >> 1] & 0xffffu); \
            const unsigned ch = (unsigned)hd ^ (unsigned)(((r & 3) << 2) | ((r >> 2) & 3)); \
            if (MODE & 2) __builtin_amdgcn_global_load_lds((const unsigned*)(kvb + key_ * 256u + ch * 16u), (LAS unsigned*)(tile + (buf_) * 8192 + i * 1024), 16, 0, 0); } } while (0)
        ATT_ISSUE(0, 0);
        for (int kt = 0; kt < ntile; ++kt) {
            LAS unsigned char* tb_ = tile + (kt & 1) * 8192;
            if (kt + 1 < ntile) { ATT_ISSUE(kt + 1, (kt + 1) & 1); asm volatile("s_waitcnt vmcnt(8)" ::: "memory"); }
            else asm volatile("s_waitcnt vmcnt(0)" ::: "memory");
            if (!(MODE & 4)) continue;
            f32x4 sa[2]; bf16x8 af[2][4];
#pragma unroll
            for (int rb = 0; rb < 2; ++rb)
#pragma unroll
                for (int ks = 0; ks < 4; ++ks) af[rb][ks] = *(const LAS bf16x8*)(tb_ + off_b(16 * rb + hd, 4 * ks + g));
#pragma unroll
            for (int rb = 0; rb < 2; ++rb) { sa[rb] = (f32x4){0.f, 0.f, 0.f, 0.f};
#pragma unroll
                for (int ks = 0; ks < 4; ++ks) sa[rb] = __builtin_amdgcn_mfma_f32_16x16x32_bf16(af[rb][ks], qf[ks], sa[rb], 0, 0, 0); }
            float mx = fmaxf(fmaxf(fmaxf(sa[0][0], sa[0][1]), fmaxf(sa[0][2], sa[0][3])), fmaxf(fmaxf(sa[1][0], sa[1][1]), fmaxf(sa[1][2], sa[1][3])));
            if (__ballot(mx > m_ref + 40.0f) != 0ull) {
                mx = fmaxf(mx, lane_xor<16>(mx)); mx = fmaxf(mx, lane_xor<32>(mx));
                const float m_new = fmaxf(m_ref, mx), alpha = __builtin_amdgcn_exp2f(m_ref - m_new);
                l_run *= alpha; m_ref = m_new;
#pragma unroll
                for (int ct = 0; ct < 8; ++ct) o[ct] *= alpha;
            }
            float pr[8], ps = 0.f;
#pragma unroll
            for (int j = 0; j < 8; ++j) { pr[j] = __builtin_amdgcn_exp2f(sa[j >> 2][j & 3] - m_ref); ps += pr[j]; }
            l_run += ps;
            u32x4 pw; pw.x = cvt_pk_bf16(pr[0], pr[1]); pw.y = cvt_pk_bf16(pr[2], pr[3]); pw.z = cvt_pk_bf16(pr[4], pr[5]); pw.w = cvt_pk_bf16(pr[6], pr[7]);
            const bf16x8 pb = __builtin_bit_cast(bf16x8, pw);
            const unsigned q4 = (unsigned)hd >> 2, p4 = (unsigned)hd & 3;
#pragma unroll
            for (int ct = 0; ct < 8; ++ct) {
                const bf16x4 vlo = __builtin_amdgcn_ds_read_tr16_b64_v4i16((LAS bf16x4*)(tb_ + off_b(4 * g + q4, 2 * ct + (p4 >> 1)) + 8 * (p4 & 1)));
                const bf16x4 vhi = __builtin_amdgcn_ds_read_tr16_b64_v4i16((LAS bf16x4*)(tb_ + off_b(16 + 4 * g + q4, 2 * ct + (p4 >> 1)) + 8 * (p4 & 1)));
                const bf16x8 va = __builtin_shufflevector(vlo, vhi, 0, 1, 2, 3, 4, 5, 6, 7);
                o[ct] = __builtin_amdgcn_mfma_f32_16x16x32_bf16(va, pb, o[ct], 0, 0, 0);
            }
            LDS_WAIT();
        }
#undef ATT_ISSUE
        float lt = l_run + lane_xor<16>(l_run); lt += lane_xor<32>(lt);
        const float inv = 1.0f / lt;
        if (hd < 8 && ((MODE & 8) || lt == 12345.678f)) {
#pragma unroll
            for (int ct = 0; ct < 8; ++ct) { const f32x4 v = o[ct] * inv; u32x2 w; w.x = cvt_pk_bf16(v.x, v.y); w.y = cvt_pk_bf16(v.z, v.w);
                *(u32x2*)(MC + t * KMIX + 256 + hd * 128 + 16 * ct + 4 * g) = w; }
        }
        if (cxv) cx_finish(p, cit, lane, tv, (LAS float*)tile);
        ++cxq;
    }
    for (; (MODE & 8) && c.gw + c.NGW * cxq < 3 * 8192; ++cxq) { float tv[32]; const int cit = c.gw + c.NGW * cxq; cx_issue(p, l, cit, lane, tv); cx_finish(p, cit, lane, tv, (LAS float*)tile); }
}

#ifndef RT_NT
#define RT_NT 2
#endif
__device__ __forceinline__ void ph_router(const Params& p, const Ctx& c, int l) {
    const float* mod = (const float*)(p.ws + WS_MOD); bf16_t* H = (bf16_t*)(p.ws + WS_H);
    int* toke = (int*)(p.ws + WS_SMALL + SM_TOKE); float* tokg = (float*)(p.ws + WS_SMALL + SM_TOKG); int* rank = (int*)(p.ws + WS_SMALL + SM_RANK); int* cnt = (int*)(p.ws + WS_SMALL + SM_CNT);
    LAS int* le = (LAS int*)(c.lds + RT_LE_OFF); LAS int* wcnt = le + 256;
    const int lane = c.lane;
    {
        const f32x4* srcE = (const f32x4*)(p.ws + WS_SMALL + SM_REW2) + (size_t)l * 8192; const f32x4* srcG = (const f32x4*)(p.ws + WS_SMALL + SM_RGW2) + (size_t)l * 1024;
        LAS f32x4* dE = (LAS f32x4*)c.lds; LAS f32x4* dG = (LAS f32x4*)(c.lds + RT_RG_OFF);
#pragma unroll
        for (int hb = 0; hb < 2; ++hb) { f32x4 t[8];
#pragma unroll
            for (int q = 0; q < 8; ++q) t[q] = srcE[c.tid + 512 * (8 * hb + q)];
#pragma unroll
            for (int q = 0; q < 8; ++q) dE[c.tid + 512 * (8 * hb + q)] = t[q]; }
        { const f32x4 t0 = srcG[c.tid], t1 = srcG[c.tid + 512]; dG[c.tid] = t0; dG[c.tid + 512] = t1; }
        __syncthreads();
    }
    for (int tile = c.vcu; tile < 256; tile += c.G) {
        constexpr int NT = RT_NT;
        const int b = (tile * 128) >> 11;
        const f32x4* ng = (const f32x4*)(p.in[I_N2G] + l * D) + lane;
        const f32x4* sh = (const f32x4*)(mod + (size_t)(l * NB + b) * 6144 + 3072) + lane; const f32x4* sc = (const f32x4*)(mod + (size_t)(l * NB + b) * 6144 + 4096) + lane;
        const LAS f32x4* rg = (const LAS f32x4*)(c.lds + RT_RG_OFF) + lane;
        f32x4 gm[4], sv[4];
#pragma unroll
        for (int j = 0; j < 4; ++j) { gm[j] = ng[64 * j] * (sc[64 * j] + 1.0f); sv[j] = sh[64 * j]; }
        f32x4 v[NT][4]; u32x2 vn[NT][4];
#pragma unroll
        for (int t = 0; t < NT; ++t)
#pragma unroll
            for (int j = 0; j < 4; ++j) vn[t][j] = ((const u32x2*)((const bf16_t*)(p.ws + WS_X16) + (size_t)(tile * 128 + c.wave * 16 + t) * D) + lane)[64 * j];
        for (int i = 0; i < 16; i += NT) {
            const int tl0 = c.wave * 16 + i, m0 = tile * 128 + tl0;
            float ss[NT], r[NT], gl[NT][4];
#pragma unroll
            for (int t = 0; t < NT; ++t) { ss[t] = 0.f;
#pragma unroll
                for (int j = 0; j < 4; ++j) { v[t][j] = (f32x4){bflo(vn[t][j].x), bfhi(vn[t][j].x), bflo(vn[t][j].y), bfhi(vn[t][j].y)}; ss[t] += (v[t][j].x * v[t][j].x + v[t][j].y * v[t][j].y) + (v[t][j].z * v[t][j].z + v[t][j].w * v[t][j].w); } }
            if (i + NT < 16) {
#pragma unroll
                for (int t = 0; t < NT; ++t)
#pragma unroll
                    for (int j = 0; j < 4; ++j) vn[t][j] = ((const u32x2*)((const bf16_t*)(p.ws + WS_X16) + (size_t)(m0 + NT + t) * D) + lane)[64 * j]; }
#pragma unroll
            for (int t = 0; t < NT; ++t) ss[t] = wave_sum(ss[t]);
#pragma unroll
            for (int t = 0; t < NT; ++t) { r[t] = 1.0f / sqrtf(ss[t] * (1.0f / D) + EPS); gl[t][0] = gl[t][1] = gl[t][2] = gl[t][3] = 0.f; }
#pragma unroll
            for (int j = 0; j < 4; ++j) {
#pragma unroll
                for (int t = 0; t < NT; ++t) { v[t][j] = v[t][j] * r[t] * gm[j] + sv[j];
                    u32x2 w; w.x = cvt_pk_bf16(v[t][j].x, v[t][j].y); w.y = cvt_pk_bf16(v[t][j].z, v[t][j].w); ((u32x2*)(H + (size_t)(m0 + t) * D) + lane)[64 * j] = w; }
#pragma unroll
                for (int e = 0; e < 4; ++e) { const f32x4 wr = rg[(j * 4 + e) * 64];
#pragma unroll
                    for (int t = 0; t < NT; ++t) { gl[t][0] += v[t][j][e] * wr.x; gl[t][1] += v[t][j][e] * wr.y; gl[t][2] += v[t][j][e] * wr.z; gl[t][3] += v[t][j][e] * wr.w; } } }
            const bool h32 = lane & 32, h16 = lane & 16, h8 = lane & 8;
            float dg[NT];
#pragma unroll
            for (int t = 0; t < NT; ++t) {
                const float c0 = (h16 ? gl[t][2] : gl[t][0]) + lane_xor<16>(h16 ? gl[t][0] : gl[t][2]), c1 = (h16 ? gl[t][3] : gl[t][1]) + lane_xor<16>(h16 ? gl[t][1] : gl[t][3]);
                float d = (h8 ? c1 : c0) + lane_xor<8>(h8 ? c0 : c1);
                d += lane_xor<4>(d); d += lane_xor<2>(d); d += lane_xor<1>(d); d += lane_xor<32>(d); dg[t] = d; }
            int gi[NT]; float gp[NT];
#pragma unroll
            for (int t = 0; t < NT; ++t) { float gq[4]; int g_ = 0; float gmax = -INFINITY;
#pragma unroll
                for (int q = 0; q < 4; ++q) { gq[q] = __shfl(dg[t], 8 * (q & 1) + 16 * (q >> 1)) + p.in[I_RGB][l * 4 + q]; if (gq[q] > gmax) { gmax = gq[q]; g_ = q; } }
                float gden = 0.f;
#pragma unroll
                for (int q = 0; q < 4; ++q) gden += __expf(gq[q] - gmax);
                gp[t] = 1.0f / gden; gi[t] = __builtin_amdgcn_readfirstlane(g_); }
            float el[NT][8];
#pragma unroll
            for (int t = 0; t < NT; ++t)
#pragma unroll
                for (int q = 0; q < 8; ++q) el[t][q] = 0.f;
#pragma unroll
            for (int j = 0; j < 4; ++j)
#pragma unroll
                for (int e = 0; e < 4; ++e)
#pragma unroll
                    for (int t = 0; t < NT; ++t) { const LAS f32x4* rr = (const LAS f32x4*)c.lds + gi[t] * 2048 + (j * 4 + e) * 128 + lane;
                        const f32x4 w0 = rr[0], w1 = rr[64]; const float hv = v[t][j][e];
                        el[t][0] += hv * w0.x; el[t][1] += hv * w0.y; el[t][2] += hv * w0.z; el[t][3] += hv * w0.w; el[t][4] += hv * w1.x; el[t][5] += hv * w1.y; el[t][6] += hv * w1.z; el[t][7] += hv * w1.w; }
            float de[NT];
#pragma unroll
            for (int t = 0; t < NT; ++t) {
                const float b0 = (h32 ? el[t][4] : el[t][0]) + lane_xor<32>(h32 ? el[t][0] : el[t][4]), b1 = (h32 ? el[t][5] : el[t][1]) + lane_xor<32>(h32 ? el[t][1] : el[t][5]);
                const float b2 = (h32 ? el[t][6] : el[t][2]) + lane_xor<32>(h32 ? el[t][2] : el[t][6]), b3 = (h32 ? el[t][7] : el[t][3]) + lane_xor<32>(h32 ? el[t][3] : el[t][7]);
                const float c0 = (h16 ? b2 : b0) + lane_xor<16>(h16 ? b0 : b2), c1 = (h16 ? b3 : b1) + lane_xor<16>(h16 ? b1 : b3);
                float d = (h8 ? c1 : c0) + lane_xor<8>(h8 ? c0 : c1);
                d += lane_xor<4>(d); d += lane_xor<2>(d); d += lane_xor<1>(d); de[t] = d; }
#pragma unroll
            for (int t = 0; t < NT; ++t) { float eq[8]; int e0 = 0, e1 = 0; float mx0 = -INFINITY, mx1 = -INFINITY;
#pragma unroll
                for (int q = 0; q < 8; ++q) { eq[q] = __shfl(de[t], 8 * (q & 1) + 16 * ((q >> 1) & 1) + 32 * (q >> 2)) + p.in[I_REB][l * 32 + gi[t] * 8 + q];
                    if (eq[q] > mx0) { mx1 = mx0; e1 = e0; mx0 = eq[q]; e0 = q; } else if (eq[q] > mx1) { mx1 = eq[q]; e1 = q; } }
                const float x1 = __expf(mx1 - mx0), den = 1.0f + x1; const int tl = tl0 + t, m = m0 + t;
                if (lane == 0) { le[2 * tl] = gi[t] * 8 + e0; le[2 * tl + 1] = gi[t] * 8 + e1; toke[2 * m] = gi[t] * 8 + e0; toke[2 * m + 1] = gi[t] * 8 + e1; tokg[2 * m] = gp[t] / den; tokg[2 * m + 1] = gp[t] * x1 / den; } }
        }
        __syncthreads();
        int myrank = 0, mye = 0;
        if (c.tid < 256) { mye = le[c.tid]; const unsigned long long ltmask = (1ull << lane) - 1ull;
            for (int ee = 0; ee < 32; ++ee) { const unsigned long long m = __ballot(mye == ee); if (mye == ee) myrank = __builtin_popcountll(m & ltmask); if (lane == 0) wcnt[c.wave * 32 + ee] = __builtin_popcountll(m); } }
        __syncthreads();
        if (c.tid < 256) { for (int w = 0; w < c.wave; ++w) myrank += wcnt[w * 32 + mye]; rank[tile * 256 + c.tid] = myrank; }
        if (c.tid < 32) cnt[tile * 32 + c.tid] = wcnt[c.tid] + wcnt[32 + c.tid] + wcnt[64 + c.tid] + wcnt[96 + c.tid];
        __syncthreads();
    }
}

__device__ __forceinline__ void ph_dispatch(const Params& p, const Ctx& c) {
    const int* toke = (const int*)(p.ws + WS_SMALL + SM_TOKE); const float* tokg = (const float*)(p.ws + WS_SMALL + SM_TOKG); const int* rank = (const int*)(p.ws + WS_SMALL + SM_RANK); const int* cnt = (const int*)(p.ws + WS_SMALL + SM_CNT);
    int* tslot = (int*)(p.ws + WS_SMALL + SM_TSLOT); int* stok = (int*)(p.ws + WS_SMALL + SM_STOK); float* sgate = (float*)(p.ws + WS_SMALL + SM_SGATE); int* texp = (int*)(p.ws + WS_SMALL + SM_TEXP);
    LAS int* tot = (LAS int*)c.lds; LAS int* pst = tot + 32; LAS int* bse = pst + 33;
    for (int tile = c.vcu; tile < 256; tile += c.G) {
        {
            LAS int* psum = bse + 32; LAS int* pbase = psum + 512;
            const int e = c.tid & 31, part = c.tid >> 5; int v[16]; int run = 0, mb = 0;
#pragma unroll
            for (int q = 0; q < 16; ++q) v[q] = cnt[(part * 16 + q) * 32 + e];
#pragma unroll
            for (int q = 0; q < 16; ++q) { if (part * 16 + q == tile) mb = run; run += v[q]; }
            psum[part * 32 + e] = run; pbase[part * 32 + e] = mb;
            __syncthreads();
            if (c.tid < 32) { int tr = 0, tb2 = 0; const int tp = tile >> 4;
                for (int q = 0; q < 16; ++q) { if (q == tp) tb2 = tr + pbase[q * 32 + c.tid]; tr += psum[q * 32 + c.tid]; }
                tot[c.tid] = tr; bse[c.tid] = tb2; }
        }
        __syncthreads();
        if (c.tid == 0) { int a = 0; for (int e = 0; e < 32; ++e) { pst[e] = a; a += ((tot[e] + 255) >> 8) << 8; } pst[32] = a; }
        __syncthreads();
        if (c.tid < 256) { const int a = tile * 256 + c.tid, e = toke[a], slot = pst[e] + bse[e] + rank[a]; stok[slot] = a >> 1; sgate[slot] = tokg[a]; tslot[a] = slot; }
        if (tile == 0) {
            for (int e = 0; e < 32; ++e) { const int pc = pst[e + 1] - pst[e]; for (int r = tot[e] + c.tid; r < pc; r += 512) { stok[pst[e] + r] = 0; sgate[pst[e] + r] = 0.f; } }
            const int ntl = pst[32] >> 8;
            for (int m = c.tid; m < ntl; m += 512) { int e = 0; while (pst[e + 1] <= (m << 8)) ++e; texp[m] = e; }
            if (c.tid == 0) texp[MAXTILES] = ntl;
        }
        __syncthreads();
    }
}

#ifndef PH_ONLY
#define PH_ONLY -1
#endif
#define IN(k) ((PH_ONLY < 0 || PH_ONLY == (k)) && lo <= (k) && (k) < hi)
#define SEAM(k) do { if (IN(k) && IN((k) + 1)) xcd_barrier(bar); } while (0)
#ifndef REP_MASK
#define REP_MASK 0
#endif
#define REP(id) (((REP_MASK) >> (id)) & 1)
#define BODY(id, cond, ...) do { __VA_ARGS__ if (REP(id) && (cond)) { xcd_barrier(bar); __VA_ARGS__ } } while (0)
template <int l>
__device__ __forceinline__ void run_layer(const Params& p, const Ctx& c, const XcdBarrier& bar, int lo, int hi) {
    bf16_t* Zb = (bf16_t*)(p.ws + WS_Z); bf16_t* Hb = (bf16_t*)(p.ws + WS_H); bf16_t* MCb = (bf16_t*)p.out;
    const float* mod = (const float*)(p.ws + WS_MOD);
    constexpr int P = 1 + 10 * l;
    if (IN(P)) { if (l == 0) { BODY(1, true, ph_norm1<0>(p, c);); } else { ph_norm1<1>(p, c); } }
    SEAM(P);
    if (IN(P + 1)) { BODY(2, true, { pg8::StaticOrder So; So.init(Hb, (bf16_t*)(p.ws + WS_WIN) + (size_t)l * NZ * D, T, NZ, D, c.G, (int)blockIdx.x);
        pg8::EpiBf16 E{Zb, NZ}; pg8::gemm_phase<pg8::EpiBf16, pg8::StaticOrder, false>(c.lds, So, E); }); }
    SEAM(P + 1);
    if (IN(P + 2)) { BODY(3, true, ph_postz(p, c, l);); }
    SEAM(P + 2);
    if (IN(P + 3)) { BODY(4, true, { pg8::StaticOrder So; So.init((bf16_t*)(p.ws + WS_CQR), (bf16_t*)(p.ws + WS_WQA) + (size_t)l * D * 256, T, D, 256, c.G, (int)blockIdx.x);
        pg8::EpiBf16 E{Hb, D}; pg8::gemm_phase<pg8::EpiBf16, pg8::StaticOrder, false>(c.lds, So, E); });
        BODY(5, true, ph_scores(p, c);); }
    SEAM(P + 3);
#ifndef ATT_PROBE
#define ATT_PROBE 0
#endif
    if (IN(P + 4)) { ph_attn<15>(p, c, l); if (ATT_PROBE) { xcd_barrier(bar); ph_attn<ATT_PROBE>(p, c, l); } }
    SEAM(P + 4);
    if (IN(P + 5)) { BODY(7, l == 0, { pg8::StaticOrder So; So.init(MCb, (bf16_t*)(p.ws + WS_WMIX) + (size_t)l * D * KMIX, T, D, KMIX, c.G, (int)blockIdx.x);
        pg8::EpiMix E{l == 0 ? p.in[I_X] : nullptr, (bf16_t*)(p.ws + WS_X16), mod + (size_t)l * NB * 6144 + 2048}; pg8::gemm_phase<pg8::EpiMix, pg8::StaticOrder, false>(c.lds, So, E); }); }
    SEAM(P + 5);
    if (IN(P + 6)) { BODY(8, true, ph_router(p, c, l);); }
    SEAM(P + 6);
    if (IN(P + 7)) { BODY(9, true, ph_dispatch(p, c);); }
    SEAM(P + 7);
    if (IN(P + 8)) { BODY(10, true, { const int* texp = (const int*)(p.ws + WS_SMALL + SM_TEXP); const int ntl = texp[MAXTILES];
        pg8::MoeOrder Mo; Mo.init(Hb, p.ws + WS_W13, D, (size_t)1024 * 1024 * 2, (const int*)(p.ws + WS_SMALL + SM_STOK), texp, ntl, c.G, c.vcu);
        pg8::EpiAct E{Zb}; pg8::gemm_phase<pg8::EpiAct, pg8::MoeOrder, true>(c.lds, Mo, E); }); }
    SEAM(P + 8);
    if (IN(P + 9)) { BODY(11, true, { const int* texp = (const int*)(p.ws + WS_SMALL + SM_TEXP); const int ntl = texp[MAXTILES];
        pg8::MoeOrder Mo; Mo.init(Zb, p.ws + WS_W2, DEXP, (size_t)1024 * 512 * 2, nullptr, texp, ntl, c.G, c.vcu);
        pg8::EpiY E{(bf16_t*)(p.ws + WS_Y), (const float*)(p.ws + WS_SMALL + SM_SGATE)}; pg8::gemm_phase<pg8::EpiY, pg8::MoeOrder, false>(c.lds, Mo, E); }); }
    SEAM(P + 9);
}

__global__ void __launch_bounds__(512, 2) fwd(Params p) {
    extern __shared__ __attribute__((aligned(16))) unsigned char lds_raw[];
    Ctx c;
    c.lds = (LAS unsigned char*)lds_raw;
    c.tid = threadIdx.x; c.lane = c.tid & 63; c.wave = __builtin_amdgcn_readfirstlane(c.tid >> 6);
    c.G = gridDim.x; { const int bx = blockIdx.x; c.vcu = (c.G % 8 == 0) ? (bx % 8) * (c.G / 8) + bx / 8 : bx; }
    c.gw = c.vcu * 8 + c.wave; c.NGW = c.G * 8;
    volatile LAS unsigned* MISC = (volatile LAS unsigned*)(c.lds + MISC_OFF);
    if (c.tid < 64) MISC[c.tid] = 0u;
    __syncthreads();
    unsigned* ctl = (unsigned*)(p.ws + WS_CTL);
    XcdBarrier bar; bar.bar = ctl + CW_BAR; bar.x = 0; bar.st = nullptr;
    const bool multi = (p.ph_hi - p.ph_lo) > 1;
    if (multi) bar = xcd_barrier_post(ctl + CW_BAR, MISC + 8);
    const int lo = p.ph_lo, hi = p.ph_hi;
    if (IN(0)) { BODY(0, true, ph_prologue(p, c);); }
    SEAM(0);
    run_layer<0>(p, c, bar, lo, hi);
    run_layer<1>(p, c, bar, lo, hi);
    if (IN(21)) ph_norm1<2>(p, c);
#undef IN
#undef SEAM
}

extern "C" void kernel_launch(void* const* d_in, const int* in_sizes, int n_in, void* d_out, int out_size, void* d_ws, size_t ws_size, hipStream_t stream) {
    static int grid = 0;
    if (grid == 0) {
        if (n_in != 27 || out_size != T * D || ws_size < WS_END) { fprintf(stderr, "kernel_launch: unexpected shapes (n_in %d out %d ws %zu, need %zu)\n", n_in, out_size, ws_size, (size_t)WS_END); grid = -1; return; }
        int dev = 0, cus = 0, per_cu = 0;
        if (hipGetDevice(&dev) != hipSuccess || hipDeviceGetAttribute(&cus, hipDeviceAttributeMultiprocessorCount, dev) != hipSuccess) { grid = -1; return; }
        if (hipFuncSetAttribute((const void*)fwd, hipFuncAttributeMaxDynamicSharedMemorySize, LDS_BYTES) != hipSuccess) { fprintf(stderr, "kernel_launch: hipFuncSetAttribute failed\n"); grid = -1; return; }
        if (hipOccupancyMaxActiveBlocksPerMultiprocessor(&per_cu, (const void*)fwd, 512, LDS_BYTES) != hipSuccess || per_cu < 1) { fprintf(stderr, "kernel_launch: occupancy query says %d blocks per CU\n", per_cu); grid = -1; return; }
        (void)hipGetLastError();
        grid = cus;
        if (grid % 8 != 0 || grid > 256) grid = (grid / 8) * 8 > 256 ? 256 : (grid / 8) * 8;
    }
    if (grid <= 0) return;
    (void)hipMemsetAsync((char*)d_ws + WS_CTL, 0, CTL_ZERO_BYTES, stream);
    Params p{};
    for (int i = 0; i < 27; ++i) p.in[i] = (const float*)d_in[i];
    p.out = (float*)d_out; p.ws = (unsigned char*)d_ws;
#if MK_SPLIT
    for (int ph = 0; ph < NPHASE; ++ph) { p.ph_lo = ph; p.ph_hi = ph + 1; hipLaunchKernelGGL(fwd, dim3(grid), dim3(512), LDS_BYTES, stream, p); }
#else
    p.ph_lo = 0; p.ph_hi = NPHASE;
    hipLaunchKernelGGL(fwd, dim3(grid), dim3(512), LDS_BYTES, stream, p);
#endif
}
```

```cpp
#include <hip/hip_runtime.h>
#include <cstdio>
#include <cstdint>

#ifndef MK_SPLIT
#define MK_SPLIT 0
#endif

#define LAS __attribute__((address_space(3)))
typedef unsigned short bf16_t;
typedef short bf16x8 __attribute__((ext_vector_type(8)));
typedef short bf16x4 __attribute__((ext_vector_type(4)));
typedef float f32x4 __attribute__((ext_vector_type(4)));
typedef float f32x16 __attribute__((ext_vector_type(16)));
typedef unsigned u32x4 __attribute__((ext_vector_type(4)));
typedef unsigned u32x2 __attribute__((ext_vector_type(2)));

constexpr int D = 1024, NB = 16, S = 2048, T = NB * S, DEPTH = 2;
constexpr int NZ = 1792;
constexpr int N_IN = 1736;
constexpr int Z_AVAL = 0, Z_AGATE = 256, Z_CQ = 512, Z_CKV = 768, Z_QI = 896, Z_KI = 1408, Z_WI = 1472, Z_UP = 1480;
constexpr int KMIX = 1536;
constexpr int NEXP = 32, DEXP = 512, MAXTILES = 288, PMAX = MAXTILES * 256;
constexpr float EPS = 1e-6f;
constexpr int SC_PER_B = 4096 * 528;

constexpr size_t MiB = 1u << 20;
constexpr size_t WS_CTL = 0, CTL_ZERO_BYTES = 64 * 1024;
constexpr size_t WS_MOD = 1 * MiB;
constexpr size_t WS_WIN = 2 * MiB;
constexpr size_t WS_WQA = 9 * MiB;
constexpr size_t WS_WMIX = 10 * MiB;
constexpr size_t WS_SMALL = 16 * MiB;
constexpr size_t WS_W13 = 20 * MiB;
constexpr size_t WS_W2 = 84 * MiB;
constexpr size_t WS_Z = 116 * MiB;
constexpr size_t WS_X16 = 228 * MiB;
constexpr size_t WS_H = 324 * MiB;
constexpr size_t WS_CQR = 388 * MiB;
constexpr size_t WS_KVN = 404 * MiB;
constexpr size_t WS_Y = 412 * MiB;
constexpr size_t WS_END = 556 * MiB;
constexpr size_t SM_TOKE = 0;
constexpr size_t SM_TOKG = 256 * 1024;
constexpr size_t SM_RANK = 512 * 1024;
constexpr size_t SM_TSLOT = 768 * 1024;
constexpr size_t SM_STOK = 1024 * 1024;
constexpr size_t SM_SGATE = 1024 * 1024 + 512 * 1024;
constexpr size_t SM_CNT = 2 * 1024 * 1024;
constexpr size_t SM_TEXP = 2 * 1024 * 1024 + 64 * 1024;
constexpr size_t SM_REW2 = 2 * 1024 * 1024 + 512 * 1024;
constexpr size_t SM_RGW2 = 3 * 1024 * 1024;
constexpr int CW_BAR = 1024;

constexpr int LDS_BYTES = 155648;
constexpr int LIST_OFF = 131072;
constexpr int MISC_OFF = 154624;
constexpr int MOE_TAB_OFF = 131072;
constexpr int RT_RG_OFF = 131072, RT_LE_OFF = 147456;
constexpr int NPHASE = 22;

__device__ __forceinline__ unsigned cvt_pk_bf16(float lo, float hi) { unsigned r; asm volatile("v_cvt_pk_bf16_f32 %0, %1, %2" : "=v"(r) : "v"(lo), "v"(hi)); return r; }
__device__ __forceinline__ float bf2f(unsigned short b) { return __uint_as_float(((unsigned)b) << 16); }
__device__ __forceinline__ float bflo(unsigned w) { return __uint_as_float(w << 16); }
__device__ __forceinline__ float bfhi(unsigned w) { return __uint_as_float(w & 0xffff0000u); }
template <int W> __device__ __forceinline__ int lane_xor_i(int iv) {
    int r;
    if constexpr (W == 1) r = __builtin_amdgcn_mov_dpp(iv, 0xB1, 0xF, 0xF, true);
    else if constexpr (W == 2) r = __builtin_amdgcn_mov_dpp(iv, 0x4E, 0xF, 0xF, true);
    else if constexpr (W == 4) { r = __builtin_amdgcn_update_dpp(iv, iv, 0x104, 0xF, 0x5, false);
                                 r = __builtin_amdgcn_update_dpp(r, iv, 0x114, 0xF, 0xA, false); }
    else if constexpr (W == 8) r = __builtin_amdgcn_mov_dpp(iv, 0x128, 0xF, 0xF, true);
    else if constexpr (W == 16) { const auto p = __builtin_amdgcn_permlane16_swap((unsigned)iv, (unsigned)iv, false, false); r = (threadIdx.x & 16) ? (int)p[0] : (int)p[1]; }
    else { const auto p = __builtin_amdgcn_permlane32_swap((unsigned)iv, (unsigned)iv, false, false); r = (threadIdx.x & 32) ? (int)p[0] : (int)p[1]; }
    return r;
}
template <int W> __device__ __forceinline__ float lane_xor(float v) { return __builtin_bit_cast(float, lane_xor_i<W>(__builtin_bit_cast(int, v))); }
template <int W> __device__ __forceinline__ unsigned lane_xor(unsigned v) { return (unsigned)lane_xor_i<W>((int)v); }
__device__ __forceinline__ float wave_sum(float v) {
    v += lane_xor<1>(v); v += lane_xor<2>(v); v += lane_xor<4>(v); v += lane_xor<8>(v); v += lane_xor<16>(v); v += lane_xor<32>(v);
    return v;
}
__device__ __forceinline__ float sigmoidf_(float x) { return 1.0f / (1.0f + __expf(-x)); }
#define LDS_WAIT() asm volatile("s_waitcnt lgkmcnt(0)" ::: "memory")
#define VM_WAIT() asm volatile("s_waitcnt vmcnt(0)" ::: "memory")

#define XB_TMO      128
#define XB_XCNT(j)  (256  + 64 * (j))
#define XB_XSUB(j)  (1280 + 64 * (j))
#define XB_XGEN(j)  (2304 + 64 * (j))
#define XB_TOP      3328
#define XB_TOPGEN   3392
#define XCD_BAR_WORDS 3456
#define XB_SPIN_CAP (1u << 22)

__device__ __forceinline__ unsigned xb_ld(unsigned* p)              { return __hip_atomic_load(p, __ATOMIC_RELAXED, __HIP_MEMORY_SCOPE_AGENT); }
__device__ __forceinline__ unsigned xb_add(unsigned* p, unsigned v) { return __hip_atomic_fetch_add(p, v, __ATOMIC_RELAXED, __HIP_MEMORY_SCOPE_AGENT); }
__device__ __forceinline__ unsigned xb_xcc_id() { return (unsigned)__builtin_amdgcn_s_getreg((3 << 11) | 20) & 0xFu; }
#define XB_SPIN(cond, bar) do { unsigned _sp = 0; while (cond) { __builtin_amdgcn_s_sleep(1); \
    if ((++_sp & 255u) == 0u) { if (xb_ld(&(bar)[XB_TMO])) break; if (_sp > XB_SPIN_CAP) { atomicAdd(&(bar)[XB_TMO], 1u); break; } } } } while (0)

struct XcdBarrier {
    unsigned* bar; unsigned x;
    volatile LAS unsigned* st;
};
__device__ __forceinline__ XcdBarrier xcd_barrier_post(unsigned* bar, volatile LAS unsigned* st) {
    XcdBarrier b; b.bar = bar; b.x = xb_xcc_id(); b.st = st;
    if (threadIdx.x == 0) (void)xb_add(&bar[XB_XCNT(b.x)], 1u);
    return b;
}
__device__ __forceinline__ void xcd_barrier_complete(unsigned* bar, unsigned x, unsigned& nloc, unsigned& nx) {
    const unsigned G = gridDim.x * gridDim.y * gridDim.z;
    unsigned sum, cnt, mine, sp = 0u;
    for (;;) {
        sum = 0u; cnt = 0u; mine = 0u;
#pragma unroll
        for (unsigned j = 0; j < 16; ++j) { const unsigned c = xb_ld(&bar[XB_XCNT(j)]); sum += c; cnt += (c > 0u) ? 1u : 0u; mine = (j == x) ? c : mine; }
        if (sum == G) break;
        __builtin_amdgcn_s_sleep(1);
        if ((++sp & 255u) == 0u) { if (xb_ld(&bar[XB_TMO])) break; if (sp > XB_SPIN_CAP) { atomicAdd(&bar[XB_TMO], 1u); break; } }
    }
    nloc = mine > 0u ? mine : 1u; nx = cnt > 0u ? cnt : 1u;
}
__device__ __forceinline__ void xcd_barrier(const XcdBarrier& b) {
    asm volatile("s_waitcnt vmcnt(0)" ::: "memory");
    __syncthreads();
    if (threadIdx.x == 0) {
        unsigned* bar = b.bar;
        __builtin_amdgcn_s_waitcnt(0);
        unsigned nloc = b.st[0], nx = b.st[1];
        if (nloc == 0u) { xcd_barrier_complete(bar, b.x, nloc, nx); b.st[0] = nloc; b.st[1] = nx; }
        const unsigned old = xb_add(&bar[XB_XSUB(b.x)], 1u);
        const unsigned gen = old / nloc;
        if (old + 1u == (gen + 1u) * nloc) {
            __builtin_amdgcn_fence(__ATOMIC_RELEASE, "agent");
            asm volatile("s_waitcnt vmcnt(0)" ::: "memory");
            const unsigned og = xb_add(&bar[XB_TOP], 1u);
            const unsigned tg = og / nx;
            if (og + 1u == (tg + 1u) * nx) xb_add(&bar[XB_TOPGEN], 1u);
            else XB_SPIN(xb_ld(&bar[XB_TOPGEN]) == tg, bar);
            __builtin_amdgcn_fence(__ATOMIC_ACQUIRE, "agent");
            xb_add(&bar[XB_XGEN(b.x)], 1u);
            asm volatile("s_waitcnt vmcnt(0)" ::: "memory");
        } else {
            XB_SPIN(xb_ld(&bar[XB_XGEN(b.x)]) == gen, bar);
            __builtin_amdgcn_fence(__ATOMIC_ACQUIRE, "agent");
            asm volatile("s_waitcnt vmcnt(0)" ::: "memory");
        }
    }
    __syncthreads();
}

namespace pg8 {
constexpr int BM = 256, BK = 64, HALF = 128, HTB = HALF * BK * 2  , STAGE_BYTES = 8 * HTB, NXCD = 8, WGM = 8;
__host__ __device__ __forceinline__ int lds_byte(int r, int c) { const int st = (r >> 4) * 2 + (c >> 5), rr = r & 15, cc = c & 31, ob = rr * 64 + cc * 2; return st * 1024 + (ob ^ (((ob >> 9) & 1) << 5)); }
__host__ __device__ __forceinline__ void stage_rc(int b, int& R, int& C) { const int st = b / 1024, sb = b % 1024, swz = sb ^ (((sb >> 9) & 1) << 5); R = (st >> 1) * 16 + swz / 64; C = (st & 1) * 32 + (swz % 64) / 2; }
__host__ __device__ __forceinline__ int perm32(int rho) { const int n = rho >> 4, i = rho & 15; return 8 * (i >> 2) + 4 * n + (i & 3); }

struct Unit { int pm, pn; const char* a; const char* b; };

struct StaticOrder {
    const char* A; const char* Bt; int K;
    int nM, nN, nwg, G, c;
    __device__ void init(const void* A_, const void* Bt_, int M, int N, int K_, int G_, int c_) { A = (const char*)A_; Bt = (const char*)Bt_; K = K_; nM = M / BM; nN = N / BM; nwg = nM * nN; G = G_; c = c_; }
    __device__ __forceinline__ bool next(int i, Unit& u) const {
        const long L = (long)i * G + c; if (L >= nwg) return false;
        int wgid = (int)L; { const int q = nwg / NXCD, r = nwg % NXCD, xcd = wgid % NXCD, off = wgid / NXCD; wgid = (xcd < r ? xcd * (q + 1) : r * (q + 1) + (xcd - r) * q) + off; }
        const int nig = WGM * nN, gid = wgid / nig, fm = gid * WGM, gsz = (nM - fm) < WGM ? (nM - fm) : WGM;
        u.pm = fm + ((wgid % nig) % gsz); u.pn = (wgid % nig) / gsz;
        u.a = A + (size_t)u.pm * BM * K * 2; u.b = Bt + (size_t)u.pn * BM * K * 2; return true;
    }
    __device__ __forceinline__ int row(int, int) const { return 0; }
};
struct MoeOrder {
    const char* A; const char* Bt; int K; const LAS int* rowtab;
    const LAS int* etab; int nunits, G, c; size_t bstride;
    static constexpr int MAXU = 6;
    __device__ __forceinline__ void init(const void* A_, const void* Bt_, int K_, size_t bstride_, const int* rowidx, const int* tile_exp, int ntiles, int G_, int c_, LAS int* lds_tab) {
        A = (const char*)A_; Bt = (const char*)Bt_; K = K_; bstride = bstride_; nunits = ntiles * 4; G = G_; c = c_;
        LAS int* rt = lds_tab; LAS int* et = lds_tab + MAXU * 256;
        for (int i = 0; i < MAXU; ++i) { const int L = i * G + c; if (L >= nunits) break; const int tile = L >> 2;
            if (rowidx && threadIdx.x < 256) rt[i * 256 + threadIdx.x] = rowidx[tile * 256 + threadIdx.x];
            if (threadIdx.x == 0) et[i] = tile_exp[tile]; }
        rowtab = rowidx ? rt : nullptr; etab = et;
        __syncthreads();
    }
    __device__ __forceinline__ bool next(int i, Unit& u) const {
        const int L = i * G + c; if (L >= nunits || i >= MAXU) return false;
        u.pm = L >> 2; u.pn = L & 3; const int e = __builtin_amdgcn_readfirstlane(etab[i]);
        u.a = A + (size_t)u.pm * BM * K * 2; u.b = Bt + (size_t)e * bstride + (size_t)u.pn * BM * K * 2; return true;
    }
    __device__ __forceinline__ int row(int i, int r) const { return rowtab[i * 256 + r]; }
};
struct NoGather { };
struct EpiBf16 {
    static constexpr bool PERM = true;
    bf16_t* O; int ldc;
    __device__ __forceinline__ void operator()(const f32x4 (&acc)[2][2][4][2], const Unit& u, int wr, int wc, int fr, int fq) const {
        const int row0 = u.pm * BM + wr * 64 + fr, col0 = u.pn * BM + wc * 32 + 8 * fq;
#pragma unroll
        for (int ai = 0; ai < 2; ++ai)
#pragma unroll
            for (int m = 0; m < 4; ++m) { bf16_t* rowp = O + (size_t)(row0 + ai * HALF + m * 16) * ldc + col0;
#pragma unroll
                for (int bj = 0; bj < 2; ++bj) { const f32x4 v0 = acc[ai][bj][m][0], v1 = acc[ai][bj][m][1];
                    u32x4 w; w.x = cvt_pk_bf16(v0[0], v0[1]); w.y = cvt_pk_bf16(v0[2], v0[3]); w.z = cvt_pk_bf16(v1[0], v1[1]); w.w = cvt_pk_bf16(v1[2], v1[3]);
                    *(u32x4*)(rowp + bj * HALF) = w; } }
    }
};
struct EpiMix {
    static constexpr bool PERM = true;
    const float* xin32; bf16_t* x16; const float* gate;
    __device__ __forceinline__ void operator()(const f32x4 (&acc)[2][2][4][2], const Unit& u, int wr, int wc, int fr, int fq) const {
        const int row0 = u.pm * BM + wr * 64 + fr, col0 = u.pn * BM + wc * 32 + 8 * fq;
        const float* gp = gate + (size_t)(u.pm >> 3) * 6144 + col0;
        f32x4 gv[2][2];
#pragma unroll
        for (int bj = 0; bj < 2; ++bj)
#pragma unroll
            for (int n = 0; n < 2; ++n) gv[bj][n] = *(const f32x4*)(gp + bj * HALF + 4 * n);
#pragma unroll
        for (int ai = 0; ai < 2; ++ai)
#pragma unroll
            for (int m = 0; m < 4; ++m) { const size_t off = (size_t)(row0 + ai * HALF + m * 16) * D + col0;
#pragma unroll
                for (int bj = 0; bj < 2; ++bj) { f32x4 x0, x1;
                    if (xin32) { x0 = *(const f32x4*)(xin32 + off + bj * HALF); x1 = *(const f32x4*)(xin32 + off + bj * HALF + 4); }
                    else { const u32x4 xv = *(const u32x4*)(x16 + off + bj * HALF); x0 = (f32x4){bflo(xv.x), bfhi(xv.x), bflo(xv.y), bfhi(xv.y)}; x1 = (f32x4){bflo(xv.z), bfhi(xv.z), bflo(xv.w), bfhi(xv.w)}; }
                    const f32x4 v0 = x0 + gv[bj][0] * acc[ai][bj][m][0], v1 = x1 + gv[bj][1] * acc[ai][bj][m][1];
                    u32x4 w; w.x = cvt_pk_bf16(v0[0], v0[1]); w.y = cvt_pk_bf16(v0[2], v0[3]); w.z = cvt_pk_bf16(v1[0], v1[1]); w.w = cvt_pk_bf16(v1[2], v1[3]);
                    *(u32x4*)(x16 + off + bj * HALF) = w; } }
    }
};
struct EpiAct {
    static constexpr bool PERM = true;
    bf16_t* O;
    __device__ __forceinline__ void operator()(const f32x4 (&acc)[2][2][4][2], const Unit& u, int wr, int wc, int fr, int fq) const {
        const int row0 = u.pm * BM + wr * 64 + fr, col0 = u.pn * 128 + wc * 16 + 4 * fq;
#pragma unroll
        for (int ai = 0; ai < 2; ++ai)
#pragma unroll
            for (int m = 0; m < 4; ++m) { bf16_t* rowp = O + (size_t)(row0 + ai * HALF + m * 16) * DEXP + col0;
#pragma unroll
                for (int bj = 0; bj < 2; ++bj) { const f32x4 a = acc[ai][bj][m][0], b = acc[ai][bj][m][1]; f32x4 r;
#pragma unroll
                    for (int j = 0; j < 4; ++j) r[j] = a[j] * b[j] * __builtin_amdgcn_rcpf(1.0f + __expf(-a[j]));
                    u32x2 w; w.x = cvt_pk_bf16(r[0], r[1]); w.y = cvt_pk_bf16(r[2], r[3]);
                    *(u32x2*)(rowp + bj * 64) = w; } }
    }
};
struct EpiY {
    static constexpr bool PERM = true;
    bf16_t* O; const float* sgate;
    __device__ __forceinline__ void operator()(const f32x4 (&acc)[2][2][4][2], const Unit& u, int wr, int wc, int fr, int fq) const {
        const int row0 = u.pm * BM + wr * 64 + fr, col0 = u.pn * BM + wc * 32 + 8 * fq;
#pragma unroll
        for (int ai = 0; ai < 2; ++ai)
#pragma unroll
            for (int m = 0; m < 4; ++m) { const int row = row0 + ai * HALF + m * 16; const float g = sgate[row]; bf16_t* rowp = O + (size_t)row * D + col0;
#pragma unroll
                for (int bj = 0; bj < 2; ++bj) { const f32x4 v0 = acc[ai][bj][m][0] * g, v1 = acc[ai][bj][m][1] * g;
                    u32x4 w; w.x = cvt_pk_bf16(v0[0], v0[1]); w.y = cvt_pk_bf16(v0[2], v0[3]); w.z = cvt_pk_bf16(v1[0], v1[1]); w.w = cvt_pk_bf16(v1[2], v1[3]);
                    *(u32x4*)(rowp + bj * HALF) = w; } }
    }
};

template <class Epi, class Sched, bool GATHER>
__device__ __forceinline__ void gemm_phase(LAS unsigned char* lds, const Sched& S, const Epi& E) {
    const int tid = threadIdx.x, wid = __builtin_amdgcn_readfirstlane(tid >> 6), lane = tid & 63, wr = wid >> 2, wc = wid & 3, fr = lane & 15, fq = lane >> 4;
    const int K = S.K, nt = K / BK;
    unsigned voffA[2], voffB[2]; int RA[2], CA[2];
#pragma unroll
    for (int i = 0; i < 2; ++i) { int R, C; stage_rc(tid * 16 + i * 8192, R, C); const int Rb = Epi::PERM ? ((R & ~31) + perm32(R & 31)) : R;
        RA[i] = R; CA[i] = C; voffA[i] = (unsigned)(R * K + C) * 2u; voffB[i] = (unsigned)(Rb * K + C) * 2u; }
    const size_t kstep = (size_t)(BK * 2);
    const size_t hstep = (size_t)HALF * K * 2;
    const unsigned ldsw = (unsigned)wid * 1024u;
    const int aoff = lds_byte(wr * 64 + fr, fq * 8), boff = lds_byte(wc * 32 + fr, fq * 8);
#define PG8_SA(b, h) (((b) * 2 + (h)) * HTB)
#define PG8_SB(b, h) ((4 + (b) * 2 + (h)) * HTB)
#define PG8_DMA(bufoff, gptr, i) __builtin_amdgcn_global_load_lds((const unsigned*)(gptr), (LAS unsigned*)(lds + (bufoff) + ldsw + (i) * 8192), 16, 0, 0)
#define PG8_STAGE(bufoff, gbase, voff) do { PG8_DMA(bufoff, (const char*)(gbase) + (voff)[0], 0); PG8_DMA(bufoff, (const char*)(gbase) + (voff)[1], 1); } while (0)
#define PG8_STAGE_A(bufoff, nx, h, kb) do { if constexpr (GATHER) { \
            PG8_DMA(bufoff, S.A + (kb) + ((nx) ? gN[h][0] : gC[h][0]), 0); PG8_DMA(bufoff, S.A + (kb) + ((nx) ? gN[h][1] : gC[h][1]), 1); } \
        else { const char* _b = ((nx) ? nA : cA) + (h) * hstep + (kb); PG8_DMA(bufoff, _b + voffA[0], 0); PG8_DMA(bufoff, _b + voffA[1], 1); } } while (0)
#define PG8_LDA(dst, b, h) do { _Pragma("unroll") for (int m = 0; m < 4; ++m) _Pragma("unroll") for (int k = 0; k < 2; ++k) dst[m][k] = *(const LAS bf16x8*)(lds + PG8_SA(b, h) + aoff + m * 2048 + k * 1024); } while (0)
#define PG8_LDB(dst, b, h) do { _Pragma("unroll") for (int n = 0; n < 2; ++n) _Pragma("unroll") for (int k = 0; k < 2; ++k) dst[n][k] = *(const LAS bf16x8*)(lds + PG8_SB(b, h) + boff + n * 2048 + k * 1024); } while (0)
#define PG8_MMA(ai, bj, At, Bt) do { __builtin_amdgcn_s_setprio(1); _Pragma("unroll") for (int m = 0; m < 4; ++m) _Pragma("unroll") for (int n = 0; n < 2; ++n) _Pragma("unroll") for (int k = 0; k < 2; ++k) \
        acc[ai][bj][m][n] = __builtin_amdgcn_mfma_f32_16x16x32_bf16(Bt[n][k], At[m][k], acc[ai][bj][m][n], 0, 0, 0); __builtin_amdgcn_s_setprio(0); } while (0)
#define PG8_WAIT_V(n) asm volatile("s_waitcnt vmcnt(" #n ")" ::: "memory")
#define PG8_WAIT_L(n) asm volatile("s_waitcnt lgkmcnt(" #n ")" ::: "memory")
#define PG8_BAR __builtin_amdgcn_s_barrier()
#define PG8_SCHED __builtin_amdgcn_sched_barrier(0)
    Unit cur, nxt; int ui = 0;
    if (!S.next(0, cur)) return;
    unsigned gC[2][2] = {{0u, 0u}, {0u, 0u}}, gN[2][2] = {{0u, 0u}, {0u, 0u}};
    if constexpr (GATHER) {
#pragma unroll
        for (int h = 0; h < 2; ++h)
#pragma unroll
            for (int i = 0; i < 2; ++i) gC[h][i] = (unsigned)(S.row(0, h * HALF + RA[i]) * K + CA[i]) * 2u;
    }
    f32x4 acc[2][2][4][2];
#pragma unroll
    for (int a = 0; a < 2; ++a)
#pragma unroll
        for (int b = 0; b < 2; ++b)
#pragma unroll
            for (int m = 0; m < 4; ++m)
#pragma unroll
                for (int n = 0; n < 2; ++n) acc[a][b][m][n] = (f32x4){0.f, 0.f, 0.f, 0.f};
    bf16x8 At[4][2], B0[2][2], B1[2][2];
    const char* cA = cur.a; const char* cB = cur.b; const char* nA = cA; const char* nB = cB;
    PG8_STAGE(PG8_SB(0, 0), cB, voffB); PG8_STAGE(PG8_SB(0, 1), cB + hstep, voffB); PG8_STAGE_A(PG8_SA(0, 0), false, 0, 0); PG8_STAGE_A(PG8_SA(0, 1), false, 1, 0);
    if (wr == 1) PG8_BAR;
    PG8_WAIT_V(2); PG8_BAR;
    PG8_STAGE(PG8_SB(1, 0), cB + kstep, voffB); PG8_STAGE_A(PG8_SA(1, 0), false, 0, kstep); PG8_STAGE(PG8_SB(1, 1), cB + hstep + kstep, voffB);
    PG8_WAIT_V(6); PG8_BAR;
    for (;;) {
        const bool has_next = S.next(ui + 1, nxt);
        nA = has_next ? nxt.a : cA; nB = has_next ? nxt.b : cB;
        if constexpr (GATHER) {
            const int nord = has_next ? ui + 1 : ui;
#pragma unroll
            for (int h = 0; h < 2; ++h)
#pragma unroll
                for (int i = 0; i < 2; ++i) gN[h][i] = (unsigned)(S.row(nord, h * HALF + RA[i]) * K + CA[i]) * 2u;
        }
        for (int t = 0; t < nt; t += 2) {
            const bool last = (t == nt - 2);
            const size_t k1 = (size_t)(t + 1) * kstep;
            const size_t k2 = last ? 0 : (size_t)(t + 2) * kstep, k3 = k2 + kstep;
            const char* b2 = (last ? nB : cB) + k2; const char* b3 = b2 + kstep;
            PG8_LDB(B0, 0, 0); PG8_LDB(B1, 0, 1); PG8_SCHED; PG8_LDA(At, 0, 0); PG8_STAGE_A(PG8_SA(1, 1), false, 1, k1);
            PG8_WAIT_V(8); PG8_WAIT_L(0); PG8_BAR; PG8_MMA(0, 0, At, B0); PG8_MMA(0, 1, At, B1); PG8_BAR; PG8_SCHED;
            PG8_LDA(At, 0, 1); PG8_STAGE(PG8_SB(0, 0), b2, voffB); PG8_STAGE(PG8_SB(0, 1), b2 + hstep, voffB); PG8_STAGE_A(PG8_SA(0, 0), last, 0, k2);
            PG8_WAIT_V(8); PG8_WAIT_L(0); PG8_BAR; PG8_MMA(1, 0, At, B0); PG8_MMA(1, 1, At, B1); PG8_BAR; PG8_SCHED;
            PG8_LDB(B0, 1, 0); PG8_LDB(B1, 1, 1); PG8_SCHED; PG8_LDA(At, 1, 0); PG8_STAGE_A(PG8_SA(0, 1), last, 1, k2);
            PG8_WAIT_V(8); PG8_WAIT_L(0); PG8_BAR; PG8_MMA(0, 0, At, B0); PG8_MMA(0, 1, At, B1); PG8_BAR; PG8_SCHED;
            PG8_LDA(At, 1, 1); PG8_STAGE(PG8_SB(1, 0), b3, voffB); PG8_STAGE(PG8_SB(1, 1), b3 + hstep, voffB); PG8_STAGE_A(PG8_SA(1, 0), last, 0, k3);
            PG8_WAIT_V(8); PG8_WAIT_L(0); PG8_BAR; PG8_MMA(1, 0, At, B0); PG8_MMA(1, 1, At, B1); PG8_BAR; PG8_SCHED;
        }
        if (wr == 0) PG8_BAR;
        E(acc, cur, wr, wc, fr, fq);
        if (!has_next) break;
#pragma unroll
        for (int a = 0; a < 2; ++a)
#pragma unroll
            for (int b = 0; b < 2; ++b)
#pragma unroll
                for (int m = 0; m < 4; ++m)
#pragma unroll
                    for (int n = 0; n < 2; ++n) acc[a][b][m][n] = (f32x4){0.f, 0.f, 0.f, 0.f};
        cur = nxt; cA = nA; cB = nB; ++ui;
        if constexpr (GATHER) {
#pragma unroll
            for (int h = 0; h < 2; ++h)
#pragma unroll
                for (int i = 0; i < 2; ++i) gC[h][i] = gN[h][i];
        }
        if (wr == 1) PG8_BAR;
    }
    PG8_WAIT_V(0);
    PG8_BAR;
#undef PG8_SA
#undef PG8_SB
#undef PG8_DMA
#undef PG8_STAGE
#undef PG8_STAGE_A
#undef PG8_LDA
#undef PG8_LDB
#undef PG8_MMA
#undef PG8_WAIT_V
#undef PG8_WAIT_L
#undef PG8_BAR
#undef PG8_SCHED
}
}

struct Params { const float* in[27]; float* out; unsigned char* ws; int ph_lo, ph_hi; };
struct Ctx { LAS unsigned char* lds; int tid, lane, wave, vcu, G, gw, NGW; };
enum { I_X = 0, I_C, I_MODW, I_MODB, I_N1G, I_WIN, I_CONVK, I_CONVB, I_CLNG, I_CLNB, I_QNG, I_KVNG, I_WUQ, I_WUK, I_WUV, I_POOLW, I_POOLS, I_WOUT, I_N2G, I_RGW, I_RGB, I_REW, I_REB, I_W1, I_W3, I_W2, I_FG };

template <class RowMap>
__device__ __forceinline__ void tr_item(const float* src, int ldn, int k0, int n0, int nvalid, bf16_t* dst, int ldk, int dk0, RowMap rm, LAS float* scr, int lane) {
#pragma unroll 8
    for (int i = 0; i < 32; ++i) { const int kk = 2 * i + (lane >> 5), n = n0 + (lane & 31); scr[kk * 33 + (lane & 31)] = (n < nvalid) ? src[(size_t)(k0 + kk) * ldn + n] : 0.f; }
    LDS_WAIT();
    const int c = lane & 7;
#pragma unroll
    for (int j = 0; j < 4; ++j) { const int n = (lane >> 3) + 8 * j; const LAS float* s = scr + (8 * c) * 33 + n;
        u32x4 o; o.x = cvt_pk_bf16(s[0 * 33], s[1 * 33]); o.y = cvt_pk_bf16(s[2 * 33], s[3 * 33]); o.z = cvt_pk_bf16(s[4 * 33], s[5 * 33]); o.w = cvt_pk_bf16(s[6 * 33], s[7 * 33]);
        *(u32x4*)(dst + (size_t)rm(n0 + n) * ldk + dk0 + k0 + 8 * c) = o; }
    LDS_WAIT();
}

__device__ __forceinline__ void conv_experts(const Params& p, const Ctx& c, int l) {
    LAS float* scr = (LAS float*)(c.lds + c.wave * 8448);
    bf16_t* W13 = (bf16_t*)(p.ws + WS_W13); bf16_t* W2 = (bf16_t*)(p.ws + WS_W2);
    for (int it = c.gw; it < 3 * 8192; it += c.NGW) {
        const int which = it >> 13, r = it & 8191, e = r >> 8;
        if (which < 2) { const int kb = (r >> 4) & 15, nb = r & 15; const float* src = p.in[which ? I_W3 : I_W1] + (size_t)(l * NEXP + e) * 1024 * 512; const int add = which ? 4 : 0;
            tr_item(src, 512, 64 * kb, 32 * nb, 512, W13 + (size_t)e * 1024 * 1024, 1024, 0, [add](int n) { return 8 * (n >> 2) + (n & 3) + add; }, scr, c.lane); }
        else { const int kb = (r >> 5) & 7, nb = r & 31; const float* src = p.in[I_W2] + (size_t)(l * NEXP + e) * 512 * 1024;
            tr_item(src, 1024, 64 * kb, 32 * nb, 1024, W2 + (size_t)e * 1024 * 512, 512, 0, [](int n) { return n; }, scr, c.lane); }
    }
}

__device__ __forceinline__ void cx_issue(const Params& p, int l, int it, int lane, float (&tv)[32]) {
    const int which = it >> 13, r = it & 8191, e = r >> 8;
    const float* src; int ldn, k0, n0;
    if (which < 2) { const int kb = (r >> 4) & 15, nb = r & 15; src = p.in[which ? I_W3 : I_W1] + (size_t)(l * NEXP + e) * 1024 * 512; ldn = 512; k0 = 64 * kb; n0 = 32 * nb; }
    else { const int kb = (r >> 5) & 7, nb = r & 31; src = p.in[I_W2] + (size_t)(l * NEXP + e) * 512 * 1024; ldn = 1024; k0 = 64 * kb; n0 = 32 * nb; }
    const float* s0 = src + (size_t)(k0 + (lane >> 5)) * ldn + n0 + (lane & 31);
#pragma unroll
    for (int i = 0; i < 32; ++i) tv[i] = s0[(size_t)(2 * i) * ldn];
}
__device__ __forceinline__ void cx_finish(const Params& p, int it, int lane, const float (&tv)[32], LAS float* scr) {
    const int which = it >> 13, r = it & 8191, e = r >> 8;
    bf16_t* dst; int ldk, k0, n0, add = 0; bool inter = false;
    if (which < 2) { const int kb = (r >> 4) & 15, nb = r & 15; dst = (bf16_t*)(p.ws + WS_W13) + (size_t)e * 1024 * 1024; ldk = 1024; k0 = 64 * kb; n0 = 32 * nb; add = which ? 4 : 0; inter = true; }
    else { const int kb = (r >> 5) & 7, nb = r & 31; dst = (bf16_t*)(p.ws + WS_W2) + (size_t)e * 1024 * 512; ldk = 512; k0 = 64 * kb; n0 = 32 * nb; }
#pragma unroll
    for (int i = 0; i < 32; ++i) scr[(2 * i + (lane >> 5)) * 33 + (lane & 31)] = tv[i];
    LDS_WAIT();
    const int cc = lane & 7;
#pragma unroll
    for (int j = 0; j < 4; ++j) { const int n = (lane >> 3) + 8 * j; const LAS float* sp = scr + (8 * cc) * 33 + n; const int nn = n0 + n; const int row = inter ? (8 * (nn >> 2) + (nn & 3) + add) : nn;
        u32x4 o; o.x = cvt_pk_bf16(sp[0 * 33], sp[1 * 33]); o.y = cvt_pk_bf16(sp[2 * 33], sp[3 * 33]); o.z = cvt_pk_bf16(sp[4 * 33], sp[5 * 33]); o.w = cvt_pk_bf16(sp[6 * 33], sp[7 * 33]);
        *(u32x4*)(dst + (size_t)row * ldk + k0 + 8 * cc) = o; }
    LDS_WAIT();
}

__device__ __forceinline__ void ph_prologue(const Params& p, const Ctx& c) {
    float* mod = (float*)(p.ws + WS_MOD);
    {
        LAS float* cond = (LAS float*)c.lds; LAS float* part = (LAS float*)(c.lds + 65536);
        bool loaded = false;
        for (int item = c.vcu; item < 192; item += c.G) {
            if (!loaded) { for (int i = c.tid; i < NB * D; i += 512) { const float v = p.in[I_C][i]; cond[i] = v / (1.0f + expf(-v)); } __syncthreads(); loaded = true; }
            const int l = item / 96, n0 = (item % 96) * 64;
            const float* W = p.in[I_MODW] + (size_t)l * D * 6144 + n0 + c.lane;
            float acc[NB];
#pragma unroll
            for (int b = 0; b < NB; ++b) acc[b] = 0.f;
#pragma unroll 8
            for (int k = c.wave * 128; k < c.wave * 128 + 128; ++k) { const float w = W[(size_t)k * 6144];
#pragma unroll
                for (int b = 0; b < NB; ++b) acc[b] += cond[b * D + k] * w; }
#pragma unroll
            for (int b = 0; b < NB; ++b) part[(c.wave * NB + b) * 64 + c.lane] = acc[b];
            __syncthreads();
            for (int o = c.tid; o < NB * 64; o += 512) { const int b = o >> 6, ln = o & 63; float s = 0.f;
#pragma unroll
                for (int w = 0; w < 8; ++w) s += part[(w * NB + b) * 64 + ln];
                mod[(size_t)(l * NB + b) * 6144 + n0 + ln] = s + p.in[I_MODB][l * 6144 + n0 + ln]; }
            __syncthreads();
        }
        __syncthreads();
    }
    {
        LAS float* scr = (LAS float*)(c.lds + c.wave * 8448);
        constexpr int I_IN = 16 * 56, I_MX = 4 * 32;
        for (int it = c.gw; it < 2 * (I_IN + 2 * I_MX); it += c.NGW) {
            const int l = it / (I_IN + 2 * I_MX); int r = it % (I_IN + 2 * I_MX);
            if (r < I_IN) { const int kb = r / 56, nb = r % 56;
                tr_item(p.in[I_WIN] + (size_t)l * D * N_IN, N_IN, 64 * kb, 32 * nb, N_IN, (bf16_t*)(p.ws + WS_WIN) + (size_t)l * NZ * D, D, 0, [](int n) { return n; }, scr, c.lane); continue; }
            r -= I_IN; const int part = r / I_MX; r %= I_MX; const int kb = r / 32, nb = r % 32;
            tr_item(p.in[I_WOUT] + (size_t)l * D * D + (size_t)(part ? 768 : 0) * D, D, 64 * kb, 32 * nb, D, (bf16_t*)(p.ws + WS_WMIX) + (size_t)l * D * KMIX, KMIX, part ? 1280 : 0, [](int n) { return n; }, scr, c.lane);
        }
    }
    for (int it = c.gw * 64 + c.lane; it < 2 * 131072; it += c.NGW * 64) {
        const int l = it >> 17, r = it & 131071, n = r & 1023, h = (r >> 10) & 7, cb = r >> 13;
        const float* wo = p.in[I_WOUT] + (size_t)l * D * D + (size_t)(256 + 64 * h) * D + n;
        const float* wv = p.in[I_WUV] + (size_t)l * 128 * 512 + (size_t)(8 * cb) * 512 + h * 64;
        float acc[8];
#pragma unroll
        for (int j = 0; j < 8; ++j) acc[j] = 0.f;
        for (int d0 = 0; d0 < 64; d0 += 16) { float w[16];
#pragma unroll
            for (int q = 0; q < 16; ++q) w[q] = wo[(size_t)(d0 + q) * D];
#pragma unroll
            for (int j = 0; j < 8; ++j) { asm volatile("" ::: "memory");
#pragma unroll
                for (int q = 0; q < 16; q += 4) { const f32x4 v4 = *(const f32x4*)(wv + j * 512 + d0 + q); acc[j] += (v4.x * w[q] + v4.y * w[q + 1]) + (v4.z * w[q + 2] + v4.w * w[q + 3]); } } }
        u32x4 o; o.x = cvt_pk_bf16(acc[0], acc[1]); o.y = cvt_pk_bf16(acc[2], acc[3]); o.z = cvt_pk_bf16(acc[4], acc[5]); o.w = cvt_pk_bf16(acc[6], acc[7]);
        *(u32x4*)((bf16_t*)(p.ws + WS_WMIX) + (size_t)l * D * KMIX + (size_t)n * KMIX + 256 + 128 * h + 8 * cb) = o;
    }
    for (int it = c.gw * 64 + c.lane; it < 2 * 32768; it += c.NGW * 64) {
        const int l = it >> 15, r = it & 32767, cb = r & 31, k = (r >> 5) & 127, h = r >> 12;
        const float* uq = p.in[I_WUQ] + (size_t)l * 256 * 512 + (size_t)(8 * cb) * 512 + h * 64;
        const float* uk = p.in[I_WUK] + (size_t)l * 128 * 512 + (size_t)k * 512 + h * 64;
        float acc[8];
#pragma unroll
        for (int j = 0; j < 8; ++j) acc[j] = 0.f;
        for (int d0 = 0; d0 < 64; d0 += 16) { f32x4 w4[4];
#pragma unroll
            for (int q = 0; q < 4; ++q) w4[q] = *(const f32x4*)(uk + d0 + 4 * q);
#pragma unroll
            for (int j = 0; j < 8; ++j) { asm volatile("" ::: "memory");
#pragma unroll
                for (int q = 0; q < 4; ++q) { const f32x4 v4 = *(const f32x4*)(uq + j * 512 + d0 + 4 * q); acc[j] += (v4.x * w4[q].x + v4.y * w4[q].y) + (v4.z * w4[q].z + v4.w * w4[q].w); } } }
        const float sc = 0.125f * 1.44269504089f;
#pragma unroll
        for (int j = 0; j < 8; ++j) acc[j] *= sc * p.in[I_QNG][l * 256 + 8 * cb + j];
        u32x4 o; o.x = cvt_pk_bf16(acc[0], acc[1]); o.y = cvt_pk_bf16(acc[2], acc[3]); o.z = cvt_pk_bf16(acc[4], acc[5]); o.w = cvt_pk_bf16(acc[6], acc[7]);
        *(u32x4*)((bf16_t*)(p.ws + WS_WQA) + (size_t)l * D * 256 + (size_t)(h * 128 + k) * 256 + 8 * cb) = o;
    }
    for (int it = c.gw * 64 + c.lane; it < 2 * 1024 * 32; it += c.NGW * 64) {
        const int l = it >> 15, r = it & 32767, k = r >> 5, g = (r >> 3) & 3, q = r & 7, e = k & 3, ln = (k >> 2) & 63, j = k >> 8;
        ((float*)(p.ws + WS_SMALL + SM_REW2))[(size_t)(l * 4 + g) * 8192 + (size_t)((((j * 4 + e) * 2 + (q >> 2)) * 64 + ln) * 4) + (q & 3)] = p.in[I_REW][(size_t)l * D * 32 + r];
    }
    for (int it = c.gw * 64 + c.lane; it < 2 * 1024 * 4; it += c.NGW * 64) {
        const int l = it >> 12, r = it & 4095, k = r >> 2, q = r & 3, e = k & 3, ln = (k >> 2) & 63, j = k >> 8;
        ((float*)(p.ws + WS_SMALL + SM_RGW2))[(size_t)l * 4096 + (size_t)(((j * 4 + e) * 64 + ln) * 4) + q] = p.in[I_RGW][(size_t)l * D * 4 + r];
    }
}

template <int MODE>
__device__ __forceinline__ void ph_norm1(const Params& p, const Ctx& c) {
    const float* mod = (const float*)(p.ws + WS_MOD);
    const bf16_t* Y = (const bf16_t*)(p.ws + WS_Y); const int* tslot = (const int*)(p.ws + WS_SMALL + SM_TSLOT);
    bf16_t* H = (bf16_t*)(p.ws + WS_H); bf16_t* X16 = (bf16_t*)(p.ws + WS_X16);
    constexpr int NR = (MODE == 0) ? 4 : 2;
    const int nrow = T / c.NGW;
    f32x4 vn[NR][4]; u32x2 xn[NR][4], an[NR][4], bn[NR][4];
    auto load_rows = [&](int r0) {
#pragma unroll
        for (int t = 0; t < NR; ++t) { const int m = c.gw + (r0 + t) * c.NGW;
            if (MODE == 0) {
#pragma unroll
                for (int j = 0; j < 4; ++j) vn[t][j] = ((const f32x4*)(p.in[I_X] + (size_t)m * D) + c.lane)[64 * j];
            } else { const int s0 = tslot[2 * m], s1 = tslot[2 * m + 1];
#pragma unroll
                for (int j = 0; j < 4; ++j) { xn[t][j] = ((const u32x2*)(X16 + (size_t)m * D) + c.lane)[64 * j]; an[t][j] = ((const u32x2*)(Y + (size_t)s0 * D) + c.lane)[64 * j]; bn[t][j] = ((const u32x2*)(Y + (size_t)s1 * D) + c.lane)[64 * j]; } } } };
    load_rows(0);
    for (int r0 = 0; r0 < nrow; r0 += NR) {
        f32x4 v[NR][4]; u32x2 ya[NR][4], yb[NR][4];
#pragma unroll
        for (int t = 0; t < NR; ++t)
#pragma unroll
            for (int j = 0; j < 4; ++j) { if (MODE == 0) v[t][j] = vn[t][j]; else { v[t][j] = (f32x4){bflo(xn[t][j].x), bfhi(xn[t][j].x), bflo(xn[t][j].y), bfhi(xn[t][j].y)}; ya[t][j] = an[t][j]; yb[t][j] = bn[t][j]; } }
        if (r0 + NR < nrow) load_rows(r0 + NR);
#pragma unroll
        for (int t = 0; t < NR; ++t) {
            const int m = c.gw + (r0 + t) * c.NGW, b = m >> 11;
            if (MODE != 0) {
                const f32x4* g2 = (const f32x4*)(mod + (size_t)((MODE - 1) * NB + b) * 6144 + 5120) + c.lane;
#pragma unroll
                for (int j = 0; j < 4; ++j) { const u32x2 a = ya[t][j], bb = yb[t][j]; const f32x4 g = g2[64 * j];
                    v[t][j].x += g.x * (bflo(a.x) + bflo(bb.x)); v[t][j].y += g.y * (bfhi(a.x) + bfhi(bb.x)); v[t][j].z += g.z * (bflo(a.y) + bflo(bb.y)); v[t][j].w += g.w * (bfhi(a.y) + bfhi(bb.y)); }
            }
            float ss = 0.f;
#pragma unroll
            for (int j = 0; j < 4; ++j) ss += (v[t][j].x * v[t][j].x + v[t][j].y * v[t][j].y) + (v[t][j].z * v[t][j].z + v[t][j].w * v[t][j].w);
            const float r = 1.0f / sqrtf(wave_sum(ss) * (1.0f / D) + EPS);
            if (MODE == 2) {
                const f32x4* fg = (const f32x4*)p.in[I_FG] + c.lane; f32x4* o = (f32x4*)(p.out + (size_t)m * D) + c.lane;
#pragma unroll
                for (int j = 0; j < 4; ++j) o[64 * j] = v[t][j] * r * fg[64 * j];
            } else {
                if (MODE == 1) { u32x2* o = (u32x2*)(X16 + (size_t)m * D) + c.lane;
#pragma unroll
                    for (int j = 0; j < 4; ++j) { u32x2 w; w.x = cvt_pk_bf16(v[t][j].x, v[t][j].y); w.y = cvt_pk_bf16(v[t][j].z, v[t][j].w); o[64 * j] = w; } }
                const int l = MODE;
                const f32x4* ng = (const f32x4*)(p.in[I_N1G] + l * D) + c.lane;
                const f32x4* sh = (const f32x4*)(mod + (size_t)(l * NB + b) * 6144) + c.lane; const f32x4* sc = (const f32x4*)(mod + (size_t)(l * NB + b) * 6144 + 1024) + c.lane;
                u32x2* o8 = (u32x2*)(H + (size_t)m * D) + c.lane;
#pragma unroll
                for (int j = 0; j < 4; ++j) { const f32x4 hv = v[t][j] * r * ng[64 * j] * (sc[64 * j] + 1.0f) + sh[64 * j]; u32x2 w; w.x = cvt_pk_bf16(hv.x, hv.y); w.y = cvt_pk_bf16(hv.z, hv.w); o8[64 * j] = w; }
            }
        }
    }
}

__device__ __forceinline__ void ph_postz(const Params& p, const Ctx& c, int l) {
    const bf16_t* Z = (const bf16_t*)(p.ws + WS_Z); bf16_t* MC = (bf16_t*)p.out;
    bf16_t* CQR = (bf16_t*)(p.ws + WS_CQR); bf16_t* KVN = (bf16_t*)(p.ws + WS_KVN);
    LAS float* U = (LAS float*)c.lds;
    const int lane = c.lane, tk0 = c.wave * 8;
    for (int unit = c.vcu; unit < 512; unit += c.G) {
        const int b = unit >> 5, s0 = (unit & 31) * 64, t0 = b * S + s0;
#pragma unroll
        for (int hb = 0; hb < 2; ++hb) {   u32x2 av[6], gv[6];
#pragma unroll
            for (int q = 0; q < 6; ++q) { const int idx = c.tid + 512 * (6 * hb + q), r = idx >> 6, c4 = idx & 63; int s = s0 - 30 + r; s = s < 0 ? 0 : (s > S - 1 ? S - 1 : s);
                const bf16_t* zr = Z + (size_t)(b * S + s) * NZ + 4 * c4; av[q] = *(const u32x2*)(zr + Z_AVAL); gv[q] = *(const u32x2*)(zr + Z_AGATE); }
#pragma unroll
            for (int q = 0; q < 6; ++q) { const int idx = c.tid + 512 * (6 * hb + q), r = idx >> 6, c4 = idx & 63, s = s0 - 30 + r; f32x4 u = {0.f, 0.f, 0.f, 0.f};
                if (s >= 0) { const u32x2 a = av[q], g = gv[q];
                    u.x = bflo(a.x) * sigmoidf_(bflo(g.x)); u.y = bfhi(a.x) * sigmoidf_(bfhi(g.x)); u.z = bflo(a.y) * sigmoidf_(bflo(g.y)); u.w = bfhi(a.y) * sigmoidf_(bfhi(g.y)); }
                if (idx < 94 * 64) *(LAS f32x4*)(U + r * 256 + 4 * c4) = u; }
            asm volatile("" ::: "memory");
        }
        __syncthreads();
        {
            const f32x4* ck = (const f32x4*)(p.in[I_CONVK] + (size_t)l * 31 * 256) + lane;
            const f32x4 cb = *((const f32x4*)(p.in[I_CONVB] + l * 256) + lane), lg = *((const f32x4*)(p.in[I_CLNG] + l * 256) + lane), lb = *((const f32x4*)(p.in[I_CLNB] + l * 256) + lane);
#pragma unroll 1
            for (int hp = 0; hp < 2; ++hp) {
                const int tq = tk0 + 4 * hp;
                f32x4 acc[4], win[4];
#pragma unroll
                for (int i = 0; i < 4; ++i) { acc[i] = (f32x4){0.f, 0.f, 0.f, 0.f}; win[i] = *(const LAS f32x4*)(U + (tq + i) * 256 + 4 * lane); }
#pragma unroll
                for (int j = 0; j < 31; ++j) { const f32x4 kj = ck[64 * j];
#pragma unroll
                    for (int i = 0; i < 4; ++i) acc[i] += win[i] * kj;
                    if (j < 30) {
#pragma unroll
                        for (int i = 0; i < 3; ++i) win[i] = win[i + 1];
                        win[3] = *(const LAS f32x4*)(U + (tq + 4 + j) * 256 + 4 * lane); } }
#pragma unroll
                for (int i = 0; i < 4; ++i) { const f32x4 v = acc[i] + cb; const float mean = wave_sum((v.x + v.y) + (v.z + v.w)) * (1.0f / 256.0f);
                    const f32x4 d = v - mean; const float var = wave_sum((d.x * d.x + d.y * d.y) + (d.z * d.z + d.w * d.w)) * (1.0f / 256.0f);
                    const float rs = 1.0f / sqrtf(var + EPS); f32x4 y = d * rs * lg + lb;
                    y.x *= sigmoidf_(y.x); y.y *= sigmoidf_(y.y); y.z *= sigmoidf_(y.z); y.w *= sigmoidf_(y.w);
                    u32x2 w; w.x = cvt_pk_bf16(y.x, y.y); w.y = cvt_pk_bf16(y.z, y.w);
                    *(u32x2*)(MC + (size_t)(t0 + tq + i) * KMIX + 4 * lane) = w; }
            }
        }
        __syncthreads();
        {   u32x2 av[10];
#pragma unroll
            for (int q = 0; q < 10; ++q) { const int idx = c.tid + 512 * q, r = idx >> 6, c4 = idx & 63; int s = s0 - 15 + r; s = s < 0 ? 0 : (s > S - 1 ? S - 1 : s);
                av[q] = *(const u32x2*)(Z + (size_t)(b * S + s) * NZ + Z_UP + 4 * c4); }
#pragma unroll
            for (int q = 0; q < 10; ++q) { const int idx = c.tid + 512 * q, r = idx >> 6, c4 = idx & 63, s = s0 - 15 + r; f32x4 u = {0.f, 0.f, 0.f, 0.f};
                if (s >= 0) { const u32x2 a = av[q]; u.x = bflo(a.x); u.y = bfhi(a.x); u.z = bflo(a.y); u.w = bfhi(a.y); }
                if (idx < 79 * 64) *(LAS f32x4*)(U + r * 256 + 4 * c4) = u; }
        }
        __syncthreads();
        f32x4 dv[8];
        {
            const int w = 2 << (lane >> 4);
#pragma unroll
            for (int i = 0; i < 8; ++i) { const int r = 15 + tk0 + i, s = s0 + tk0 + i; f32x4 sum = {0.f, 0.f, 0.f, 0.f};
#pragma unroll
                for (int q = 0; q < 16; ++q) { const f32x4 u = *(const LAS f32x4*)(U + (r - q) * 256 + 4 * lane); if (q < w) sum += u; }
                const float cntf = (float)((s + 1) < w ? (s + 1) : w);
                dv[i] = sum / cntf - *(const LAS f32x4*)(U + r * 256 + 4 * lane); }
        }
        __syncthreads();
        {
            LAS float* Dw = U + c.wave * 2048;
#pragma unroll
            for (int i = 0; i < 8; ++i) *(LAS f32x4*)(Dw + i * 256 + 4 * lane) = dv[i];
            LDS_WAIT();
            const int g = lane >> 4, o4 = (lane & 15) * 4;
            const float* pw = p.in[I_POOLW] + (size_t)(l * 4 + g) * 4096 + o4;
            f32x4 out[8];
#pragma unroll
            for (int i = 0; i < 8; ++i) out[i] = (f32x4){0.f, 0.f, 0.f, 0.f};
            for (int ii = 0; ii < 64; ii += 4) {
                asm volatile("" ::: "memory");
                const f32x4 w0 = *(const f32x4*)(pw + (ii + 0) * 64), w1 = *(const f32x4*)(pw + (ii + 1) * 64), w2 = *(const f32x4*)(pw + (ii + 2) * 64), w3 = *(const f32x4*)(pw + (ii + 3) * 64);
#pragma unroll
                for (int i = 0; i < 8; ++i) { const f32x4 d = *(const LAS f32x4*)(Dw + i * 256 + 64 * g + ii); out[i] += w0 * d.x + w1 * d.y + w2 * d.z + w3 * d.w; } }
            const f32x4 ps = *((const f32x4*)(p.in[I_POOLS] + l * 256) + lane);
#pragma unroll
            for (int i = 0; i < 8; ++i) { const f32x4 y = out[i] * ps; u32x2 w; w.x = cvt_pk_bf16(y.x, y.y); w.y = cvt_pk_bf16(y.z, y.w);
                *(u32x2*)(MC + (size_t)(t0 + tk0 + i) * KMIX + 1280 + 4 * lane) = w; }
        }
        asm volatile("" ::: "memory");
        {
            const float kg0 = p.in[I_KVNG][l * 128 + 2 * lane], kg1 = p.in[I_KVNG][l * 128 + 2 * lane + 1];
            u32x2 qv[8]; unsigned kvv[8];
#pragma unroll
            for (int i = 0; i < 8; ++i) { const bf16_t* zr = Z + (size_t)(t0 + tk0 + i) * NZ; qv[i] = *(const u32x2*)(zr + Z_CQ + 4 * lane); kvv[i] = *(const unsigned*)(zr + Z_CKV + 2 * lane); }
#pragma unroll
            for (int i = 0; i < 8; ++i) { const size_t t = (size_t)(t0 + tk0 + i);
                const u32x2 q = qv[i]; const float q0 = bflo(q.x), q1 = bfhi(q.x), q2 = bflo(q.y), q3 = bfhi(q.y);
                const float rq = 1.0f / sqrtf(wave_sum((q0 * q0 + q1 * q1) + (q2 * q2 + q3 * q3)) * (1.0f / 256.0f) + EPS);
                u32x2 w; w.x = cvt_pk_bf16(q0 * rq, q1 * rq); w.y = cvt_pk_bf16(q2 * rq, q3 * rq); *(u32x2*)(CQR + t * 256 + 4 * lane) = w;
                const unsigned kv = kvv[i]; const float k0 = bflo(kv), k1 = bfhi(kv);
                const float rk = 1.0f / sqrtf(wave_sum(k0 * k0 + k1 * k1) * (1.0f / 128.0f) + EPS);
                *(unsigned*)(KVN + t * 128 + 2 * lane) = cvt_pk_bf16(k0 * rk * kg0, k1 * rk * kg1); }
        }
        __syncthreads();
    }
}

__device__ __forceinline__ size_t sc_off(int b, int cq) { return (size_t)b * SC_PER_B + (size_t)2048 * cq * (cq + 1); }
__device__ __forceinline__ void ph_scores(const Params& p, const Ctx& c) {
    const bf16_t* Z = (const bf16_t*)(p.ws + WS_Z); float* SC = (float*)(p.ws + WS_Y);
    const int lane = c.lane, l15 = lane & 15, g = lane >> 4;
    for (int U = c.gw; U < NB * 576; U += c.NGW) {
        const int b = U / 576, u = U % 576;
        int cg = 0; while (8 * (cg + 1) * (cg + 2) <= u) ++cg;
        const int r = u - 8 * cg * (cg + 1), q16 = r / (cg + 1), seg = r % (cg + 1), cq = 4 * cg + (q16 >> 2), q4 = q16 & 3;
        const int n = 64 * (cq + 1), kt0 = seg * 16, kt1 = (kt0 + 16 < 4 * (cq + 1)) ? kt0 + 16 : 4 * (cq + 1);
        const size_t tq = (size_t)b * S + cq * 64 + q4 * 16 + l15;
        const bf16_t* zq = Z + tq * NZ;
        bf16x8 bq[8][2];
#pragma unroll
        for (int h = 0; h < 8; ++h)
#pragma unroll
            for (int s = 0; s < 2; ++s) bq[h][s] = *(const bf16x8*)(zq + Z_QI + h * 64 + 32 * s + 8 * g);
        float wq[8];
        { const u32x4 wv = *(const u32x4*)(zq + Z_WI); const float isc = 0.044194173824159216f;
          wq[0] = bflo(wv.x) * isc; wq[1] = bfhi(wv.x) * isc; wq[2] = bflo(wv.y) * isc; wq[3] = bfhi(wv.y) * isc; wq[4] = bflo(wv.z) * isc; wq[5] = bfhi(wv.z) * isc; wq[6] = bflo(wv.w) * isc; wq[7] = bfhi(wv.w) * isc; }
        float* srow = SC + sc_off(b, cq) + (size_t)(q4 * 16 + l15) * n;
        const bf16_t* zkb = Z + ((size_t)b * S + l15) * NZ + Z_KI + 8 * g;
        bf16x8 nk0 = *(const bf16x8*)(zkb + (size_t)kt0 * 16 * NZ), nk1 = *(const bf16x8*)(zkb + (size_t)kt0 * 16 * NZ + 32);
        for (int kt = kt0; kt < kt1; ++kt) {
            const bf16x8 ak0 = nk0, ak1 = nk1;
            if (kt + 1 < kt1) { nk0 = *(const bf16x8*)(zkb + (size_t)(kt + 1) * 16 * NZ); nk1 = *(const bf16x8*)(zkb + (size_t)(kt + 1) * 16 * NZ + 32); }
            f32x4 sc = {0.f, 0.f, 0.f, 0.f};
#pragma unroll
            for (int h = 0; h < 8; ++h) { f32x4 a = {0.f, 0.f, 0.f, 0.f};
                a = __builtin_amdgcn_mfma_f32_16x16x32_bf16(ak0, bq[h][0], a, 0, 0, 0);
                a = __builtin_amdgcn_mfma_f32_16x16x32_bf16(ak1, bq[h][1], a, 0, 0, 0);
#pragma unroll
                for (int i = 0; i < 4; ++i) sc[i] += wq[h] * fmaxf(a[i], 0.f); }
            *(f32x4*)(srow + kt * 16 + 4 * g) = sc;
        }
    }
}

__device__ __forceinline__ unsigned off_b(unsigned row, unsigned ch) { return 256u * row + 16u * (ch ^ (((row & 3) << 2) | ((row >> 2) & 3))); }
template <int MODE>
__device__ __forceinline__ void ph_attn(const Params& p, const Ctx& c, int l) {
    const float* SC = (const float*)(p.ws + WS_Y); const bf16_t* QA = (const bf16_t*)(p.ws + WS_H); const bf16_t* KVN = (const bf16_t*)(p.ws + WS_KVN);
    bf16_t* MC = (bf16_t*)p.out;
    const int lane = c.lane, g = lane >> 4, hd = lane & 15;
    LAS unsigned char* tile = c.lds + c.wave * 16384;
    LAS unsigned short* lst = (LAS unsigned short*)(c.lds + LIST_OFF + c.wave * 512);
    const unsigned long long ltmask = (1ull << lane) - 1ull;
    const int xg = blockIdx.x & 7, wv = (blockIdx.x >> 3) * 8 + c.wave, nwv = (c.G >> 3) * 8;
    int cxq = 0;
    float svn[32];
#define ATT_PREFETCH(qn_) do { const int bn_ = xg + 8 * ((qn_) / S), sn_ = (qn_) % S, cn_ = sn_ >> 6, nn_ = 64 * (cn_ + 1); \
        const float* srn_ = SC + sc_off(bn_, cn_) + (size_t)(sn_ & 63) * nn_ + lane; \
        _Pragma("unroll") for (int j = 0; j < 32; ++j) svn[j] = srn_[64 * (j <= cn_ ? j : cn_)]; } while (0)
    if ((MODE & 1) && wv < 2 * S) ATT_PREFETCH(wv);
    for (int qi = wv; qi < 2 * S; qi += nwv) {
        const int b = xg + 8 * (qi / S), s = qi % S, cq = s >> 6, n = 64 * (cq + 1), nk = n < 256 ? n : 256;
        const size_t t = (size_t)b * S + s;
        float sv[32];
#pragma unroll
        for (int j = 0; j < 32; ++j) sv[j] = svn[j];
        if ((MODE & 1) && qi + nwv < 2 * S) ATT_PREFETCH(qi + nwv);
        float tv[32]; const int cit = c.gw + c.NGW * cxq; const bool cxv = (MODE & 8) && cit < 3 * 8192;
        if (cxv) cx_issue(p, l, cit, lane, tv);
        if (cq < 4 || !(MODE & 1)) { for (int i = lane; i < nk; i += 64) lst[i] = (unsigned short)i; }
        else {
            unsigned key[32]; unsigned kmin = 0xffffffffu, kmax = 0u;
#pragma unroll
            for (int j = 0; j < 32; ++j) key[j] = 0u;
#pragma unroll
            for (int jb = 0; jb < 4; ++jb) if (8 * jb <= cq) {
#pragma unroll
                for (int j = 8 * jb; j < 8 * jb + 8; ++j) { const unsigned u = __float_as_uint(sv[j] + 0.0f); const unsigned k = (u & 0x80000000u) ? ~u : (u | 0x80000000u);
                    key[j] = (j <= cq) ? k : 0u; kmin = (j <= cq && k < kmin) ? k : kmin; kmax = (j <= cq && k > kmax) ? k : kmax; } }
#define KMM(W) { const unsigned a = lane_xor<W>(kmin), bb = lane_xor<W>(kmax); kmin = a < kmin ? a : kmin; kmax = bb > kmax ? bb : kmax; }
            KMM(1) KMM(2) KMM(4) KMM(8) KMM(16) KMM(32)
#undef KMM
            unsigned lo = __builtin_amdgcn_readfirstlane(kmin), hi = __builtin_amdgcn_readfirstlane(kmax); int c_lo = n, c_hi = 0; int it = 0;
            unsigned thr = 0u; int need = 0; bool done = false;
            while (lo < hi && (c_lo - c_hi) > 64) {
                unsigned mid;
                if (it < 20) {
                    const float lo_v = __uint_as_float((lo & 0x80000000u) ? (lo ^ 0x80000000u) : ~lo), hi_v = __uint_as_float((hi & 0x80000000u) ? (hi ^ 0x80000000u) : ~hi);
                    const float f = (it & 1) ? 0.5f : (float)(c_lo - 256) / (float)(c_lo - c_hi);
                    const float mid_v = lo_v + (hi_v - lo_v) * f + 0.0f;
                    const unsigned mu = __float_as_uint(mid_v); mid = (mu & 0x80000000u) ? ~mu : (mu | 0x80000000u);
                } else mid = lo + ((hi - lo) >> 1) + 1u;
                mid = mid > lo ? mid : lo + 1u; mid = mid < hi ? mid : hi;
                int cnt = 0;
#pragma unroll
                for (int jb = 0; jb < 4; ++jb) if (8 * jb <= cq) {
                    unsigned long long bm[8];
#pragma unroll
                    for (int j = 0; j < 8; ++j) bm[j] = __ballot(key[8 * jb + j] >= mid);
#pragma unroll
                    for (int j = 0; j < 8; ++j) cnt += __builtin_popcountll(bm[j]); }
                if (cnt >= 256) { lo = mid; c_lo = cnt; if (cnt == 256) { thr = mid; need = 1 << 20; done = true; break; } } else { hi = mid - 1u; c_hi = cnt; }
                ++it;
            }
            if (!done) {
                if (lo == hi) {
                    thr = lo; int cgt = 0;
#pragma unroll
                    for (int j = 0; j < 32; ++j) cgt += __builtin_popcountll(__ballot(key[j] > thr));
                    need = 256 - cgt;
                } else {
                    LAS unsigned* cand = (LAS unsigned*)lst; int base = 0;
#pragma unroll
                    for (int jb = 0; jb < 4; ++jb) if (8 * jb <= cq) {
#pragma unroll
                        for (int j = 8 * jb; j < 8 * jb + 8; ++j) { const bool isc = key[j] >= lo && key[j] <= hi; const unsigned long long bc = __ballot(isc);
                            if (isc) cand[base + __builtin_popcountll(bc & ltmask)] = key[j]; base += __builtin_popcountll(bc); } }
                    const int m = base;
                    const unsigned ck = lane < m ? cand[lane] : 0u;
                    int gt = 0, ge = 0;
                    for (int q = 0; q < m; ++q) { const unsigned v = (unsigned)__builtin_amdgcn_readlane((int)ck, q); gt += v > ck; ge += v >= ck; }
                    const int r = 256 - c_hi;
                    const unsigned long long hit = __ballot(lane < m && gt < r && r <= ge);
                    const int src = __builtin_ctzll(hit);
                    thr = __shfl(ck, src); need = r - __shfl(gt, src);
                }
            }
            asm volatile("" ::: "memory");
            {
                int base = 0, tb = 0;
#pragma unroll
                for (int jb = 0; jb < 4; ++jb) if (8 * jb <= cq) {
#pragma unroll
                    for (int j = 8 * jb; j < 8 * jb + 8; ++j) {
                        const bool gt = key[j] > thr, tie = key[j] == thr; const unsigned long long bt = __ballot(tie);
                        const int trank = tb + __builtin_popcountll(bt & ltmask); const bool sel = gt || (tie && trank < need);
                        const unsigned long long bs = __ballot(sel); const int pos = base + __builtin_popcountll(bs & ltmask);
                        if (sel && pos < 256) lst[pos] = (unsigned short)(64 * j + lane);
                        base += __builtin_popcountll(bs); tb += __builtin_popcountll(bt); } }
            }
        }
        bf16x8 qf[4];
#pragma unroll
        for (int ks = 0; ks < 4; ++ks) { qf[ks] = (bf16x8){0, 0, 0, 0, 0, 0, 0, 0}; if (hd < 8) qf[ks] = *(const bf16x8*)(QA + t * D + hd * 128 + 32 * ks + 8 * g); }
        float m_ref = -INFINITY, l_run = 0.f;
        f32x4 o[8];
#pragma unroll
        for (int ct = 0; ct < 8; ++ct) o[ct] = (f32x4){0.f, 0.f, 0.f, 0.f};
        const char* kvb = (const char*)(KVN + (size_t)b * S * 128);
        const int ntile = nk >> 5;
        LDS_WAIT();
#define ATT_ISSUE(kt_, buf_) do { const u32x4 kq_ = *(const LAS u32x4*)(lst + (kt_) * 32 + 8 * g); _Pragma("unroll") for (int i = 0; i < 8; ++i) { const int r = 4 * i + g; \
            const unsigned key_ = (i & 1) ? (kq_[i >> 1] >> 16) : (kq_[i >> 1] & 0xffffu); \
            const unsigned ch = (unsigned)hd ^ (unsigned)(((r & 3) << 2) | ((r >> 2) & 3)); \
            if (MODE & 2) __builtin_amdgcn_global_load_lds((const unsigned*)(kvb + key_ * 256u + ch * 16u), (LAS unsigned*)(tile + (buf_) * 8192 + i * 1024), 16, 0, 0); } } while (0)
        ATT_ISSUE(0, 0);
        for (int kt = 0; kt < ntile; ++kt) {
            LAS unsigned char* tb_ = tile + (kt & 1) * 8192;
            if (kt + 1 < ntile) { ATT_ISSUE(kt + 1, (kt + 1) & 1); asm volatile("s_waitcnt vmcnt(8)" ::: "memory"); }
            else asm volatile("s_waitcnt vmcnt(0)" ::: "memory");
            if (!(MODE & 4)) continue;
            f32x4 sa[2]; bf16x8 af[2][4];
#pragma unroll
            for (int rb = 0; rb < 2; ++rb)
#pragma unroll
                for (int ks = 0; ks < 4; ++ks) af[rb][ks] = *(const LAS bf16x8*)(tb_ + off_b(16 * rb + hd, 4 * ks + g));
#pragma unroll
            for (int rb = 0; rb < 2; ++rb) { sa[rb] = (f32x4){0.f, 0.f, 0.f, 0.f};
#pragma unroll
                for (int ks = 0; ks < 4; ++ks) sa[rb] = __builtin_amdgcn_mfma_f32_16x16x32_bf16(af[rb][ks], qf[ks], sa[rb], 0, 0, 0); }
            float mx = fmaxf(fmaxf(fmaxf(sa[0][0], sa[0][1]), fmaxf(sa[0][2], sa[0][3])), fmaxf(fmaxf(sa[1][0], sa[1][1]), fmaxf(sa[1][2], sa[1][3])));
            if (__ballot(mx > m_ref + 40.0f) != 0ull) {
                mx = fmaxf(mx, lane_xor<16>(mx)); mx = fmaxf(mx, lane_xor<32>(mx));
                const float m_new = fmaxf(m_ref, mx), alpha = __builtin_amdgcn_exp2f(m_ref - m_new);
                l_run *= alpha; m_ref = m_new;
#pragma unroll
                for (int ct = 0; ct < 8; ++ct) o[ct] *= alpha;
            }
            float pr[8], ps = 0.f;
#pragma unroll
            for (int j = 0; j < 8; ++j) { pr[j] = __builtin_amdgcn_exp2f(sa[j >> 2][j & 3] - m_ref); ps += pr[j]; }
            l_run += ps;
            u32x4 pw; pw.x = cvt_pk_bf16(pr[0], pr[1]); pw.y = cvt_pk_bf16(pr[2], pr[3]); pw.z = cvt_pk_bf16(pr[4], pr[5]); pw.w = cvt_pk_bf16(pr[6], pr[7]);
            const bf16x8 pb = __builtin_bit_cast(bf16x8, pw);
            const unsigned q4 = (unsigned)hd >> 2, p4 = (unsigned)hd & 3;
#pragma unroll
            for (int ct = 0; ct < 8; ++ct) {
                const bf16x4 vlo = __builtin_amdgcn_ds_read_tr16_b64_v4i16((LAS bf16x4*)(tb_ + off_b(4 * g + q4, 2 * ct + (p4 >> 1)) + 8 * (p4 & 1)));
                const bf16x4 vhi = __builtin_amdgcn_ds_read_tr16_b64_v4i16((LAS bf16x4*)(tb_ + off_b(16 + 4 * g + q4, 2 * ct + (p4 >> 1)) + 8 * (p4 & 1)));
                const bf16x8 va = __builtin_shufflevector(vlo, vhi, 0, 1, 2, 3, 4, 5, 6, 7);
                o[ct] = __builtin_amdgcn_mfma_f32_16x16x32_bf16(va, pb, o[ct], 0, 0, 0);
            }
            LDS_WAIT();
        }
#undef ATT_ISSUE
        float lt = l_run + lane_xor<16>(l_run); lt += lane_xor<32>(lt);
        const float inv = 1.0f / lt;
        if (hd < 8 && ((MODE & 8) || lt == 12345.678f)) {
#pragma unroll
            for (int ct = 0; ct < 8; ++ct) { const f32x4 v = o[ct] * inv; u32x2 w; w.x = cvt_pk_bf16(v.x, v.y); w.y = cvt_pk_bf16(v.z, v.w);
                *(u32x2*)(MC + t * KMIX + 256 + hd * 128 + 16 * ct + 4 * g) = w; }
        }
        if (cxv) cx_finish(p, cit, lane, tv, (LAS float*)tile);
        ++cxq;
    }
#undef ATT_PREFETCH
    for (; (MODE & 8) && c.gw + c.NGW * cxq < 3 * 8192; ++cxq) { float tv[32]; const int cit = c.gw + c.NGW * cxq; cx_issue(p, l, cit, lane, tv); cx_finish(p, cit, lane, tv, (LAS float*)tile); }
}

#ifndef RT_NT
#define RT_NT 2
#endif
__device__ __forceinline__ void ph_router(const Params& p, const Ctx& c, int l) {
    const float* mod = (const float*)(p.ws + WS_MOD); bf16_t* H = (bf16_t*)(p.ws + WS_H);
    int* toke = (int*)(p.ws + WS_SMALL + SM_TOKE); float* tokg = (float*)(p.ws + WS_SMALL + SM_TOKG); int* rank = (int*)(p.ws + WS_SMALL + SM_RANK); int* cnt = (int*)(p.ws + WS_SMALL + SM_CNT);
    LAS int* le = (LAS int*)(c.lds + RT_LE_OFF); LAS int* wcnt = le + 256;
    const int lane = c.lane;
    {
        const f32x4* srcE = (const f32x4*)(p.ws + WS_SMALL + SM_REW2) + (size_t)l * 8192; const f32x4* srcG = (const f32x4*)(p.ws + WS_SMALL + SM_RGW2) + (size_t)l * 1024;
        LAS f32x4* dE = (LAS f32x4*)c.lds; LAS f32x4* dG = (LAS f32x4*)(c.lds + RT_RG_OFF);
#pragma unroll
        for (int hb = 0; hb < 2; ++hb) { f32x4 t[8];
#pragma unroll
            for (int q = 0; q < 8; ++q) t[q] = srcE[c.tid + 512 * (8 * hb + q)];
#pragma unroll
            for (int q = 0; q < 8; ++q) dE[c.tid + 512 * (8 * hb + q)] = t[q]; }
        { const f32x4 t0 = srcG[c.tid], t1 = srcG[c.tid + 512]; dG[c.tid] = t0; dG[c.tid + 512] = t1; }
        __syncthreads();
    }
    for (int tile = c.vcu; tile < 256; tile += c.G) {
        constexpr int NT = RT_NT;
        const int b = (tile * 128) >> 11;
        const f32x4* ng = (const f32x4*)(p.in[I_N2G] + l * D) + lane;
        const f32x4* sh = (const f32x4*)(mod + (size_t)(l * NB + b) * 6144 + 3072) + lane; const f32x4* sc = (const f32x4*)(mod + (size_t)(l * NB + b) * 6144 + 4096) + lane;
        const LAS f32x4* rg = (const LAS f32x4*)(c.lds + RT_RG_OFF) + lane;
        f32x4 gm[4], sv[4];
#pragma unroll
        for (int j = 0; j < 4; ++j) { gm[j] = ng[64 * j] * (sc[64 * j] + 1.0f); sv[j] = sh[64 * j]; }
        f32x4 v[NT][4]; u32x2 vn[NT][4];
#pragma unroll
        for (int t = 0; t < NT; ++t)
#pragma unroll
            for (int j = 0; j < 4; ++j) vn[t][j] = ((const u32x2*)((const bf16_t*)(p.ws + WS_X16) + (size_t)(tile * 128 + c.wave * 16 + t) * D) + lane)[64 * j];
        for (int i = 0; i < 16; i += NT) {
            const int tl0 = c.wave * 16 + i, m0 = tile * 128 + tl0;
            float ss[NT], r[NT], gl[NT][4];
#pragma unroll
            for (int t = 0; t < NT; ++t) { ss[t] = 0.f;
#pragma unroll
                for (int j = 0; j < 4; ++j) { v[t][j] = (f32x4){bflo(vn[t][j].x), bfhi(vn[t][j].x), bflo(vn[t][j].y), bfhi(vn[t][j].y)}; ss[t] += (v[t][j].x * v[t][j].x + v[t][j].y * v[t][j].y) + (v[t][j].z * v[t][j].z + v[t][j].w * v[t][j].w); } }
            if (i + NT < 16) {
#pragma unroll
                for (int t = 0; t < NT; ++t)
#pragma unroll
                    for (int j = 0; j < 4; ++j) vn[t][j] = ((const u32x2*)((const bf16_t*)(p.ws + WS_X16) + (size_t)(m0 + NT + t) * D) + lane)[64 * j]; }
#pragma unroll
            for (int t = 0; t < NT; ++t) ss[t] = wave_sum(ss[t]);
#pragma unroll
            for (int t = 0; t < NT; ++t) { r[t] = 1.0f / sqrtf(ss[t] * (1.0f / D) + EPS); gl[t][0] = gl[t][1] = gl[t][2] = gl[t][3] = 0.f; }
#pragma unroll
            for (int j = 0; j < 4; ++j) {
#pragma unroll
                for (int t = 0; t < NT; ++t) { v[t][j] = v[t][j] * r[t] * gm[j] + sv[j];
                    u32x2 w; w.x = cvt_pk_bf16(v[t][j].x, v[t][j].y); w.y = cvt_pk_bf16(v[t][j].z, v[t][j].w); ((u32x2*)(H + (size_t)(m0 + t) * D) + lane)[64 * j] = w; }
#pragma unroll
                for (int e = 0; e < 4; ++e) { const f32x4 wr = rg[(j * 4 + e) * 64];
#pragma unroll
                    for (int t = 0; t < NT; ++t) { gl[t][0] += v[t][j][e] * wr.x; gl[t][1] += v[t][j][e] * wr.y; gl[t][2] += v[t][j][e] * wr.z; gl[t][3] += v[t][j][e] * wr.w; } } }
            const bool h32 = lane & 32, h16 = lane & 16, h8 = lane & 8;
            float dg[NT];
#pragma unroll
            for (int t = 0; t < NT; ++t) {
                const float c0 = (h16 ? gl[t][2] : gl[t][0]) + lane_xor<16>(h16 ? gl[t][0] : gl[t][2]), c1 = (h16 ? gl[t][3] : gl[t][1]) + lane_xor<16>(h16 ? gl[t][1] : gl[t][3]);
                float d = (h8 ? c1 : c0) + lane_xor<8>(h8 ? c0 : c1);
                d += lane_xor<4>(d); d += lane_xor<2>(d); d += lane_xor<1>(d); d += lane_xor<32>(d); dg[t] = d; }
            int gi[NT]; float gp[NT];
#pragma unroll
            for (int t = 0; t < NT; ++t) { float gq[4]; int g_ = 0; float gmax = -INFINITY;
#pragma unroll
                for (int q = 0; q < 4; ++q) { gq[q] = __shfl(dg[t], 8 * (q & 1) + 16 * (q >> 1)) + p.in[I_RGB][l * 4 + q]; if (gq[q] > gmax) { gmax = gq[q]; g_ = q; } }
                float gden = 0.f;
#pragma unroll
                for (int q = 0; q < 4; ++q) gden += __expf(gq[q] - gmax);
                gp[t] = 1.0f / gden; gi[t] = __builtin_amdgcn_readfirstlane(g_); }
            float el[NT][8];
#pragma unroll
            for (int t = 0; t < NT; ++t)
#pragma unroll
                for (int q = 0; q < 8; ++q) el[t][q] = 0.f;
#pragma unroll
            for (int j = 0; j < 4; ++j)
#pragma unroll
                for (int e = 0; e < 4; ++e)
#pragma unroll
                    for (int t = 0; t < NT; ++t) { const LAS f32x4* rr = (const LAS f32x4*)c.lds + gi[t] * 2048 + (j * 4 + e) * 128 + lane;
                        const f32x4 w0 = rr[0], w1 = rr[64]; const float hv = v[t][j][e];
                        el[t][0] += hv * w0.x; el[t][1] += hv * w0.y; el[t][2] += hv * w0.z; el[t][3] += hv * w0.w; el[t][4] += hv * w1.x; el[t][5] += hv * w1.y; el[t][6] += hv * w1.z; el[t][7] += hv * w1.w; }
            float de[NT];
#pragma unroll
            for (int t = 0; t < NT; ++t) {
                const float b0 = (h32 ? el[t][4] : el[t][0]) + lane_xor<32>(h32 ? el[t][0] : el[t][4]), b1 = (h32 ? el[t][5] : el[t][1]) + lane_xor<32>(h32 ? el[t][1] : el[t][5]);
                const float b2 = (h32 ? el[t][6] : el[t][2]) + lane_xor<32>(h32 ? el[t][2] : el[t][6]), b3 = (h32 ? el[t][7] : el[t][3]) + lane_xor<32>(h32 ? el[t][3] : el[t][7]);
                const float c0 = (h16 ? b2 : b0) + lane_xor<16>(h16 ? b0 : b2), c1 = (h16 ? b3 : b1) + lane_xor<16>(h16 ? b1 : b3);
                float d = (h8 ? c1 : c0) + lane_xor<8>(h8 ? c0 : c1);
                d += lane_xor<4>(d); d += lane_xor<2>(d); d += lane_xor<1>(d); de[t] = d; }
#pragma unroll
            for (int t = 0; t < NT; ++t) { float eq[8]; int e0 = 0, e1 = 0; float mx0 = -INFINITY, mx1 = -INFINITY;
#pragma unroll
                for (int q = 0; q < 8; ++q) { eq[q] = __shfl(de[t], 8 * (q & 1) + 16 * ((q >> 1) & 1) + 32 * (q >> 2)) + p.in[I_REB][l * 32 + gi[t] * 8 + q];
                    if (eq[q] > mx0) { mx1 = mx0; e1 = e0; mx0 = eq[q]; e0 = q; } else if (eq[q] > mx1) { mx1 = eq[q]; e1 = q; } }
                const float x1 = __expf(mx1 - mx0), den = 1.0f + x1; const int tl = tl0 + t, m = m0 + t;
                if (lane == 0) { le[2 * tl] = gi[t] * 8 + e0; le[2 * tl + 1] = gi[t] * 8 + e1; toke[2 * m] = gi[t] * 8 + e0; toke[2 * m + 1] = gi[t] * 8 + e1; tokg[2 * m] = gp[t] / den; tokg[2 * m + 1] = gp[t] * x1 / den; } }
        }
        __syncthreads();
        int myrank = 0, mye = 0;
        if (c.tid < 256) { mye = le[c.tid]; const unsigned long long ltmask = (1ull << lane) - 1ull;
            for (int ee = 0; ee < 32; ++ee) { const unsigned long long m = __ballot(mye == ee); if (mye == ee) myrank = __builtin_popcountll(m & ltmask); if (lane == 0) wcnt[c.wave * 32 + ee] = __builtin_popcountll(m); } }
        __syncthreads();
        if (c.tid < 256) { for (int w = 0; w < c.wave; ++w) myrank += wcnt[w * 32 + mye]; rank[tile * 256 + c.tid] = myrank; }
        if (c.tid < 32) cnt[tile * 32 + c.tid] = wcnt[c.tid] + wcnt[32 + c.tid] + wcnt[64 + c.tid] + wcnt[96 + c.tid];
        __syncthreads();
    }
}

__device__ __forceinline__ void ph_dispatch(const Params& p, const Ctx& c) {
    const int* toke = (const int*)(p.ws + WS_SMALL + SM_TOKE); const float* tokg = (const float*)(p.ws + WS_SMALL + SM_TOKG); const int* rank = (const int*)(p.ws + WS_SMALL + SM_RANK); const int* cnt = (const int*)(p.ws + WS_SMALL + SM_CNT);
    int* tslot = (int*)(p.ws + WS_SMALL + SM_TSLOT); int* stok = (int*)(p.ws + WS_SMALL + SM_STOK); float* sgate = (float*)(p.ws + WS_SMALL + SM_SGATE); int* texp = (int*)(p.ws + WS_SMALL + SM_TEXP);
    LAS int* tot = (LAS int*)c.lds; LAS int* pst = tot + 32; LAS int* bse = pst + 33;
    for (int tile = c.vcu; tile < 256; tile += c.G) {
        {
            LAS int* psum = bse + 32; LAS int* pbase = psum + 512;
            const int e = c.tid & 31, part = c.tid >> 5; int v[16]; int run = 0, mb = 0;
#pragma unroll
            for (int q = 0; q < 16; ++q) v[q] = cnt[(part * 16 + q) * 32 + e];
#pragma unroll
            for (int q = 0; q < 16; ++q) { if (part * 16 + q == tile) mb = run; run += v[q]; }
            psum[part * 32 + e] = run; pbase[part * 32 + e] = mb;
            __syncthreads();
            if (c.tid < 32) { int tr = 0, tb2 = 0; const int tp = tile >> 4;
                for (int q = 0; q < 16; ++q) { if (q == tp) tb2 = tr + pbase[q * 32 + c.tid]; tr += psum[q * 32 + c.tid]; }
                tot[c.tid] = tr; bse[c.tid] = tb2; }
        }
        __syncthreads();
        if (c.tid == 0) { int a = 0; for (int e = 0; e < 32; ++e) { pst[e] = a; a += ((tot[e] + 255) >> 8) << 8; } pst[32] = a; }
        __syncthreads();
        if (c.tid < 256) { const int a = tile * 256 + c.tid, e = toke[a], slot = pst[e] + bse[e] + rank[a]; stok[slot] = a >> 1; sgate[slot] = tokg[a]; tslot[a] = slot; }
        if (tile == 0) {
            for (int e = 0; e < 32; ++e) { const int pc = pst[e + 1] - pst[e]; for (int r = tot[e] + c.tid; r < pc; r += 512) { stok[pst[e] + r] = 0; sgate[pst[e] + r] = 0.f; } }
            const int ntl = pst[32] >> 8;
            for (int m = c.tid; m < ntl; m += 512) { int e = 0; while (pst[e + 1] <= (m << 8)) ++e; texp[m] = e; }
            if (c.tid == 0) texp[MAXTILES] = ntl;
        }
        __syncthreads();
    }
}

#ifndef PH_ONLY
#define PH_ONLY -1
#endif
#define IN(k) ((PH_ONLY < 0 || PH_ONLY == (k)) && lo <= (k) && (k) < hi)
#define SEAM(k) do { if (IN(k) && IN((k) + 1)) xcd_barrier(bar); } while (0)
#ifndef REP_MASK
#define REP_MASK 0
#endif
#define REP(id) (((REP_MASK) >> (id)) & 1)
#define BODY(id, cond, ...) do { __VA_ARGS__ if (REP(id) && (cond)) { xcd_barrier(bar); __VA_ARGS__ } } while (0)
template <int l>
__device__ __forceinline__ void run_layer(const Params& p, const Ctx& c, const XcdBarrier& bar, int lo, int hi) {
    bf16_t* Zb = (bf16_t*)(p.ws + WS_Z); bf16_t* Hb = (bf16_t*)(p.ws + WS_H); bf16_t* MCb = (bf16_t*)p.out;
    const float* mod = (const float*)(p.ws + WS_MOD);
    constexpr int P = 1 + 10 * l;
    if (IN(P)) { if (l == 0) { BODY(1, true, ph_norm1<0>(p, c);); } else { ph_norm1<1>(p, c); } }
    SEAM(P);
    if (IN(P + 1)) { BODY(2, true, { pg8::StaticOrder So; So.init(Hb, (bf16_t*)(p.ws + WS_WIN) + (size_t)l * NZ * D, T, NZ, D, c.G, (int)blockIdx.x);
        pg8::EpiBf16 E{Zb, NZ}; pg8::gemm_phase<pg8::EpiBf16, pg8::StaticOrder, false>(c.lds, So, E); }); }
    SEAM(P + 1);
    if (IN(P + 2)) { BODY(3, true, ph_postz(p, c, l);); }
    SEAM(P + 2);
    if (IN(P + 3)) { BODY(4, true, { pg8::StaticOrder So; So.init((bf16_t*)(p.ws + WS_CQR), (bf16_t*)(p.ws + WS_WQA) + (size_t)l * D * 256, T, D, 256, c.G, (int)blockIdx.x);
        pg8::EpiBf16 E{Hb, D}; pg8::gemm_phase<pg8::EpiBf16, pg8::StaticOrder, false>(c.lds, So, E); });
        BODY(5, true, ph_scores(p, c);); }
    SEAM(P + 3);
#ifndef ATT_PROBE
#define ATT_PROBE 0
#endif
    if (IN(P + 4)) { ph_attn<15>(p, c, l); if (ATT_PROBE) { xcd_barrier(bar); ph_attn<ATT_PROBE>(p, c, l); } }
    SEAM(P + 4);
    if (IN(P + 5)) { BODY(7, l == 0, { pg8::StaticOrder So; So.init(MCb, (bf16_t*)(p.ws + WS_WMIX) + (size_t)l * D * KMIX, T, D, KMIX, c.G, (int)blockIdx.x);
        pg8::EpiMix E{l == 0 ? p.in[I_X] : nullptr, (bf16_t*)(p.ws + WS_X16), mod + (size_t)l * NB * 6144 + 2048}; pg8::gemm_phase<pg8::EpiMix, pg8::StaticOrder, false>(c.lds, So, E); }); }
    SEAM(P + 5);
    if (IN(P + 6)) { BODY(8, true, ph_router(p, c, l);); }
    SEAM(P + 6);
    if (IN(P + 7)) { BODY(9, true, ph_dispatch(p, c);); }
    SEAM(P + 7);
    if (IN(P + 8)) { BODY(10, true, { const int* texp = (const int*)(p.ws + WS_SMALL + SM_TEXP); const int ntl = texp[MAXTILES];
        pg8::MoeOrder Mo; Mo.init(Hb, p.ws + WS_W13, D, (size_t)1024 * 1024 * 2, (const int*)(p.ws + WS_SMALL + SM_STOK), texp, ntl, c.G, c.vcu, (LAS int*)(c.lds + MOE_TAB_OFF));
        pg8::EpiAct E{Zb}; pg8::gemm_phase<pg8::EpiAct, pg8::MoeOrder, true>(c.lds, Mo, E); }); }
    SEAM(P + 8);
    if (IN(P + 9)) { BODY(11, true, { const int* texp = (const int*)(p.ws + WS_SMALL + SM_TEXP); const int ntl = texp[MAXTILES];
        pg8::MoeOrder Mo; Mo.init(Zb, p.ws + WS_W2, DEXP, (size_t)1024 * 512 * 2, nullptr, texp, ntl, c.G, c.vcu, (LAS int*)(c.lds + MOE_TAB_OFF));
        pg8::EpiY E{(bf16_t*)(p.ws + WS_Y), (const float*)(p.ws + WS_SMALL + SM_SGATE)}; pg8::gemm_phase<pg8::EpiY, pg8::MoeOrder, false>(c.lds, Mo, E); }); }
    SEAM(P + 9);
}

__global__ void __launch_bounds__(512, 2) fwd(Params p) {
    extern __shared__ __attribute__((aligned(16))) unsigned char lds_raw[];
    Ctx c;
    c.lds = (LAS unsigned char*)lds_raw;
    c.tid = threadIdx.x; c.lane = c.tid & 63; c.wave = __builtin_amdgcn_readfirstlane(c.tid >> 6);
    c.G = gridDim.x; { const int bx = blockIdx.x; c.vcu = (c.G % 8 == 0) ? (bx % 8) * (c.G / 8) + bx / 8 : bx; }
    c.gw = c.vcu * 8 + c.wave; c.NGW = c.G * 8;
    volatile LAS unsigned* MISC = (volatile LAS unsigned*)(c.lds + MISC_OFF);
    if (c.tid < 64) MISC[c.tid] = 0u;
    __syncthreads();
    unsigned* ctl = (unsigned*)(p.ws + WS_CTL);
    XcdBarrier bar; bar.bar = ctl + CW_BAR; bar.x = 0; bar.st = nullptr;
    const bool multi = (p.ph_hi - p.ph_lo) > 1;
    if (multi) bar = xcd_barrier_post(ctl + CW_BAR, MISC + 8);
    const int lo = p.ph_lo, hi = p.ph_hi;
    if (IN(0)) { BODY(0, true, ph_prologue(p, c);); }
    SEAM(0);
    run_layer<0>(p, c, bar, lo, hi);
    run_layer<1>(p, c, bar, lo, hi);
    if (IN(21)) ph_norm1<2>(p, c);
#undef IN
#undef SEAM
}

extern "C" void kernel_launch(void* const* d_in, const int* in_sizes, int n_in, void* d_out, int out_size, void* d_ws, size_t ws_size, hipStream_t stream) {
    static int grid = 0;
    if (grid == 0) {
        if (n_in != 27 || out_size != T * D || ws_size < WS_END) { fprintf(stderr, "kernel_launch: unexpected shapes (n_in %d out %d ws %zu, need %zu)\n", n_in, out_size, ws_size, (size_t)WS_END); grid = -1; return; }
        int dev = 0, cus = 0, per_cu = 0;
        if (hipGetDevice(&dev) != hipSuccess || hipDeviceGetAttribute(&cus, hipDeviceAttributeMultiprocessorCount, dev) != hipSuccess) { grid = -1; return; }
        if (hipFuncSetAttribute((const void*)fwd, hipFuncAttributeMaxDynamicSharedMemorySize, LDS_BYTES) != hipSuccess) { fprintf(stderr, "kernel_launch: hipFuncSetAttribute failed\n"); grid = -1; return; }
        if (hipOccupancyMaxActiveBlocksPerMultiprocessor(&per_cu, (const void*)fwd, 512, LDS_BYTES) != hipSuccess || per_cu < 1) { fprintf(stderr, "kernel_launch: occupancy query says %d blocks per CU\n", per_cu); grid = -1; return; }
        (void)hipGetLastError();
        grid = cus;
        if (grid % 8 != 0 || grid > 256) grid = (grid / 8) * 8 > 256 ? 256 : (grid / 8) * 8;
    }
    if (grid <= 0) return;
    (void)hipMemsetAsync((char*)d_ws + WS_CTL, 0, CTL_ZERO_BYTES, stream);
    Params p{};
    for (int i = 0; i < 27; ++i) p.in[i] = (const float*)d_in[i];
    p.out = (float*)d_out; p.ws = (unsigned char*)d_ws;
#if MK_SPLIT
    for (int ph = 0; ph < NPHASE; ++ph) { p.ph_lo = ph; p.ph_hi = ph + 1; hipLaunchKernelGGL(fwd, dim3(grid), dim3(512), LDS_BYTES, stream, p); }
#else
    p.ph_lo = 0; p.ph_hi = NPHASE;
    hipLaunchKernelGGL(fwd, dim3(grid), dim3(512), LDS_BYTES, stream, p);
#endif
}
```

```cpp
#include <hip/hip_runtime.h>
#include <cstdio>
#include <cstdint>

#ifndef MK_SPLIT
#define MK_SPLIT 0
#endif

#define LAS __attribute__((address_space(3)))
typedef unsigned short bf16_t;
typedef short bf16x8 __attribute__((ext_vector_type(8)));
typedef short bf16x4 __attribute__((ext_vector_type(4)));
typedef float f32x4 __attribute__((ext_vector_type(4)));
typedef float f32x16 __attribute__((ext_vector_type(16)));
typedef unsigned u32x4 __attribute__((ext_vector_type(4)));
typedef unsigned u32x2 __attribute__((ext_vector_type(2)));

constexpr int D = 1024, NB = 16, S = 2048, T = NB * S, DEPTH = 2;
constexpr int NZ = 1792;
constexpr int N_IN = 1736;
constexpr int Z_AVAL = 0, Z_AGATE = 256, Z_CQ = 512, Z_CKV = 768, Z_QI = 896, Z_KI = 1408, Z_WI = 1472, Z_UP = 1480;
constexpr int KMIX = 1536;
constexpr int NEXP = 32, DEXP = 512, MAXTILES = 288, PMAX = MAXTILES * 256;
constexpr float EPS = 1e-6f;
constexpr int SC_PER_B = 4096 * 528;

constexpr size_t MiB = 1u << 20;
constexpr size_t WS_CTL = 0, CTL_ZERO_BYTES = 64 * 1024;
constexpr size_t WS_MOD = 1 * MiB;
constexpr size_t WS_WIN = 2 * MiB;
constexpr size_t WS_WQA = 9 * MiB;
constexpr size_t WS_WMIX = 10 * MiB;
constexpr size_t WS_SMALL = 16 * MiB;
constexpr size_t WS_W13 = 20 * MiB;
constexpr size_t WS_W2 = 84 * MiB;
constexpr size_t WS_Z = 116 * MiB;
constexpr size_t WS_X16 = 228 * MiB;
constexpr size_t WS_H = 324 * MiB;
constexpr size_t WS_CQR = 388 * MiB;
constexpr size_t WS_KVN = 404 * MiB;
constexpr size_t WS_Y = 412 * MiB;
constexpr size_t WS_END = 556 * MiB;
constexpr size_t SM_TOKE = 0;
constexpr size_t SM_TOKG = 256 * 1024;
constexpr size_t SM_RANK = 512 * 1024;
constexpr size_t SM_TSLOT = 768 * 1024;
constexpr size_t SM_STOK = 1024 * 1024;
constexpr size_t SM_SGATE = 1024 * 1024 + 512 * 1024;
constexpr size_t SM_CNT = 2 * 1024 * 1024;
constexpr size_t SM_TEXP = 2 * 1024 * 1024 + 64 * 1024;
constexpr size_t SM_REW2 = 2 * 1024 * 1024 + 512 * 1024;
constexpr size_t SM_RGW2 = 3 * 1024 * 1024;
constexpr int CW_BAR = 1024;

constexpr int LDS_BYTES = 155648;
constexpr int LIST_OFF = 131072;
constexpr int MISC_OFF = 154624;
constexpr int MOE_TAB_OFF = 131072;
constexpr int RT_RG_OFF = 131072, RT_LE_OFF = 147456;
constexpr int NPHASE = 22;

__device__ __forceinline__ unsigned cvt_pk_bf16(float lo, float hi) { unsigned r; asm volatile("v_cvt_pk_bf16_f32 %0, %1, %2" : "=v"(r) : "v"(lo), "v"(hi)); return r; }
__device__ __forceinline__ float bf2f(unsigned short b) { return __uint_as_float(((unsigned)b) << 16); }
__device__ __forceinline__ float bflo(unsigned w) { return __uint_as_float(w << 16); }
__device__ __forceinline__ float bfhi(unsigned w) { return __uint_as_float(w & 0xffff0000u); }
template <int W> __device__ __forceinline__ int lane_xor_i(int iv) {
    int r;
    if constexpr (W == 1) r = __builtin_amdgcn_mov_dpp(iv, 0xB1, 0xF, 0xF, true);
    else if constexpr (W == 2) r = __builtin_amdgcn_mov_dpp(iv, 0x4E, 0xF, 0xF, true);
    else if constexpr (W == 4) { r = __builtin_amdgcn_update_dpp(iv, iv, 0x104, 0xF, 0x5, false);
                                 r = __builtin_amdgcn_update_dpp(r, iv, 0x114, 0xF, 0xA, false); }
    else if constexpr (W == 8) r = __builtin_amdgcn_mov_dpp(iv, 0x128, 0xF, 0xF, true);
    else if constexpr (W == 16) { const auto p = __builtin_amdgcn_permlane16_swap((unsigned)iv, (unsigned)iv, false, false); r = (threadIdx.x & 16) ? (int)p[0] : (int)p[1]; }
    else { const auto p = __builtin_amdgcn_permlane32_swap((unsigned)iv, (unsigned)iv, false, false); r = (threadIdx.x & 32) ? (int)p[0] : (int)p[1]; }
    return r;
}
template <int W> __device__ __forceinline__ float lane_xor(float v) { return __builtin_bit_cast(float, lane_xor_i<W>(__builtin_bit_cast(int, v))); }
template <int W> __device__ __forceinline__ unsigned lane_xor(unsigned v) { return (unsigned)lane_xor_i<W>((int)v); }
__device__ __forceinline__ float wave_sum(float v) {
    v += lane_xor<1>(v); v += lane_xor<2>(v); v += lane_xor<4>(v); v += lane_xor<8>(v); v += lane_xor<16>(v); v += lane_xor<32>(v);
    return v;
}
__device__ __forceinline__ float sigmoidf_(float x) { return 1.0f / (1.0f + __expf(-x)); }
#define LDS_WAIT() asm volatile("s_waitcnt lgkmcnt(0)" ::: "memory")
#define VM_WAIT() asm volatile("s_waitcnt vmcnt(0)" ::: "memory")

#define XB_TMO      128
#define XB_XCNT(j)  (256  + 64 * (j))
#define XB_XSUB(j)  (1280 + 64 * (j))
#define XB_XGEN(j)  (2304 + 64 * (j))
#define XB_TOP      3328
#define XB_TOPGEN   3392
#define XCD_BAR_WORDS 3456
#define XB_SPIN_CAP (1u << 22)

__device__ __forceinline__ unsigned xb_ld(unsigned* p)              { return __hip_atomic_load(p, __ATOMIC_RELAXED, __HIP_MEMORY_SCOPE_AGENT); }
__device__ __forceinline__ unsigned xb_add(unsigned* p, unsigned v) { return __hip_atomic_fetch_add(p, v, __ATOMIC_RELAXED, __HIP_MEMORY_SCOPE_AGENT); }
__device__ __forceinline__ unsigned xb_xcc_id() { return (unsigned)__builtin_amdgcn_s_getreg((3 << 11) | 20) & 0xFu; }
#define XB_SPIN(cond, bar) do { unsigned _sp = 0; while (cond) { __builtin_amdgcn_s_sleep(1); \
    if ((++_sp & 255u) == 0u) { if (xb_ld(&(bar)[XB_TMO])) break; if (_sp > XB_SPIN_CAP) { atomicAdd(&(bar)[XB_TMO], 1u); break; } } } } while (0)

struct XcdBarrier {
    unsigned* bar; unsigned x;
    volatile LAS unsigned* st;
};
__device__ __forceinline__ XcdBarrier xcd_barrier_post(unsigned* bar, volatile LAS unsigned* st) {
    XcdBarrier b; b.bar = bar; b.x = xb_xcc_id(); b.st = st;
    if (threadIdx.x == 0) (void)xb_add(&bar[XB_XCNT(b.x)], 1u);
    return b;
}
__device__ __forceinline__ void xcd_barrier_complete(unsigned* bar, unsigned x, unsigned& nloc, unsigned& nx) {
    const unsigned G = gridDim.x * gridDim.y * gridDim.z;
    unsigned sum, cnt, mine, sp = 0u;
    for (;;) {
        sum = 0u; cnt = 0u; mine = 0u;
#pragma unroll
        for (unsigned j = 0; j < 16; ++j) { const unsigned c = xb_ld(&bar[XB_XCNT(j)]); sum += c; cnt += (c > 0u) ? 1u : 0u; mine = (j == x) ? c : mine; }
        if (sum == G) break;
        __builtin_amdgcn_s_sleep(1);
        if ((++sp & 255u) == 0u) { if (xb_ld(&bar[XB_TMO])) break; if (sp > XB_SPIN_CAP) { atomicAdd(&bar[XB_TMO], 1u); break; } }
    }
    nloc = mine > 0u ? mine : 1u; nx = cnt > 0u ? cnt : 1u;
}
__device__ __forceinline__ void xcd_barrier(const XcdBarrier& b) {
    asm volatile("s_waitcnt vmcnt(0)" ::: "memory");
    __syncthreads();
    if (threadIdx.x == 0) {
        unsigned* bar = b.bar;
        __builtin_amdgcn_s_waitcnt(0);
        unsigned nloc = b.st[0], nx = b.st[1];
        if (nloc == 0u) { xcd_barrier_complete(bar, b.x, nloc, nx); b.st[0] = nloc; b.st[1] = nx; }
        const unsigned old = xb_add(&bar[XB_XSUB(b.x)], 1u);
        const unsigned gen = old / nloc;
        if (old + 1u == (gen + 1u) * nloc) {
            __builtin_amdgcn_fence(__ATOMIC_RELEASE, "agent");
            asm volatile("s_waitcnt vmcnt(0)" ::: "memory");
            const unsigned og = xb_add(&bar[XB_TOP], 1u);
            const unsigned tg = og / nx;
            if (og + 1u == (tg + 1u) * nx) xb_add(&bar[XB_TOPGEN], 1u);
            else XB_SPIN(xb_ld(&bar[XB_TOPGEN]) == tg, bar);
            __builtin_amdgcn_fence(__ATOMIC_ACQUIRE, "agent");
            xb_add(&bar[XB_XGEN(b.x)], 1u);
            asm volatile("s_waitcnt vmcnt(0)" ::: "memory");
        } else {
            XB_SPIN(xb_ld(&bar[XB_XGEN(b.x)]) == gen, bar);
            __builtin_amdgcn_fence(__ATOMIC_ACQUIRE, "agent");
            asm volatile("s_waitcnt vmcnt(0)" ::: "memory");
        }
    }
    __syncthreads();
}

namespace pg8 {
constexpr int BM = 256, BK = 64, HALF = 128, HTB = HALF * BK * 2  , STAGE_BYTES = 8 * HTB, NXCD = 8, WGM = 8;
__host__ __device__ __forceinline__ int lds_byte(int r, int c) { const int st = (r >> 4) * 2 + (c >> 5), rr = r & 15, cc = c & 31, ob = rr * 64 + cc * 2; return st * 1024 + (ob ^ (((ob >> 9) & 1) << 5)); }
__host__ __device__ __forceinline__ void stage_rc(int b, int& R, int& C) { const int st = b / 1024, sb = b % 1024, swz = sb ^ (((sb >> 9) & 1) << 5); R = (st >> 1) * 16 + swz / 64; C = (st & 1) * 32 + (swz % 64) / 2; }
__host__ __device__ __forceinline__ int perm32(int rho) { const int n = rho >> 4, i = rho & 15; return 8 * (i >> 2) + 4 * n + (i & 3); }

struct Unit { int pm, pn; const char* a; const char* b; };

struct StaticOrder {
    const char* A; const char* Bt; int K;
    int nM, nN, nwg, G, c;
    __device__ void init(const void* A_, const void* Bt_, int M, int N, int K_, int G_, int c_) { A = (const char*)A_; Bt = (const char*)Bt_; K = K_; nM = M / BM; nN = N / BM; nwg = nM * nN; G = G_; c = c_; }
    __device__ __forceinline__ bool next(int i, Unit& u) const {
        const long L = (long)i * G + c; if (L >= nwg) return false;
        int wgid = (int)L; { const int q = nwg / NXCD, r = nwg % NXCD, xcd = wgid % NXCD, off = wgid / NXCD; wgid = (xcd < r ? xcd * (q + 1) : r * (q + 1) + (xcd - r) * q) + off; }
        const int nig = WGM * nN, gid = wgid / nig, fm = gid * WGM, gsz = (nM - fm) < WGM ? (nM - fm) : WGM;
        u.pm = fm + ((wgid % nig) % gsz); u.pn = (wgid % nig) / gsz;
        u.a = A + (size_t)u.pm * BM * K * 2; u.b = Bt + (size_t)u.pn * BM * K * 2; return true;
    }
    __device__ __forceinline__ int row(int, int) const { return 0; }
};
struct MoeOrder {
    const char* A; const char* Bt; int K; const LAS int* rowtab;
    const LAS int* etab; int nunits, G, c; size_t bstride;
    static constexpr int MAXU = 6;
    __device__ __forceinline__ void init(const void* A_, const void* Bt_, int K_, size_t bstride_, const int* rowidx, const int* tile_exp, int ntiles, int G_, int c_, LAS int* lds_tab) {
        A = (const char*)A_; Bt = (const char*)Bt_; K = K_; bstride = bstride_; nunits = ntiles * 4; G = G_; c = c_;
        LAS int* rt = lds_tab; LAS int* et = lds_tab + MAXU * 256;
        for (int i = 0; i < MAXU; ++i) { const int L = i * G + c; if (L >= nunits) break; const int tile = L >> 2;
            if (rowidx && threadIdx.x < 256) rt[i * 256 + threadIdx.x] = rowidx[tile * 256 + threadIdx.x];
            if (threadIdx.x == 0) et[i] = tile_exp[tile]; }
        rowtab = rowidx ? rt : nullptr; etab = et;
        __syncthreads();
    }
    __device__ __forceinline__ bool next(int i, Unit& u) const {
        const int L = i * G + c; if (L >= nunits || i >= MAXU) return false;
        u.pm = L >> 2; u.pn = L & 3; const int e = __builtin_amdgcn_readfirstlane(etab[i]);
        u.a = A + (size_t)u.pm * BM * K * 2; u.b = Bt + (size_t)e * bstride + (size_t)u.pn * BM * K * 2; return true;
    }
    __device__ __forceinline__ int row(int i, int r) const { return rowtab[i * 256 + r]; }
};
struct NoGather { };
struct EpiBf16 {
    static constexpr bool PERM = true;
    bf16_t* O; int ldc;
    __device__ __forceinline__ void operator()(const f32x4 (&acc)[2][2][4][2], const Unit& u, int wr, int wc, int fr, int fq) const {
        const int row0 = u.pm * BM + wr * 64 + fr, col0 = u.pn * BM + wc * 32 + 8 * fq;
#pragma unroll
        for (int ai = 0; ai < 2; ++ai)
#pragma unroll
            for (int m = 0; m < 4; ++m) { bf16_t* rowp = O + (size_t)(row0 + ai * HALF + m * 16) * ldc + col0;
#pragma unroll
                for (int bj = 0; bj < 2; ++bj) { const f32x4 v0 = acc[ai][bj][m][0], v1 = acc[ai][bj][m][1];
                    u32x4 w; w.x = cvt_pk_bf16(v0[0], v0[1]); w.y = cvt_pk_bf16(v0[2], v0[3]); w.z = cvt_pk_bf16(v1[0], v1[1]); w.w = cvt_pk_bf16(v1[2], v1[3]);
                    *(u32x4*)(rowp + bj * HALF) = w; } }
    }
};
struct EpiMix {
    static constexpr bool PERM = true;
    const float* xin32; bf16_t* x16; const float* gate;
    __device__ __forceinline__ void operator()(const f32x4 (&acc)[2][2][4][2], const Unit& u, int wr, int wc, int fr, int fq) const {
        const int row0 = u.pm * BM + wr * 64 + fr, col0 = u.pn * BM + wc * 32 + 8 * fq;
        const float* gp = gate + (size_t)(u.pm >> 3) * 6144 + col0;
        f32x4 gv[2][2];
#pragma unroll
        for (int bj = 0; bj < 2; ++bj)
#pragma unroll
            for (int n = 0; n < 2; ++n) gv[bj][n] = *(const f32x4*)(gp + bj * HALF + 4 * n);
#pragma unroll
        for (int ai = 0; ai < 2; ++ai)
#pragma unroll
            for (int m = 0; m < 4; ++m) { const size_t off = (size_t)(row0 + ai * HALF + m * 16) * D + col0;
#pragma unroll
                for (int bj = 0; bj < 2; ++bj) { f32x4 x0, x1;
                    if (xin32) { x0 = *(const f32x4*)(xin32 + off + bj * HALF); x1 = *(const f32x4*)(xin32 + off + bj * HALF + 4); }
                    else { const u32x4 xv = *(const u32x4*)(x16 + off + bj * HALF); x0 = (f32x4){bflo(xv.x), bfhi(xv.x), bflo(xv.y), bfhi(xv.y)}; x1 = (f32x4){bflo(xv.z), bfhi(xv.z), bflo(xv.w), bfhi(xv.w)}; }
                    const f32x4 v0 = x0 + gv[bj][0] * acc[ai][bj][m][0], v1 = x1 + gv[bj][1] * acc[ai][bj][m][1];
                    u32x4 w; w.x = cvt_pk_bf16(v0[0], v0[1]); w.y = cvt_pk_bf16(v0[2], v0[3]); w.z = cvt_pk_bf16(v1[0], v1[1]); w.w = cvt_pk_bf16(v1[2], v1[3]);
                    *(u32x4*)(x16 + off + bj * HALF) = w; } }
    }
};
struct EpiAct {
    static constexpr bool PERM = true;
    bf16_t* O;
    __device__ __forceinline__ void operator()(const f32x4 (&acc)[2][2][4][2], const Unit& u, int wr, int wc, int fr, int fq) const {
        const int row0 = u.pm * BM + wr * 64 + fr, col0 = u.pn * 128 + wc * 16 + 4 * fq;
#pragma unroll
        for (int ai = 0; ai < 2; ++ai)
#pragma unroll
            for (int m = 0; m < 4; ++m) { bf16_t* rowp = O + (size_t)(row0 + ai * HALF + m * 16) * DEXP + col0;
#pragma unroll
                for (int bj = 0; bj < 2; ++bj) { const f32x4 a = acc[ai][bj][m][0], b = acc[ai][bj][m][1]; f32x4 r;
#pragma unroll
                    for (int j = 0; j < 4; ++j) r[j] = a[j] * b[j] * __builtin_amdgcn_rcpf(1.0f + __expf(-a[j]));
                    u32x2 w; w.x = cvt_pk_bf16(r[0], r[1]); w.y = cvt_pk_bf16(r[2], r[3]);
                    *(u32x2*)(rowp + bj * 64) = w; } }
    }
};
struct EpiY {
    static constexpr bool PERM = true;
    bf16_t* O; const float* sgate;
    __device__ __forceinline__ void operator()(const f32x4 (&acc)[2][2][4][2], const Unit& u, int wr, int wc, int fr, int fq) const {
        const int row0 = u.pm * BM + wr * 64 + fr, col0 = u.pn * BM + wc * 32 + 8 * fq;
#pragma unroll
        for (int ai = 0; ai < 2; ++ai)
#pragma unroll
            for (int m = 0; m < 4; ++m) { const int row = row0 + ai * HALF + m * 16; const float g = sgate[row]; bf16_t* rowp = O + (size_t)row * D + col0;
#pragma unroll
                for (int bj = 0; bj < 2; ++bj) { const f32x4 v0 = acc[ai][bj][m][0] * g, v1 = acc[ai][bj][m][1] * g;
                    u32x4 w; w.x = cvt_pk_bf16(v0[0], v0[1]); w.y = cvt_pk_bf16(v0[2], v0[3]); w.z = cvt_pk_bf16(v1[0], v1[1]); w.w = cvt_pk_bf16(v1[2], v1[3]);
                    *(u32x4*)(rowp + bj * HALF) = w; } }
    }
};

template <class Epi, class Sched, bool GATHER>
__device__ __forceinline__ void gemm_phase(LAS unsigned char* lds, const Sched& S, const Epi& E) {
    const int tid = threadIdx.x, wid = __builtin_amdgcn_readfirstlane(tid >> 6), lane = tid & 63, wr = wid >> 2, wc = wid & 3, fr = lane & 15, fq = lane >> 4;
    const int K = S.K, nt = K / BK;
    unsigned voffA[2], voffB[2]; int RA[2], CA[2];
#pragma unroll
    for (int i = 0; i < 2; ++i) { int R, C; stage_rc(tid * 16 + i * 8192, R, C); const int Rb = Epi::PERM ? ((R & ~31) + perm32(R & 31)) : R;
        RA[i] = R; CA[i] = C; voffA[i] = (unsigned)(R * K + C) * 2u; voffB[i] = (unsigned)(Rb * K + C) * 2u; }
    const size_t kstep = (size_t)(BK * 2);
    const size_t hstep = (size_t)HALF * K * 2;
    const unsigned ldsw = (unsigned)wid * 1024u;
    const int aoff = lds_byte(wr * 64 + fr, fq * 8), boff = lds_byte(wc * 32 + fr, fq * 8);
#define PG8_SA(b, h) (((b) * 2 + (h)) * HTB)
#define PG8_SB(b, h) ((4 + (b) * 2 + (h)) * HTB)
#define PG8_DMA(bufoff, gptr, i) __builtin_amdgcn_global_load_lds((const unsigned*)(gptr), (LAS unsigned*)(lds + (bufoff) + ldsw + (i) * 8192), 16, 0, 0)
#define PG8_STAGE(bufoff, gbase, voff) do { PG8_DMA(bufoff, (const char*)(gbase) + (voff)[0], 0); PG8_DMA(bufoff, (const char*)(gbase) + (voff)[1], 1); } while (0)
#define PG8_STAGE_A(bufoff, nx, h, kb) do { if constexpr (GATHER) { \
            PG8_DMA(bufoff, S.A + (kb) + ((nx) ? gN[h][0] : gC[h][0]), 0); PG8_DMA(bufoff, S.A + (kb) + ((nx) ? gN[h][1] : gC[h][1]), 1); } \
        else { const char* _b = ((nx) ? nA : cA) + (h) * hstep + (kb); PG8_DMA(bufoff, _b + voffA[0], 0); PG8_DMA(bufoff, _b + voffA[1], 1); } } while (0)
#define PG8_LDA(dst, b, h) do { _Pragma("unroll") for (int m = 0; m < 4; ++m) _Pragma("unroll") for (int k = 0; k < 2; ++k) dst[m][k] = *(const LAS bf16x8*)(lds + PG8_SA(b, h) + aoff + m * 2048 + k * 1024); } while (0)
#define PG8_LDB(dst, b, h) do { _Pragma("unroll") for (int n = 0; n < 2; ++n) _Pragma("unroll") for (int k = 0; k < 2; ++k) dst[n][k] = *(const LAS bf16x8*)(lds + PG8_SB(b, h) + boff + n * 2048 + k * 1024); } while (0)
#define PG8_MMA(ai, bj, At, Bt) do { __builtin_amdgcn_s_setprio(1); _Pragma("unroll") for (int m = 0; m < 4; ++m) _Pragma("unroll") for (int n = 0; n < 2; ++n) _Pragma("unroll") for (int k = 0; k < 2; ++k) \
        acc[ai][bj][m][n] = __builtin_amdgcn_mfma_f32_16x16x32_bf16(Bt[n][k], At[m][k], acc[ai][bj][m][n], 0, 0, 0); __builtin_amdgcn_s_setprio(0); } while (0)
#define PG8_WAIT_V(n) asm volatile("s_waitcnt vmcnt(" #n ")" ::: "memory")
#define PG8_WAIT_L(n) asm volatile("s_waitcnt lgkmcnt(" #n ")" ::: "memory")
#define PG8_BAR __builtin_amdgcn_s_barrier()
#define PG8_SCHED __builtin_amdgcn_sched_barrier(0)
    Unit cur, nxt; int ui = 0;
    if (!S.next(0, cur)) return;
    unsigned gC[2][2] = {{0u, 0u}, {0u, 0u}}, gN[2][2] = {{0u, 0u}, {0u, 0u}};
    if constexpr (GATHER) {
#pragma unroll
        for (int h = 0; h < 2; ++h)
#pragma unroll
            for (int i = 0; i < 2; ++i) gC[h][i] = (unsigned)(S.row(0, h * HALF + RA[i]) * K + CA[i]) * 2u;
    }
    f32x4 acc[2][2][4][2];
#pragma unroll
    for (int a = 0; a < 2; ++a)
#pragma unroll
        for (int b = 0; b < 2; ++b)
#pragma unroll
            for (int m = 0; m < 4; ++m)
#pragma unroll
                for (int n = 0; n < 2; ++n) acc[a][b][m][n] = (f32x4){0.f, 0.f, 0.f, 0.f};
    bf16x8 At[4][2], B0[2][2], B1[2][2];
    const char* cA = cur.a; const char* cB = cur.b; const char* nA = cA; const char* nB = cB;
    PG8_STAGE(PG8_SB(0, 0), cB, voffB); PG8_STAGE(PG8_SB(0, 1), cB + hstep, voffB); PG8_STAGE_A(PG8_SA(0, 0), false, 0, 0); PG8_STAGE_A(PG8_SA(0, 1), false, 1, 0);
    if (wr == 1) PG8_BAR;
    PG8_WAIT_V(2); PG8_BAR;
    PG8_STAGE(PG8_SB(1, 0), cB + kstep, voffB); PG8_STAGE_A(PG8_SA(1, 0), false, 0, kstep); PG8_STAGE(PG8_SB(1, 1), cB + hstep + kstep, voffB);
    PG8_WAIT_V(6); PG8_BAR;
    for (;;) {
        const bool has_next = S.next(ui + 1, nxt);
        nA = has_next ? nxt.a : cA; nB = has_next ? nxt.b : cB;
        if constexpr (GATHER) {
            const int nord = has_next ? ui + 1 : ui;
#pragma unroll
            for (int h = 0; h < 2; ++h)
#pragma unroll
                for (int i = 0; i < 2; ++i) gN[h][i] = (unsigned)(S.row(nord, h * HALF + RA[i]) * K + CA[i]) * 2u;
        }
        for (int t = 0; t < nt; t += 2) {
            const bool last = (t == nt - 2);
            const size_t k1 = (size_t)(t + 1) * kstep;
            const size_t k2 = last ? 0 : (size_t)(t + 2) * kstep, k3 = k2 + kstep;
            const char* b2 = (last ? nB : cB) + k2; const char* b3 = b2 + kstep;
            PG8_LDB(B0, 0, 0); PG8_LDB(B1, 0, 1); PG8_SCHED; PG8_LDA(At, 0, 0); PG8_STAGE_A(PG8_SA(1, 1), false, 1, k1);
            PG8_WAIT_V(8); PG8_WAIT_L(0); PG8_BAR; PG8_MMA(0, 0, At, B0); PG8_MMA(0, 1, At, B1); PG8_BAR; PG8_SCHED;
            PG8_LDA(At, 0, 1); PG8_STAGE(PG8_SB(0, 0), b2, voffB); PG8_STAGE(PG8_SB(0, 1), b2 + hstep, voffB); PG8_STAGE_A(PG8_SA(0, 0), last, 0, k2);
            PG8_WAIT_V(8); PG8_WAIT_L(0); PG8_BAR; PG8_MMA(1, 0, At, B0); PG8_MMA(1, 1, At, B1); PG8_BAR; PG8_SCHED;
            PG8_LDB(B0, 1, 0); PG8_LDB(B1, 1, 1); PG8_SCHED; PG8_LDA(At, 1, 0); PG8_STAGE_A(PG8_SA(0, 1), last, 1, k2);
            PG8_WAIT_V(8); PG8_WAIT_L(0); PG8_BAR; PG8_MMA(0, 0, At, B0); PG8_MMA(0, 1, At, B1); PG8_BAR; PG8_SCHED;
            PG8_LDA(At, 1, 1); PG8_STAGE(PG8_SB(1, 0), b3, voffB); PG8_STAGE(PG8_SB(1, 1), b3 + hstep, voffB); PG8_STAGE_A(PG8_SA(1, 0), last, 0, k3);
            PG8_WAIT_V(8); PG8_WAIT_L(0); PG8_BAR; PG8_MMA(1, 0, At, B0); PG8_MMA(1, 1, At, B1); PG8_BAR; PG8_SCHED;
        }
        if (wr == 0) PG8_BAR;
        E(acc, cur, wr, wc, fr, fq);
        if (!has_next) break;
#pragma unroll
        for (int a = 0; a < 2; ++a)
#pragma unroll
            for (int b = 0; b < 2; ++b)
#pragma unroll
                for (int m = 0; m < 4; ++m)
#pragma unroll
                    for (int n = 0; n < 2; ++n) acc[a][b][m][n] = (f32x4){0.f, 0.f, 0.f, 0.f};
        cur = nxt; cA = nA; cB = nB; ++ui;
        if constexpr (GATHER) {
#pragma unroll
            for (int h = 0; h < 2; ++h)
#pragma unroll
                for (int i = 0; i < 2; ++i) gC[h][i] = gN[h][i];
        }
        if (wr == 1) PG8_BAR;
    }
    PG8_WAIT_V(0);
    PG8_BAR;
#undef PG8_SA
#undef PG8_SB
#undef PG8_DMA
#undef PG8_STAGE
#undef PG8_STAGE_A
#undef PG8_LDA
#undef PG8_LDB
#undef PG8_MMA
#undef PG8_WAIT_V
#undef PG8_WAIT_L
#undef PG8_BAR
#undef PG8_SCHED
}
}

struct Params { const float* in[27]; float* out; unsigned char* ws; int ph_lo, ph_hi; };
struct Ctx { LAS unsigned char* lds; int tid, lane, wave, vcu, G, gw, NGW; };
enum { I_X = 0, I_C, I_MODW, I_MODB, I_N1G, I_WIN, I_CONVK, I_CONVB, I_CLNG, I_CLNB, I_QNG, I_KVNG, I_WUQ, I_WUK, I_WUV, I_POOLW, I_POOLS, I_WOUT, I_N2G, I_RGW, I_RGB, I_REW, I_REB, I_W1, I_W3, I_W2, I_FG };

template <class RowMap>
__device__ __forceinline__ void tr_item(const float* src, int ldn, int k0, int n0, int nvalid, bf16_t* dst, int ldk, int dk0, RowMap rm, LAS float* scr, int lane) {
#pragma unroll 8
    for (int i = 0; i < 32; ++i) { const int kk = 2 * i + (lane >> 5), n = n0 + (lane & 31); scr[kk * 33 + (lane & 31)] = (n < nvalid) ? src[(size_t)(k0 + kk) * ldn + n] : 0.f; }
    LDS_WAIT();
    const int c = lane & 7;
#pragma unroll
    for (int j = 0; j < 4; ++j) { const int n = (lane >> 3) + 8 * j; const LAS float* s = scr + (8 * c) * 33 + n;
        u32x4 o; o.x = cvt_pk_bf16(s[0 * 33], s[1 * 33]); o.y = cvt_pk_bf16(s[2 * 33], s[3 * 33]); o.z = cvt_pk_bf16(s[4 * 33], s[5 * 33]); o.w = cvt_pk_bf16(s[6 * 33], s[7 * 33]);
        *(u32x4*)(dst + (size_t)rm(n0 + n) * ldk + dk0 + k0 + 8 * c) = o; }
    LDS_WAIT();
}

__device__ __forceinline__ void conv_experts(const Params& p, const Ctx& c, int l) {
    LAS float* scr = (LAS float*)(c.lds + c.wave * 8448);
    bf16_t* W13 = (bf16_t*)(p.ws + WS_W13); bf16_t* W2 = (bf16_t*)(p.ws + WS_W2);
    for (int it = c.gw; it < 3 * 8192; it += c.NGW) {
        const int which = it >> 13, r = it & 8191, e = r >> 8;
        if (which < 2) { const int kb = (r >> 4) & 15, nb = r & 15; const float* src = p.in[which ? I_W3 : I_W1] + (size_t)(l * NEXP + e) * 1024 * 512; const int add = which ? 4 : 0;
            tr_item(src, 512, 64 * kb, 32 * nb, 512, W13 + (size_t)e * 1024 * 1024, 1024, 0, [add](int n) { return 8 * (n >> 2) + (n & 3) + add; }, scr, c.lane); }
        else { const int kb = (r >> 5) & 7, nb = r & 31; const float* src = p.in[I_W2] + (size_t)(l * NEXP + e) * 512 * 1024;
            tr_item(src, 1024, 64 * kb, 32 * nb, 1024, W2 + (size_t)e * 1024 * 512, 512, 0, [](int n) { return n; }, scr, c.lane); }
    }
}

__device__ __forceinline__ void cx_issue(const Params& p, int l, int it, int lane, float (&tv)[32]) {
    const int which = it >> 13, r = it & 8191, e = r >> 8;
    const float* src; int ldn, k0, n0;
    if (which < 2) { const int kb = (r >> 4) & 15, nb = r & 15; src = p.in[which ? I_W3 : I_W1] + (size_t)(l * NEXP + e) * 1024 * 512; ldn = 512; k0 = 64 * kb; n0 = 32 * nb; }
    else { const int kb = (r >> 5) & 7, nb = r & 31; src = p.in[I_W2] + (size_t)(l * NEXP + e) * 512 * 1024; ldn = 1024; k0 = 64 * kb; n0 = 32 * nb; }
    const float* s0 = src + (size_t)(k0 + (lane >> 5)) * ldn + n0 + (lane & 31);
#pragma unroll
    for (int i = 0; i < 32; ++i) tv[i] = s0[(size_t)(2 * i) * ldn];
}
__device__ __forceinline__ void cx_finish(const Params& p, int it, int lane, const float (&tv)[32], LAS float* scr) {
    const int which = it >> 13, r = it & 8191, e = r >> 8;
    bf16_t* dst; int ldk, k0, n0, add = 0; bool inter = false;
    if (which < 2) { const int kb = (r >> 4) & 15, nb = r & 15; dst = (bf16_t*)(p.ws + WS_W13) + (size_t)e * 1024 * 1024; ldk = 1024; k0 = 64 * kb; n0 = 32 * nb; add = which ? 4 : 0; inter = true; }
    else { const int kb = (r >> 5) & 7, nb = r & 31; dst = (bf16_t*)(p.ws + WS_W2) + (size_t)e * 1024 * 512; ldk = 512; k0 = 64 * kb; n0 = 32 * nb; }
#pragma unroll
    for (int i = 0; i < 32; ++i) scr[(2 * i + (lane >> 5)) * 33 + (lane & 31)] = tv[i];
    LDS_WAIT();
    const int cc = lane & 7;
#pragma unroll
    for (int j = 0; j < 4; ++j) { const int n = (lane >> 3) + 8 * j; const LAS float* sp = scr + (8 * cc) * 33 + n; const int nn = n0 + n; const int row = inter ? (8 * (nn >> 2) + (nn & 3) + add) : nn;
        u32x4 o; o.x = cvt_pk_bf16(sp[0 * 33], sp[1 * 33]); o.y = cvt_pk_bf16(sp[2 * 33], sp[3 * 33]); o.z = cvt_pk_bf16(sp[4 * 33], sp[5 * 33]); o.w = cvt_pk_bf16(sp[6 * 33], sp[7 * 33]);
        *(u32x4*)(dst + (size_t)row * ldk + k0 + 8 * cc) = o; }
    LDS_WAIT();
}

__device__ __forceinline__ void ph_prologue(const Params& p, const Ctx& c) {
    float* mod = (float*)(p.ws + WS_MOD);
    {
        LAS float* cond = (LAS float*)c.lds; LAS float* part = (LAS float*)(c.lds + 65536);
        bool loaded = false;
        for (int item = c.vcu; item < 192; item += c.G) {
            if (!loaded) { for (int i = c.tid; i < NB * D; i += 512) { const float v = p.in[I_C][i]; cond[i] = v / (1.0f + expf(-v)); } __syncthreads(); loaded = true; }
            const int l = item / 96, n0 = (item % 96) * 64;
            const float* W = p.in[I_MODW] + (size_t)l * D * 6144 + n0 + c.lane;
            float acc[NB];
#pragma unroll
            for (int b = 0; b < NB; ++b) acc[b] = 0.f;
#pragma unroll 8
            for (int k = c.wave * 128; k < c.wave * 128 + 128; ++k) { const float w = W[(size_t)k * 6144];
#pragma unroll
                for (int b = 0; b < NB; ++b) acc[b] += cond[b * D + k] * w; }
#pragma unroll
            for (int b = 0; b < NB; ++b) part[(c.wave * NB + b) * 64 + c.lane] = acc[b];
            __syncthreads();
            for (int o = c.tid; o < NB * 64; o += 512) { const int b = o >> 6, ln = o & 63; float s = 0.f;
#pragma unroll
                for (int w = 0; w < 8; ++w) s += part[(w * NB + b) * 64 + ln];
                mod[(size_t)(l * NB + b) * 6144 + n0 + ln] = s + p.in[I_MODB][l * 6144 + n0 + ln]; }
            __syncthreads();
        }
        __syncthreads();
    }
    {
        LAS float* scr = (LAS float*)(c.lds + c.wave * 8448);
        constexpr int I_IN = 16 * 56;
        for (int it = c.gw; it < 2 * I_IN; it += c.NGW) {
            const int l = it / I_IN, r = it % I_IN, kb = r / 56, nb = r % 56;
            tr_item(p.in[I_WIN] + (size_t)l * D * N_IN, N_IN, 64 * kb, 32 * nb, N_IN, (bf16_t*)(p.ws + WS_WIN) + (size_t)l * NZ * D, D, 0, [](int n) { return n; }, scr, c.lane);
        }
    }
}
__device__ __forceinline__ void ph_prologue_rest(const Params& p, const Ctx& c, int wid, int nw) {
    {
        LAS float* scr = (LAS float*)(c.lds + c.wave * 8448);
        constexpr int I_MX = 4 * 32;
        for (int it = wid; it < 2 * 2 * I_MX; it += nw) {
            const int l = it / (2 * I_MX); int r = it % (2 * I_MX); const int part = r / I_MX; r %= I_MX; const int kb = r / 32, nb = r % 32;
            tr_item(p.in[I_WOUT] + (size_t)l * D * D + (size_t)(part ? 768 : 0) * D, D, 64 * kb, 32 * nb, D, (bf16_t*)(p.ws + WS_WMIX) + (size_t)l * D * KMIX, KMIX, part ? 1280 : 0, [](int n) { return n; }, scr, c.lane);
        }
    }
    for (int it = wid * 64 + c.lane; it < 2 * 131072; it += nw * 64) {
        const int l = it >> 17, r = it & 131071, n = r & 1023, h = (r >> 10) & 7, cb = r >> 13;
        const float* wo = p.in[I_WOUT] + (size_t)l * D * D + (size_t)(256 + 64 * h) * D + n;
        const float* wv = p.in[I_WUV] + (size_t)l * 128 * 512 + (size_t)(8 * cb) * 512 + h * 64;
        float acc[8];
#pragma unroll
        for (int j = 0; j < 8; ++j) acc[j] = 0.f;
        for (int d0 = 0; d0 < 64; d0 += 16) { float w[16];
#pragma unroll
            for (int q = 0; q < 16; ++q) w[q] = wo[(size_t)(d0 + q) * D];
#pragma unroll
            for (int j = 0; j < 8; ++j) { asm volatile("" ::: "memory");
#pragma unroll
                for (int q = 0; q < 16; q += 4) { const f32x4 v4 = *(const f32x4*)(wv + j * 512 + d0 + q); acc[j] += (v4.x * w[q] + v4.y * w[q + 1]) + (v4.z * w[q + 2] + v4.w * w[q + 3]); } } }
        u32x4 o; o.x = cvt_pk_bf16(acc[0], acc[1]); o.y = cvt_pk_bf16(acc[2], acc[3]); o.z = cvt_pk_bf16(acc[4], acc[5]); o.w = cvt_pk_bf16(acc[6], acc[7]);
        *(u32x4*)((bf16_t*)(p.ws + WS_WMIX) + (size_t)l * D * KMIX + (size_t)n * KMIX + 256 + 128 * h + 8 * cb) = o;
    }
    for (int it = wid * 64 + c.lane; it < 2 * 32768; it += nw * 64) {
        const int l = it >> 15, r = it & 32767, cb = r & 31, k = (r >> 5) & 127, h = r >> 12;
        const float* uq = p.in[I_WUQ] + (size_t)l * 256 * 512 + (size_t)(8 * cb) * 512 + h * 64;
        const float* uk = p.in[I_WUK] + (size_t)l * 128 * 512 + (size_t)k * 512 + h * 64;
        float acc[8];
#pragma unroll
        for (int j = 0; j < 8; ++j) acc[j] = 0.f;
        for (int d0 = 0; d0 < 64; d0 += 16) { f32x4 w4[4];
#pragma unroll
            for (int q = 0; q < 4; ++q) w4[q] = *(const f32x4*)(uk + d0 + 4 * q);
#pragma unroll
            for (int j = 0; j < 8; ++j) { asm volatile("" ::: "memory");
#pragma unroll
                for (int q = 0; q < 4; ++q) { const f32x4 v4 = *(const f32x4*)(uq + j * 512 + d0 + 4 * q); acc[j] += (v4.x * w4[q].x + v4.y * w4[q].y) + (v4.z * w4[q].z + v4.w * w4[q].w); } } }
        const float sc = 0.125f * 1.44269504089f;
#pragma unroll
        for (int j = 0; j < 8; ++j) acc[j] *= sc * p.in[I_QNG][l * 256 + 8 * cb + j];
        u32x4 o; o.x = cvt_pk_bf16(acc[0], acc[1]); o.y = cvt_pk_bf16(acc[2], acc[3]); o.z = cvt_pk_bf16(acc[4], acc[5]); o.w = cvt_pk_bf16(acc[6], acc[7]);
        *(u32x4*)((bf16_t*)(p.ws + WS_WQA) + (size_t)l * D * 256 + (size_t)(h * 128 + k) * 256 + 8 * cb) = o;
    }
    for (int it = wid * 64 + c.lane; it < 2 * 1024 * 32; it += nw * 64) {
        const int l = it >> 15, r = it & 32767, k = r >> 5, g = (r >> 3) & 3, q = r & 7, e = k & 3, ln = (k >> 2) & 63, j = k >> 8;
        ((float*)(p.ws + WS_SMALL + SM_REW2))[(size_t)(l * 4 + g) * 8192 + (size_t)((((j * 4 + e) * 2 + (q >> 2)) * 64 + ln) * 4) + (q & 3)] = p.in[I_REW][(size_t)l * D * 32 + r];
    }
    for (int it = wid * 64 + c.lane; it < 2 * 1024 * 4; it += nw * 64) {
        const int l = it >> 12, r = it & 4095, k = r >> 2, q = r & 3, e = k & 3, ln = (k >> 2) & 63, j = k >> 8;
        ((float*)(p.ws + WS_SMALL + SM_RGW2))[(size_t)l * 4096 + (size_t)(((j * 4 + e) * 64 + ln) * 4) + q] = p.in[I_RGW][(size_t)l * D * 4 + r];
    }
}

template <int MODE>
__device__ __forceinline__ void ph_norm1(const Params& p, const Ctx& c) {
    const float* mod = (const float*)(p.ws + WS_MOD);
    const bf16_t* Y = (const bf16_t*)(p.ws + WS_Y); const int* tslot = (const int*)(p.ws + WS_SMALL + SM_TSLOT);
    bf16_t* H = (bf16_t*)(p.ws + WS_H); bf16_t* X16 = (bf16_t*)(p.ws + WS_X16);
    constexpr int NR = (MODE == 0) ? 4 : 2;
    const int nrow = T / c.NGW;
    f32x4 vn[NR][4]; u32x2 xn[NR][4], an[NR][4], bn[NR][4];
    auto load_rows = [&](int r0) {
#pragma unroll
        for (int t = 0; t < NR; ++t) { const int m = c.gw + (r0 + t) * c.NGW;
            if (MODE == 0) {
#pragma unroll
                for (int j = 0; j < 4; ++j) vn[t][j] = ((const f32x4*)(p.in[I_X] + (size_t)m * D) + c.lane)[64 * j];
            } else { const int s0 = tslot[2 * m], s1 = tslot[2 * m + 1];
#pragma unroll
                for (int j = 0; j < 4; ++j) { xn[t][j] = ((const u32x2*)(X16 + (size_t)m * D) + c.lane)[64 * j]; an[t][j] = ((const u32x2*)(Y + (size_t)s0 * D) + c.lane)[64 * j]; bn[t][j] = ((const u32x2*)(Y + (size_t)s1 * D) + c.lane)[64 * j]; } } } };
    load_rows(0);
    for (int r0 = 0; r0 < nrow; r0 += NR) {
        f32x4 v[NR][4]; u32x2 ya[NR][4], yb[NR][4];
#pragma unroll
        for (int t = 0; t < NR; ++t)
#pragma unroll
            for (int j = 0; j < 4; ++j) { if (MODE == 0) v[t][j] = vn[t][j]; else { v[t][j] = (f32x4){bflo(xn[t][j].x), bfhi(xn[t][j].x), bflo(xn[t][j].y), bfhi(xn[t][j].y)}; ya[t][j] = an[t][j]; yb[t][j] = bn[t][j]; } }
        if (r0 + NR < nrow) load_rows(r0 + NR);
#pragma unroll
        for (int t = 0; t < NR; ++t) {
            const int m = c.gw + (r0 + t) * c.NGW, b = m >> 11;
            if (MODE != 0) {
                const f32x4* g2 = (const f32x4*)(mod + (size_t)((MODE - 1) * NB + b) * 6144 + 5120) + c.lane;
#pragma unroll
                for (int j = 0; j < 4; ++j) { const u32x2 a = ya[t][j], bb = yb[t][j]; const f32x4 g = g2[64 * j];
                    v[t][j].x += g.x * (bflo(a.x) + bflo(bb.x)); v[t][j].y += g.y * (bfhi(a.x) + bfhi(bb.x)); v[t][j].z += g.z * (bflo(a.y) + bflo(bb.y)); v[t][j].w += g.w * (bfhi(a.y) + bfhi(bb.y)); }
            }
            float ss = 0.f;
#pragma unroll
            for (int j = 0; j < 4; ++j) ss += (v[t][j].x * v[t][j].x + v[t][j].y * v[t][j].y) + (v[t][j].z * v[t][j].z + v[t][j].w * v[t][j].w);
            const float r = 1.0f / sqrtf(wave_sum(ss) * (1.0f / D) + EPS);
            if (MODE == 2) {
                const f32x4* fg = (const f32x4*)p.in[I_FG] + c.lane; f32x4* o = (f32x4*)(p.out + (size_t)m * D) + c.lane;
#pragma unroll
                for (int j = 0; j < 4; ++j) o[64 * j] = v[t][j] * r * fg[64 * j];
            } else {
                if (MODE == 1) { u32x2* o = (u32x2*)(X16 + (size_t)m * D) + c.lane;
#pragma unroll
                    for (int j = 0; j < 4; ++j) { u32x2 w; w.x = cvt_pk_bf16(v[t][j].x, v[t][j].y); w.y = cvt_pk_bf16(v[t][j].z, v[t][j].w); o[64 * j] = w; } }
                const int l = MODE;
                const f32x4* ng = (const f32x4*)(p.in[I_N1G] + l * D) + c.lane;
                const f32x4* sh = (const f32x4*)(mod + (size_t)(l * NB + b) * 6144) + c.lane; const f32x4* sc = (const f32x4*)(mod + (size_t)(l * NB + b) * 6144 + 1024) + c.lane;
                u32x2* o8 = (u32x2*)(H + (size_t)m * D) + c.lane;
#pragma unroll
                for (int j = 0; j < 4; ++j) { const f32x4 hv = v[t][j] * r * ng[64 * j] * (sc[64 * j] + 1.0f) + sh[64 * j]; u32x2 w; w.x = cvt_pk_bf16(hv.x, hv.y); w.y = cvt_pk_bf16(hv.z, hv.w); o8[64 * j] = w; }
            }
        }
    }
}

__device__ __forceinline__ void ph_postz(const Params& p, const Ctx& c, int l) {
    const bf16_t* Z = (const bf16_t*)(p.ws + WS_Z); bf16_t* MC = (bf16_t*)p.out;
    bf16_t* CQR = (bf16_t*)(p.ws + WS_CQR); bf16_t* KVN = (bf16_t*)(p.ws + WS_KVN);
    LAS float* U = (LAS float*)c.lds;
    const int lane = c.lane, tk0 = c.wave * 8;
    for (int unit = c.vcu; unit < 512; unit += c.G) {
        const int b = unit >> 5, s0 = (unit & 31) * 64, t0 = b * S + s0;
#pragma unroll
        for (int hb = 0; hb < 2; ++hb) {   u32x2 av[6], gv[6];
#pragma unroll
            for (int q = 0; q < 6; ++q) { const int idx = c.tid + 512 * (6 * hb + q), r = idx >> 6, c4 = idx & 63; int s = s0 - 30 + r; s = s < 0 ? 0 : (s > S - 1 ? S - 1 : s);
                const bf16_t* zr = Z + (size_t)(b * S + s) * NZ + 4 * c4; av[q] = *(const u32x2*)(zr + Z_AVAL); gv[q] = *(const u32x2*)(zr + Z_AGATE); }
#pragma unroll
            for (int q = 0; q < 6; ++q) { const int idx = c.tid + 512 * (6 * hb + q), r = idx >> 6, c4 = idx & 63, s = s0 - 30 + r; f32x4 u = {0.f, 0.f, 0.f, 0.f};
                if (s >= 0) { const u32x2 a = av[q], g = gv[q];
                    u.x = bflo(a.x) * sigmoidf_(bflo(g.x)); u.y = bfhi(a.x) * sigmoidf_(bfhi(g.x)); u.z = bflo(a.y) * sigmoidf_(bflo(g.y)); u.w = bfhi(a.y) * sigmoidf_(bfhi(g.y)); }
                if (idx < 94 * 64) *(LAS f32x4*)(U + r * 256 + 4 * c4) = u; }
            asm volatile("" ::: "memory");
        }
        __syncthreads();
        {
            const f32x4* ck = (const f32x4*)(p.in[I_CONVK] + (size_t)l * 31 * 256) + lane;
            const f32x4 cb = *((const f32x4*)(p.in[I_CONVB] + l * 256) + lane), lg = *((const f32x4*)(p.in[I_CLNG] + l * 256) + lane), lb = *((const f32x4*)(p.in[I_CLNB] + l * 256) + lane);
#pragma unroll 1
            for (int hp = 0; hp < 2; ++hp) {
                const int tq = tk0 + 4 * hp;
                f32x4 acc[4], win[4];
#pragma unroll
                for (int i = 0; i < 4; ++i) { acc[i] = (f32x4){0.f, 0.f, 0.f, 0.f}; win[i] = *(const LAS f32x4*)(U + (tq + i) * 256 + 4 * lane); }
#pragma unroll
                for (int j = 0; j < 31; ++j) { const f32x4 kj = ck[64 * j];
#pragma unroll
                    for (int i = 0; i < 4; ++i) acc[i] += win[i] * kj;
                    if (j < 30) {
#pragma unroll
                        for (int i = 0; i < 3; ++i) win[i] = win[i + 1];
                        win[3] = *(const LAS f32x4*)(U + (tq + 4 + j) * 256 + 4 * lane); } }
#pragma unroll
                for (int i = 0; i < 4; ++i) { const f32x4 v = acc[i] + cb; const float mean = wave_sum((v.x + v.y) + (v.z + v.w)) * (1.0f / 256.0f);
                    const f32x4 d = v - mean; const float var = wave_sum((d.x * d.x + d.y * d.y) + (d.z * d.z + d.w * d.w)) * (1.0f / 256.0f);
                    const float rs = 1.0f / sqrtf(var + EPS); f32x4 y = d * rs * lg + lb;
                    y.x *= sigmoidf_(y.x); y.y *= sigmoidf_(y.y); y.z *= sigmoidf_(y.z); y.w *= sigmoidf_(y.w);
                    u32x2 w; w.x = cvt_pk_bf16(y.x, y.y); w.y = cvt_pk_bf16(y.z, y.w);
                    *(u32x2*)(MC + (size_t)(t0 + tq + i) * KMIX + 4 * lane) = w; }
            }
        }
        __syncthreads();
        {   u32x2 av[10];
#pragma unroll
            for (int q = 0; q < 10; ++q) { const int idx = c.tid + 512 * q, r = idx >> 6, c4 = idx & 63; int s = s0 - 15 + r; s = s < 0 ? 0 : (s > S - 1 ? S - 1 : s);
                av[q] = *(const u32x2*)(Z + (size_t)(b * S + s) * NZ + Z_UP + 4 * c4); }
#pragma unroll
            for (int q = 0; q < 10; ++q) { const int idx = c.tid + 512 * q, r = idx >> 6, c4 = idx & 63, s = s0 - 15 + r; f32x4 u = {0.f, 0.f, 0.f, 0.f};
                if (s >= 0) { const u32x2 a = av[q]; u.x = bflo(a.x); u.y = bfhi(a.x); u.z = bflo(a.y); u.w = bfhi(a.y); }
                if (idx < 79 * 64) *(LAS f32x4*)(U + r * 256 + 4 * c4) = u; }
        }
        __syncthreads();
        f32x4 dv[8];
        {
            const int w = 2 << (lane >> 4);
#pragma unroll
            for (int i = 0; i < 8; ++i) { const int r = 15 + tk0 + i, s = s0 + tk0 + i; f32x4 sum = {0.f, 0.f, 0.f, 0.f};
#pragma unroll
                for (int q = 0; q < 16; ++q) { const f32x4 u = *(const LAS f32x4*)(U + (r - q) * 256 + 4 * lane); if (q < w) sum += u; }
                const float cntf = (float)((s + 1) < w ? (s + 1) : w);
                dv[i] = sum / cntf - *(const LAS f32x4*)(U + r * 256 + 4 * lane); }
        }
        __syncthreads();
        {
            LAS float* Dw = U + c.wave * 2048;
#pragma unroll
            for (int i = 0; i < 8; ++i) *(LAS f32x4*)(Dw + i * 256 + 4 * lane) = dv[i];
            LDS_WAIT();
            const int g = lane >> 4, o4 = (lane & 15) * 4;
            const float* pw = p.in[I_POOLW] + (size_t)(l * 4 + g) * 4096 + o4;
            f32x4 out[8];
#pragma unroll
            for (int i = 0; i < 8; ++i) out[i] = (f32x4){0.f, 0.f, 0.f, 0.f};
            for (int ii = 0; ii < 64; ii += 4) {
                asm volatile("" ::: "memory");
                const f32x4 w0 = *(const f32x4*)(pw + (ii + 0) * 64), w1 = *(const f32x4*)(pw + (ii + 1) * 64), w2 = *(const f32x4*)(pw + (ii + 2) * 64), w3 = *(const f32x4*)(pw + (ii + 3) * 64);
#pragma unroll
                for (int i = 0; i < 8; ++i) { const f32x4 d = *(const LAS f32x4*)(Dw + i * 256 + 64 * g + ii); out[i] += w0 * d.x + w1 * d.y + w2 * d.z + w3 * d.w; } }
            const f32x4 ps = *((const f32x4*)(p.in[I_POOLS] + l * 256) + lane);
#pragma unroll
            for (int i = 0; i < 8; ++i) { const f32x4 y = out[i] * ps; u32x2 w; w.x = cvt_pk_bf16(y.x, y.y); w.y = cvt_pk_bf16(y.z, y.w);
                *(u32x2*)(MC + (size_t)(t0 + tk0 + i) * KMIX + 1280 + 4 * lane) = w; }
        }
        asm volatile("" ::: "memory");
        {
            const float kg0 = p.in[I_KVNG][l * 128 + 2 * lane], kg1 = p.in[I_KVNG][l * 128 + 2 * lane + 1];
            u32x2 qv[8]; unsigned kvv[8];
#pragma unroll
            for (int i = 0; i < 8; ++i) { const bf16_t* zr = Z + (size_t)(t0 + tk0 + i) * NZ; qv[i] = *(const u32x2*)(zr + Z_CQ + 4 * lane); kvv[i] = *(const unsigned*)(zr + Z_CKV + 2 * lane); }
#pragma unroll
            for (int i = 0; i < 8; ++i) { const size_t t = (size_t)(t0 + tk0 + i);
                const u32x2 q = qv[i]; const float q0 = bflo(q.x), q1 = bfhi(q.x), q2 = bflo(q.y), q3 = bfhi(q.y);
                const float rq = 1.0f / sqrtf(wave_sum((q0 * q0 + q1 * q1) + (q2 * q2 + q3 * q3)) * (1.0f / 256.0f) + EPS);
                u32x2 w; w.x = cvt_pk_bf16(q0 * rq, q1 * rq); w.y = cvt_pk_bf16(q2 * rq, q3 * rq); *(u32x2*)(CQR + t * 256 + 4 * lane) = w;
                const unsigned kv = kvv[i]; const float k0 = bflo(kv), k1 = bfhi(kv);
                const float rk = 1.0f / sqrtf(wave_sum(k0 * k0 + k1 * k1) * (1.0f / 128.0f) + EPS);
                *(unsigned*)(KVN + t * 128 + 2 * lane) = cvt_pk_bf16(k0 * rk * kg0, k1 * rk * kg1); }
        }
        __syncthreads();
    }
}

__device__ __forceinline__ size_t sc_off(int b, int cq) { return (size_t)b * SC_PER_B + (size_t)2048 * cq * (cq + 1); }
__device__ __forceinline__ void ph_scores(const Params& p, const Ctx& c) {
    const bf16_t* Z = (const bf16_t*)(p.ws + WS_Z); float* SC = (float*)(p.ws + WS_Y);
    const int lane = c.lane, l15 = lane & 15, g = lane >> 4;
    for (int U = c.gw; U < NB * 576; U += c.NGW) {
        const int b = U / 576, u = U % 576;
        int cg = 0; while (8 * (cg + 1) * (cg + 2) <= u) ++cg;
        const int r = u - 8 * cg * (cg + 1), q16 = r / (cg + 1), seg = r % (cg + 1), cq = 4 * cg + (q16 >> 2), q4 = q16 & 3;
        const int n = 64 * (cq + 1), kt0 = seg * 16, kt1 = (kt0 + 16 < 4 * (cq + 1)) ? kt0 + 16 : 4 * (cq + 1);
        const size_t tq = (size_t)b * S + cq * 64 + q4 * 16 + l15;
        const bf16_t* zq = Z + tq * NZ;
        bf16x8 bq[8][2];
#pragma unroll
        for (int h = 0; h < 8; ++h)
#pragma unroll
            for (int s = 0; s < 2; ++s) bq[h][s] = *(const bf16x8*)(zq + Z_QI + h * 64 + 32 * s + 8 * g);
        float wq[8];
        { const u32x4 wv = *(const u32x4*)(zq + Z_WI); const float isc = 0.044194173824159216f;
          wq[0] = bflo(wv.x) * isc; wq[1] = bfhi(wv.x) * isc; wq[2] = bflo(wv.y) * isc; wq[3] = bfhi(wv.y) * isc; wq[4] = bflo(wv.z) * isc; wq[5] = bfhi(wv.z) * isc; wq[6] = bflo(wv.w) * isc; wq[7] = bfhi(wv.w) * isc; }
        float* srow = SC + sc_off(b, cq) + (size_t)(q4 * 16 + l15) * n;
        const bf16_t* zkb = Z + ((size_t)b * S + l15) * NZ + Z_KI + 8 * g;
        bf16x8 nk0 = *(const bf16x8*)(zkb + (size_t)kt0 * 16 * NZ), nk1 = *(const bf16x8*)(zkb + (size_t)kt0 * 16 * NZ + 32);
        for (int kt = kt0; kt < kt1; ++kt) {
            const bf16x8 ak0 = nk0, ak1 = nk1;
            if (kt + 1 < kt1) { nk0 = *(const bf16x8*)(zkb + (size_t)(kt + 1) * 16 * NZ); nk1 = *(const bf16x8*)(zkb + (size_t)(kt + 1) * 16 * NZ + 32); }
            f32x4 sc = {0.f, 0.f, 0.f, 0.f};
#pragma unroll
            for (int h = 0; h < 8; ++h) { f32x4 a = {0.f, 0.f, 0.f, 0.f};
                a = __builtin_amdgcn_mfma_f32_16x16x32_bf16(ak0, bq[h][0], a, 0, 0, 0);
                a = __builtin_amdgcn_mfma_f32_16x16x32_bf16(ak1, bq[h][1], a, 0, 0, 0);
#pragma unroll
                for (int i = 0; i < 4; ++i) sc[i] += wq[h] * fmaxf(a[i], 0.f); }
            *(f32x4*)(srow + kt * 16 + 4 * g) = sc;
        }
    }
}

__device__ __forceinline__ unsigned off_b(unsigned row, unsigned ch) { return 256u * row + 16u * (ch ^ (((row & 3) << 2) | ((row >> 2) & 3))); }
template <int MODE>
__device__ __forceinline__ void ph_attn(const Params& p, const Ctx& c, int l) {
    const float* SC = (const float*)(p.ws + WS_Y); const bf16_t* QA = (const bf16_t*)(p.ws + WS_H); const bf16_t* KVN = (const bf16_t*)(p.ws + WS_KVN);
    bf16_t* MC = (bf16_t*)p.out;
    const int lane = c.lane, g = lane >> 4, hd = lane & 15;
    LAS unsigned char* tile = c.lds + c.wave * 16384;
    LAS unsigned short* lst = (LAS unsigned short*)(c.lds + LIST_OFF + c.wave * 512);
    const unsigned long long ltmask = (1ull << lane) - 1ull;
    const int xg = blockIdx.x & 7, wv = (blockIdx.x >> 3) * 8 + c.wave, nwv = (c.G >> 3) * 8;
    int cxq = 0;
    float svn[32];
#define ATT_PREFETCH(qn_) do { const int bn_ = xg + 8 * ((qn_) / S), sn_ = (qn_) % S, cn_ = sn_ >> 6, nn_ = 64 * (cn_ + 1); \
        const float* srn_ = SC + sc_off(bn_, cn_) + (size_t)(sn_ & 63) * nn_ + lane; \
        _Pragma("unroll") for (int j = 0; j < 32; ++j) svn[j] = srn_[64 * (j <= cn_ ? j : cn_)]; } while (0)
    if ((MODE & 1) && wv < 2 * S) ATT_PREFETCH(wv);
    for (int qi = wv; qi < 2 * S; qi += nwv) {
        const int b = xg + 8 * (qi / S), s = qi % S, cq = s >> 6, n = 64 * (cq + 1), nk = n < 256 ? n : 256;
        const size_t t = (size_t)b * S + s;
        float sv[32];
#pragma unroll
        for (int j = 0; j < 32; ++j) sv[j] = svn[j];
        if ((MODE & 1) && qi + nwv < 2 * S) ATT_PREFETCH(qi + nwv);
        float tv[32]; const int cit = c.gw + c.NGW * cxq; const bool cxv = (MODE & 8) && cit < 3 * 8192;
        if (cxv) cx_issue(p, l, cit, lane, tv);
        if (cq < 4 || !(MODE & 1)) { for (int i = lane; i < nk; i += 64) lst[i] = (unsigned short)i; }
        else {
            unsigned key[32]; unsigned kmin = 0xffffffffu, kmax = 0u;
#pragma unroll
            for (int j = 0; j < 32; ++j) key[j] = 0u;
#pragma unroll
            for (int jb = 0; jb < 4; ++jb) if (8 * jb <= cq) {
#pragma unroll
                for (int j = 8 * jb; j < 8 * jb + 8; ++j) { const unsigned u = __float_as_uint(sv[j] + 0.0f); const unsigned k = (u & 0x80000000u) ? ~u : (u | 0x80000000u);
                    key[j] = (j <= cq) ? k : 0u; kmin = (j <= cq && k < kmin) ? k : kmin; kmax = (j <= cq && k > kmax) ? k : kmax; } }
#define KMM(W) { const unsigned a = lane_xor<W>(kmin), bb = lane_xor<W>(kmax); kmin = a < kmin ? a : kmin; kmax = bb > kmax ? bb : kmax; }
            KMM(1) KMM(2) KMM(4) KMM(8) KMM(16) KMM(32)
#undef KMM
            unsigned lo = __builtin_amdgcn_readfirstlane(kmin), hi = __builtin_amdgcn_readfirstlane(kmax); int c_lo = n, c_hi = 0; int it = 0;
            unsigned thr = 0u; int need = 0; bool done = false;
            while (lo < hi && (c_lo - c_hi) > 64) {
                unsigned mid;
                if (it < 20) {
                    const float lo_v = __uint_as_float((lo & 0x80000000u) ? (lo ^ 0x80000000u) : ~lo), hi_v = __uint_as_float((hi & 0x80000000u) ? (hi ^ 0x80000000u) : ~hi);
                    const float f = (it & 1) ? 0.5f : (float)(c_lo - 256) / (float)(c_lo - c_hi);
                    const float mid_v = lo_v + (hi_v - lo_v) * f + 0.0f;
                    const unsigned mu = __float_as_uint(mid_v); mid = (mu & 0x80000000u) ? ~mu : (mu | 0x80000000u);
                } else mid = lo + ((hi - lo) >> 1) + 1u;
                mid = mid > lo ? mid : lo + 1u; mid = mid < hi ? mid : hi;
                int cnt = 0;
#pragma unroll
                for (int jb = 0; jb < 4; ++jb) if (8 * jb <= cq) {
                    unsigned long long bm[8];
#pragma unroll
                    for (int j = 0; j < 8; ++j) bm[j] = __ballot(key[8 * jb + j] >= mid);
#pragma unroll
                    for (int j = 0; j < 8; ++j) cnt += __builtin_popcountll(bm[j]); }
                if (cnt >= 256) { lo = mid; c_lo = cnt; if (cnt == 256) { thr = mid; need = 1 << 20; done = true; break; } } else { hi = mid - 1u; c_hi = cnt; }
                ++it;
            }
            if (!done) {
                if (lo == hi) {
                    thr = lo; int cgt = 0;
#pragma unroll
                    for (int j = 0; j < 32; ++j) cgt += __builtin_popcountll(__ballot(key[j] > thr));
                    need = 256 - cgt;
                } else {
                    LAS unsigned* cand = (LAS unsigned*)lst; int base = 0;
#pragma unroll
                    for (int jb = 0; jb < 4; ++jb) if (8 * jb <= cq) {
#pragma unroll
                        for (int j = 8 * jb; j < 8 * jb + 8; ++j) { const bool isc = key[j] >= lo && key[j] <= hi; const unsigned long long bc = __ballot(isc);
                            if (isc) cand[base + __builtin_popcountll(bc & ltmask)] = key[j]; base += __builtin_popcountll(bc); } }
                    const int m = base;
                    const unsigned ck = lane < m ? cand[lane] : 0u;
                    int gt = 0, ge = 0;
                    for (int q = 0; q < m; ++q) { const unsigned v = (unsigned)__builtin_amdgcn_readlane((int)ck, q); gt += v > ck; ge += v >= ck; }
                    const int r = 256 - c_hi;
                    const unsigned long long hit = __ballot(lane < m && gt < r && r <= ge);
                    const int src = __builtin_ctzll(hit);
                    thr = __shfl(ck, src); need = r - __shfl(gt, src);
                }
            }
            asm volatile("" ::: "memory");
            {
                int base = 0, tb = 0;
#pragma unroll
                for (int jb = 0; jb < 4; ++jb) if (8 * jb <= cq) {
#pragma unroll
                    for (int j = 8 * jb; j < 8 * jb + 8; ++j) {
                        const bool gt = key[j] > thr, tie = key[j] == thr; const unsigned long long bt = __ballot(tie);
                        const int trank = tb + __builtin_popcountll(bt & ltmask); const bool sel = gt || (tie && trank < need);
                        const unsigned long long bs = __ballot(sel); const int pos = base + __builtin_popcountll(bs & ltmask);
                        if (sel && pos < 256) lst[pos] = (unsigned short)(64 * j + lane);
                        base += __builtin_popcountll(bs); tb += __builtin_popcountll(bt); } }
            }
        }
        bf16x8 qf[4];
#pragma unroll
        for (int ks = 0; ks < 4; ++ks) { qf[ks] = (bf16x8){0, 0, 0, 0, 0, 0, 0, 0}; if (hd < 8) qf[ks] = *(const bf16x8*)(QA + t * D + hd * 128 + 32 * ks + 8 * g); }
        float m_ref = -INFINITY, l_run = 0.f;
        f32x4 o[8];
#pragma unroll
        for (int ct = 0; ct < 8; ++ct) o[ct] = (f32x4){0.f, 0.f, 0.f, 0.f};
        const char* kvb = (const char*)(KVN + (size_t)b * S * 128);
        const int ntile = nk >> 5;
        LDS_WAIT();
#define ATT_ISSUE(kt_, buf_) do { const u32x4 kq_ = *(const LAS u32x4*)(lst + (kt_) * 32 + 8 * g); _Pragma("unroll") for (int i = 0; i < 8; ++i) { const int r = 4 * i + g; \
            const unsigned key_ = (i & 1) ? (kq_[i >> 1] >> 16) : (kq_[i >> 1] & 0xffffu); \
            const unsigned ch = (unsigned)hd ^ (unsigned)(((r & 3) << 2) | ((r >> 2) & 3)); \
            if (MODE & 2) __builtin_amdgcn_global_load_lds((const unsigned*)(kvb + key_ * 256u + ch * 16u), (LAS unsigned*)(tile + (buf_) * 8192 + i * 1024), 16, 0, 0); } } while (0)
        ATT_ISSUE(0, 0);
        for (int kt = 0; kt < ntile; ++kt) {
            LAS unsigned char* tb_ = tile + (kt & 1) * 8192;
            if (kt + 1 < ntile) { ATT_ISSUE(kt + 1, (kt + 1) & 1); asm volatile("s_waitcnt vmcnt(8)" ::: "memory"); }
            else asm volatile("s_waitcnt vmcnt(0)" ::: "memory");
            if (!(MODE & 4)) continue;
            f32x4 sa[2]; bf16x8 af[2][4];
#pragma unroll
            for (int rb = 0; rb < 2; ++rb)
#pragma unroll
                for (int ks = 0; ks < 4; ++ks) af[rb][ks] = *(const LAS bf16x8*)(tb_ + off_b(16 * rb + hd, 4 * ks + g));
#pragma unroll
            for (int rb = 0; rb < 2; ++rb) { sa[rb] = (f32x4){0.f, 0.f, 0.f, 0.f};
#pragma unroll
                for (int ks = 0; ks < 4; ++ks) sa[rb] = __builtin_amdgcn_mfma_f32_16x16x32_bf16(af[rb][ks], qf[ks], sa[rb], 0, 0, 0); }
            float mx = fmaxf(fmaxf(fmaxf(sa[0][0], sa[0][1]), fmaxf(sa[0][2], sa[0][3])), fmaxf(fmaxf(sa[1][0], sa[1][1]), fmaxf(sa[1][2], sa[1][3])));
            if (__ballot(mx > m_ref + 40.0f) != 0ull) {
                mx = fmaxf(mx, lane_xor<16>(mx)); mx = fmaxf(mx, lane_xor<32>(mx));
                const float m_new = fmaxf(m_ref, mx), alpha = __builtin_amdgcn_exp2f(m_ref - m_new);
                l_run *= alpha; m_ref = m_new;
#pragma unroll
                for (int ct = 0; ct < 8; ++ct) o[ct] *= alpha;
            }
            float pr[8], ps = 0.f;
#pragma unroll
            for (int j = 0; j < 8; ++j) { pr[j] = __builtin_amdgcn_exp2f(sa[j >> 2][j & 3] - m_ref); ps += pr[j]; }
            l_run += ps;
            u32x4 pw; pw.x = cvt_pk_bf16(pr[0], pr[1]); pw.y = cvt_pk_bf16(pr[2], pr[3]); pw.z = cvt_pk_bf16(pr[4], pr[5]); pw.w = cvt_pk_bf16(pr[6], pr[7]);
            const bf16x8 pb = __builtin_bit_cast(bf16x8, pw);
            const unsigned q4 = (unsigned)hd >> 2, p4 = (unsigned)hd & 3;
#pragma unroll
            for (int ct = 0; ct < 8; ++ct) {
                const bf16x4 vlo = __builtin_amdgcn_ds_read_tr16_b64_v4i16((LAS bf16x4*)(tb_ + off_b(4 * g + q4, 2 * ct + (p4 >> 1)) + 8 * (p4 & 1)));
                const bf16x4 vhi = __builtin_amdgcn_ds_read_tr16_b64_v4i16((LAS bf16x4*)(tb_ + off_b(16 + 4 * g + q4, 2 * ct + (p4 >> 1)) + 8 * (p4 & 1)));
                const bf16x8 va = __builtin_shufflevector(vlo, vhi, 0, 1, 2, 3, 4, 5, 6, 7);
                o[ct] = __builtin_amdgcn_mfma_f32_16x16x32_bf16(va, pb, o[ct], 0, 0, 0);
            }
            LDS_WAIT();
        }
#undef ATT_ISSUE
        float lt = l_run + lane_xor<16>(l_run); lt += lane_xor<32>(lt);
        const float inv = 1.0f / lt;
        if (hd < 8 && ((MODE & 8) || lt == 12345.678f)) {
#pragma unroll
            for (int ct = 0; ct < 8; ++ct) { const f32x4 v = o[ct] * inv; u32x2 w; w.x = cvt_pk_bf16(v.x, v.y); w.y = cvt_pk_bf16(v.z, v.w);
                *(u32x2*)(MC + t * KMIX + 256 + hd * 128 + 16 * ct + 4 * g) = w; }
        }
        if (cxv) cx_finish(p, cit, lane, tv, (LAS float*)tile);
        ++cxq;
    }
#undef ATT_PREFETCH
    for (; (MODE & 8) && c.gw + c.NGW * cxq < 3 * 8192; ++cxq) { float tv[32]; const int cit = c.gw + c.NGW * cxq; cx_issue(p, l, cit, lane, tv); cx_finish(p, cit, lane, tv, (LAS float*)tile); }
}

#ifndef RT_NT
#define RT_NT 2
#endif
__device__ __forceinline__ void ph_router(const Params& p, const Ctx& c, int l) {
    const float* mod = (const float*)(p.ws + WS_MOD); bf16_t* H = (bf16_t*)(p.ws + WS_H);
    int* toke = (int*)(p.ws + WS_SMALL + SM_TOKE); float* tokg = (float*)(p.ws + WS_SMALL + SM_TOKG); int* rank = (int*)(p.ws + WS_SMALL + SM_RANK); int* cnt = (int*)(p.ws + WS_SMALL + SM_CNT);
    LAS int* le = (LAS int*)(c.lds + RT_LE_OFF); LAS int* wcnt = le + 256;
    const int lane = c.lane;
    {
        const f32x4* srcE = (const f32x4*)(p.ws + WS_SMALL + SM_REW2) + (size_t)l * 8192; const f32x4* srcG = (const f32x4*)(p.ws + WS_SMALL + SM_RGW2) + (size_t)l * 1024;
        LAS f32x4* dE = (LAS f32x4*)c.lds; LAS f32x4* dG = (LAS f32x4*)(c.lds + RT_RG_OFF);
#pragma unroll
        for (int hb = 0; hb < 2; ++hb) { f32x4 t[8];
#pragma unroll
            for (int q = 0; q < 8; ++q) t[q] = srcE[c.tid + 512 * (8 * hb + q)];
#pragma unroll
            for (int q = 0; q < 8; ++q) dE[c.tid + 512 * (8 * hb + q)] = t[q]; }
        { const f32x4 t0 = srcG[c.tid], t1 = srcG[c.tid + 512]; dG[c.tid] = t0; dG[c.tid + 512] = t1; }
        __syncthreads();
    }
    for (int tile = c.vcu; tile < 256; tile += c.G) {
        constexpr int NT = RT_NT;
        const int b = (tile * 128) >> 11;
        const f32x4* ng = (const f32x4*)(p.in[I_N2G] + l * D) + lane;
        const f32x4* sh = (const f32x4*)(mod + (size_t)(l * NB + b) * 6144 + 3072) + lane; const f32x4* sc = (const f32x4*)(mod + (size_t)(l * NB + b) * 6144 + 4096) + lane;
        const LAS f32x4* rg = (const LAS f32x4*)(c.lds + RT_RG_OFF) + lane;
        f32x4 gm[4], sv[4];
#pragma unroll
        for (int j = 0; j < 4; ++j) { gm[j] = ng[64 * j] * (sc[64 * j] + 1.0f); sv[j] = sh[64 * j]; }
        f32x4 v[NT][4]; u32x2 vn[NT][4];
#pragma unroll
        for (int t = 0; t < NT; ++t)
#pragma unroll
            for (int j = 0; j < 4; ++j) vn[t][j] = ((const u32x2*)((const bf16_t*)(p.ws + WS_X16) + (size_t)(tile * 128 + c.wave * 16 + t) * D) + lane)[64 * j];
        for (int i = 0; i < 16; i += NT) {
            const int tl0 = c.wave * 16 + i, m0 = tile * 128 + tl0;
            float ss[NT], r[NT], gl[NT][4];
#pragma unroll
            for (int t = 0; t < NT; ++t) { ss[t] = 0.f;
#pragma unroll
                for (int j = 0; j < 4; ++j) { v[t][j] = (f32x4){bflo(vn[t][j].x), bfhi(vn[t][j].x), bflo(vn[t][j].y), bfhi(vn[t][j].y)}; ss[t] += (v[t][j].x * v[t][j].x + v[t][j].y * v[t][j].y) + (v[t][j].z * v[t][j].z + v[t][j].w * v[t][j].w); } }
            if (i + NT < 16) {
#pragma unroll
                for (int t = 0; t < NT; ++t)
#pragma unroll
                    for (int j = 0; j < 4; ++j) vn[t][j] = ((const u32x2*)((const bf16_t*)(p.ws + WS_X16) + (size_t)(m0 + NT + t) * D) + lane)[64 * j]; }
#pragma unroll
            for (int t = 0; t < NT; ++t) ss[t] = wave_sum(ss[t]);
#pragma unroll
            for (int t = 0; t < NT; ++t) { r[t] = 1.0f / sqrtf(ss[t] * (1.0f / D) + EPS); gl[t][0] = gl[t][1] = gl[t][2] = gl[t][3] = 0.f; }
#pragma unroll
            for (int j = 0; j < 4; ++j) {
#pragma unroll
                for (int t = 0; t < NT; ++t) { v[t][j] = v[t][j] * r[t] * gm[j] + sv[j];
                    u32x2 w; w.x = cvt_pk_bf16(v[t][j].x, v[t][j].y); w.y = cvt_pk_bf16(v[t][j].z, v[t][j].w); ((u32x2*)(H + (size_t)(m0 + t) * D) + lane)[64 * j] = w; }
#pragma unroll
                for (int e = 0; e < 4; ++e) { const f32x4 wr = rg[(j * 4 + e) * 64];
#pragma unroll
                    for (int t = 0; t < NT; ++t) { gl[t][0] += v[t][j][e] * wr.x; gl[t][1] += v[t][j][e] * wr.y; gl[t][2] += v[t][j][e] * wr.z; gl[t][3] += v[t][j][e] * wr.w; } } }
            const bool h32 = lane & 32, h16 = lane & 16, h8 = lane & 8;
            float dg[NT];
#pragma unroll
            for (int t = 0; t < NT; ++t) {
                const float c0 = (h16 ? gl[t][2] : gl[t][0]) + lane_xor<16>(h16 ? gl[t][0] : gl[t][2]), c1 = (h16 ? gl[t][3] : gl[t][1]) + lane_xor<16>(h16 ? gl[t][1] : gl[t][3]);
                float d = (h8 ? c1 : c0) + lane_xor<8>(h8 ? c0 : c1);
                d += lane_xor<4>(d); d += lane_xor<2>(d); d += lane_xor<1>(d); d += lane_xor<32>(d); dg[t] = d; }
            int gi[NT]; float gp[NT];
#pragma unroll
            for (int t = 0; t < NT; ++t) { float gq[4]; int g_ = 0; float gmax = -INFINITY;
#pragma unroll
                for (int q = 0; q < 4; ++q) { gq[q] = __shfl(dg[t], 8 * (q & 1) + 16 * (q >> 1)) + p.in[I_RGB][l * 4 + q]; if (gq[q] > gmax) { gmax = gq[q]; g_ = q; } }
                float gden = 0.f;
#pragma unroll
                for (int q = 0; q < 4; ++q) gden += __expf(gq[q] - gmax);
                gp[t] = 1.0f / gden; gi[t] = __builtin_amdgcn_readfirstlane(g_); }
            float el[NT][8];
#pragma unroll
            for (int t = 0; t < NT; ++t)
#pragma unroll
                for (int q = 0; q < 8; ++q) el[t][q] = 0.f;
#pragma unroll
            for (int j = 0; j < 4; ++j)
#pragma unroll
                for (int e = 0; e < 4; ++e)
#pragma unroll
                    for (int t = 0; t < NT; ++t) { const LAS f32x4* rr = (const LAS f32x4*)c.lds + gi[t] * 2048 + (j * 4 + e) * 128 + lane;
                        const f32x4 w0 = rr[0], w1 = rr[64]; const float hv = v[t][j][e];
                        el[t][0] += hv * w0.x; el[t][1] += hv * w0.y; el[t][2] += hv * w0.z; el[t][3] += hv * w0.w; el[t][4] += hv * w1.x; el[t][5] += hv * w1.y; el[t][6] += hv * w1.z; el[t][7] += hv * w1.w; }
            float de[NT];
#pragma unroll
            for (int t = 0; t < NT; ++t) {
                const float b0 = (h32 ? el[t][4] : el[t][0]) + lane_xor<32>(h32 ? el[t][0] : el[t][4]), b1 = (h32 ? el[t][5] : el[t][1]) + lane_xor<32>(h32 ? el[t][1] : el[t][5]);
                const float b2 = (h32 ? el[t][6] : el[t][2]) + lane_xor<32>(h32 ? el[t][2] : el[t][6]), b3 = (h32 ? el[t][7] : el[t][3]) + lane_xor<32>(h32 ? el[t][3] : el[t][7]);
                const float c0 = (h16 ? b2 : b0) + lane_xor<16>(h16 ? b0 : b2), c1 = (h16 ? b3 : b1) + lane_xor<16>(h16 ? b1 : b3);
                float d = (h8 ? c1 : c0) + lane_xor<8>(h8 ? c0 : c1);
                d += lane_xor<4>(d); d += lane_xor<2>(d); d += lane_xor<1>(d); de[t] = d; }
#pragma unroll
            for (int t = 0; t < NT; ++t) { float eq[8]; int e0 = 0, e1 = 0; float mx0 = -INFINITY, mx1 = -INFINITY;
#pragma unroll
                for (int q = 0; q < 8; ++q) { eq[q] = __shfl(de[t], 8 * (q & 1) + 16 * ((q >> 1) & 1) + 32 * (q >> 2)) + p.in[I_REB][l * 32 + gi[t] * 8 + q];
                    if (eq[q] > mx0) { mx1 = mx0; e1 = e0; mx0 = eq[q]; e0 = q; } else if (eq[q] > mx1) { mx1 = eq[q]; e1 = q; } }
                const float x1 = __expf(mx1 - mx0), den = 1.0f + x1; const int tl = tl0 + t, m = m0 + t;
                if (lane == 0) { le[2 * tl] = gi[t] * 8 + e0; le[2 * tl + 1] = gi[t] * 8 + e1; toke[2 * m] = gi[t] * 8 + e0; toke[2 * m + 1] = gi[t] * 8 + e1; tokg[2 * m] = gp[t] / den; tokg[2 * m + 1] = gp[t] * x1 / den; } }
        }
        __syncthreads();
        int myrank = 0, mye = 0;
        if (c.tid < 256) { mye = le[c.tid]; const unsigned long long ltmask = (1ull << lane) - 1ull;
            for (int ee = 0; ee < 32; ++ee) { const unsigned long long m = __ballot(mye == ee); if (mye == ee) myrank = __builtin_popcountll(m & ltmask); if (lane == 0) wcnt[c.wave * 32 + ee] = __builtin_popcountll(m); } }
        __syncthreads();
        if (c.tid < 256) { for (int w = 0; w < c.wave; ++w) myrank += wcnt[w * 32 + mye]; rank[tile * 256 + c.tid] = myrank; }
        if (c.tid < 32) cnt[tile * 32 + c.tid] = wcnt[c.tid] + wcnt[32 + c.tid] + wcnt[64 + c.tid] + wcnt[96 + c.tid];
        __syncthreads();
    }
}

__device__ __forceinline__ void ph_dispatch(const Params& p, const Ctx& c) {
    const int* toke = (const int*)(p.ws + WS_SMALL + SM_TOKE); const float* tokg = (const float*)(p.ws + WS_SMALL + SM_TOKG); const int* rank = (const int*)(p.ws + WS_SMALL + SM_RANK); const int* cnt = (const int*)(p.ws + WS_SMALL + SM_CNT);
    int* tslot = (int*)(p.ws + WS_SMALL + SM_TSLOT); int* stok = (int*)(p.ws + WS_SMALL + SM_STOK); float* sgate = (float*)(p.ws + WS_SMALL + SM_SGATE); int* texp = (int*)(p.ws + WS_SMALL + SM_TEXP);
    LAS int* tot = (LAS int*)c.lds; LAS int* pst = tot + 32; LAS int* bse = pst + 33;
    for (int tile = c.vcu; tile < 256; tile += c.G) {
        {
            LAS int* psum = bse + 32; LAS int* pbase = psum + 512;
            const int e = c.tid & 31, part = c.tid >> 5; int v[16]; int run = 0, mb = 0;
#pragma unroll
            for (int q = 0; q < 16; ++q) v[q] = cnt[(part * 16 + q) * 32 + e];
#pragma unroll
            for (int q = 0; q < 16; ++q) { if (part * 16 + q == tile) mb = run; run += v[q]; }
            psum[part * 32 + e] = run; pbase[part * 32 + e] = mb;
            __syncthreads();
            if (c.tid < 32) { int tr = 0, tb2 = 0; const int tp = tile >> 4;
                for (int q = 0; q < 16; ++q) { if (q == tp) tb2 = tr + pbase[q * 32 + c.tid]; tr += psum[q * 32 + c.tid]; }
                tot[c.tid] = tr; bse[c.tid] = tb2; }
        }
        __syncthreads();
        if (c.tid == 0) { int a = 0; for (int e = 0; e < 32; ++e) { pst[e] = a; a += ((tot[e] + 255) >> 8) << 8; } pst[32] = a; }
        __syncthreads();
        if (c.tid < 256) { const int a = tile * 256 + c.tid, e = toke[a], slot = pst[e] + bse[e] + rank[a]; stok[slot] = a >> 1; sgate[slot] = tokg[a]; tslot[a] = slot; }
        if (tile == 0) {
            for (int e = 0; e < 32; ++e) { const int pc = pst[e + 1] - pst[e]; for (int r = tot[e] + c.tid; r < pc; r += 512) { stok[pst[e] + r] = 0; sgate[pst[e] + r] = 0.f; } }
            const int ntl = pst[32] >> 8;
            for (int m = c.tid; m < ntl; m += 512) { int e = 0; while (pst[e + 1] <= (m << 8)) ++e; texp[m] = e; }
            if (c.tid == 0) texp[MAXTILES] = ntl;
        }
        __syncthreads();
    }
}

#ifndef PH_ONLY
#define PH_ONLY -1
#endif
#define IN(k) ((PH_ONLY < 0 || PH_ONLY == (k)) && lo <= (k) && (k) < hi)
#define SEAM(k) do { if (IN(k) && IN((k) + 1)) xcd_barrier(bar); } while (0)
#ifndef REP_MASK
#define REP_MASK 0
#endif
#define REP(id) (((REP_MASK) >> (id)) & 1)
#define BODY(id, cond, ...) do { __VA_ARGS__ if (REP(id) && (cond)) { xcd_barrier(bar); __VA_ARGS__ } } while (0)
template <int l>
__device__ __forceinline__ void run_layer(const Params& p, const Ctx& c, const XcdBarrier& bar, int lo, int hi) {
    bf16_t* Zb = (bf16_t*)(p.ws + WS_Z); bf16_t* Hb = (bf16_t*)(p.ws + WS_H); bf16_t* MCb = (bf16_t*)p.out;
    const float* mod = (const float*)(p.ws + WS_MOD);
    constexpr int P = 1 + 10 * l;
    if (IN(P)) { if (l == 0) { BODY(1, true, ph_norm1<0>(p, c);); } else { ph_norm1<1>(p, c); } }
    SEAM(P);
    if (IN(P + 1)) { BODY(2, true, { pg8::StaticOrder So; So.init(Hb, (bf16_t*)(p.ws + WS_WIN) + (size_t)l * NZ * D, T, NZ, D, c.G, (int)blockIdx.x);
        pg8::EpiBf16 E{Zb, NZ}; pg8::gemm_phase<pg8::EpiBf16, pg8::StaticOrder, false>(c.lds, So, E); });
        if (l == 0) { constexpr int NU = (T / 256) * (NZ / 256); const int rem = NU % c.G;
            if (rem == 0) ph_prologue_rest(p, c, c.gw, c.NGW); else if ((int)blockIdx.x >= rem) ph_prologue_rest(p, c, ((int)blockIdx.x - rem) * 8 + c.wave, (c.G - rem) * 8); } }
    SEAM(P + 1);
    if (IN(P + 2)) { BODY(3, true, ph_postz(p, c, l);); }
    SEAM(P + 2);
    if (IN(P + 3)) { BODY(4, true, { pg8::StaticOrder So; So.init((bf16_t*)(p.ws + WS_CQR), (bf16_t*)(p.ws + WS_WQA) + (size_t)l * D * 256, T, D, 256, c.G, (int)blockIdx.x);
        pg8::EpiBf16 E{Hb, D}; pg8::gemm_phase<pg8::EpiBf16, pg8::StaticOrder, false>(c.lds, So, E); });
        BODY(5, true, ph_scores(p, c);); }
    SEAM(P + 3);
#ifndef ATT_PROBE
#define ATT_PROBE 0
#endif
    if (IN(P + 4)) { ph_attn<15>(p, c, l); if (ATT_PROBE) { xcd_barrier(bar); ph_attn<ATT_PROBE>(p, c, l); } }
    SEAM(P + 4);
    if (IN(P + 5)) { BODY(7, l == 0, { pg8::StaticOrder So; So.init(MCb, (bf16_t*)(p.ws + WS_WMIX) + (size_t)l * D * KMIX, T, D, KMIX, c.G, (int)blockIdx.x);
        pg8::EpiMix E{l == 0 ? p.in[I_X] : nullptr, (bf16_t*)(p.ws + WS_X16), mod + (size_t)l * NB * 6144 + 2048}; pg8::gemm_phase<pg8::EpiMix, pg8::StaticOrder, false>(c.lds, So, E); }); }
    SEAM(P + 5);
    if (IN(P + 6)) { BODY(8, true, ph_router(p, c, l);); }
    SEAM(P + 6);
    if (IN(P + 7)) { BODY(9, true, ph_dispatch(p, c);); }
    SEAM(P + 7);
    if (IN(P + 8)) { BODY(10, true, { const int* texp = (const int*)(p.ws + WS_SMALL + SM_TEXP); const int ntl = texp[MAXTILES];
        pg8::MoeOrder Mo; Mo.init(Hb, p.ws + WS_W13, D, (size_t)1024 * 1024 * 2, (const int*)(p.ws + WS_SMALL + SM_STOK), texp, ntl, c.G, c.vcu, (LAS int*)(c.lds + MOE_TAB_OFF));
        pg8::EpiAct E{Zb}; pg8::gemm_phase<pg8::EpiAct, pg8::MoeOrder, true>(c.lds, Mo, E); }); }
    SEAM(P + 8);
    if (IN(P + 9)) { BODY(11, true, { const int* texp = (const int*)(p.ws + WS_SMALL + SM_TEXP); const int ntl = texp[MAXTILES];
        pg8::MoeOrder Mo; Mo.init(Zb, p.ws + WS_W2, DEXP, (size_t)1024 * 512 * 2, nullptr, texp, ntl, c.G, c.vcu, (LAS int*)(c.lds + MOE_TAB_OFF));
        pg8::EpiY E{(bf16_t*)(p.ws + WS_Y), (const float*)(p.ws + WS_SMALL + SM_SGATE)}; pg8::gemm_phase<pg8::EpiY, pg8::MoeOrder, false>(c.lds, Mo, E); }); }
    SEAM(P + 9);
}

__global__ void __launch_bounds__(512, 2) fwd(Params p) {
    extern __shared__ __attribute__((aligned(16))) unsigned char lds_raw[];
    Ctx c;
    c.lds = (LAS unsigned char*)lds_raw;
    c.tid = threadIdx.x; c.lane = c.tid & 63; c.wave = __builtin_amdgcn_readfirstlane(c.tid >> 6);
    c.G = gridDim.x; { const int bx = blockIdx.x; c.vcu = (c.G % 8 == 0) ? (bx % 8) * (c.G / 8) + bx / 8 : bx; }
    c.gw = c.vcu * 8 + c.wave; c.NGW = c.G * 8;
    volatile LAS unsigned* MISC = (volatile LAS unsigned*)(c.lds + MISC_OFF);
    if (c.tid < 64) MISC[c.tid] = 0u;
    __syncthreads();
    unsigned* ctl = (unsigned*)(p.ws + WS_CTL);
    XcdBarrier bar; bar.bar = ctl + CW_BAR; bar.x = 0; bar.st = nullptr;
    const bool multi = (p.ph_hi - p.ph_lo) > 1;
    if (multi) bar = xcd_barrier_post(ctl + CW_BAR, MISC + 8);
    const int lo = p.ph_lo, hi = p.ph_hi;
    if (IN(0)) { BODY(0, true, ph_prologue(p, c);); }
    SEAM(0);
    run_layer<0>(p, c, bar, lo, hi);
    run_layer<1>(p, c, bar, lo, hi);
    if (IN(21)) ph_norm1<2>(p, c);
#undef IN
#undef SEAM
}

extern "C" void kernel_launch(void* const* d_in, const int* in_sizes, int n_in, void* d_out, int out_size, void* d_ws, size_t ws_size, hipStream_t stream) {
    static int grid = 0;
    if (grid == 0) {
        if (n_in != 27 || out_size != T * D || ws_size < WS_END) { fprintf(stderr, "kernel_launch: unexpected shapes (n_in %d out %d ws %zu, need %zu)\n", n_in, out_size, ws_size, (size_t)WS_END); grid = -1; return; }
        int dev = 0, cus = 0, per_cu = 0;
        if (hipGetDevice(&dev) != hipSuccess || hipDeviceGetAttribute(&cus, hipDeviceAttributeMultiprocessorCount, dev) != hipSuccess) { grid = -1; return; }
        if (hipFuncSetAttribute((const void*)fwd, hipFuncAttributeMaxDynamicSharedMemorySize, LDS_BYTES) != hipSuccess) { fprintf(stderr, "kernel_launch: hipFuncSetAttribute failed\n"); grid = -1; return; }
        if (hipOccupancyMaxActiveBlocksPerMultiprocessor(&per_cu, (const void*)fwd, 512, LDS_BYTES) != hipSuccess || per_cu < 1) { fprintf(stderr, "kernel_launch: occupancy query says %d blocks per CU\n", per_cu); grid = -1; return; }
        (void)hipGetLastError();
        grid = cus;
        if (grid % 8 != 0 || grid > 256) grid = (grid / 8) * 8 > 256 ? 256 : (grid / 8) * 8;
    }
    if (grid <= 0) return;
    (void)hipMemsetAsync((char*)d_ws + WS_CTL, 0, CTL_ZERO_BYTES, stream);
    Params p{};
    for (int i = 0; i < 27; ++i) p.in[i] = (const float*)d_in[i];
    p.out = (float*)d_out; p.ws = (unsigned char*)d_ws;
#if MK_SPLIT
    for (int ph = 0; ph < NPHASE; ++ph) { p.ph_lo = ph; p.ph_hi = ph + 1; hipLaunchKernelGGL(fwd, dim3(grid), dim3(512), LDS_BYTES, stream, p); }
#else
    p.ph_lo = 0; p.ph_hi = NPHASE;
    hipLaunchKernelGGL(fwd, dim3(grid), dim3(512), LDS_BYTES, stream, p);
#endif
}
```

```cpp
#include <hip/hip_runtime.h>
#include <cstdio>
#include <cstdint>

#ifndef MK_SPLIT
#define MK_SPLIT 0
#endif

#define LAS __attribute__((address_space(3)))
typedef unsigned short bf16_t;
typedef short bf16x8 __attribute__((ext_vector_type(8)));
typedef short bf16x4 __attribute__((ext_vector_type(4)));
typedef float f32x4 __attribute__((ext_vector_type(4)));
typedef float f32x2 __attribute__((ext_vector_type(2)));
typedef float f32x16 __attribute__((ext_vector_type(16)));
typedef unsigned u32x4 __attribute__((ext_vector_type(4)));
typedef unsigned u32x2 __attribute__((ext_vector_type(2)));

constexpr int D = 1024, NB = 16, S = 2048, T = NB * S, DEPTH = 2;
constexpr int NZ = 1792;
constexpr int N_IN = 1736;
constexpr int Z_AVAL = 0, Z_AGATE = 256, Z_CQ = 512, Z_CKV = 768, Z_QI = 896, Z_KI = 1408, Z_WI = 1472, Z_UP = 1480;
constexpr int KMIX = 1536;
constexpr int NEXP = 32, DEXP = 512, MAXTILES = 288, PMAX = MAXTILES * 256;
constexpr float EPS = 1e-6f;
constexpr int SC_PER_B = 4096 * 528;

constexpr size_t MiB = 1u << 20;
constexpr size_t WS_CTL = 0, CTL_ZERO_BYTES = 64 * 1024;
constexpr size_t WS_MOD = 1 * MiB;
constexpr size_t WS_WIN = 2 * MiB;
constexpr size_t WS_WQA = 9 * MiB;
constexpr size_t WS_WMIX = 10 * MiB;
constexpr size_t WS_SMALL = 16 * MiB;
constexpr size_t WS_W13 = 20 * MiB;
constexpr size_t WS_W2 = 84 * MiB;
constexpr size_t WS_Z = 116 * MiB;
constexpr size_t WS_X16 = 228 * MiB;
constexpr size_t WS_H = 324 * MiB;
constexpr size_t WS_CQR = 388 * MiB;
constexpr size_t WS_KVN = 404 * MiB;
constexpr size_t WS_Y = 412 * MiB;
constexpr size_t WS_END = 556 * MiB;
constexpr size_t SM_TOKE = 0;
constexpr size_t SM_TOKG = 256 * 1024;
constexpr size_t SM_RANK = 512 * 1024;
constexpr size_t SM_TSLOT = 768 * 1024;
constexpr size_t SM_STOK = 1024 * 1024;
constexpr size_t SM_SGATE = 1024 * 1024 + 512 * 1024;
constexpr size_t SM_CNT = 2 * 1024 * 1024;
constexpr size_t SM_TEXP = 2 * 1024 * 1024 + 64 * 1024;
constexpr size_t SM_REW2 = 2 * 1024 * 1024 + 512 * 1024;
constexpr size_t SM_PWT = 3 * 1024 * 1024 + 64 * 1024;
constexpr size_t SM_RGW2 = 3 * 1024 * 1024;
constexpr int CW_BAR = 1024;

constexpr int LDS_BYTES = 155648;
constexpr int LIST_OFF = 131072;
constexpr int MISC_OFF = 154624;
constexpr int MOE_TAB_OFF = 131072;
constexpr int RT_RG_OFF = 131072, RT_LE_OFF = 147456;
constexpr int NPHASE = 22;

__device__ __forceinline__ unsigned cvt_pk_bf16(float lo, float hi) { unsigned r; asm volatile("v_cvt_pk_bf16_f32 %0, %1, %2" : "=v"(r) : "v"(lo), "v"(hi)); return r; }
__device__ __forceinline__ float bf2f(unsigned short b) { return __uint_as_float(((unsigned)b) << 16); }
__device__ __forceinline__ float bflo(unsigned w) { return __uint_as_float(w << 16); }
__device__ __forceinline__ float bfhi(unsigned w) { return __uint_as_float(w & 0xffff0000u); }
template <int W> __device__ __forceinline__ int lane_xor_i(int iv) {
    int r;
    if constexpr (W == 1) r = __builtin_amdgcn_mov_dpp(iv, 0xB1, 0xF, 0xF, true);
    else if constexpr (W == 2) r = __builtin_amdgcn_mov_dpp(iv, 0x4E, 0xF, 0xF, true);
    else if constexpr (W == 4) { r = __builtin_amdgcn_update_dpp(iv, iv, 0x104, 0xF, 0x5, false);
                                 r = __builtin_amdgcn_update_dpp(r, iv, 0x114, 0xF, 0xA, false); }
    else if constexpr (W == 8) r = __builtin_amdgcn_mov_dpp(iv, 0x128, 0xF, 0xF, true);
    else if constexpr (W == 16) { const auto p = __builtin_amdgcn_permlane16_swap((unsigned)iv, (unsigned)iv, false, false); r = (threadIdx.x & 16) ? (int)p[0] : (int)p[1]; }
    else { const auto p = __builtin_amdgcn_permlane32_swap((unsigned)iv, (unsigned)iv, false, false); r = (threadIdx.x & 32) ? (int)p[0] : (int)p[1]; }
    return r;
}
template <int W> __device__ __forceinline__ float lane_xor(float v) { return __builtin_bit_cast(float, lane_xor_i<W>(__builtin_bit_cast(int, v))); }
template <int W> __device__ __forceinline__ unsigned lane_xor(unsigned v) { return (unsigned)lane_xor_i<W>((int)v); }
__device__ __forceinline__ float wave_sum(float v) {
    v += lane_xor<1>(v); v += lane_xor<2>(v); v += lane_xor<4>(v); v += lane_xor<8>(v); v += lane_xor<16>(v); v += lane_xor<32>(v);
    return v;
}
__device__ __forceinline__ float sigmoidf_(float x) { return __builtin_amdgcn_rcpf(1.0f + __builtin_amdgcn_exp2f(-1.44269504089f * x)); }
#define LDS_WAIT() asm volatile("s_waitcnt lgkmcnt(0)" ::: "memory")
#define VM_WAIT() asm volatile("s_waitcnt vmcnt(0)" ::: "memory")

#define XB_TMO      128
#define XB_XCNT(j)  (256  + 64 * (j))
#define XB_XSUB(j)  (1280 + 64 * (j))
#define XB_XGEN(j)  (2304 + 64 * (j))
#define XB_TOP      3328
#define XB_TOPGEN   3392
#define XCD_BAR_WORDS 3456
#define XB_SPIN_CAP (1u << 22)

__device__ __forceinline__ unsigned xb_ld(unsigned* p)              { return __hip_atomic_load(p, __ATOMIC_RELAXED, __HIP_MEMORY_SCOPE_AGENT); }
__device__ __forceinline__ unsigned xb_add(unsigned* p, unsigned v) { return __hip_atomic_fetch_add(p, v, __ATOMIC_RELAXED, __HIP_MEMORY_SCOPE_AGENT); }
__device__ __forceinline__ unsigned xb_xcc_id() { return (unsigned)__builtin_amdgcn_s_getreg((3 << 11) | 20) & 0xFu; }
#define XB_SPIN(cond, bar) do { unsigned _sp = 0; while (cond) { __builtin_amdgcn_s_sleep(1); \
    if ((++_sp & 255u) == 0u) { if (xb_ld(&(bar)[XB_TMO])) break; if (_sp > XB_SPIN_CAP) { atomicAdd(&(bar)[XB_TMO], 1u); break; } } } } while (0)

struct XcdBarrier {
    unsigned* bar; unsigned x;
    volatile LAS unsigned* st;
};
__device__ __forceinline__ XcdBarrier xcd_barrier_post(unsigned* bar, volatile LAS unsigned* st) {
    XcdBarrier b; b.bar = bar; b.x = xb_xcc_id(); b.st = st;
    if (threadIdx.x == 0) (void)xb_add(&bar[XB_XCNT(b.x)], 1u);
    return b;
}
__device__ __forceinline__ void xcd_barrier_complete(unsigned* bar, unsigned x, unsigned& nloc, unsigned& nx) {
    const unsigned G = gridDim.x * gridDim.y * gridDim.z;
    unsigned sum, cnt, mine, sp = 0u;
    for (;;) {
        sum = 0u; cnt = 0u; mine = 0u;
#pragma unroll
        for (unsigned j = 0; j < 16; ++j) { const unsigned c = xb_ld(&bar[XB_XCNT(j)]); sum += c; cnt += (c > 0u) ? 1u : 0u; mine = (j == x) ? c : mine; }
        if (sum == G) break;
        __builtin_amdgcn_s_sleep(1);
        if ((++sp & 255u) == 0u) { if (xb_ld(&bar[XB_TMO])) break; if (sp > XB_SPIN_CAP) { atomicAdd(&bar[XB_TMO], 1u); break; } }
    }
    nloc = mine > 0u ? mine : 1u; nx = cnt > 0u ? cnt : 1u;
}
__device__ __forceinline__ void xcd_barrier(const XcdBarrier& b) {
    asm volatile("s_waitcnt vmcnt(0)" ::: "memory");
    __syncthreads();
    if (threadIdx.x == 0) {
        unsigned* bar = b.bar;
        __builtin_amdgcn_s_waitcnt(0);
        unsigned nloc = b.st[0], nx = b.st[1];
        if (nloc == 0u) { xcd_barrier_complete(bar, b.x, nloc, nx); b.st[0] = nloc; b.st[1] = nx; }
        const unsigned old = xb_add(&bar[XB_XSUB(b.x)], 1u);
        const unsigned gen = old / nloc;
        if (old + 1u == (gen + 1u) * nloc) {
            __builtin_amdgcn_fence(__ATOMIC_RELEASE, "agent");
            asm volatile("s_waitcnt vmcnt(0)" ::: "memory");
            const unsigned og = xb_add(&bar[XB_TOP], 1u);
            const unsigned tg = og / nx;
            if (og + 1u == (tg + 1u) * nx) xb_add(&bar[XB_TOPGEN], 1u);
            else XB_SPIN(xb_ld(&bar[XB_TOPGEN]) == tg, bar);
            __builtin_amdgcn_fence(__ATOMIC_ACQUIRE, "agent");
            xb_add(&bar[XB_XGEN(b.x)], 1u);
            asm volatile("s_waitcnt vmcnt(0)" ::: "memory");
        } else {
            XB_SPIN(xb_ld(&bar[XB_XGEN(b.x)]) == gen, bar);
            __builtin_amdgcn_fence(__ATOMIC_ACQUIRE, "agent");
            asm volatile("s_waitcnt vmcnt(0)" ::: "memory");
        }
    }
    __syncthreads();
}

namespace pg8 {
constexpr int BM = 256, BK = 64, HALF = 128, HTB = HALF * BK * 2  , STAGE_BYTES = 8 * HTB, NXCD = 8, WGM = 8;
__host__ __device__ __forceinline__ int lds_byte(int r, int c) { const int st = (r >> 4) * 2 + (c >> 5), rr = r & 15, cc = c & 31, ob = rr * 64 + cc * 2; return st * 1024 + (ob ^ (((ob >> 9) & 1) << 5)); }
__host__ __device__ __forceinline__ void stage_rc(int b, int& R, int& C) { const int st = b / 1024, sb = b % 1024, swz = sb ^ (((sb >> 9) & 1) << 5); R = (st >> 1) * 16 + swz / 64; C = (st & 1) * 32 + (swz % 64) / 2; }
__host__ __device__ __forceinline__ int perm32(int rho) { const int n = rho >> 4, i = rho & 15; return 8 * (i >> 2) + 4 * n + (i & 3); }

struct Unit { int pm, pn; const char* a; const char* b; };

struct StaticOrder {
    const char* A; const char* Bt; int K;
    int nM, nN, nwg, G, c;
    __device__ void init(const void* A_, const void* Bt_, int M, int N, int K_, int G_, int c_) { A = (const char*)A_; Bt = (const char*)Bt_; K = K_; nM = M / BM; nN = N / BM; nwg = nM * nN; G = G_; c = c_; }
    __device__ __forceinline__ bool next(int i, Unit& u) const {
        const long L = (long)i * G + c; if (L >= nwg) return false;
        int wgid = (int)L; { const int q = nwg / NXCD, r = nwg % NXCD, xcd = wgid % NXCD, off = wgid / NXCD; wgid = (xcd < r ? xcd * (q + 1) : r * (q + 1) + (xcd - r) * q) + off; }
        const int nig = WGM * nN, gid = wgid / nig, fm = gid * WGM, gsz = (nM - fm) < WGM ? (nM - fm) : WGM;
        u.pm = fm + ((wgid % nig) % gsz); u.pn = (wgid % nig) / gsz;
        u.a = A + (size_t)u.pm * BM * K * 2; u.b = Bt + (size_t)u.pn * BM * K * 2; return true;
    }
    __device__ __forceinline__ int row(int, int) const { return 0; }
};
struct MoeOrder {
    const char* A; const char* Bt; int K; const LAS int* rowtab;
    const LAS int* etab; int nunits, G, c; size_t bstride;
    static constexpr int MAXU = 12;
    __device__ __forceinline__ void init(const void* A_, const void* Bt_, int K_, size_t bstride_, const int* rowidx, const int* tile_exp, int ntiles, int G_, int c_, LAS int* lds_tab) {
        A = (const char*)A_; Bt = (const char*)Bt_; K = K_; bstride = bstride_; nunits = ntiles * 4; G = G_; c = c_;
        LAS int* rt = lds_tab; LAS int* et = lds_tab + MAXU * 256;
        for (int i = 0; i < MAXU; ++i) { const int L = i * G + c; if (L >= nunits) break; const int tile = L >> 2;
            if (rowidx && threadIdx.x < 256) rt[i * 256 + threadIdx.x] = rowidx[tile * 256 + threadIdx.x];
            if (threadIdx.x == 0) et[i] = tile_exp[tile]; }
        rowtab = rowidx ? rt : nullptr; etab = et;
        __syncthreads();
    }
    __device__ __forceinline__ bool next(int i, Unit& u) const {
        const int L = i * G + c; if (L >= nunits || i >= MAXU) return false;
        u.pm = L >> 2; u.pn = L & 3; const int e = __builtin_amdgcn_readfirstlane(etab[i]);
        u.a = A + (size_t)u.pm * BM * K * 2; u.b = Bt + (size_t)e * bstride + (size_t)u.pn * BM * K * 2; return true;
    }
    __device__ __forceinline__ int row(int i, int r) const { return rowtab[i * 256 + r]; }
};
struct NoGather { };
struct EpiBf16 {
    static constexpr bool PERM = true;
    bf16_t* O; int ldc;
    __device__ __forceinline__ void operator()(const f32x4 (&acc)[2][2][4][2], const Unit& u, int wr, int wc, int fr, int fq) const {
        const int row0 = u.pm * BM + wr * 64 + fr, col0 = u.pn * BM + wc * 32 + 8 * fq;
#pragma unroll
        for (int ai = 0; ai < 2; ++ai)
#pragma unroll
            for (int m = 0; m < 4; ++m) { bf16_t* rowp = O + (size_t)(row0 + ai * HALF + m * 16) * ldc + col0;
#pragma unroll
                for (int bj = 0; bj < 2; ++bj) { const f32x4 v0 = acc[ai][bj][m][0], v1 = acc[ai][bj][m][1];
                    u32x4 w; w.x = cvt_pk_bf16(v0[0], v0[1]); w.y = cvt_pk_bf16(v0[2], v0[3]); w.z = cvt_pk_bf16(v1[0], v1[1]); w.w = cvt_pk_bf16(v1[2], v1[3]);
                    *(u32x4*)(rowp + bj * HALF) = w; } }
    }
};
template <bool F32IN>
struct EpiMix {
    static constexpr bool PERM = true;
    const float* xin32; bf16_t* x16; const float* gate;
    __device__ __forceinline__ void operator()(const f32x4 (&acc)[2][2][4][2], const Unit& u, int wr, int wc, int fr, int fq) const {
        const int row0 = u.pm * BM + wr * 64 + fr, col0 = u.pn * BM + wc * 32 + 8 * fq;
        const float* gp = gate + (size_t)(u.pm >> 3) * 6144 + col0;
        f32x4 gv[2][2];
#pragma unroll
        for (int bj = 0; bj < 2; ++bj)
#pragma unroll
            for (int n = 0; n < 2; ++n) gv[bj][n] = *(const f32x4*)(gp + bj * HALF + 4 * n);
#pragma unroll
        for (int ai = 0; ai < 2; ++ai)
#pragma unroll
            for (int mh = 0; mh < 2; ++mh) {
                f32x4 xa[2][2][2]; u32x4 xb[2][2];
#pragma unroll
                for (int mm = 0; mm < 2; ++mm) { const size_t off = (size_t)(row0 + ai * HALF + (2 * mh + mm) * 16) * D + col0;
#pragma unroll
                    for (int bj = 0; bj < 2; ++bj) { if (F32IN) { xa[mm][bj][0] = *(const f32x4*)(xin32 + off + bj * HALF); xa[mm][bj][1] = *(const f32x4*)(xin32 + off + bj * HALF + 4); } else xb[mm][bj] = *(const u32x4*)(x16 + off + bj * HALF); } }
#pragma unroll
                for (int mm = 0; mm < 2; ++mm) { const int m = 2 * mh + mm; const size_t off = (size_t)(row0 + ai * HALF + m * 16) * D + col0;
#pragma unroll
                    for (int bj = 0; bj < 2; ++bj) { f32x4 x0, x1;
                        if (F32IN) { x0 = xa[mm][bj][0]; x1 = xa[mm][bj][1]; }
                        else { const u32x4 xv = xb[mm][bj]; x0 = (f32x4){bflo(xv.x), bfhi(xv.x), bflo(xv.y), bfhi(xv.y)}; x1 = (f32x4){bflo(xv.z), bfhi(xv.z), bflo(xv.w), bfhi(xv.w)}; }
                        const f32x4 v0 = x0 + gv[bj][0] * acc[ai][bj][m][0], v1 = x1 + gv[bj][1] * acc[ai][bj][m][1];
                        u32x4 w; w.x = cvt_pk_bf16(v0[0], v0[1]); w.y = cvt_pk_bf16(v0[2], v0[3]); w.z = cvt_pk_bf16(v1[0], v1[1]); w.w = cvt_pk_bf16(v1[2], v1[3]);
                        *(u32x4*)(x16 + off + bj * HALF) = w; } }
                asm volatile("" ::: "memory"); }
    }
};
struct EpiAct {
    static constexpr bool PERM = true;
    bf16_t* O;
    __device__ __forceinline__ void operator()(const f32x4 (&acc)[2][2][4][2], const Unit& u, int wr, int wc, int fr, int fq) const {
        const int row0 = u.pm * BM + wr * 64 + fr, col0 = u.pn * 128 + wc * 16 + 4 * fq;
#pragma unroll
        for (int ai = 0; ai < 2; ++ai)
#pragma unroll
            for (int m = 0; m < 4; ++m) { bf16_t* rowp = O + (size_t)(row0 + ai * HALF + m * 16) * DEXP + col0;
#pragma unroll
                for (int bj = 0; bj < 2; ++bj) { const f32x4 a = acc[ai][bj][m][0], b = acc[ai][bj][m][1]; f32x4 r;
#pragma unroll
                    for (int j = 0; j < 4; ++j) r[j] = a[j] * b[j] * __builtin_amdgcn_rcpf(1.0f + __expf(-a[j]));
                    u32x2 w; w.x = cvt_pk_bf16(r[0], r[1]); w.y = cvt_pk_bf16(r[2], r[3]);
                    *(u32x2*)(rowp + bj * 64) = w; } }
    }
};
struct EpiY {
    static constexpr bool PERM = true;
    bf16_t* O; const float* sgate;
    __device__ __forceinline__ void operator()(const f32x4 (&acc)[2][2][4][2], const Unit& u, int wr, int wc, int fr, int fq) const {
        const int row0 = u.pm * BM + wr * 64 + fr, col0 = u.pn * BM + wc * 32 + 8 * fq;
        float gg[2][4];
#pragma unroll
        for (int ai = 0; ai < 2; ++ai)
#pragma unroll
            for (int m = 0; m < 4; ++m) gg[ai][m] = sgate[row0 + ai * HALF + m * 16];
#pragma unroll
        for (int ai = 0; ai < 2; ++ai)
#pragma unroll
            for (int m = 0; m < 4; ++m) { const int row = row0 + ai * HALF + m * 16; const float g = gg[ai][m]; bf16_t* rowp = O + (size_t)row * D + col0;
#pragma unroll
                for (int bj = 0; bj < 2; ++bj) { const f32x4 v0 = acc[ai][bj][m][0] * g, v1 = acc[ai][bj][m][1] * g;
                    u32x4 w; w.x = cvt_pk_bf16(v0[0], v0[1]); w.y = cvt_pk_bf16(v0[2], v0[3]); w.z = cvt_pk_bf16(v1[0], v1[1]); w.w = cvt_pk_bf16(v1[2], v1[3]);
                    *(u32x4*)(rowp + bj * HALF) = w; } }
    }
};

template <class Epi, class Sched, bool GATHER>
__device__ __forceinline__ void gemm_phase(LAS unsigned char* lds, const Sched& S, const Epi& E) {
    const int tid = threadIdx.x, wid = __builtin_amdgcn_readfirstlane(tid >> 6), lane = tid & 63, wr = wid >> 2, wc = wid & 3, fr = lane & 15, fq = lane >> 4;
    const int K = S.K, nt = K / BK;
    unsigned voffA[2], voffB[2]; int RA[2], CA[2];
#pragma unroll
    for (int i = 0; i < 2; ++i) { int R, C; stage_rc(tid * 16 + i * 8192, R, C); const int Rb = Epi::PERM ? ((R & ~31) + perm32(R & 31)) : R;
        RA[i] = R; CA[i] = C; voffA[i] = (unsigned)(R * K + C) * 2u; voffB[i] = (unsigned)(Rb * K + C) * 2u; }
    const size_t kstep = (size_t)(BK * 2);
    const size_t hstep = (size_t)HALF * K * 2;
    const unsigned ldsw = (unsigned)wid * 1024u;
    const int aoff = lds_byte(wr * 64 + fr, fq * 8), boff = lds_byte(wc * 32 + fr, fq * 8);
#define PG8_SA(b, h) (((b) * 2 + (h)) * HTB)
#define PG8_SB(b, h) ((4 + (b) * 2 + (h)) * HTB)
#define PG8_DMA(bufoff, gptr, i) __builtin_amdgcn_global_load_lds((const unsigned*)(gptr), (LAS unsigned*)(lds + (bufoff) + ldsw + (i) * 8192), 16, 0, 0)
#define PG8_STAGE(bufoff, gbase, voff) do { PG8_DMA(bufoff, (const char*)(gbase) + (voff)[0], 0); PG8_DMA(bufoff, (const char*)(gbase) + (voff)[1], 1); } while (0)
#define PG8_STAGE_A(bufoff, nx, h, kb) do { if constexpr (GATHER) { \
            PG8_DMA(bufoff, S.A + (kb) + ((nx) ? gN[h][0] : gC[h][0]), 0); PG8_DMA(bufoff, S.A + (kb) + ((nx) ? gN[h][1] : gC[h][1]), 1); } \
        else { const char* _b = ((nx) ? nA : cA) + (h) * hstep + (kb); PG8_DMA(bufoff, _b + voffA[0], 0); PG8_DMA(bufoff, _b + voffA[1], 1); } } while (0)
#define PG8_LDA(dst, b, h) do { _Pragma("unroll") for (int m = 0; m < 4; ++m) _Pragma("unroll") for (int k = 0; k < 2; ++k) dst[m][k] = *(const LAS bf16x8*)(lds + PG8_SA(b, h) + aoff + m * 2048 + k * 1024); } while (0)
#define PG8_LDB(dst, b, h) do { _Pragma("unroll") for (int n = 0; n < 2; ++n) _Pragma("unroll") for (int k = 0; k < 2; ++k) dst[n][k] = *(const LAS bf16x8*)(lds + PG8_SB(b, h) + boff + n * 2048 + k * 1024); } while (0)
#define PG8_MMA(ai, bj, At, Bt) do { __builtin_amdgcn_s_setprio(1); _Pragma("unroll") for (int m = 0; m < 4; ++m) _Pragma("unroll") for (int n = 0; n < 2; ++n) _Pragma("unroll") for (int k = 0; k < 2; ++k) \
        acc[ai][bj][m][n] = __builtin_amdgcn_mfma_f32_16x16x32_bf16(Bt[n][k], At[m][k], acc[ai][bj][m][n], 0, 0, 0); __builtin_amdgcn_s_setprio(0); } while (0)
#define PG8_WAIT_V(n) asm volatile("s_waitcnt vmcnt(" #n ")" ::: "memory")
#define PG8_WAIT_L(n) asm volatile("s_waitcnt lgkmcnt(" #n ")" ::: "memory")
#define PG8_BAR __builtin_amdgcn_s_barrier()
#define PG8_SCHED __builtin_amdgcn_sched_barrier(0)
    Unit cur, nxt; int ui = 0;
    if (!S.next(0, cur)) return;
    unsigned gC[2][2] = {{0u, 0u}, {0u, 0u}}, gN[2][2] = {{0u, 0u}, {0u, 0u}};
    if constexpr (GATHER) {
#pragma unroll
        for (int h = 0; h < 2; ++h)
#pragma unroll
            for (int i = 0; i < 2; ++i) gC[h][i] = (unsigned)(S.row(0, h * HALF + RA[i]) * K + CA[i]) * 2u;
    }
    f32x4 acc[2][2][4][2];
#pragma unroll
    for (int a = 0; a < 2; ++a)
#pragma unroll
        for (int b = 0; b < 2; ++b)
#pragma unroll
            for (int m = 0; m < 4; ++m)
#pragma unroll
                for (int n = 0; n < 2; ++n) acc[a][b][m][n] = (f32x4){0.f, 0.f, 0.f, 0.f};
    bf16x8 At[4][2], B0[2][2], B1[2][2];
    const char* cA = cur.a; const char* cB = cur.b; const char* nA = cA; const char* nB = cB;
    PG8_STAGE(PG8_SB(0, 0), cB, voffB); PG8_STAGE(PG8_SB(0, 1), cB + hstep, voffB); PG8_STAGE_A(PG8_SA(0, 0), false, 0, 0); PG8_STAGE_A(PG8_SA(0, 1), false, 1, 0);
    if (wr == 1) PG8_BAR;
    PG8_WAIT_V(2); PG8_BAR;
    PG8_STAGE(PG8_SB(1, 0), cB + kstep, voffB); PG8_STAGE_A(PG8_SA(1, 0), false, 0, kstep); PG8_STAGE(PG8_SB(1, 1), cB + hstep + kstep, voffB);
    PG8_WAIT_V(6); PG8_BAR;
    for (;;) {
        const bool has_next = S.next(ui + 1, nxt);
        nA = has_next ? nxt.a : cA; nB = has_next ? nxt.b : cB;
        if constexpr (GATHER) {
            const int nord = has_next ? ui + 1 : ui;
#pragma unroll
            for (int h = 0; h < 2; ++h)
#pragma unroll
                for (int i = 0; i < 2; ++i) gN[h][i] = (unsigned)(S.row(nord, h * HALF + RA[i]) * K + CA[i]) * 2u;
        }
        for (int t = 0; t < nt; t += 2) {
            const bool last = (t == nt - 2);
            const size_t k1 = (size_t)(t + 1) * kstep;
            const size_t k2 = last ? 0 : (size_t)(t + 2) * kstep, k3 = k2 + kstep;
            const char* b2 = (last ? nB : cB) + k2; const char* b3 = b2 + kstep;
            PG8_LDB(B0, 0, 0); PG8_LDB(B1, 0, 1); PG8_SCHED; PG8_LDA(At, 0, 0); PG8_STAGE_A(PG8_SA(1, 1), false, 1, k1);
            PG8_WAIT_V(8); PG8_WAIT_L(0); PG8_BAR; PG8_MMA(0, 0, At, B0); PG8_MMA(0, 1, At, B1); PG8_BAR; PG8_SCHED;
            PG8_LDA(At, 0, 1); PG8_STAGE(PG8_SB(0, 0), b2, voffB); PG8_STAGE(PG8_SB(0, 1), b2 + hstep, voffB); PG8_STAGE_A(PG8_SA(0, 0), last, 0, k2);
            PG8_WAIT_V(8); PG8_WAIT_L(0); PG8_BAR; PG8_MMA(1, 0, At, B0); PG8_MMA(1, 1, At, B1); PG8_BAR; PG8_SCHED;
            PG8_LDB(B0, 1, 0); PG8_LDB(B1, 1, 1); PG8_SCHED; PG8_LDA(At, 1, 0); PG8_STAGE_A(PG8_SA(0, 1), last, 1, k2);
            PG8_WAIT_V(8); PG8_WAIT_L(0); PG8_BAR; PG8_MMA(0, 0, At, B0); PG8_MMA(0, 1, At, B1); PG8_BAR; PG8_SCHED;
            PG8_LDA(At, 1, 1); PG8_STAGE(PG8_SB(1, 0), b3, voffB); PG8_STAGE(PG8_SB(1, 1), b3 + hstep, voffB); PG8_STAGE_A(PG8_SA(1, 0), last, 0, k3);
            PG8_WAIT_V(8); PG8_WAIT_L(0); PG8_BAR; PG8_MMA(1, 0, At, B0); PG8_MMA(1, 1, At, B1); PG8_BAR; PG8_SCHED;
        }
        if (wr == 0) PG8_BAR;
        E(acc, cur, wr, wc, fr, fq);
        if (!has_next) break;
#pragma unroll
        for (int a = 0; a < 2; ++a)
#pragma unroll
            for (int b = 0; b < 2; ++b)
#pragma unroll
                for (int m = 0; m < 4; ++m)
#pragma unroll
                    for (int n = 0; n < 2; ++n) acc[a][b][m][n] = (f32x4){0.f, 0.f, 0.f, 0.f};
        cur = nxt; cA = nA; cB = nB; ++ui;
        if constexpr (GATHER) {
#pragma unroll
            for (int h = 0; h < 2; ++h)
#pragma unroll
                for (int i = 0; i < 2; ++i) gC[h][i] = gN[h][i];
        }
        if (wr == 1) PG8_BAR;
    }
    PG8_WAIT_V(0);
    PG8_BAR;
#undef PG8_SA
#undef PG8_SB
#undef PG8_DMA
#undef PG8_STAGE
#undef PG8_STAGE_A
#undef PG8_LDA
#undef PG8_LDB
#undef PG8_MMA
#undef PG8_WAIT_V
#undef PG8_WAIT_L
#undef PG8_BAR
#undef PG8_SCHED
}
}

struct Params { const float* in[27]; float* out; unsigned char* ws; int ph_lo, ph_hi; };
struct Ctx { LAS unsigned char* lds; int tid, lane, wave, vcu, G, gw, NGW; mutable unsigned long long sw_t0, sw_sum; };
#ifndef SW_ID
#define SW_ID 0
#endif
#define SW_START(id) do { if (SW_ID == (id)) c.sw_t0 = __builtin_amdgcn_s_memrealtime(); } while (0)
#define SW_STOP(id) do { if (SW_ID == (id)) c.sw_sum += __builtin_amdgcn_s_memrealtime() - c.sw_t0; } while (0)
enum { I_X = 0, I_C, I_MODW, I_MODB, I_N1G, I_WIN, I_CONVK, I_CONVB, I_CLNG, I_CLNB, I_QNG, I_KVNG, I_WUQ, I_WUK, I_WUV, I_POOLW, I_POOLS, I_WOUT, I_N2G, I_RGW, I_RGB, I_REW, I_REB, I_W1, I_W3, I_W2, I_FG };

template <class RowMap>
__device__ __forceinline__ void tr_item(const float* src, int ldn, int k0, int n0, int nvalid, bf16_t* dst, int ldk, int dk0, RowMap rm, LAS float* scr, int lane) {
#pragma unroll 8
    for (int i = 0; i < 32; ++i) { const int kk = 2 * i + (lane >> 5), n = n0 + (lane & 31); scr[kk * 33 + (lane & 31)] = (n < nvalid) ? src[(size_t)(k0 + kk) * ldn + n] : 0.f; }
    LDS_WAIT();
    const int c = lane & 7;
#pragma unroll
    for (int j = 0; j < 4; ++j) { const int n = (lane >> 3) + 8 * j; const LAS float* s = scr + (8 * c) * 33 + n;
        u32x4 o; o.x = cvt_pk_bf16(s[0 * 33], s[1 * 33]); o.y = cvt_pk_bf16(s[2 * 33], s[3 * 33]); o.z = cvt_pk_bf16(s[4 * 33], s[5 * 33]); o.w = cvt_pk_bf16(s[6 * 33], s[7 * 33]);
        *(u32x4*)(dst + (size_t)rm(n0 + n) * ldk + dk0 + k0 + 8 * c) = o; }
    LDS_WAIT();
}

__device__ __forceinline__ void conv_experts(const Params& p, const Ctx& c, int l) {
    LAS float* scr = (LAS float*)(c.lds + c.wave * 8448);
    bf16_t* W13 = (bf16_t*)(p.ws + WS_W13); bf16_t* W2 = (bf16_t*)(p.ws + WS_W2);
    for (int it = c.gw; it < 3 * 8192; it += c.NGW) {
        const int which = it >> 13, r = it & 8191, e = r >> 8;
        if (which < 2) { const int kb = (r >> 4) & 15, nb = r & 15; const float* src = p.in[which ? I_W3 : I_W1] + (size_t)(l * NEXP + e) * 1024 * 512; const int add = which ? 4 : 0;
            tr_item(src, 512, 64 * kb, 32 * nb, 512, W13 + (size_t)e * 1024 * 1024, 1024, 0, [add](int n) { return 8 * (n >> 2) + (n & 3) + add; }, scr, c.lane); }
        else { const int kb = (r >> 5) & 7, nb = r & 31; const float* src = p.in[I_W2] + (size_t)(l * NEXP + e) * 512 * 1024;
            tr_item(src, 1024, 64 * kb, 32 * nb, 1024, W2 + (size_t)e * 1024 * 512, 512, 0, [](int n) { return n; }, scr, c.lane); }
    }
}

__device__ __forceinline__ void cx_issue(const Params& p, int l, int it, int lane, float (&tv)[32]) {
    const int which = it >> 13, r = it & 8191, e = r >> 8;
    const float* src; int ldn, k0, n0;
    if (which < 2) { const int kb = (r >> 4) & 15, nb = r & 15; src = p.in[which ? I_W3 : I_W1] + (size_t)(l * NEXP + e) * 1024 * 512; ldn = 512; k0 = 64 * kb; n0 = 32 * nb; }
    else { const int kb = (r >> 5) & 7, nb = r & 31; src = p.in[I_W2] + (size_t)(l * NEXP + e) * 512 * 1024; ldn = 1024; k0 = 64 * kb; n0 = 32 * nb; }
    const float* s0 = src + (size_t)(k0 + (lane >> 5)) * ldn + n0 + (lane & 31);
#pragma unroll
    for (int i = 0; i < 32; ++i) tv[i] = s0[(size_t)(2 * i) * ldn];
}
__device__ __forceinline__ void cx_finish(const Params& p, int it, int lane, const float (&tv)[32], LAS float* scr) {
    const int which = it >> 13, r = it & 8191, e = r >> 8;
    bf16_t* dst; int ldk, k0, n0, add = 0; bool inter = false;
    if (which < 2) { const int kb = (r >> 4) & 15, nb = r & 15; dst = (bf16_t*)(p.ws + WS_W13) + (size_t)e * 1024 * 1024; ldk = 1024; k0 = 64 * kb; n0 = 32 * nb; add = which ? 4 : 0; inter = true; }
    else { const int kb = (r >> 5) & 7, nb = r & 31; dst = (bf16_t*)(p.ws + WS_W2) + (size_t)e * 1024 * 512; ldk = 512; k0 = 64 * kb; n0 = 32 * nb; }
#pragma unroll
    for (int i = 0; i < 32; ++i) scr[(2 * i + (lane >> 5)) * 33 + (lane & 31)] = tv[i];
    LDS_WAIT();
    const int cc = lane & 7;
#pragma unroll
    for (int j = 0; j < 4; ++j) { const int n = (lane >> 3) + 8 * j; const LAS float* sp = scr + (8 * cc) * 33 + n; const int nn = n0 + n; const int row = inter ? (8 * (nn >> 2) + (nn & 3) + add) : nn;
        u32x4 o; o.x = cvt_pk_bf16(sp[0 * 33], sp[1 * 33]); o.y = cvt_pk_bf16(sp[2 * 33], sp[3 * 33]); o.z = cvt_pk_bf16(sp[4 * 33], sp[5 * 33]); o.w = cvt_pk_bf16(sp[6 * 33], sp[7 * 33]);
        *(u32x4*)(dst + (size_t)row * ldk + k0 + 8 * cc) = o; }
    LDS_WAIT();
}

__device__ __forceinline__ void ph_prologue(const Params& p, const Ctx& c) {
    float* mod = (float*)(p.ws + WS_MOD);
    {
        LAS float* cond = (LAS float*)c.lds; LAS float* part = (LAS float*)(c.lds + 65536);
        bool loaded = false;
        for (int item = c.vcu; item < 192; item += c.G) {
            if (!loaded) { for (int i = c.tid; i < NB * D; i += 512) { const float v = p.in[I_C][i]; cond[i] = v / (1.0f + expf(-v)); } __syncthreads(); loaded = true; }
            const int l = item / 96, n0 = (item % 96) * 64;
            const float* W = p.in[I_MODW] + (size_t)l * D * 6144 + n0 + c.lane;
            float acc[NB];
#pragma unroll
            for (int b = 0; b < NB; ++b) acc[b] = 0.f;
#pragma unroll 8
            for (int k = c.wave * 128; k < c.wave * 128 + 128; ++k) { const float w = W[(size_t)k * 6144];
#pragma unroll
                for (int b = 0; b < NB; ++b) acc[b] += cond[b * D + k] * w; }
#pragma unroll
            for (int b = 0; b < NB; ++b) part[(c.wave * NB + b) * 64 + c.lane] = acc[b];
            __syncthreads();
            for (int o = c.tid; o < NB * 64; o += 512) { const int b = o >> 6, ln = o & 63; float s = 0.f;
#pragma unroll
                for (int w = 0; w < 8; ++w) s += part[(w * NB + b) * 64 + ln];
                mod[(size_t)(l * NB + b) * 6144 + n0 + ln] = s + p.in[I_MODB][l * 6144 + n0 + ln]; }
            __syncthreads();
        }
        __syncthreads();
    }
    {
        LAS float* scr = (LAS float*)(c.lds + c.wave * 8448);
        constexpr int I_IN = 16 * 56;
        for (int it = c.gw; it < 2 * I_IN; it += c.NGW) {
            const int l = it / I_IN, r = it % I_IN, kb = r / 56, nb = r % 56;
            tr_item(p.in[I_WIN] + (size_t)l * D * N_IN, N_IN, 64 * kb, 32 * nb, N_IN, (bf16_t*)(p.ws + WS_WIN) + (size_t)l * NZ * D, D, 0, [](int n) { return n; }, scr, c.lane);
        }
    }
}
__device__ __forceinline__ void ph_prologue_rest(const Params& p, const Ctx& c, int wid, int nw) {
    {
        LAS float* scr = (LAS float*)(c.lds + c.wave * 8448);
        constexpr int I_MX = 4 * 32;
        for (int it = wid; it < 2 * 2 * I_MX; it += nw) {
            const int l = it / (2 * I_MX); int r = it % (2 * I_MX); const int part = r / I_MX; r %= I_MX; const int kb = r / 32, nb = r % 32;
            tr_item(p.in[I_WOUT] + (size_t)l * D * D + (size_t)(part ? 768 : 0) * D, D, 64 * kb, 32 * nb, D, (bf16_t*)(p.ws + WS_WMIX) + (size_t)l * D * KMIX, KMIX, part ? 1280 : 0, [](int n) { return n; }, scr, c.lane);
        }
    }
    for (int it = wid * 64 + c.lane; it < 2 * 131072; it += nw * 64) {
        const int l = it >> 17, r = it & 131071, n = r & 1023, h = (r >> 10) & 7, cb = r >> 13;
        const float* wo = p.in[I_WOUT] + (size_t)l * D * D + (size_t)(256 + 64 * h) * D + n;
        const float* wv = p.in[I_WUV] + (size_t)l * 128 * 512 + (size_t)(8 * cb) * 512 + h * 64;
        float acc[8];
#pragma unroll
        for (int j = 0; j < 8; ++j) acc[j] = 0.f;
        for (int d0 = 0; d0 < 64; d0 += 16) { float w[16];
#pragma unroll
            for (int q = 0; q < 16; ++q) w[q] = wo[(size_t)(d0 + q) * D];
#pragma unroll
            for (int j = 0; j < 8; ++j) { asm volatile("" ::: "memory");
#pragma unroll
                for (int q = 0; q < 16; q += 4) { const f32x4 v4 = *(const f32x4*)(wv + j * 512 + d0 + q); acc[j] += (v4.x * w[q] + v4.y * w[q + 1]) + (v4.z * w[q + 2] + v4.w * w[q + 3]); } } }
        u32x4 o; o.x = cvt_pk_bf16(acc[0], acc[1]); o.y = cvt_pk_bf16(acc[2], acc[3]); o.z = cvt_pk_bf16(acc[4], acc[5]); o.w = cvt_pk_bf16(acc[6], acc[7]);
        *(u32x4*)((bf16_t*)(p.ws + WS_WMIX) + (size_t)l * D * KMIX + (size_t)n * KMIX + 256 + 128 * h + 8 * cb) = o;
    }
    for (int it = wid * 64 + c.lane; it < 2 * 32768; it += nw * 64) {
        const int l = it >> 15, r = it & 32767, cb = r & 31, k = (r >> 5) & 127, h = r >> 12;
        const float* uq = p.in[I_WUQ] + (size_t)l * 256 * 512 + (size_t)(8 * cb) * 512 + h * 64;
        const float* uk = p.in[I_WUK] + (size_t)l * 128 * 512 + (size_t)k * 512 + h * 64;
        float acc[8];
#pragma unroll
        for (int j = 0; j < 8; ++j) acc[j] = 0.f;
        for (int d0 = 0; d0 < 64; d0 += 16) { f32x4 w4[4];
#pragma unroll
            for (int q = 0; q < 4; ++q) w4[q] = *(const f32x4*)(uk + d0 + 4 * q);
#pragma unroll
            for (int j = 0; j < 8; ++j) { asm volatile("" ::: "memory");
#pragma unroll
                for (int q = 0; q < 4; ++q) { const f32x4 v4 = *(const f32x4*)(uq + j * 512 + d0 + 4 * q); acc[j] += (v4.x * w4[q].x + v4.y * w4[q].y) + (v4.z * w4[q].z + v4.w * w4[q].w); } } }
        const float sc = 0.125f * 1.44269504089f;
#pragma unroll
        for (int j = 0; j < 8; ++j) acc[j] *= sc * p.in[I_QNG][l * 256 + 8 * cb + j];
        u32x4 o; o.x = cvt_pk_bf16(acc[0], acc[1]); o.y = cvt_pk_bf16(acc[2], acc[3]); o.z = cvt_pk_bf16(acc[4], acc[5]); o.w = cvt_pk_bf16(acc[6], acc[7]);
        *(u32x4*)((bf16_t*)(p.ws + WS_WQA) + (size_t)l * D * 256 + (size_t)(h * 128 + k) * 256 + 8 * cb) = o;
    }
    for (int it = wid * 64 + c.lane; it < 2 * 1024 * 32; it += nw * 64) {
        const int l = it >> 15, r = it & 32767, k = r >> 5, g = (r >> 3) & 3, q = r & 7, e = k & 3, ln = (k >> 2) & 63, j = k >> 8;
        ((float*)(p.ws + WS_SMALL + SM_REW2))[(size_t)(l * 4 + g) * 8192 + (size_t)((((j * 4 + e) * 2 + (q >> 2)) * 64 + ln) * 4) + (q & 3)] = p.in[I_REW][(size_t)l * D * 32 + r];
    }
    for (int it = wid * 64 + c.lane; it < 2 * 1024 * 4; it += nw * 64) {
        const int l = it >> 12, r = it & 4095, k = r >> 2, q = r & 3, e = k & 3, ln = (k >> 2) & 63, j = k >> 8;
        ((float*)(p.ws + WS_SMALL + SM_RGW2))[(size_t)l * 4096 + (size_t)(((j * 4 + e) * 64 + ln) * 4) + q] = p.in[I_RGW][(size_t)l * D * 4 + r];
    }
    for (int it = wid * 64 + c.lane; it < 2 * 4 * 64 * 8; it += nw * 64) {
        const int lg = it >> 9, r = it & 511, o = r >> 3, ib = r & 7; const float* src = p.in[I_POOLW] + (size_t)lg * 4096 + (size_t)(8 * ib) * 64 + o;
        u32x4 w; w.x = cvt_pk_bf16(src[0], src[64]); w.y = cvt_pk_bf16(src[128], src[192]); w.z = cvt_pk_bf16(src[256], src[320]); w.w = cvt_pk_bf16(src[384], src[448]);
        *(u32x4*)((bf16_t*)(p.ws + WS_SMALL + SM_PWT) + (size_t)lg * 4096 + o * 64 + 8 * ib) = w;
    }
}

template <int MODE>
__device__ __forceinline__ void ph_norm1(const Params& p, const Ctx& c) {
    const float* mod = (const float*)(p.ws + WS_MOD);
    const bf16_t* Y = (const bf16_t*)(p.ws + WS_Y); const int* tslot = (const int*)(p.ws + WS_SMALL + SM_TSLOT);
    bf16_t* H = (bf16_t*)(p.ws + WS_H); bf16_t* X16 = (bf16_t*)(p.ws + WS_X16);
    constexpr int NR = (MODE == 0) ? 4 : 2;
    const int nrow = T / c.NGW;
    f32x4 vn[NR][4]; u32x2 xn[NR][4], an[NR][4], bn[NR][4];
    auto load_rows = [&](int r0) {
#pragma unroll
        for (int t = 0; t < NR; ++t) { const int m = c.gw + (r0 + t) * c.NGW;
            if (MODE == 0) {
#pragma unroll
                for (int j = 0; j < 4; ++j) vn[t][j] = ((const f32x4*)(p.in[I_X] + (size_t)m * D) + c.lane)[64 * j];
            } else { const int s0 = tslot[2 * m], s1 = tslot[2 * m + 1];
#pragma unroll
                for (int j = 0; j < 4; ++j) { xn[t][j] = ((const u32x2*)(X16 + (size_t)m * D) + c.lane)[64 * j]; an[t][j] = ((const u32x2*)(Y + (size_t)s0 * D) + c.lane)[64 * j]; bn[t][j] = ((const u32x2*)(Y + (size_t)s1 * D) + c.lane)[64 * j]; } } } };
    load_rows(0);
    for (int r0 = 0; r0 < nrow; r0 += NR) {
        f32x4 v[NR][4]; u32x2 ya[NR][4], yb[NR][4];
#pragma unroll
        for (int t = 0; t < NR; ++t)
#pragma unroll
            for (int j = 0; j < 4; ++j) { if (MODE == 0) v[t][j] = vn[t][j]; else { v[t][j] = (f32x4){bflo(xn[t][j].x), bfhi(xn[t][j].x), bflo(xn[t][j].y), bfhi(xn[t][j].y)}; ya[t][j] = an[t][j]; yb[t][j] = bn[t][j]; } }
        if (r0 + NR < nrow) load_rows(r0 + NR);
#pragma unroll
        for (int t = 0; t < NR; ++t) {
            const int m = c.gw + (r0 + t) * c.NGW, b = m >> 11;
            if (MODE != 0) {
                const f32x4* g2 = (const f32x4*)(mod + (size_t)((MODE - 1) * NB + b) * 6144 + 5120) + c.lane;
#pragma unroll
                for (int j = 0; j < 4; ++j) { const u32x2 a = ya[t][j], bb = yb[t][j]; const f32x4 g = g2[64 * j];
                    v[t][j].x += g.x * (bflo(a.x) + bflo(bb.x)); v[t][j].y += g.y * (bfhi(a.x) + bfhi(bb.x)); v[t][j].z += g.z * (bflo(a.y) + bflo(bb.y)); v[t][j].w += g.w * (bfhi(a.y) + bfhi(bb.y)); }
            }
            float ss = 0.f;
#pragma unroll
            for (int j = 0; j < 4; ++j) ss += (v[t][j].x * v[t][j].x + v[t][j].y * v[t][j].y) + (v[t][j].z * v[t][j].z + v[t][j].w * v[t][j].w);
            const float r = 1.0f / sqrtf(wave_sum(ss) * (1.0f / D) + EPS);
            if (MODE == 2) {
                const f32x4* fg = (const f32x4*)p.in[I_FG] + c.lane; f32x4* o = (f32x4*)(p.out + (size_t)m * D) + c.lane;
#pragma unroll
                for (int j = 0; j < 4; ++j) o[64 * j] = v[t][j] * r * fg[64 * j];
            } else {
                if (MODE == 1) { u32x2* o = (u32x2*)(X16 + (size_t)m * D) + c.lane;
#pragma unroll
                    for (int j = 0; j < 4; ++j) { u32x2 w; w.x = cvt_pk_bf16(v[t][j].x, v[t][j].y); w.y = cvt_pk_bf16(v[t][j].z, v[t][j].w); o[64 * j] = w; } }
                const int l = MODE;
                const f32x4* ng = (const f32x4*)(p.in[I_N1G] + l * D) + c.lane;
                const f32x4* sh = (const f32x4*)(mod + (size_t)(l * NB + b) * 6144) + c.lane; const f32x4* sc = (const f32x4*)(mod + (size_t)(l * NB + b) * 6144 + 1024) + c.lane;
                u32x2* o8 = (u32x2*)(H + (size_t)m * D) + c.lane;
#pragma unroll
                for (int j = 0; j < 4; ++j) { const f32x4 hv = v[t][j] * r * ng[64 * j] * (sc[64 * j] + 1.0f) + sh[64 * j]; u32x2 w; w.x = cvt_pk_bf16(hv.x, hv.y); w.y = cvt_pk_bf16(hv.z, hv.w); o8[64 * j] = w; }
            }
        }
    }
}

__device__ __forceinline__ void ph_postz(const Params& p, const Ctx& c, int l) {
    const bf16_t* Z = (const bf16_t*)(p.ws + WS_Z); bf16_t* MC = (bf16_t*)p.out;
    bf16_t* CQR = (bf16_t*)(p.ws + WS_CQR); bf16_t* KVN = (bf16_t*)(p.ws + WS_KVN);
    LAS float* U = (LAS float*)c.lds;
    const int lane = c.lane, tk0 = c.wave * 8;
    LAS f32x4* CK = (LAS f32x4*)(c.lds + 98304);
    { const f32x4* src = (const f32x4*)(p.in[I_CONVK] + (size_t)l * 31 * 256); f32x4 t[4];
#pragma unroll
      for (int q = 0; q < 4; ++q) { const int i = c.tid + 512 * q; t[q] = src[i < 31 * 64 ? i : 0]; }
#pragma unroll
      for (int q = 0; q < 4; ++q) { const int i = c.tid + 512 * q; if (i < 31 * 64) CK[i] = t[q]; } }
    __syncthreads();
    for (int unit = c.vcu; unit < 512; unit += c.G) {
        const int b = unit >> 5, s0 = (unit & 31) * 64, t0 = b * S + s0;
        SW_START(1);
#pragma unroll
        for (int hb = 0; hb < 2; ++hb) {   u32x2 av[6], gv[6];
#pragma unroll
            for (int q = 0; q < 6; ++q) { const int idx = c.tid + 512 * (6 * hb + q), r = idx >> 6, c4 = idx & 63; int s = s0 - 30 + r; s = s < 0 ? 0 : (s > S - 1 ? S - 1 : s);
                const bf16_t* zr = Z + (size_t)(b * S + s) * NZ + 4 * c4; av[q] = *(const u32x2*)(zr + Z_AVAL); gv[q] = *(const u32x2*)(zr + Z_AGATE); }
#pragma unroll
            for (int q = 0; q < 6; ++q) { const int idx = c.tid + 512 * (6 * hb + q), r = idx >> 6, c4 = idx & 63, s = s0 - 30 + r; f32x4 u = {0.f, 0.f, 0.f, 0.f};
                if (s >= 0) { const u32x2 a = av[q], g = gv[q];
                    u.x = bflo(a.x) * sigmoidf_(bflo(g.x)); u.y = bfhi(a.x) * sigmoidf_(bfhi(g.x)); u.z = bflo(a.y) * sigmoidf_(bflo(g.y)); u.w = bfhi(a.y) * sigmoidf_(bfhi(g.y)); }
                if (idx < 94 * 64) *(LAS f32x4*)(U + r * 256 + 4 * c4) = u; }
            asm volatile("" ::: "memory");
        }
        __syncthreads();
        SW_STOP(1); SW_START(2);
        {
            const LAS f32x4* ck = CK + lane;
            const f32x4 cb = *((const f32x4*)(p.in[I_CONVB] + l * 256) + lane), lg = *((const f32x4*)(p.in[I_CLNG] + l * 256) + lane), lb = *((const f32x4*)(p.in[I_CLNB] + l * 256) + lane);
#pragma unroll 1
            for (int hp = 0; hp < 2; ++hp) {
                const int tq = tk0 + 4 * hp;
                f32x4 acc[4], win[4];
#pragma unroll
                for (int i = 0; i < 4; ++i) { acc[i] = (f32x4){0.f, 0.f, 0.f, 0.f}; win[i] = *(const LAS f32x4*)(U + (tq + i) * 256 + 4 * lane); }
#pragma unroll
                for (int j = 0; j < 31; ++j) { const f32x4 kj = ck[64 * j];
#pragma unroll
                    for (int i = 0; i < 4; ++i) acc[i] += win[i] * kj;
                    if (j < 30) {
#pragma unroll
                        for (int i = 0; i < 3; ++i) win[i] = win[i + 1];
                        win[3] = *(const LAS f32x4*)(U + (tq + 4 + j) * 256 + 4 * lane); } }
#pragma unroll
                for (int i = 0; i < 4; ++i) { const f32x4 v = acc[i] + cb; const float mean = wave_sum((v.x + v.y) + (v.z + v.w)) * (1.0f / 256.0f);
                    const f32x4 d = v - mean; const float var = wave_sum((d.x * d.x + d.y * d.y) + (d.z * d.z + d.w * d.w)) * (1.0f / 256.0f);
                    const float rs = 1.0f / sqrtf(var + EPS); f32x4 y = d * rs * lg + lb;
                    y.x *= sigmoidf_(y.x); y.y *= sigmoidf_(y.y); y.z *= sigmoidf_(y.z); y.w *= sigmoidf_(y.w);
                    u32x2 w; w.x = cvt_pk_bf16(y.x, y.y); w.y = cvt_pk_bf16(y.z, y.w);
                    *(u32x2*)(MC + (size_t)(t0 + tq + i) * KMIX + 4 * lane) = w; }
            }
        }
        __syncthreads();
        SW_STOP(2); SW_START(3);
        {   u32x2 av[10];
#pragma unroll
            for (int q = 0; q < 10; ++q) { const int idx = c.tid + 512 * q, r = idx >> 6, c4 = idx & 63; int s = s0 - 15 + r; s = s < 0 ? 0 : (s > S - 1 ? S - 1 : s);
                av[q] = *(const u32x2*)(Z + (size_t)(b * S + s) * NZ + Z_UP + 4 * c4); }
#pragma unroll
            for (int q = 0; q < 10; ++q) { const int idx = c.tid + 512 * q, r = idx >> 6, c4 = idx & 63, s = s0 - 15 + r; f32x4 u = {0.f, 0.f, 0.f, 0.f};
                if (s >= 0) { const u32x2 a = av[q]; u.x = bflo(a.x); u.y = bfhi(a.x); u.z = bflo(a.y); u.w = bfhi(a.y); }
                if (idx < 79 * 64) *(LAS f32x4*)(U + r * 256 + 4 * c4) = u; }
        }
        __syncthreads();
        f32x4 dv[8];
        {
            const int w = 2 << (lane >> 4);
#pragma unroll
            for (int i = 0; i < 8; ++i) { const int r = 15 + tk0 + i, s = s0 + tk0 + i; f32x4 sum = {0.f, 0.f, 0.f, 0.f};
#pragma unroll
                for (int q = 0; q < 16; ++q) { const f32x4 u = *(const LAS f32x4*)(U + (r - q) * 256 + 4 * lane); if (q < w) sum += u; }
                const float rc = __builtin_amdgcn_rcpf((float)((s + 1) < w ? (s + 1) : w));
                dv[i] = sum * rc - *(const LAS f32x4*)(U + r * 256 + 4 * lane); }
        }
        SW_STOP(3); SW_START(5);
        {
            __syncthreads();
            LAS bf16_t* D16 = (LAS bf16_t*)c.lds;
#pragma unroll
            for (int i = 0; i < 8; ++i) { u32x2 w; w.x = cvt_pk_bf16(dv[i].x, dv[i].y); w.y = cvt_pk_bf16(dv[i].z, dv[i].w); *(LAS u32x2*)(D16 + (tk0 + i) * 264 + 4 * lane) = w; }
            __syncthreads();
            const int mt = c.wave & 3, g0 = (c.wave >> 2) * 2, fr = lane & 15, fq = lane >> 4;
            const bf16_t* PWT = (const bf16_t*)(p.ws + WS_SMALL + SM_PWT) + (size_t)l * 4 * 4096;
#pragma unroll
            for (int gg = 0; gg < 2; ++gg) { const int g = g0 + gg;
                const bf16x8 d0 = *(const LAS bf16x8*)(D16 + (16 * mt + fr) * 264 + 64 * g + 8 * fq), d1 = *(const LAS bf16x8*)(D16 + (16 * mt + fr) * 264 + 64 * g + 32 + 8 * fq);
#pragma unroll
                for (int nt = 0; nt < 4; ++nt) {
                    const bf16_t* wp = PWT + (size_t)g * 4096 + (16 * nt + fr) * 64 + 8 * fq;
                    const bf16x8 w0 = *(const bf16x8*)wp, w1 = *(const bf16x8*)(wp + 32);
                    f32x4 acc = {0.f, 0.f, 0.f, 0.f};
                    acc = __builtin_amdgcn_mfma_f32_16x16x32_bf16(w0, d0, acc, 0, 0, 0); acc = __builtin_amdgcn_mfma_f32_16x16x32_bf16(w1, d1, acc, 0, 0, 0);
                    const int oc = 64 * g + 16 * nt + 4 * fq;
                    const f32x4 ps = *(const f32x4*)(p.in[I_POOLS] + l * 256 + oc); const f32x4 y = acc * ps;
                    u32x2 w; w.x = cvt_pk_bf16(y.x, y.y); w.y = cvt_pk_bf16(y.z, y.w);
                    *(u32x2*)(MC + (size_t)(t0 + 16 * mt + fr) * KMIX + 1280 + oc) = w; } }
        }
        SW_STOP(5); SW_START(6);
        asm volatile("" ::: "memory");
        {
            const float kg0 = p.in[I_KVNG][l * 128 + 2 * lane], kg1 = p.in[I_KVNG][l * 128 + 2 * lane + 1];
            u32x2 qv[8]; unsigned kvv[8];
#pragma unroll
            for (int i = 0; i < 8; ++i) { const bf16_t* zr = Z + (size_t)(t0 + tk0 + i) * NZ; qv[i] = *(const u32x2*)(zr + Z_CQ + 4 * lane); kvv[i] = *(const unsigned*)(zr + Z_CKV + 2 * lane); }
#pragma unroll
            for (int i = 0; i < 8; ++i) { const size_t t = (size_t)(t0 + tk0 + i);
                const u32x2 q = qv[i]; const float q0 = bflo(q.x), q1 = bfhi(q.x), q2 = bflo(q.y), q3 = bfhi(q.y);
                const float rq = 1.0f / sqrtf(wave_sum((q0 * q0 + q1 * q1) + (q2 * q2 + q3 * q3)) * (1.0f / 256.0f) + EPS);
                u32x2 w; w.x = cvt_pk_bf16(q0 * rq, q1 * rq); w.y = cvt_pk_bf16(q2 * rq, q3 * rq); *(u32x2*)(CQR + t * 256 + 4 * lane) = w;
                const unsigned kv = kvv[i]; const float k0 = bflo(kv), k1 = bfhi(kv);
                const float rk = 1.0f / sqrtf(wave_sum(k0 * k0 + k1 * k1) * (1.0f / 128.0f) + EPS);
                *(unsigned*)(KVN + t * 128 + 2 * lane) = cvt_pk_bf16(k0 * rk * kg0, k1 * rk * kg1); }
        }
        SW_STOP(6);
        __syncthreads();
    }
}

__device__ __forceinline__ size_t sc_off(int b, int cq) { return (size_t)b * SC_PER_B + (size_t)2048 * cq * (cq + 1); }
__device__ __forceinline__ void ph_scores(const Params& p, const Ctx& c) {
    const bf16_t* Z = (const bf16_t*)(p.ws + WS_Z); float* SC = (float*)(p.ws + WS_Y);
    const int lane = c.lane, l15 = lane & 15, g = lane >> 4;
    for (int U = c.gw; U < NB * 576; U += c.NGW) {
        const int b = U / 576, u = U % 576;
        int cg = 0; while (8 * (cg + 1) * (cg + 2) <= u) ++cg;
        const int r = u - 8 * cg * (cg + 1), q16 = r / (cg + 1), seg = r % (cg + 1), cq = 4 * cg + (q16 >> 2), q4 = q16 & 3;
        const int n = 64 * (cq + 1), kt0 = seg * 16, kt1 = (kt0 + 16 < 4 * (cq + 1)) ? kt0 + 16 : 4 * (cq + 1);
        SW_START(20);
        const size_t tq = (size_t)b * S + cq * 64 + q4 * 16 + l15;
        const bf16_t* zq = Z + tq * NZ;
        bf16x8 bq[8][2];
#pragma unroll
        for (int h = 0; h < 8; ++h)
#pragma unroll
            for (int s = 0; s < 2; ++s) bq[h][s] = *(const bf16x8*)(zq + Z_QI + h * 64 + 32 * s + 8 * g);
        float wq[8];
        { const u32x4 wv = *(const u32x4*)(zq + Z_WI); const float isc = 0.044194173824159216f;
          wq[0] = bflo(wv.x) * isc; wq[1] = bfhi(wv.x) * isc; wq[2] = bflo(wv.y) * isc; wq[3] = bfhi(wv.y) * isc; wq[4] = bflo(wv.z) * isc; wq[5] = bfhi(wv.z) * isc; wq[6] = bflo(wv.w) * isc; wq[7] = bfhi(wv.w) * isc; }
        float* srow = SC + sc_off(b, cq) + (size_t)(q4 * 16 + l15) * n;
        const bf16_t* zkb = Z + ((size_t)b * S + l15) * NZ + Z_KI + 8 * g;
        bf16x8 nk[2][2];
#pragma unroll
        for (int u2 = 0; u2 < 2; ++u2) { nk[u2][0] = *(const bf16x8*)(zkb + (size_t)(kt0 + u2) * 16 * NZ); nk[u2][1] = *(const bf16x8*)(zkb + (size_t)(kt0 + u2) * 16 * NZ + 32); }
        asm volatile("s_waitcnt vmcnt(0)" ::: "memory"); SW_STOP(20); SW_START(21);
        for (int kt = kt0; kt < kt1; kt += 2) {
            bf16x8 ak[2][2];
#pragma unroll
            for (int u2 = 0; u2 < 2; ++u2) { ak[u2][0] = nk[u2][0]; ak[u2][1] = nk[u2][1]; }
            if (kt + 2 < kt1) {
#pragma unroll
                for (int u2 = 0; u2 < 2; ++u2) { nk[u2][0] = *(const bf16x8*)(zkb + (size_t)(kt + 2 + u2) * 16 * NZ); nk[u2][1] = *(const bf16x8*)(zkb + (size_t)(kt + 2 + u2) * 16 * NZ + 32); } }
            f32x2 s01[2] = {{0.f, 0.f}, {0.f, 0.f}}, s23[2] = {{0.f, 0.f}, {0.f, 0.f}};
#pragma unroll
            for (int h = 0; h < 8; ++h) {
#pragma unroll
                for (int u2 = 0; u2 < 2; ++u2) { f32x4 a = {0.f, 0.f, 0.f, 0.f};
                    a = __builtin_amdgcn_mfma_f32_16x16x32_bf16(ak[u2][0], bq[h][0], a, 0, 0, 0);
                    a = __builtin_amdgcn_mfma_f32_16x16x32_bf16(ak[u2][1], bq[h][1], a, 0, 0, 0);
                    const f32x2 r01 = {__int_as_float(max(__float_as_int(a[0]), 0)), __int_as_float(max(__float_as_int(a[1]), 0))}, r23 = {__int_as_float(max(__float_as_int(a[2]), 0)), __int_as_float(max(__float_as_int(a[3]), 0))};
                    const f32x2 w2 = {wq[h], wq[h]}; s01[u2] = __builtin_elementwise_fma(r01, w2, s01[u2]); s23[u2] = __builtin_elementwise_fma(r23, w2, s23[u2]); } }
#pragma unroll
            for (int u2 = 0; u2 < 2; ++u2) *(f32x4*)(srow + (kt + u2) * 16 + 4 * g) = (f32x4){s01[u2].x, s01[u2].y, s23[u2].x, s23[u2].y};
        }
        SW_STOP(21);
    }
}

__device__ __forceinline__ unsigned off_b(unsigned row, unsigned ch) { return 256u * row + 16u * (ch ^ (((row & 3) << 2) | ((row >> 2) & 3))); }
template <int MODE>
__device__ __forceinline__ void ph_attn(const Params& p, const Ctx& c, int l) {
    const float* SC = (const float*)(p.ws + WS_Y); const bf16_t* QA = (const bf16_t*)(p.ws + WS_H); const bf16_t* KVN = (const bf16_t*)(p.ws + WS_KVN);
    bf16_t* MC = (bf16_t*)p.out;
    const int lane = c.lane, g = lane >> 4, hd = lane & 15;
    LAS unsigned char* tile = c.lds + c.wave * 16384;
    LAS unsigned* lst = (LAS unsigned*)(c.lds + LIST_OFF + c.wave * 1088);
    const unsigned long long ltmask = (1ull << lane) - 1ull;
    const int xg = blockIdx.x & 7, wv = (blockIdx.x >> 3) * 8 + c.wave, nwv = (c.G >> 3) * 8;
    int cxq = 0;
    float svn[32];
#define ATT_PREFETCH(qn_) do { const int bn_ = xg + 8 * ((qn_) / S), sn_ = (qn_) % S, cn_ = sn_ >> 6, nn_ = 64 * (cn_ + 1); \
        const float* srn_ = SC + sc_off(bn_, cn_) + (size_t)(sn_ & 63) * nn_ + lane; \
        _Pragma("unroll") for (int j = 0; j < 32; ++j) svn[j] = srn_[64 * (j <= cn_ ? j : cn_)]; } while (0)
    if ((MODE & 1) && wv < 2 * S) ATT_PREFETCH(wv);
    for (int qi = wv; qi < 2 * S; qi += nwv) {
        const int b = xg + 8 * (qi / S), s = qi % S, cq = s >> 6, n = 64 * (cq + 1), nk = n < 256 ? n : 256;
        const size_t t = (size_t)b * S + s;
        float sv[32];
#pragma unroll
        for (int j = 0; j < 32; ++j) sv[j] = svn[j];
        if ((MODE & 1) && qi + nwv < 2 * S) ATT_PREFETCH(qi + nwv);
        float tv[32]; const int cit = c.gw + c.NGW * cxq; const bool cxv = (MODE & 8) && cit < 3 * 8192;
        if (cxv) cx_issue(p, l, cit, lane, tv);
        SW_START(10);
        if (cq < 4 || !(MODE & 1)) { for (int i = lane; i < nk; i += 64) lst[i] = (unsigned)i * 256u; }
        else {
            unsigned key[32]; unsigned kmin = 0xffffffffu, kmax = 0u;
#pragma unroll
            for (int j = 0; j < 32; ++j) key[j] = 0u;
#pragma unroll
            for (int jb = 0; jb < 4; ++jb) if (8 * jb <= cq) {
#pragma unroll
                for (int j = 8 * jb; j < 8 * jb + 8; ++j) { const unsigned u = __float_as_uint(sv[j] + 0.0f); const unsigned k = (u & 0x80000000u) ? ~u : (u | 0x80000000u);
                    key[j] = (j <= cq) ? k : 0u; kmin = (j <= cq && k < kmin) ? k : kmin; kmax = (j <= cq && k > kmax) ? k : kmax; } }
#define KMM(W) { const unsigned a = lane_xor<W>(kmin), bb = lane_xor<W>(kmax); kmin = a < kmin ? a : kmin; kmax = bb > kmax ? bb : kmax; }
            KMM(1) KMM(2) KMM(4) KMM(8) KMM(16) KMM(32)
#undef KMM
            SW_START(11);
            unsigned lo = __builtin_amdgcn_readfirstlane(kmin), hi = __builtin_amdgcn_readfirstlane(kmax); int c_lo = n, c_hi = 0; int it = 0;
            unsigned thr = 0u; int need = 0; bool done = false;
            while (lo < hi && (c_lo - c_hi) > 64) {
                unsigned mid;
                if (it < 20) {
                    const float lo_v = __uint_as_float((lo & 0x80000000u) ? (lo ^ 0x80000000u) : ~lo), hi_v = __uint_as_float((hi & 0x80000000u) ? (hi ^ 0x80000000u) : ~hi);
                    const float f = (it & 1) ? 0.5f : (float)(c_lo - 256) * __builtin_amdgcn_rcpf((float)(c_lo - c_hi));
                    const float mid_v = lo_v + (hi_v - lo_v) * f + 0.0f;
                    const unsigned mu = __float_as_uint(mid_v); mid = (mu & 0x80000000u) ? ~mu : (mu | 0x80000000u);
                } else mid = lo + ((hi - lo) >> 1) + 1u;
                mid = mid > lo ? mid : lo + 1u; mid = mid < hi ? mid : hi;
                int cnt = 0;
#pragma unroll
                for (int jb = 0; jb < 4; ++jb) if (8 * jb <= cq) {
                    unsigned long long bm[8];
#pragma unroll
                    for (int j = 0; j < 8; ++j) bm[j] = __ballot(key[8 * jb + j] >= mid);
#pragma unroll
                    for (int j = 0; j < 8; ++j) cnt += __builtin_popcountll(bm[j]); }
                if (cnt >= 256) { lo = mid; c_lo = cnt; if (cnt == 256) { thr = mid; need = 1 << 20; done = true; break; } } else { hi = mid - 1u; c_hi = cnt; }
                ++it;
            }
            SW_STOP(11); SW_START(12);
            if (!done) {
                if (lo == hi) {
                    thr = lo; int cgt = 0;
#pragma unroll
                    for (int j = 0; j < 32; ++j) cgt += __builtin_popcountll(__ballot(key[j] > thr));
                    need = 256 - cgt;
                } else {
                    LAS unsigned* cand = (LAS unsigned*)lst; int base = 0;
#pragma unroll
                    for (int jb = 0; jb < 4; ++jb) if (8 * jb <= cq) {
#pragma unroll
                        for (int j = 8 * jb; j < 8 * jb + 8; ++j) { const bool isc = key[j] >= lo && key[j] <= hi; const unsigned long long bc = __ballot(isc);
                            if (isc) cand[base + __builtin_popcountll(bc & ltmask)] = key[j]; base += __builtin_popcountll(bc); } }
                    const int m = base;
                    const unsigned ck = lane < m ? cand[lane] : 0u;
                    int gt = 0, ge = 0;
                    for (int q = 0; q < m; ++q) { const unsigned v = (unsigned)__builtin_amdgcn_readlane((int)ck, q); gt += v > ck; ge += v >= ck; }
                    const int r = 256 - c_hi;
                    const unsigned long long hit = __ballot(lane < m && gt < r && r <= ge);
                    const int src = __builtin_ctzll(hit);
                    thr = __shfl(ck, src); need = r - __shfl(gt, src);
                }
            }
            SW_STOP(12); SW_START(13);
            asm volatile("" ::: "memory");
            {
                int base = 0, tb = 0;
#pragma unroll
                for (int jb = 0; jb < 4; ++jb) if (8 * jb <= cq) {
#pragma unroll
                    for (int j = 8 * jb; j < 8 * jb + 8; ++j) {
                        const bool gt = key[j] > thr, tie = key[j] == thr; const unsigned long long bt = __ballot(tie);
                        const int trank = tb + __builtin_popcountll(bt & ltmask); const bool sel = gt || (tie && trank < need);
                        const unsigned long long bs = __ballot(sel); const int pos = base + __builtin_popcountll(bs & ltmask);
                        if (sel && pos < 256) lst[pos] = (unsigned)(64 * j + lane) * 256u;
                        base += __builtin_popcountll(bs); tb += __builtin_popcountll(bt); } }
            }
        }
        if (cq >= 4 && (MODE & 1)) SW_STOP(13);
        SW_STOP(10); SW_START(14);
        bf16x8 qf[4];
#pragma unroll
        for (int ks = 0; ks < 4; ++ks) { qf[ks] = (bf16x8){0, 0, 0, 0, 0, 0, 0, 0}; if (hd < 8) qf[ks] = *(const bf16x8*)(QA + t * D + hd * 128 + 32 * ks + 8 * g); }
        float m_ref = -INFINITY, l_run = 0.f;
        f32x4 o[8];
#pragma unroll
        for (int ct = 0; ct < 8; ++ct) o[ct] = (f32x4){0.f, 0.f, 0.f, 0.f};
        const char* kvb = (const char*)(KVN + (size_t)b * S * 128);
        const int ntile = nk >> 5;
        LDS_WAIT();
        unsigned choff[4];
#pragma unroll
        for (int i = 0; i < 4; ++i) choff[i] = (((unsigned)hd ^ (unsigned)((g << 2) | i)) * 16u);
#define ATT_ISSUE(kt_, buf_) do { const u32x4 kq0_ = *(const LAS u32x4*)(lst + (kt_) * 32 + 8 * g), kq1_ = *(const LAS u32x4*)(lst + (kt_) * 32 + 8 * g + 4); _Pragma("unroll") for (int i = 0; i < 8; ++i) { \
            const unsigned off_ = (i < 4 ? kq0_[i & 3] : kq1_[i & 3]) + choff[i & 3]; \
            if (MODE & 2) __builtin_amdgcn_global_load_lds((const unsigned*)(kvb + off_), (LAS unsigned*)(tile + (buf_) * 8192 + i * 1024), 16, 0, 0); } } while (0)
        ATT_ISSUE(0, 0);
        for (int kt = 0; kt < ntile; ++kt) {
            LAS unsigned char* tb_ = tile + (kt & 1) * 8192;
            if (kt + 1 < ntile) { ATT_ISSUE(kt + 1, (kt + 1) & 1); asm volatile("s_waitcnt vmcnt(8)" ::: "memory"); }
            else asm volatile("s_waitcnt vmcnt(0)" ::: "memory");
            if (!(MODE & 4)) continue;
            f32x4 sa[2]; bf16x8 af[2][4];
#pragma unroll
            for (int rb = 0; rb < 2; ++rb)
#pragma unroll
                for (int ks = 0; ks < 4; ++ks) af[rb][ks] = *(const LAS bf16x8*)(tb_ + off_b(16 * rb + hd, 4 * ks + g));
#pragma unroll
            for (int rb = 0; rb < 2; ++rb) { sa[rb] = (f32x4){0.f, 0.f, 0.f, 0.f};
#pragma unroll
                for (int ks = 0; ks < 4; ++ks) sa[rb] = __builtin_amdgcn_mfma_f32_16x16x32_bf16(af[rb][ks], qf[ks], sa[rb], 0, 0, 0); }
            float pr[8], ps = 0.f;
#pragma unroll
            for (int j = 0; j < 8; ++j) { pr[j] = __builtin_amdgcn_exp2f(sa[j >> 2][j & 3] - m_ref); ps += pr[j]; }
            if (__ballot(!(ps < 8.0e12f)) != 0ull) {
                float mx = fmaxf(fmaxf(fmaxf(sa[0][0], sa[0][1]), fmaxf(sa[0][2], sa[0][3])), fmaxf(fmaxf(sa[1][0], sa[1][1]), fmaxf(sa[1][2], sa[1][3])));
                mx = fmaxf(mx, lane_xor<16>(mx)); mx = fmaxf(mx, lane_xor<32>(mx));
                const float m_new = fmaxf(m_ref, mx), alpha = __builtin_amdgcn_exp2f(m_ref - m_new);
                l_run *= alpha; m_ref = m_new;
#pragma unroll
                for (int ct = 0; ct < 8; ++ct) o[ct] *= alpha;
                ps = 0.f;
#pragma unroll
                for (int j = 0; j < 8; ++j) { pr[j] = __builtin_amdgcn_exp2f(sa[j >> 2][j & 3] - m_ref); ps += pr[j]; }
            }
            l_run += ps;
            u32x4 pw; pw.x = cvt_pk_bf16(pr[0], pr[1]); pw.y = cvt_pk_bf16(pr[2], pr[3]); pw.z = cvt_pk_bf16(pr[4], pr[5]); pw.w = cvt_pk_bf16(pr[6], pr[7]);
            const bf16x8 pb = __builtin_bit_cast(bf16x8, pw);
            const unsigned q4 = (unsigned)hd >> 2, p4 = (unsigned)hd & 3;
#pragma unroll
            for (int ct = 0; ct < 8; ++ct) {
                const bf16x4 vlo = __builtin_amdgcn_ds_read_tr16_b64_v4i16((LAS bf16x4*)(tb_ + off_b(4 * g + q4, 2 * ct + (p4 >> 1)) + 8 * (p4 & 1)));
                const bf16x4 vhi = __builtin_amdgcn_ds_read_tr16_b64_v4i16((LAS bf16x4*)(tb_ + off_b(16 + 4 * g + q4, 2 * ct + (p4 >> 1)) + 8 * (p4 & 1)));
                const bf16x8 va = __builtin_shufflevector(vlo, vhi, 0, 1, 2, 3, 4, 5, 6, 7);
                o[ct] = __builtin_amdgcn_mfma_f32_16x16x32_bf16(va, pb, o[ct], 0, 0, 0);
            }
            LDS_WAIT();
        }
        SW_STOP(14); SW_START(16);
#undef ATT_ISSUE
        float lt = l_run + lane_xor<16>(l_run); lt += lane_xor<32>(lt);
        const float inv = 1.0f / lt;
        if (hd < 8 && ((MODE & 8) || lt == 12345.678f)) {
#pragma unroll
            for (int ct = 0; ct < 8; ++ct) { const f32x4 v = o[ct] * inv; u32x2 w; w.x = cvt_pk_bf16(v.x, v.y); w.y = cvt_pk_bf16(v.z, v.w);
                *(u32x2*)(MC + t * KMIX + 256 + hd * 128 + 16 * ct + 4 * g) = w; }
        }
        SW_STOP(16); SW_START(15);
        if (cxv) cx_finish(p, cit, lane, tv, (LAS float*)tile);
        SW_STOP(15);
        ++cxq;
    }
#undef ATT_PREFETCH
    for (; (MODE & 8) && c.gw + c.NGW * cxq < 3 * 8192; ++cxq) { float tv[32]; const int cit = c.gw + c.NGW * cxq; cx_issue(p, l, cit, lane, tv); cx_finish(p, cit, lane, tv, (LAS float*)tile); }
}

#ifndef RT_NT
#define RT_NT 2
#endif
__device__ __forceinline__ void ph_router(const Params& p, const Ctx& c, int l) {
    const float* mod = (const float*)(p.ws + WS_MOD); bf16_t* H = (bf16_t*)(p.ws + WS_H);
    int* toke = (int*)(p.ws + WS_SMALL + SM_TOKE); float* tokg = (float*)(p.ws + WS_SMALL + SM_TOKG); int* rank = (int*)(p.ws + WS_SMALL + SM_RANK); int* cnt = (int*)(p.ws + WS_SMALL + SM_CNT);
    LAS int* le = (LAS int*)(c.lds + RT_LE_OFF); LAS int* wcnt = le + 256;
    const int lane = c.lane;
    SW_START(30);
    {
        const f32x4* srcE = (const f32x4*)(p.ws + WS_SMALL + SM_REW2) + (size_t)l * 8192; const f32x4* srcG = (const f32x4*)(p.ws + WS_SMALL + SM_RGW2) + (size_t)l * 1024;
        LAS f32x4* dE = (LAS f32x4*)c.lds; LAS f32x4* dG = (LAS f32x4*)(c.lds + RT_RG_OFF);
#pragma unroll
        for (int hb = 0; hb < 2; ++hb) { f32x4 t[8];
#pragma unroll
            for (int q = 0; q < 8; ++q) t[q] = srcE[c.tid + 512 * (8 * hb + q)];
#pragma unroll
            for (int q = 0; q < 8; ++q) dE[c.tid + 512 * (8 * hb + q)] = t[q]; }
        { const f32x4 t0 = srcG[c.tid], t1 = srcG[c.tid + 512]; dG[c.tid] = t0; dG[c.tid + 512] = t1; }
        __syncthreads();
    }
    SW_STOP(30);
    for (int tile = c.vcu; tile < 256; tile += c.G) {
        SW_START(31);
        constexpr int NT = RT_NT;
        const int b = (tile * 128) >> 11;
        const f32x4* ng = (const f32x4*)(p.in[I_N2G] + l * D) + lane;
        const f32x4* sh = (const f32x4*)(mod + (size_t)(l * NB + b) * 6144 + 3072) + lane; const f32x4* sc = (const f32x4*)(mod + (size_t)(l * NB + b) * 6144 + 4096) + lane;
        const LAS f32x4* rg = (const LAS f32x4*)(c.lds + RT_RG_OFF) + lane;
        f32x4 gm[4], sv[4];
#pragma unroll
        for (int j = 0; j < 4; ++j) { gm[j] = ng[64 * j] * (sc[64 * j] + 1.0f); sv[j] = sh[64 * j]; }
        f32x4 v[NT][4]; u32x2 vn[NT][4];
#pragma unroll
        for (int t = 0; t < NT; ++t)
#pragma unroll
            for (int j = 0; j < 4; ++j) vn[t][j] = ((const u32x2*)((const bf16_t*)(p.ws + WS_X16) + (size_t)(tile * 128 + c.wave * 16 + t) * D) + lane)[64 * j];
        for (int i = 0; i < 16; i += NT) {
            const int tl0 = c.wave * 16 + i, m0 = tile * 128 + tl0;
            float ss[NT], r[NT], gl[NT][4];
#pragma unroll
            for (int t = 0; t < NT; ++t) { ss[t] = 0.f;
#pragma unroll
                for (int j = 0; j < 4; ++j) { v[t][j] = (f32x4){bflo(vn[t][j].x), bfhi(vn[t][j].x), bflo(vn[t][j].y), bfhi(vn[t][j].y)}; ss[t] += (v[t][j].x * v[t][j].x + v[t][j].y * v[t][j].y) + (v[t][j].z * v[t][j].z + v[t][j].w * v[t][j].w); } }
            if (i + NT < 16) {
#pragma unroll
                for (int t = 0; t < NT; ++t)
#pragma unroll
                    for (int j = 0; j < 4; ++j) vn[t][j] = ((const u32x2*)((const bf16_t*)(p.ws + WS_X16) + (size_t)(m0 + NT + t) * D) + lane)[64 * j]; }
#pragma unroll
            for (int t = 0; t < NT; ++t) ss[t] = wave_sum(ss[t]);
            f32x2 gl2[NT][2];
#pragma unroll
            for (int t = 0; t < NT; ++t) { r[t] = 1.0f / sqrtf(ss[t] * (1.0f / D) + EPS); gl2[t][0] = gl2[t][1] = (f32x2){0.f, 0.f}; }
#pragma unroll
            for (int j = 0; j < 4; ++j) {
#pragma unroll
                for (int t = 0; t < NT; ++t) { v[t][j] = v[t][j] * r[t] * gm[j] + sv[j];
                    u32x2 w; w.x = cvt_pk_bf16(v[t][j].x, v[t][j].y); w.y = cvt_pk_bf16(v[t][j].z, v[t][j].w); ((u32x2*)(H + (size_t)(m0 + t) * D) + lane)[64 * j] = w; }
#pragma unroll
                for (int e = 0; e < 4; ++e) { const f32x4 wr = rg[(j * 4 + e) * 64];
#pragma unroll
                    for (int t = 0; t < NT; ++t) { const f32x2 hv2 = {v[t][j][e], v[t][j][e]}; gl2[t][0] = __builtin_elementwise_fma(hv2, (f32x2){wr.x, wr.y}, gl2[t][0]); gl2[t][1] = __builtin_elementwise_fma(hv2, (f32x2){wr.z, wr.w}, gl2[t][1]); } } }
#pragma unroll
            for (int t = 0; t < NT; ++t) { gl[t][0] = gl2[t][0].x; gl[t][1] = gl2[t][0].y; gl[t][2] = gl2[t][1].x; gl[t][3] = gl2[t][1].y; }
            const bool h32 = lane & 32, h16 = lane & 16, h8 = lane & 8;
            float dg[NT];
#pragma unroll
            for (int t = 0; t < NT; ++t) {
                const float c0 = (h16 ? gl[t][2] : gl[t][0]) + lane_xor<16>(h16 ? gl[t][0] : gl[t][2]), c1 = (h16 ? gl[t][3] : gl[t][1]) + lane_xor<16>(h16 ? gl[t][1] : gl[t][3]);
                float d = (h8 ? c1 : c0) + lane_xor<8>(h8 ? c0 : c1);
                d += lane_xor<4>(d); d += lane_xor<2>(d); d += lane_xor<1>(d); d += lane_xor<32>(d); dg[t] = d; }
            int gi[NT]; float gp[NT];
#pragma unroll
            for (int t = 0; t < NT; ++t) { float gq[4]; int g_ = 0; float gmax = -INFINITY;
#pragma unroll
                for (int q = 0; q < 4; ++q) { gq[q] = __shfl(dg[t], 8 * (q & 1) + 16 * (q >> 1)) + p.in[I_RGB][l * 4 + q]; if (gq[q] > gmax) { gmax = gq[q]; g_ = q; } }
                float gden = 0.f;
#pragma unroll
                for (int q = 0; q < 4; ++q) gden += __expf(gq[q] - gmax);
                gp[t] = 1.0f / gden; gi[t] = __builtin_amdgcn_readfirstlane(g_); }
            float el[NT][8]; f32x2 el2[NT][4];
#pragma unroll
            for (int t = 0; t < NT; ++t)
#pragma unroll
                for (int q = 0; q < 4; ++q) el2[t][q] = (f32x2){0.f, 0.f};
#pragma unroll
            for (int j = 0; j < 4; ++j)
#pragma unroll
                for (int e = 0; e < 4; ++e)
#pragma unroll
                    for (int t = 0; t < NT; ++t) { const LAS f32x4* rr = (const LAS f32x4*)c.lds + gi[t] * 2048 + (j * 4 + e) * 128 + lane;
                        const f32x4 w0 = rr[0], w1 = rr[64]; const float hv = v[t][j][e];
                        const f32x2 hv2 = {hv, hv}; el2[t][0] = __builtin_elementwise_fma(hv2, (f32x2){w0.x, w0.y}, el2[t][0]); el2[t][1] = __builtin_elementwise_fma(hv2, (f32x2){w0.z, w0.w}, el2[t][1]);
                        el2[t][2] = __builtin_elementwise_fma(hv2, (f32x2){w1.x, w1.y}, el2[t][2]); el2[t][3] = __builtin_elementwise_fma(hv2, (f32x2){w1.z, w1.w}, el2[t][3]); }
#pragma unroll
            for (int t = 0; t < NT; ++t)
#pragma unroll
                for (int q = 0; q < 4; ++q) { el[t][2 * q] = el2[t][q].x; el[t][2 * q + 1] = el2[t][q].y; }
            float de[NT];
#pragma unroll
            for (int t = 0; t < NT; ++t) {
                const float b0 = (h32 ? el[t][4] : el[t][0]) + lane_xor<32>(h32 ? el[t][0] : el[t][4]), b1 = (h32 ? el[t][5] : el[t][1]) + lane_xor<32>(h32 ? el[t][1] : el[t][5]);
                const float b2 = (h32 ? el[t][6] : el[t][2]) + lane_xor<32>(h32 ? el[t][2] : el[t][6]), b3 = (h32 ? el[t][7] : el[t][3]) + lane_xor<32>(h32 ? el[t][3] : el[t][7]);
                const float c0 = (h16 ? b2 : b0) + lane_xor<16>(h16 ? b0 : b2), c1 = (h16 ? b3 : b1) + lane_xor<16>(h16 ? b1 : b3);
                float d = (h8 ? c1 : c0) + lane_xor<8>(h8 ? c0 : c1);
                d += lane_xor<4>(d); d += lane_xor<2>(d); d += lane_xor<1>(d); de[t] = d; }
#pragma unroll
            for (int t = 0; t < NT; ++t) { float eq[8]; int e0 = 0, e1 = 0; float mx0 = -INFINITY, mx1 = -INFINITY;
#pragma unroll
                for (int q = 0; q < 8; ++q) { eq[q] = __shfl(de[t], 8 * (q & 1) + 16 * ((q >> 1) & 1) + 32 * (q >> 2)) + p.in[I_REB][l * 32 + gi[t] * 8 + q];
                    if (eq[q] > mx0) { mx1 = mx0; e1 = e0; mx0 = eq[q]; e0 = q; } else if (eq[q] > mx1) { mx1 = eq[q]; e1 = q; } }
                const float x1 = __expf(mx1 - mx0), den = 1.0f + x1; const int tl = tl0 + t, m = m0 + t;
                if (lane == 0) { le[2 * tl] = gi[t] * 8 + e0; le[2 * tl + 1] = gi[t] * 8 + e1; toke[2 * m] = gi[t] * 8 + e0; toke[2 * m + 1] = gi[t] * 8 + e1; tokg[2 * m] = gp[t] / den; tokg[2 * m + 1] = gp[t] * x1 / den; } }
        }
        SW_STOP(31);
        __syncthreads();
        SW_START(32);
        int myrank = 0, mye = 0;
        if (c.tid < 256) { mye = le[c.tid]; const unsigned long long ltmask = (1ull << lane) - 1ull;
            for (int ee = 0; ee < 32; ++ee) { const unsigned long long m = __ballot(mye == ee); if (mye == ee) myrank = __builtin_popcountll(m & ltmask); if (lane == 0) wcnt[c.wave * 32 + ee] = __builtin_popcountll(m); } }
        __syncthreads();
        if (c.tid < 256) { for (int w = 0; w < c.wave; ++w) myrank += wcnt[w * 32 + mye]; rank[tile * 256 + c.tid] = myrank; }
        if (c.tid < 32) cnt[tile * 32 + c.tid] = wcnt[c.tid] + wcnt[32 + c.tid] + wcnt[64 + c.tid] + wcnt[96 + c.tid];
        __syncthreads();
        SW_STOP(32);
    }
}

__device__ __forceinline__ void ph_dispatch(const Params& p, const Ctx& c) {
    const int* toke = (const int*)(p.ws + WS_SMALL + SM_TOKE); const float* tokg = (const float*)(p.ws + WS_SMALL + SM_TOKG); const int* rank = (const int*)(p.ws + WS_SMALL + SM_RANK); const int* cnt = (const int*)(p.ws + WS_SMALL + SM_CNT);
    int* tslot = (int*)(p.ws + WS_SMALL + SM_TSLOT); int* stok = (int*)(p.ws + WS_SMALL + SM_STOK); float* sgate = (float*)(p.ws + WS_SMALL + SM_SGATE); int* texp = (int*)(p.ws + WS_SMALL + SM_TEXP);
    LAS int* tot = (LAS int*)c.lds; LAS int* pst = tot + 32; LAS int* bse = pst + 33;
    for (int tile = c.vcu; tile < 256; tile += c.G) {
        {
            LAS int* psum = bse + 32; LAS int* pbase = psum + 512;
            const int e = c.tid & 31, part = c.tid >> 5; int v[16]; int run = 0, mb = 0;
#pragma unroll
            for (int q = 0; q < 16; ++q) v[q] = cnt[(part * 16 + q) * 32 + e];
#pragma unroll
            for (int q = 0; q < 16; ++q) { if (part * 16 + q == tile) mb = run; run += v[q]; }
            psum[part * 32 + e] = run; pbase[part * 32 + e] = mb;
            __syncthreads();
            if (c.tid < 32) { int tr = 0, tb2 = 0; const int tp = tile >> 4;
                for (int q = 0; q < 16; ++q) { if (q == tp) tb2 = tr + pbase[q * 32 + c.tid]; tr += psum[q * 32 + c.tid]; }
                tot[c.tid] = tr; bse[c.tid] = tb2; }
        }
        __syncthreads();
        if (c.tid == 0) { int a = 0; for (int e = 0; e < 32; ++e) { pst[e] = a; a += ((tot[e] + 255) >> 8) << 8; } pst[32] = a; }
        __syncthreads();
        if (c.tid < 256) { const int a = tile * 256 + c.tid, e = toke[a], slot = pst[e] + bse[e] + rank[a]; stok[slot] = a >> 1; sgate[slot] = tokg[a]; tslot[a] = slot; }
        if (tile == 0) {
            for (int e = 0; e < 32; ++e) { const int pc = pst[e + 1] - pst[e]; for (int r = tot[e] + c.tid; r < pc; r += 512) { stok[pst[e] + r] = 0; sgate[pst[e] + r] = 0.f; } }
            const int ntl = pst[32] >> 8;
            for (int m = c.tid; m < ntl; m += 512) { int e = 0; while (pst[e + 1] <= (m << 8)) ++e; texp[m] = e; }
            if (c.tid == 0) texp[MAXTILES] = ntl;
        }
        __syncthreads();
    }
}

#ifndef PH_ONLY
#define PH_ONLY -1
#endif
#define IN(k) ((PH_ONLY < 0 || PH_ONLY == (k)) && lo <= (k) && (k) < hi)
#define SEAM(k) do { if (IN(k) && IN((k) + 1)) xcd_barrier(bar); } while (0)
#ifndef REP_MASK
#define REP_MASK 0
#endif
#define REP(id) (((REP_MASK) >> (id)) & 1)
#define BODY(id, cond, ...) do { __VA_ARGS__ if (REP(id) && (cond)) { xcd_barrier(bar); __VA_ARGS__ } } while (0)
template <int l>
__device__ __forceinline__ void run_layer(const Params& p, const Ctx& c, const XcdBarrier& bar, int lo, int hi) {
    bf16_t* Zb = (bf16_t*)(p.ws + WS_Z); bf16_t* Hb = (bf16_t*)(p.ws + WS_H); bf16_t* MCb = (bf16_t*)p.out;
    const float* mod = (const float*)(p.ws + WS_MOD);
    constexpr int P = 1 + 10 * l;
    if (IN(P)) { if (l == 0) { BODY(1, true, ph_norm1<0>(p, c);); } else { ph_norm1<1>(p, c); } }
    SEAM(P);
    if (IN(P + 1)) { BODY(2, true, { pg8::StaticOrder So; So.init(Hb, (bf16_t*)(p.ws + WS_WIN) + (size_t)l * NZ * D, T, NZ, D, c.G, (int)blockIdx.x);
        pg8::EpiBf16 E{Zb, NZ}; pg8::gemm_phase<pg8::EpiBf16, pg8::StaticOrder, false>(c.lds, So, E); });
        if (l == 0) { constexpr int NU = (T / 256) * (NZ / 256); const int rem = NU % c.G;
            if (rem == 0) ph_prologue_rest(p, c, c.gw, c.NGW); else if ((int)blockIdx.x >= rem) ph_prologue_rest(p, c, ((int)blockIdx.x - rem) * 8 + c.wave, (c.G - rem) * 8); } }
    SEAM(P + 1);
    if (IN(P + 2)) { BODY(3, true, ph_postz(p, c, l);); }
    SEAM(P + 2);
    if (IN(P + 3)) { BODY(4, true, { pg8::StaticOrder So; So.init((bf16_t*)(p.ws + WS_CQR), (bf16_t*)(p.ws + WS_WQA) + (size_t)l * D * 256, T, D, 256, c.G, (int)blockIdx.x);
        pg8::EpiBf16 E{Hb, D}; pg8::gemm_phase<pg8::EpiBf16, pg8::StaticOrder, false>(c.lds, So, E); });
        BODY(5, true, ph_scores(p, c);); }
    SEAM(P + 3);
#ifndef ATT_PROBE
#define ATT_PROBE 0
#endif
    if (IN(P + 4)) { ph_attn<15>(p, c, l); if (ATT_PROBE) { xcd_barrier(bar); ph_attn<ATT_PROBE>(p, c, l); } }
    SEAM(P + 4);
    if (IN(P + 5)) { BODY(7, l == 0, { pg8::StaticOrder So; So.init(MCb, (bf16_t*)(p.ws + WS_WMIX) + (size_t)l * D * KMIX, T, D, KMIX, c.G, (int)blockIdx.x);
        pg8::EpiMix<l == 0> E{l == 0 ? p.in[I_X] : nullptr, (bf16_t*)(p.ws + WS_X16), mod + (size_t)l * NB * 6144 + 2048}; pg8::gemm_phase<pg8::EpiMix<l == 0>, pg8::StaticOrder, false>(c.lds, So, E); }); }
    SEAM(P + 5);
    if (IN(P + 6)) { BODY(8, true, ph_router(p, c, l);); }
    SEAM(P + 6);
    if (IN(P + 7)) { BODY(9, true, ph_dispatch(p, c);); }
    SEAM(P + 7);
    if (IN(P + 8)) { BODY(10, true, { const int* texp = (const int*)(p.ws + WS_SMALL + SM_TEXP); const int ntl = texp[MAXTILES];
        pg8::MoeOrder Mo; Mo.init(Hb, p.ws + WS_W13, D, (size_t)1024 * 1024 * 2, (const int*)(p.ws + WS_SMALL + SM_STOK), texp, ntl, c.G, c.vcu, (LAS int*)(c.lds + MOE_TAB_OFF));
        pg8::EpiAct E{Zb}; pg8::gemm_phase<pg8::EpiAct, pg8::MoeOrder, true>(c.lds, Mo, E); }); }
    SEAM(P + 8);
    if (IN(P + 9)) { BODY(11, true, { const int* texp = (const int*)(p.ws + WS_SMALL + SM_TEXP); const int ntl = texp[MAXTILES];
        pg8::MoeOrder Mo; Mo.init(Zb, p.ws + WS_W2, DEXP, (size_t)1024 * 512 * 2, nullptr, texp, ntl, c.G, c.vcu, (LAS int*)(c.lds + MOE_TAB_OFF));
        pg8::EpiY E{(bf16_t*)(p.ws + WS_Y), (const float*)(p.ws + WS_SMALL + SM_SGATE)}; pg8::gemm_phase<pg8::EpiY, pg8::MoeOrder, false>(c.lds, Mo, E); }); }
    SEAM(P + 9);
}

__global__ void __launch_bounds__(512, 2) fwd(Params p) {
    extern __shared__ __attribute__((aligned(16))) unsigned char lds_raw[];
    Ctx c;
    c.lds = (LAS unsigned char*)lds_raw;
    c.tid = threadIdx.x; c.lane = c.tid & 63; c.wave = __builtin_amdgcn_readfirstlane(c.tid >> 6);
    c.G = gridDim.x; { const int bx = blockIdx.x; c.vcu = (c.G % 8 == 0) ? (bx % 8) * (c.G / 8) + bx / 8 : bx; }
    c.gw = c.vcu * 8 + c.wave; c.NGW = c.G * 8; c.sw_t0 = 0ull; c.sw_sum = 0ull;
    volatile LAS unsigned* MISC = (volatile LAS unsigned*)(c.lds + MISC_OFF);
    if (c.tid < 64) MISC[c.tid] = 0u;
    __syncthreads();
    unsigned* ctl = (unsigned*)(p.ws + WS_CTL);
    XcdBarrier bar; bar.bar = ctl + CW_BAR; bar.x = 0; bar.st = nullptr;
    const bool multi = (p.ph_hi - p.ph_lo) > 1;
    if (multi) bar = xcd_barrier_post(ctl + CW_BAR, MISC + 8);
    const int lo = p.ph_lo, hi = p.ph_hi;
    if (IN(0)) { BODY(0, true, ph_prologue(p, c);); }
    SEAM(0);
    run_layer<0>(p, c, bar, lo, hi);
    run_layer<1>(p, c, bar, lo, hi);
    if (IN(21)) ph_norm1<2>(p, c);
    if (SW_ID) { const unsigned long long t0 = __builtin_amdgcn_s_memrealtime(); while (__builtin_amdgcn_s_memrealtime() - t0 < 8ull * c.sw_sum) __builtin_amdgcn_s_sleep(8); }
#undef IN
#undef SEAM
}

extern "C" void kernel_launch(void* const* d_in, const int* in_sizes, int n_in, void* d_out, int out_size, void* d_ws, size_t ws_size, hipStream_t stream) {
    static int grid = 0;
    if (grid == 0) {
        if (n_in != 27 || out_size != T * D || ws_size < WS_END) { fprintf(stderr, "kernel_launch: unexpected shapes (n_in %d out %d ws %zu, need %zu)\n", n_in, out_size, ws_size, (size_t)WS_END); grid = -1; return; }
        int dev = 0, cus = 0, per_cu = 0;
        if (hipGetDevice(&dev) != hipSuccess || hipDeviceGetAttribute(&cus, hipDeviceAttributeMultiprocessorCount, dev) != hipSuccess) { grid = -1; return; }
        if (hipFuncSetAttribute((const void*)fwd, hipFuncAttributeMaxDynamicSharedMemorySize, LDS_BYTES) != hipSuccess) { fprintf(stderr, "kernel_launch: hipFuncSetAttribute failed\n"); grid = -1; return; }
        if (hipOccupancyMaxActiveBlocksPerMultiprocessor(&per_cu, (const void*)fwd, 512, LDS_BYTES) != hipSuccess || per_cu < 1) { fprintf(stderr, "kernel_launch: occupancy query says %d blocks per CU\n", per_cu); grid = -1; return; }
        (void)hipGetLastError();
        grid = cus >= 256 ? 256 : (cus >= 128 ? 128 : 0);
        if (grid == 0) { fprintf(stderr, "kernel_launch: %d CUs: this kernel needs at least 128\n", cus); grid = -1; return; }
    }
    if (grid <= 0) return;
    (void)hipMemsetAsync((char*)d_ws + WS_CTL, 0, CTL_ZERO_BYTES, stream);
    Params p{};
    for (int i = 0; i < 27; ++i) p.in[i] = (const float*)d_in[i];
    p.out = (float*)d_out; p.ws = (unsigned char*)d_ws;
#if MK_SPLIT
    for (int ph = 0; ph < NPHASE; ++ph) { p.ph_lo = ph; p.ph_hi = ph + 1; hipLaunchKernelGGL(fwd, dim3(grid), dim3(512), LDS_BYTES, stream, p); }
#else
    p.ph_lo = 0; p.ph_hi = NPHASE;
    hipLaunchKernelGGL(fwd, dim3(grid), dim3(512), LDS_BYTES, stream, p);
#endif
}
```

```cpp
#include <hip/hip_runtime.h>
#include <cstdio>
#include <cstdint>

#ifndef MK_SPLIT
#define MK_SPLIT 0
#endif

#define LAS __attribute__((address_space(3)))
typedef unsigned short bf16_t;
typedef short bf16x8 __attribute__((ext_vector_type(8)));
typedef short bf16x4 __attribute__((ext_vector_type(4)));
typedef float f32x4 __attribute__((ext_vector_type(4)));
typedef float f32x2 __attribute__((ext_vector_type(2)));
typedef float f32x16 __attribute__((ext_vector_type(16)));
typedef unsigned u32x4 __attribute__((ext_vector_type(4)));
typedef unsigned u32x2 __attribute__((ext_vector_type(2)));

constexpr int D = 1024, NB = 16, S = 2048, T = NB * S, DEPTH = 2;
constexpr int NZ = 1792;
constexpr int N_IN = 1736;
constexpr int Z_AVAL = 0, Z_AGATE = 256, Z_CQ = 512, Z_CKV = 768, Z_QI = 896, Z_KI = 1408, Z_WI = 1472, Z_UP = 1480;
constexpr int KMIX = 1536;
constexpr int NEXP = 32, DEXP = 512, MAXTILES = 288, PMAX = MAXTILES * 256;
constexpr float EPS = 1e-6f;
constexpr int SC_PER_B = 4096 * 528;

constexpr size_t MiB = 1u << 20;
constexpr size_t WS_CTL = 0, CTL_ZERO_BYTES = 64 * 1024;
constexpr size_t WS_MOD = 1 * MiB;
constexpr size_t WS_WIN = 2 * MiB;
constexpr size_t WS_WQA = 9 * MiB;
constexpr size_t WS_WMIX = 10 * MiB;
constexpr size_t WS_SMALL = 16 * MiB;
constexpr size_t WS_W13 = 20 * MiB;
constexpr size_t WS_W2 = 84 * MiB;
constexpr size_t WS_Z = 116 * MiB;
constexpr size_t WS_X16 = 228 * MiB;
constexpr size_t WS_H = 324 * MiB;
constexpr size_t WS_CQR = 388 * MiB;
constexpr size_t WS_KVN = 404 * MiB;
constexpr size_t WS_Y = 412 * MiB;
constexpr size_t WS_ELIST = 556 * MiB;
constexpr size_t WS_END = 572 * MiB;
constexpr size_t SM_TOKE = 0;
constexpr size_t SM_TOKG = 256 * 1024;
constexpr size_t SM_RANK = 512 * 1024;
constexpr size_t SM_TSLOT = 768 * 1024;
constexpr size_t SM_STOK = 1024 * 1024;
constexpr size_t SM_SGATE = 1024 * 1024 + 512 * 1024;
constexpr size_t SM_CNT = 2 * 1024 * 1024;
constexpr size_t SM_TEXP = 2 * 1024 * 1024 + 64 * 1024;
constexpr size_t SM_REW2 = 2 * 1024 * 1024 + 512 * 1024;
constexpr size_t SM_PWT = 3 * 1024 * 1024 + 64 * 1024;
constexpr size_t SM_RGW2 = 3 * 1024 * 1024;
constexpr int CW_BAR = 1024;
constexpr int CW_ECUR = 8192;

constexpr int LDS_BYTES = 155648;
constexpr int LIST_OFF = 131072;
constexpr int MISC_OFF = 154624;
constexpr int MOE_TAB_OFF = 131072;
constexpr int RT_RG_OFF = 131072, RT_LE_OFF = 147456;
constexpr int NPHASE = 22;

__device__ __forceinline__ unsigned cvt_pk_bf16(float lo, float hi) { unsigned r; asm volatile("v_cvt_pk_bf16_f32 %0, %1, %2" : "=v"(r) : "v"(lo), "v"(hi)); return r; }
__device__ __forceinline__ float bf2f(unsigned short b) { return __uint_as_float(((unsigned)b) << 16); }
__device__ __forceinline__ float bflo(unsigned w) { return __uint_as_float(w << 16); }
__device__ __forceinline__ float bfhi(unsigned w) { return __uint_as_float(w & 0xffff0000u); }
template <int W> __device__ __forceinline__ int lane_xor_i(int iv) {
    int r;
    if constexpr (W == 1) r = __builtin_amdgcn_mov_dpp(iv, 0xB1, 0xF, 0xF, true);
    else if constexpr (W == 2) r = __builtin_amdgcn_mov_dpp(iv, 0x4E, 0xF, 0xF, true);
    else if constexpr (W == 4) { r = __builtin_amdgcn_update_dpp(iv, iv, 0x104, 0xF, 0x5, false);
                                 r = __builtin_amdgcn_update_dpp(r, iv, 0x114, 0xF, 0xA, false); }
    else if constexpr (W == 8) r = __builtin_amdgcn_mov_dpp(iv, 0x128, 0xF, 0xF, true);
    else if constexpr (W == 16) { const auto p = __builtin_amdgcn_permlane16_swap((unsigned)iv, (unsigned)iv, false, false); r = (threadIdx.x & 16) ? (int)p[0] : (int)p[1]; }
    else { const auto p = __builtin_amdgcn_permlane32_swap((unsigned)iv, (unsigned)iv, false, false); r = (threadIdx.x & 32) ? (int)p[0] : (int)p[1]; }
    return r;
}
template <int W> __device__ __forceinline__ float lane_xor(float v) { return __builtin_bit_cast(float, lane_xor_i<W>(__builtin_bit_cast(int, v))); }
template <int W> __device__ __forceinline__ unsigned lane_xor(unsigned v) { return (unsigned)lane_xor_i<W>((int)v); }
__device__ __forceinline__ float wave_sum(float v) {
    v += lane_xor<1>(v); v += lane_xor<2>(v); v += lane_xor<4>(v); v += lane_xor<8>(v); v += lane_xor<16>(v); v += lane_xor<32>(v);
    return v;
}
__device__ __forceinline__ float sigmoidf_(float x) { return __builtin_amdgcn_rcpf(1.0f + __builtin_amdgcn_exp2f(-1.44269504089f * x)); }
#define LDS_WAIT() asm volatile("s_waitcnt lgkmcnt(0)" ::: "memory")
#define VM_WAIT() asm volatile("s_waitcnt vmcnt(0)" ::: "memory")

#define XB_TMO      128
#define XB_XCNT(j)  (256  + 64 * (j))
#define XB_XSUB(j)  (1280 + 64 * (j))
#define XB_XGEN(j)  (2304 + 64 * (j))
#define XB_TOP      3328
#define XB_TOPGEN   3392
#define XCD_BAR_WORDS 3456
#define XB_SPIN_CAP (1u << 22)

__device__ __forceinline__ unsigned xb_ld(unsigned* p)              { return __hip_atomic_load(p, __ATOMIC_RELAXED, __HIP_MEMORY_SCOPE_AGENT); }
__device__ __forceinline__ unsigned xb_add(unsigned* p, unsigned v) { return __hip_atomic_fetch_add(p, v, __ATOMIC_RELAXED, __HIP_MEMORY_SCOPE_AGENT); }
__device__ __forceinline__ unsigned xb_xcc_id() { return (unsigned)__builtin_amdgcn_s_getreg((3 << 11) | 20) & 0xFu; }
#define XB_SPIN(cond, bar) do { unsigned _sp = 0; while (cond) { __builtin_amdgcn_s_sleep(1); \
    if ((++_sp & 255u) == 0u) { if (xb_ld(&(bar)[XB_TMO])) break; if (_sp > XB_SPIN_CAP) { atomicAdd(&(bar)[XB_TMO], 1u); break; } } } } while (0)

struct XcdBarrier {
    unsigned* bar; unsigned x;
    volatile LAS unsigned* st;
};
__device__ __forceinline__ XcdBarrier xcd_barrier_post(unsigned* bar, volatile LAS unsigned* st) {
    XcdBarrier b; b.bar = bar; b.x = xb_xcc_id(); b.st = st;
    if (threadIdx.x == 0) (void)xb_add(&bar[XB_XCNT(b.x)], 1u);
    return b;
}
__device__ __forceinline__ void xcd_barrier_complete(unsigned* bar, unsigned x, unsigned& nloc, unsigned& nx) {
    const unsigned G = gridDim.x * gridDim.y * gridDim.z;
    unsigned sum, cnt, mine, sp = 0u;
    for (;;) {
        sum = 0u; cnt = 0u; mine = 0u;
#pragma unroll
        for (unsigned j = 0; j < 16; ++j) { const unsigned c = xb_ld(&bar[XB_XCNT(j)]); sum += c; cnt += (c > 0u) ? 1u : 0u; mine = (j == x) ? c : mine; }
        if (sum == G) break;
        __builtin_amdgcn_s_sleep(1);
        if ((++sp & 255u) == 0u) { if (xb_ld(&bar[XB_TMO])) break; if (sp > XB_SPIN_CAP) { atomicAdd(&bar[XB_TMO], 1u); break; } }
    }
    nloc = mine > 0u ? mine : 1u; nx = cnt > 0u ? cnt : 1u;
}
__device__ __forceinline__ void xcd_barrier(const XcdBarrier& b) {
    asm volatile("s_waitcnt vmcnt(0)" ::: "memory");
    __syncthreads();
    if (threadIdx.x == 0) {
        unsigned* bar = b.bar;
        __builtin_amdgcn_s_waitcnt(0);
        unsigned nloc = b.st[0], nx = b.st[1];
        if (nloc == 0u) { xcd_barrier_complete(bar, b.x, nloc, nx); b.st[0] = nloc; b.st[1] = nx; }
        const unsigned old = xb_add(&bar[XB_XSUB(b.x)], 1u);
        const unsigned gen = old / nloc;
        if (old + 1u == (gen + 1u) * nloc) {
            __builtin_amdgcn_fence(__ATOMIC_RELEASE, "agent");
            asm volatile("s_waitcnt vmcnt(0)" ::: "memory");
            const unsigned og = xb_add(&bar[XB_TOP], 1u);
            const unsigned tg = og / nx;
            if (og + 1u == (tg + 1u) * nx) xb_add(&bar[XB_TOPGEN], 1u);
            else XB_SPIN(xb_ld(&bar[XB_TOPGEN]) == tg, bar);
            __builtin_amdgcn_fence(__ATOMIC_ACQUIRE, "agent");
            xb_add(&bar[XB_XGEN(b.x)], 1u);
            asm volatile("s_waitcnt vmcnt(0)" ::: "memory");
        } else {
            XB_SPIN(xb_ld(&bar[XB_XGEN(b.x)]) == gen, bar);
            __builtin_amdgcn_fence(__ATOMIC_ACQUIRE, "agent");
            asm volatile("s_waitcnt vmcnt(0)" ::: "memory");
        }
    }
    __syncthreads();
}

namespace pg8 {
constexpr int BM = 256, BK = 64, HALF = 128, HTB = HALF * BK * 2  , STAGE_BYTES = 8 * HTB, NXCD = 8, WGM = 8;
__host__ __device__ __forceinline__ int lds_byte(int r, int c) { const int st = (r >> 4) * 2 + (c >> 5), rr = r & 15, cc = c & 31, ob = rr * 64 + cc * 2; return st * 1024 + (ob ^ (((ob >> 9) & 1) << 5)); }
__host__ __device__ __forceinline__ void stage_rc(int b, int& R, int& C) { const int st = b / 1024, sb = b % 1024, swz = sb ^ (((sb >> 9) & 1) << 5); R = (st >> 1) * 16 + swz / 64; C = (st & 1) * 32 + (swz % 64) / 2; }
__host__ __device__ __forceinline__ int perm32(int rho) { const int n = rho >> 4, i = rho & 15; return 8 * (i >> 2) + 4 * n + (i & 3); }

struct Unit { int pm, pn; const char* a; const char* b; };

struct StaticOrder {
    const char* A; const char* Bt; int K;
    int nM, nN, nwg, G, c;
    __device__ void init(const void* A_, const void* Bt_, int M, int N, int K_, int G_, int c_) { A = (const char*)A_; Bt = (const char*)Bt_; K = K_; nM = M / BM; nN = N / BM; nwg = nM * nN; G = G_; c = c_; }
    __device__ __forceinline__ bool next(int i, Unit& u) const {
        const long L = (long)i * G + c; if (L >= nwg) return false;
        int wgid = (int)L; { const int q = nwg / NXCD, r = nwg % NXCD, xcd = wgid % NXCD, off = wgid / NXCD; wgid = (xcd < r ? xcd * (q + 1) : r * (q + 1) + (xcd - r) * q) + off; }
        const int nig = WGM * nN, gid = wgid / nig, fm = gid * WGM, gsz = (nM - fm) < WGM ? (nM - fm) : WGM;
        u.pm = fm + ((wgid % nig) % gsz); u.pn = (wgid % nig) / gsz;
        u.a = A + (size_t)u.pm * BM * K * 2; u.b = Bt + (size_t)u.pn * BM * K * 2; return true;
    }
    __device__ __forceinline__ int row(int, int) const { return 0; }
};
struct MoeOrder {
    const char* A; const char* Bt; int K; const LAS int* rowtab;
    const LAS int* etab; int nunits, G, c; size_t bstride;
    static constexpr int MAXU = 12;
    __device__ __forceinline__ void init(const void* A_, const void* Bt_, int K_, size_t bstride_, bool gather, int ntiles, int G_, int c_, LAS int* lds_tab) {
        A = (const char*)A_; Bt = (const char*)Bt_; K = K_; bstride = bstride_; nunits = ntiles * 4; G = G_; c = c_;
        rowtab = gather ? lds_tab : nullptr; etab = lds_tab + MAXU * 256;
    }
    __device__ __forceinline__ bool next(int i, Unit& u) const {
        const int L = i * G + c; if (L >= nunits || i >= MAXU) return false;
        u.pm = L >> 2; u.pn = L & 3; const int e = __builtin_amdgcn_readfirstlane(etab[i]);
        u.a = A + (size_t)u.pm * BM * K * 2; u.b = Bt + (size_t)e * bstride + (size_t)u.pn * BM * K * 2; return true;
    }
    __device__ __forceinline__ int row(int i, int r) const { return rowtab[i * 256 + r]; }
};
struct NoGather { };
struct EpiBf16 {
    static constexpr bool PERM = true;
    bf16_t* O; int ldc;
    __device__ __forceinline__ void operator()(const f32x4 (&acc)[2][2][4][2], const Unit& u, int wr, int wc, int fr, int fq) const {
        const int row0 = u.pm * BM + wr * 64 + fr, col0 = u.pn * BM + wc * 32 + 8 * fq;
#pragma unroll
        for (int ai = 0; ai < 2; ++ai)
#pragma unroll
            for (int m = 0; m < 4; ++m) { bf16_t* rowp = O + (size_t)(row0 + ai * HALF + m * 16) * ldc + col0;
#pragma unroll
                for (int bj = 0; bj < 2; ++bj) { const f32x4 v0 = acc[ai][bj][m][0], v1 = acc[ai][bj][m][1];
                    u32x4 w; w.x = cvt_pk_bf16(v0[0], v0[1]); w.y = cvt_pk_bf16(v0[2], v0[3]); w.z = cvt_pk_bf16(v1[0], v1[1]); w.w = cvt_pk_bf16(v1[2], v1[3]);
                    *(u32x4*)(rowp + bj * HALF) = w; } }
    }
};
template <bool F32IN>
struct EpiMix {
    static constexpr bool PERM = true;
    const float* xin32; bf16_t* x16; const float* gate;
    __device__ __forceinline__ void operator()(const f32x4 (&acc)[2][2][4][2], const Unit& u, int wr, int wc, int fr, int fq) const {
        const int row0 = u.pm * BM + wr * 64 + fr, col0 = u.pn * BM + wc * 32 + 8 * fq;
        const float* gp = gate + (size_t)(u.pm >> 3) * 6144 + col0;
        f32x4 gv[2][2];
#pragma unroll
        for (int bj = 0; bj < 2; ++bj)
#pragma unroll
            for (int n = 0; n < 2; ++n) gv[bj][n] = *(const f32x4*)(gp + bj * HALF + 4 * n);
#pragma unroll
        for (int ai = 0; ai < 2; ++ai)
#pragma unroll
            for (int mh = 0; mh < 2; ++mh) {
                f32x4 xa[2][2][2]; u32x4 xb[2][2];
#pragma unroll
                for (int mm = 0; mm < 2; ++mm) { const size_t off = (size_t)(row0 + ai * HALF + (2 * mh + mm) * 16) * D + col0;
#pragma unroll
                    for (int bj = 0; bj < 2; ++bj) { if (F32IN) { xa[mm][bj][0] = *(const f32x4*)(xin32 + off + bj * HALF); xa[mm][bj][1] = *(const f32x4*)(xin32 + off + bj * HALF + 4); } else xb[mm][bj] = *(const u32x4*)(x16 + off + bj * HALF); } }
#pragma unroll
                for (int mm = 0; mm < 2; ++mm) { const int m = 2 * mh + mm; const size_t off = (size_t)(row0 + ai * HALF + m * 16) * D + col0;
#pragma unroll
                    for (int bj = 0; bj < 2; ++bj) { f32x4 x0, x1;
                        if (F32IN) { x0 = xa[mm][bj][0]; x1 = xa[mm][bj][1]; }
                        else { const u32x4 xv = xb[mm][bj]; x0 = (f32x4){bflo(xv.x), bfhi(xv.x), bflo(xv.y), bfhi(xv.y)}; x1 = (f32x4){bflo(xv.z), bfhi(xv.z), bflo(xv.w), bfhi(xv.w)}; }
                        const f32x4 v0 = x0 + gv[bj][0] * acc[ai][bj][m][0], v1 = x1 + gv[bj][1] * acc[ai][bj][m][1];
                        u32x4 w; w.x = cvt_pk_bf16(v0[0], v0[1]); w.y = cvt_pk_bf16(v0[2], v0[3]); w.z = cvt_pk_bf16(v1[0], v1[1]); w.w = cvt_pk_bf16(v1[2], v1[3]);
                        *(u32x4*)(x16 + off + bj * HALF) = w; } }
                asm volatile("" ::: "memory"); }
    }
};
struct EpiAct {
    static constexpr bool PERM = true;
    bf16_t* O;
    __device__ __forceinline__ void operator()(const f32x4 (&acc)[2][2][4][2], const Unit& u, int wr, int wc, int fr, int fq) const {
        const int row0 = u.pm * BM + wr * 64 + fr, col0 = u.pn * 128 + wc * 16 + 4 * fq;
#pragma unroll
        for (int ai = 0; ai < 2; ++ai)
#pragma unroll
            for (int m = 0; m < 4; ++m) { bf16_t* rowp = O + (size_t)(row0 + ai * HALF + m * 16) * DEXP + col0;
#pragma unroll
                for (int bj = 0; bj < 2; ++bj) { const f32x4 a = acc[ai][bj][m][0], b = acc[ai][bj][m][1]; f32x4 r;
#pragma unroll
                    for (int j = 0; j < 4; ++j) r[j] = a[j] * b[j] * __builtin_amdgcn_rcpf(1.0f + __expf(-a[j]));
                    u32x2 w; w.x = cvt_pk_bf16(r[0], r[1]); w.y = cvt_pk_bf16(r[2], r[3]);
                    *(u32x2*)(rowp + bj * 64) = w; } }
    }
};
struct EpiY {
    static constexpr bool PERM = true;
    bf16_t* O; const float* sgate;
    __device__ __forceinline__ void operator()(const f32x4 (&acc)[2][2][4][2], const Unit& u, int wr, int wc, int fr, int fq) const {
        const int row0 = u.pm * BM + wr * 64 + fr, col0 = u.pn * BM + wc * 32 + 8 * fq;
        float gg[2][4];
#pragma unroll
        for (int ai = 0; ai < 2; ++ai)
#pragma unroll
            for (int m = 0; m < 4; ++m) gg[ai][m] = sgate[row0 + ai * HALF + m * 16];
#pragma unroll
        for (int ai = 0; ai < 2; ++ai)
#pragma unroll
            for (int m = 0; m < 4; ++m) { const int row = row0 + ai * HALF + m * 16; const float g = gg[ai][m]; bf16_t* rowp = O + (size_t)row * D + col0;
#pragma unroll
                for (int bj = 0; bj < 2; ++bj) { const f32x4 v0 = acc[ai][bj][m][0] * g, v1 = acc[ai][bj][m][1] * g;
                    u32x4 w; w.x = cvt_pk_bf16(v0[0], v0[1]); w.y = cvt_pk_bf16(v0[2], v0[3]); w.z = cvt_pk_bf16(v1[0], v1[1]); w.w = cvt_pk_bf16(v1[2], v1[3]);
                    *(u32x4*)(rowp + bj * HALF) = w; } }
    }
};

template <class Epi, class Sched, bool GATHER>
__device__ __forceinline__ void gemm_phase(LAS unsigned char* lds, const Sched& S, const Epi& E) {
    const int tid = threadIdx.x, wid = __builtin_amdgcn_readfirstlane(tid >> 6), lane = tid & 63, wr = wid >> 2, wc = wid & 3, fr = lane & 15, fq = lane >> 4;
    const int K = S.K, nt = K / BK;
    unsigned voffA[2], voffB[2]; int RA[2], CA[2];
#pragma unroll
    for (int i = 0; i < 2; ++i) { int R, C; stage_rc(tid * 16 + i * 8192, R, C); const int Rb = Epi::PERM ? ((R & ~31) + perm32(R & 31)) : R;
        RA[i] = R; CA[i] = C; voffA[i] = (unsigned)(R * K + C) * 2u; voffB[i] = (unsigned)(Rb * K + C) * 2u; }
    const size_t kstep = (size_t)(BK * 2);
    const size_t hstep = (size_t)HALF * K * 2;
    const unsigned ldsw = (unsigned)wid * 1024u;
    const int aoff = lds_byte(wr * 64 + fr, fq * 8), boff = lds_byte(wc * 32 + fr, fq * 8);
#define PG8_SA(b, h) (((b) * 2 + (h)) * HTB)
#define PG8_SB(b, h) ((4 + (b) * 2 + (h)) * HTB)
#define PG8_DMA(bufoff, gptr, i) __builtin_amdgcn_global_load_lds((const unsigned*)(gptr), (LAS unsigned*)(lds + (bufoff) + ldsw + (i) * 8192), 16, 0, 0)
#define PG8_STAGE(bufoff, gbase, voff) do { PG8_DMA(bufoff, (const char*)(gbase) + (voff)[0], 0); PG8_DMA(bufoff, (const char*)(gbase) + (voff)[1], 1); } while (0)
#define PG8_STAGE_A(bufoff, nx, h, kb) do { if constexpr (GATHER) { \
            PG8_DMA(bufoff, S.A + (kb) + ((nx) ? gN[h][0] : gC[h][0]), 0); PG8_DMA(bufoff, S.A + (kb) + ((nx) ? gN[h][1] : gC[h][1]), 1); } \
        else { const char* _b = ((nx) ? nA : cA) + (h) * hstep + (kb); PG8_DMA(bufoff, _b + voffA[0], 0); PG8_DMA(bufoff, _b + voffA[1], 1); } } while (0)
#define PG8_LDA(dst, b, h) do { _Pragma("unroll") for (int m = 0; m < 4; ++m) _Pragma("unroll") for (int k = 0; k < 2; ++k) dst[m][k] = *(const LAS bf16x8*)(lds + PG8_SA(b, h) + aoff + m * 2048 + k * 1024); } while (0)
#define PG8_LDB(dst, b, h) do { _Pragma("unroll") for (int n = 0; n < 2; ++n) _Pragma("unroll") for (int k = 0; k < 2; ++k) dst[n][k] = *(const LAS bf16x8*)(lds + PG8_SB(b, h) + boff + n * 2048 + k * 1024); } while (0)
#define PG8_MMA(ai, bj, At, Bt) do { __builtin_amdgcn_s_setprio(1); _Pragma("unroll") for (int m = 0; m < 4; ++m) _Pragma("unroll") for (int n = 0; n < 2; ++n) _Pragma("unroll") for (int k = 0; k < 2; ++k) \
        acc[ai][bj][m][n] = __builtin_amdgcn_mfma_f32_16x16x32_bf16(Bt[n][k], At[m][k], acc[ai][bj][m][n], 0, 0, 0); __builtin_amdgcn_s_setprio(0); } while (0)
#define PG8_WAIT_V(n) asm volatile("s_waitcnt vmcnt(" #n ")" ::: "memory")
#define PG8_WAIT_L(n) asm volatile("s_waitcnt lgkmcnt(" #n ")" ::: "memory")
#define PG8_BAR __builtin_amdgcn_s_barrier()
#define PG8_SCHED __builtin_amdgcn_sched_barrier(0)
    Unit cur, nxt; int ui = 0;
    if (!S.next(0, cur)) return;
    unsigned gC[2][2] = {{0u, 0u}, {0u, 0u}}, gN[2][2] = {{0u, 0u}, {0u, 0u}};
    if constexpr (GATHER) {
#pragma unroll
        for (int h = 0; h < 2; ++h)
#pragma unroll
            for (int i = 0; i < 2; ++i) gC[h][i] = (unsigned)(S.row(0, h * HALF + RA[i]) * K + CA[i]) * 2u;
    }
    f32x4 acc[2][2][4][2];
#pragma unroll
    for (int a = 0; a < 2; ++a)
#pragma unroll
        for (int b = 0; b < 2; ++b)
#pragma unroll
            for (int m = 0; m < 4; ++m)
#pragma unroll
                for (int n = 0; n < 2; ++n) acc[a][b][m][n] = (f32x4){0.f, 0.f, 0.f, 0.f};
    bf16x8 At[4][2], B0[2][2], B1[2][2];
    const char* cA = cur.a; const char* cB = cur.b; const char* nA = cA; const char* nB = cB;
    PG8_STAGE(PG8_SB(0, 0), cB, voffB); PG8_STAGE(PG8_SB(0, 1), cB + hstep, voffB); PG8_STAGE_A(PG8_SA(0, 0), false, 0, 0); PG8_STAGE_A(PG8_SA(0, 1), false, 1, 0);
    if (wr == 1) PG8_BAR;
    PG8_WAIT_V(2); PG8_BAR;
    PG8_STAGE(PG8_SB(1, 0), cB + kstep, voffB); PG8_STAGE_A(PG8_SA(1, 0), false, 0, kstep); PG8_STAGE(PG8_SB(1, 1), cB + hstep + kstep, voffB);
    PG8_WAIT_V(6); PG8_BAR;
    for (;;) {
        const bool has_next = S.next(ui + 1, nxt);
        nA = has_next ? nxt.a : cA; nB = has_next ? nxt.b : cB;
        if constexpr (GATHER) {
            const int nord = has_next ? ui + 1 : ui;
#pragma unroll
            for (int h = 0; h < 2; ++h)
#pragma unroll
                for (int i = 0; i < 2; ++i) gN[h][i] = (unsigned)(S.row(nord, h * HALF + RA[i]) * K + CA[i]) * 2u;
        }
        for (int t = 0; t < nt; t += 2) {
            const bool last = (t == nt - 2);
            const size_t k1 = (size_t)(t + 1) * kstep;
            const size_t k2 = last ? 0 : (size_t)(t + 2) * kstep, k3 = k2 + kstep;
            const char* b2 = (last ? nB : cB) + k2; const char* b3 = b2 + kstep;
            PG8_LDB(B0, 0, 0); PG8_LDB(B1, 0, 1); PG8_SCHED; PG8_LDA(At, 0, 0); PG8_STAGE_A(PG8_SA(1, 1), false, 1, k1);
            PG8_WAIT_V(8); PG8_WAIT_L(0); PG8_BAR; PG8_MMA(0, 0, At, B0); PG8_MMA(0, 1, At, B1); PG8_BAR; PG8_SCHED;
            PG8_LDA(At, 0, 1); PG8_STAGE(PG8_SB(0, 0), b2, voffB); PG8_STAGE(PG8_SB(0, 1), b2 + hstep, voffB); PG8_STAGE_A(PG8_SA(0, 0), last, 0, k2);
            PG8_WAIT_V(8); PG8_WAIT_L(0); PG8_BAR; PG8_MMA(1, 0, At, B0); PG8_MMA(1, 1, At, B1); PG8_BAR; PG8_SCHED;
            PG8_LDB(B0, 1, 0); PG8_LDB(B1, 1, 1); PG8_SCHED; PG8_LDA(At, 1, 0); PG8_STAGE_A(PG8_SA(0, 1), last, 1, k2);
            PG8_WAIT_V(8); PG8_WAIT_L(0); PG8_BAR; PG8_MMA(0, 0, At, B0); PG8_MMA(0, 1, At, B1); PG8_BAR; PG8_SCHED;
            PG8_LDA(At, 1, 1); PG8_STAGE(PG8_SB(1, 0), b3, voffB); PG8_STAGE(PG8_SB(1, 1), b3 + hstep, voffB); PG8_STAGE_A(PG8_SA(1, 0), last, 0, k3);
            PG8_WAIT_V(8); PG8_WAIT_L(0); PG8_BAR; PG8_MMA(1, 0, At, B0); PG8_MMA(1, 1, At, B1); PG8_BAR; PG8_SCHED;
        }
        if (wr == 0) PG8_BAR;
        E(acc, cur, wr, wc, fr, fq);
        if (!has_next) break;
#pragma unroll
        for (int a = 0; a < 2; ++a)
#pragma unroll
            for (int b = 0; b < 2; ++b)
#pragma unroll
                for (int m = 0; m < 4; ++m)
#pragma unroll
                    for (int n = 0; n < 2; ++n) acc[a][b][m][n] = (f32x4){0.f, 0.f, 0.f, 0.f};
        cur = nxt; cA = nA; cB = nB; ++ui;
        if constexpr (GATHER) {
#pragma unroll
            for (int h = 0; h < 2; ++h)
#pragma unroll
                for (int i = 0; i < 2; ++i) gC[h][i] = gN[h][i];
        }
        if (wr == 1) PG8_BAR;
    }
    PG8_WAIT_V(0);
    PG8_BAR;
#undef PG8_SA
#undef PG8_SB
#undef PG8_DMA
#undef PG8_STAGE
#undef PG8_STAGE_A
#undef PG8_LDA
#undef PG8_LDB
#undef PG8_MMA
#undef PG8_WAIT_V
#undef PG8_WAIT_L
#undef PG8_BAR
#undef PG8_SCHED
}
}

struct Params { const float* in[27]; float* out; unsigned char* ws; int ph_lo, ph_hi; };
struct Ctx { LAS unsigned char* lds; int tid, lane, wave, vcu, G, gw, NGW; mutable unsigned long long sw_t0, sw_sum; };
#ifndef SW_ID
#define SW_ID 0
#endif
#define SW_START(id) do { if (SW_ID == (id)) c.sw_t0 = __builtin_amdgcn_s_memrealtime(); } while (0)
#define SW_STOP(id) do { if (SW_ID == (id)) c.sw_sum += __builtin_amdgcn_s_memrealtime() - c.sw_t0; } while (0)
enum { I_X = 0, I_C, I_MODW, I_MODB, I_N1G, I_WIN, I_CONVK, I_CONVB, I_CLNG, I_CLNB, I_QNG, I_KVNG, I_WUQ, I_WUK, I_WUV, I_POOLW, I_POOLS, I_WOUT, I_N2G, I_RGW, I_RGB, I_REW, I_REB, I_W1, I_W3, I_W2, I_FG };

template <class RowMap>
__device__ __forceinline__ void tr_item(const float* src, int ldn, int k0, int n0, int nvalid, bf16_t* dst, int ldk, int dk0, RowMap rm, LAS float* scr, int lane) {
#pragma unroll 8
    for (int i = 0; i < 32; ++i) { const int kk = 2 * i + (lane >> 5), n = n0 + (lane & 31); scr[kk * 33 + (lane & 31)] = (n < nvalid) ? src[(size_t)(k0 + kk) * ldn + n] : 0.f; }
    LDS_WAIT();
    const int c = lane & 7;
#pragma unroll
    for (int j = 0; j < 4; ++j) { const int n = (lane >> 3) + 8 * j; const LAS float* s = scr + (8 * c) * 33 + n;
        u32x4 o; o.x = cvt_pk_bf16(s[0 * 33], s[1 * 33]); o.y = cvt_pk_bf16(s[2 * 33], s[3 * 33]); o.z = cvt_pk_bf16(s[4 * 33], s[5 * 33]); o.w = cvt_pk_bf16(s[6 * 33], s[7 * 33]);
        *(u32x4*)(dst + (size_t)rm(n0 + n) * ldk + dk0 + k0 + 8 * c) = o; }
    LDS_WAIT();
}

__device__ __forceinline__ void conv_experts(const Params& p, const Ctx& c, int l) {
    LAS float* scr = (LAS float*)(c.lds + c.wave * 8448);
    bf16_t* W13 = (bf16_t*)(p.ws + WS_W13); bf16_t* W2 = (bf16_t*)(p.ws + WS_W2);
    for (int it = c.gw; it < 3 * 8192; it += c.NGW) {
        const int which = it >> 13, r = it & 8191, e = r >> 8;
        if (which < 2) { const int kb = (r >> 4) & 15, nb = r & 15; const float* src = p.in[which ? I_W3 : I_W1] + (size_t)(l * NEXP + e) * 1024 * 512; const int add = which ? 4 : 0;
            tr_item(src, 512, 64 * kb, 32 * nb, 512, W13 + (size_t)e * 1024 * 1024, 1024, 0, [add](int n) { return 8 * (n >> 2) + (n & 3) + add; }, scr, c.lane); }
        else { const int kb = (r >> 5) & 7, nb = r & 31; const float* src = p.in[I_W2] + (size_t)(l * NEXP + e) * 512 * 1024;
            tr_item(src, 1024, 64 * kb, 32 * nb, 1024, W2 + (size_t)e * 1024 * 512, 512, 0, [](int n) { return n; }, scr, c.lane); }
    }
}

__device__ __forceinline__ void cx_issue(const Params& p, int l, int it, int lane, float (&tv)[32]) {
    const int which = it >> 13, r = it & 8191, e = r >> 8;
    const float* src; int ldn, k0, n0;
    if (which < 2) { const int kb = (r >> 4) & 15, nb = r & 15; src = p.in[which ? I_W3 : I_W1] + (size_t)(l * NEXP + e) * 1024 * 512; ldn = 512; k0 = 64 * kb; n0 = 32 * nb; }
    else { const int kb = (r >> 5) & 7, nb = r & 31; src = p.in[I_W2] + (size_t)(l * NEXP + e) * 512 * 1024; ldn = 1024; k0 = 64 * kb; n0 = 32 * nb; }
    const float* s0 = src + (size_t)(k0 + (lane >> 5)) * ldn + n0 + (lane & 31);
#pragma unroll
    for (int i = 0; i < 32; ++i) tv[i] = s0[(size_t)(2 * i) * ldn];
}
__device__ __forceinline__ void cx_finish(const Params& p, int it, int lane, const float (&tv)[32], LAS float* scr) {
    const int which = it >> 13, r = it & 8191, e = r >> 8;
    bf16_t* dst; int ldk, k0, n0, add = 0; bool inter = false;
    if (which < 2) { const int kb = (r >> 4) & 15, nb = r & 15; dst = (bf16_t*)(p.ws + WS_W13) + (size_t)e * 1024 * 1024; ldk = 1024; k0 = 64 * kb; n0 = 32 * nb; add = which ? 4 : 0; inter = true; }
    else { const int kb = (r >> 5) & 7, nb = r & 31; dst = (bf16_t*)(p.ws + WS_W2) + (size_t)e * 1024 * 512; ldk = 512; k0 = 64 * kb; n0 = 32 * nb; }
#pragma unroll
    for (int i = 0; i < 32; ++i) scr[(2 * i + (lane >> 5)) * 33 + (lane & 31)] = tv[i];
    LDS_WAIT();
    const int cc = lane & 7;
#pragma unroll
    for (int j = 0; j < 4; ++j) { const int n = (lane >> 3) + 8 * j; const LAS float* sp = scr + (8 * cc) * 33 + n; const int nn = n0 + n; const int row = inter ? (8 * (nn >> 2) + (nn & 3) + add) : nn;
        u32x4 o; o.x = cvt_pk_bf16(sp[0 * 33], sp[1 * 33]); o.y = cvt_pk_bf16(sp[2 * 33], sp[3 * 33]); o.z = cvt_pk_bf16(sp[4 * 33], sp[5 * 33]); o.w = cvt_pk_bf16(sp[6 * 33], sp[7 * 33]);
        *(u32x4*)(dst + (size_t)row * ldk + k0 + 8 * cc) = o; }
    LDS_WAIT();
}

__device__ __forceinline__ void ph_prologue(const Params& p, const Ctx& c) {
    float* mod = (float*)(p.ws + WS_MOD);
    {
        LAS float* cond = (LAS float*)c.lds; LAS float* part = (LAS float*)(c.lds + 65536);
        bool loaded = false;
        for (int item = c.vcu; item < 192; item += c.G) {
            if (!loaded) { for (int i = c.tid; i < NB * D; i += 512) { const float v = p.in[I_C][i]; cond[i] = v / (1.0f + expf(-v)); } __syncthreads(); loaded = true; }
            const int l = item / 96, n0 = (item % 96) * 64;
            const float* W = p.in[I_MODW] + (size_t)l * D * 6144 + n0 + c.lane;
            float acc[NB];
#pragma unroll
            for (int b = 0; b < NB; ++b) acc[b] = 0.f;
#pragma unroll 8
            for (int k = c.wave * 128; k < c.wave * 128 + 128; ++k) { const float w = W[(size_t)k * 6144];
#pragma unroll
                for (int b = 0; b < NB; ++b) acc[b] += cond[b * D + k] * w; }
#pragma unroll
            for (int b = 0; b < NB; ++b) part[(c.wave * NB + b) * 64 + c.lane] = acc[b];
            __syncthreads();
            for (int o = c.tid; o < NB * 64; o += 512) { const int b = o >> 6, ln = o & 63; float s = 0.f;
#pragma unroll
                for (int w = 0; w < 8; ++w) s += part[(w * NB + b) * 64 + ln];
                mod[(size_t)(l * NB + b) * 6144 + n0 + ln] = s + p.in[I_MODB][l * 6144 + n0 + ln]; }
            __syncthreads();
        }
        __syncthreads();
    }
    {
        LAS float* scr = (LAS float*)(c.lds + c.wave * 8448);
        constexpr int I_IN = 16 * 56;
        for (int it = c.gw; it < 2 * I_IN; it += c.NGW) {
            const int l = it / I_IN, r = it % I_IN, kb = r / 56, nb = r % 56;
            tr_item(p.in[I_WIN] + (size_t)l * D * N_IN, N_IN, 64 * kb, 32 * nb, N_IN, (bf16_t*)(p.ws + WS_WIN) + (size_t)l * NZ * D, D, 0, [](int n) { return n; }, scr, c.lane);
        }
    }
}
__device__ __forceinline__ void ph_prologue_rest(const Params& p, const Ctx& c, int wid, int nw) {
    {
        LAS float* scr = (LAS float*)(c.lds + c.wave * 8448);
        constexpr int I_MX = 4 * 32;
        for (int it = wid; it < 2 * 2 * I_MX; it += nw) {
            const int l = it / (2 * I_MX); int r = it % (2 * I_MX); const int part = r / I_MX; r %= I_MX; const int kb = r / 32, nb = r % 32;
            tr_item(p.in[I_WOUT] + (size_t)l * D * D + (size_t)(part ? 768 : 0) * D, D, 64 * kb, 32 * nb, D, (bf16_t*)(p.ws + WS_WMIX) + (size_t)l * D * KMIX, KMIX, part ? 1280 : 0, [](int n) { return n; }, scr, c.lane);
        }
    }
    for (int it = wid * 64 + c.lane; it < 2 * 131072; it += nw * 64) {
        const int l = it >> 17, r = it & 131071, n = r & 1023, h = (r >> 10) & 7, cb = r >> 13;
        const float* wo = p.in[I_WOUT] + (size_t)l * D * D + (size_t)(256 + 64 * h) * D + n;
        const float* wv = p.in[I_WUV] + (size_t)l * 128 * 512 + (size_t)(8 * cb) * 512 + h * 64;
        float acc[8];
#pragma unroll
        for (int j = 0; j < 8; ++j) acc[j] = 0.f;
        for (int d0 = 0; d0 < 64; d0 += 16) { float w[16];
#pragma unroll
            for (int q = 0; q < 16; ++q) w[q] = wo[(size_t)(d0 + q) * D];
#pragma unroll
            for (int j = 0; j < 8; ++j) { asm volatile("" ::: "memory");
#pragma unroll
                for (int q = 0; q < 16; q += 4) { const f32x4 v4 = *(const f32x4*)(wv + j * 512 + d0 + q); acc[j] += (v4.x * w[q] + v4.y * w[q + 1]) + (v4.z * w[q + 2] + v4.w * w[q + 3]); } } }
        u32x4 o; o.x = cvt_pk_bf16(acc[0], acc[1]); o.y = cvt_pk_bf16(acc[2], acc[3]); o.z = cvt_pk_bf16(acc[4], acc[5]); o.w = cvt_pk_bf16(acc[6], acc[7]);
        *(u32x4*)((bf16_t*)(p.ws + WS_WMIX) + (size_t)l * D * KMIX + (size_t)n * KMIX + 256 + 128 * h + 8 * cb) = o;
    }
    for (int it = wid * 64 + c.lane; it < 2 * 32768; it += nw * 64) {
        const int l = it >> 15, r = it & 32767, cb = r & 31, k = (r >> 5) & 127, h = r >> 12;
        const float* uq = p.in[I_WUQ] + (size_t)l * 256 * 512 + (size_t)(8 * cb) * 512 + h * 64;
        const float* uk = p.in[I_WUK] + (size_t)l * 128 * 512 + (size_t)k * 512 + h * 64;
        float acc[8];
#pragma unroll
        for (int j = 0; j < 8; ++j) acc[j] = 0.f;
        for (int d0 = 0; d0 < 64; d0 += 16) { f32x4 w4[4];
#pragma unroll
            for (int q = 0; q < 4; ++q) w4[q] = *(const f32x4*)(uk + d0 + 4 * q);
#pragma unroll
            for (int j = 0; j < 8; ++j) { asm volatile("" ::: "memory");
#pragma unroll
                for (int q = 0; q < 4; ++q) { const f32x4 v4 = *(const f32x4*)(uq + j * 512 + d0 + 4 * q); acc[j] += (v4.x * w4[q].x + v4.y * w4[q].y) + (v4.z * w4[q].z + v4.w * w4[q].w); } } }
        const float sc = 0.125f * 1.44269504089f;
#pragma unroll
        for (int j = 0; j < 8; ++j) acc[j] *= sc * p.in[I_QNG][l * 256 + 8 * cb + j];
        u32x4 o; o.x = cvt_pk_bf16(acc[0], acc[1]); o.y = cvt_pk_bf16(acc[2], acc[3]); o.z = cvt_pk_bf16(acc[4], acc[5]); o.w = cvt_pk_bf16(acc[6], acc[7]);
        *(u32x4*)((bf16_t*)(p.ws + WS_WQA) + (size_t)l * D * 256 + (size_t)(h * 128 + k) * 256 + 8 * cb) = o;
    }
    for (int it = wid * 64 + c.lane; it < 2 * 1024 * 32; it += nw * 64) {
        const int l = it >> 15, r = it & 32767, k = r >> 5, g = (r >> 3) & 3, q = r & 7, e = k & 3, ln = (k >> 2) & 63, j = k >> 8;
        ((float*)(p.ws + WS_SMALL + SM_REW2))[(size_t)(l * 4 + g) * 8192 + (size_t)((((j * 4 + e) * 2 + (q >> 2)) * 64 + ln) * 4) + (q & 3)] = p.in[I_REW][(size_t)l * D * 32 + r];
    }
    for (int it = wid * 64 + c.lane; it < 2 * 1024 * 4; it += nw * 64) {
        const int l = it >> 12, r = it & 4095, k = r >> 2, q = r & 3, e = k & 3, ln = (k >> 2) & 63, j = k >> 8;
        ((float*)(p.ws + WS_SMALL + SM_RGW2))[(size_t)l * 4096 + (size_t)(((j * 4 + e) * 64 + ln) * 4) + q] = p.in[I_RGW][(size_t)l * D * 4 + r];
    }
    for (int it = wid * 64 + c.lane; it < 2 * 4 * 64 * 8; it += nw * 64) {
        const int lg = it >> 9, r = it & 511, o = r >> 3, ib = r & 7; const float* src = p.in[I_POOLW] + (size_t)lg * 4096 + (size_t)(8 * ib) * 64 + o;
        u32x4 w; w.x = cvt_pk_bf16(src[0], src[64]); w.y = cvt_pk_bf16(src[128], src[192]); w.z = cvt_pk_bf16(src[256], src[320]); w.w = cvt_pk_bf16(src[384], src[448]);
        *(u32x4*)((bf16_t*)(p.ws + WS_SMALL + SM_PWT) + (size_t)lg * 4096 + o * 64 + 8 * ib) = w;
    }
}

template <int MODE>
__device__ __forceinline__ void ph_norm1(const Params& p, const Ctx& c) {
    const float* mod = (const float*)(p.ws + WS_MOD);
    const bf16_t* Y = (const bf16_t*)(p.ws + WS_Y); const int* tslot = (const int*)(p.ws + WS_SMALL + SM_TSLOT);
    bf16_t* H = (bf16_t*)(p.ws + WS_H); bf16_t* X16 = (bf16_t*)(p.ws + WS_X16);
    constexpr int NR = (MODE == 0) ? 4 : 2;
    const int nrow = T / c.NGW;
    f32x4 vn[NR][4]; u32x2 xn[NR][4], an[NR][4], bn[NR][4];
    auto load_rows = [&](int r0) {
#pragma unroll
        for (int t = 0; t < NR; ++t) { const int m = c.gw + (r0 + t) * c.NGW;
            if (MODE == 0) {
#pragma unroll
                for (int j = 0; j < 4; ++j) vn[t][j] = ((const f32x4*)(p.in[I_X] + (size_t)m * D) + c.lane)[64 * j];
            } else { const int s0 = tslot[2 * m], s1 = tslot[2 * m + 1];
#pragma unroll
                for (int j = 0; j < 4; ++j) { xn[t][j] = ((const u32x2*)(X16 + (size_t)m * D) + c.lane)[64 * j]; an[t][j] = ((const u32x2*)(Y + (size_t)s0 * D) + c.lane)[64 * j]; bn[t][j] = ((const u32x2*)(Y + (size_t)s1 * D) + c.lane)[64 * j]; } } } };
    load_rows(0);
    for (int r0 = 0; r0 < nrow; r0 += NR) {
        f32x4 v[NR][4]; u32x2 ya[NR][4], yb[NR][4];
#pragma unroll
        for (int t = 0; t < NR; ++t)
#pragma unroll
            for (int j = 0; j < 4; ++j) { if (MODE == 0) v[t][j] = vn[t][j]; else { v[t][j] = (f32x4){bflo(xn[t][j].x), bfhi(xn[t][j].x), bflo(xn[t][j].y), bfhi(xn[t][j].y)}; ya[t][j] = an[t][j]; yb[t][j] = bn[t][j]; } }
        if (r0 + NR < nrow) load_rows(r0 + NR);
#pragma unroll
        for (int t = 0; t < NR; ++t) {
            const int m = c.gw + (r0 + t) * c.NGW, b = m >> 11;
            if (MODE != 0) {
                const f32x4* g2 = (const f32x4*)(mod + (size_t)((MODE - 1) * NB + b) * 6144 + 5120) + c.lane;
#pragma unroll
                for (int j = 0; j < 4; ++j) { const u32x2 a = ya[t][j], bb = yb[t][j]; const f32x4 g = g2[64 * j];
                    v[t][j].x += g.x * (bflo(a.x) + bflo(bb.x)); v[t][j].y += g.y * (bfhi(a.x) + bfhi(bb.x)); v[t][j].z += g.z * (bflo(a.y) + bflo(bb.y)); v[t][j].w += g.w * (bfhi(a.y) + bfhi(bb.y)); }
            }
            float ss = 0.f;
#pragma unroll
            for (int j = 0; j < 4; ++j) ss += (v[t][j].x * v[t][j].x + v[t][j].y * v[t][j].y) + (v[t][j].z * v[t][j].z + v[t][j].w * v[t][j].w);
            const float r = 1.0f / sqrtf(wave_sum(ss) * (1.0f / D) + EPS);
            if (MODE == 2) {
                const f32x4* fg = (const f32x4*)p.in[I_FG] + c.lane; f32x4* o = (f32x4*)(p.out + (size_t)m * D) + c.lane;
#pragma unroll
                for (int j = 0; j < 4; ++j) o[64 * j] = v[t][j] * r * fg[64 * j];
            } else {
                if (MODE == 1) { u32x2* o = (u32x2*)(X16 + (size_t)m * D) + c.lane;
#pragma unroll
                    for (int j = 0; j < 4; ++j) { u32x2 w; w.x = cvt_pk_bf16(v[t][j].x, v[t][j].y); w.y = cvt_pk_bf16(v[t][j].z, v[t][j].w); o[64 * j] = w; } }
                const int l = MODE;
                const f32x4* ng = (const f32x4*)(p.in[I_N1G] + l * D) + c.lane;
                const f32x4* sh = (const f32x4*)(mod + (size_t)(l * NB + b) * 6144) + c.lane; const f32x4* sc = (const f32x4*)(mod + (size_t)(l * NB + b) * 6144 + 1024) + c.lane;
                u32x2* o8 = (u32x2*)(H + (size_t)m * D) + c.lane;
#pragma unroll
                for (int j = 0; j < 4; ++j) { const f32x4 hv = v[t][j] * r * ng[64 * j] * (sc[64 * j] + 1.0f) + sh[64 * j]; u32x2 w; w.x = cvt_pk_bf16(hv.x, hv.y); w.y = cvt_pk_bf16(hv.z, hv.w); o8[64 * j] = w; }
            }
        }
    }
}

__device__ __forceinline__ void ph_postz(const Params& p, const Ctx& c, int l) {
    const bf16_t* Z = (const bf16_t*)(p.ws + WS_Z); bf16_t* MC = (bf16_t*)p.out;
    bf16_t* CQR = (bf16_t*)(p.ws + WS_CQR); bf16_t* KVN = (bf16_t*)(p.ws + WS_KVN);
    LAS float* U = (LAS float*)c.lds;
    const int lane = c.lane, tk0 = c.wave * 8;
    LAS f32x4* CK = (LAS f32x4*)(c.lds + 98304);
    { const f32x4* src = (const f32x4*)(p.in[I_CONVK] + (size_t)l * 31 * 256); f32x4 t[4];
#pragma unroll
      for (int q = 0; q < 4; ++q) { const int i = c.tid + 512 * q; t[q] = src[i < 31 * 64 ? i : 0]; }
#pragma unroll
      for (int q = 0; q < 4; ++q) { const int i = c.tid + 512 * q; if (i < 31 * 64) CK[i] = t[q]; } }
    __syncthreads();
    for (int unit = c.vcu; unit < 512; unit += c.G) {
        const int b = unit >> 5, s0 = (unit & 31) * 64, t0 = b * S + s0;
        SW_START(1);
#pragma unroll
        for (int hb = 0; hb < 2; ++hb) {   u32x2 av[6], gv[6];
#pragma unroll
            for (int q = 0; q < 6; ++q) { const int idx = c.tid + 512 * (6 * hb + q), r = idx >> 6, c4 = idx & 63; int s = s0 - 30 + r; s = s < 0 ? 0 : (s > S - 1 ? S - 1 : s);
                const bf16_t* zr = Z + (size_t)(b * S + s) * NZ + 4 * c4; av[q] = *(const u32x2*)(zr + Z_AVAL); gv[q] = *(const u32x2*)(zr + Z_AGATE); }
#pragma unroll
            for (int q = 0; q < 6; ++q) { const int idx = c.tid + 512 * (6 * hb + q), r = idx >> 6, c4 = idx & 63, s = s0 - 30 + r; f32x4 u = {0.f, 0.f, 0.f, 0.f};
                if (s >= 0) { const u32x2 a = av[q], g = gv[q];
                    u.x = bflo(a.x) * sigmoidf_(bflo(g.x)); u.y = bfhi(a.x) * sigmoidf_(bfhi(g.x)); u.z = bflo(a.y) * sigmoidf_(bflo(g.y)); u.w = bfhi(a.y) * sigmoidf_(bfhi(g.y)); }
                if (idx < 94 * 64) *(LAS f32x4*)(U + r * 256 + 4 * c4) = u; }
            asm volatile("" ::: "memory");
        }
        __syncthreads();
        SW_STOP(1); SW_START(2);
        {
            const LAS f32x4* ck = CK + lane;
            const f32x4 cb = *((const f32x4*)(p.in[I_CONVB] + l * 256) + lane), lg = *((const f32x4*)(p.in[I_CLNG] + l * 256) + lane), lb = *((const f32x4*)(p.in[I_CLNB] + l * 256) + lane);
#pragma unroll 1
            for (int hp = 0; hp < 2; ++hp) {
                const int tq = tk0 + 4 * hp;
                f32x4 acc[4], win[4];
#pragma unroll
                for (int i = 0; i < 4; ++i) { acc[i] = (f32x4){0.f, 0.f, 0.f, 0.f}; win[i] = *(const LAS f32x4*)(U + (tq + i) * 256 + 4 * lane); }
#pragma unroll
                for (int j = 0; j < 31; ++j) { const f32x4 kj = ck[64 * j];
#pragma unroll
                    for (int i = 0; i < 4; ++i) acc[i] += win[i] * kj;
                    if (j < 30) {
#pragma unroll
                        for (int i = 0; i < 3; ++i) win[i] = win[i + 1];
                        win[3] = *(const LAS f32x4*)(U + (tq + 4 + j) * 256 + 4 * lane); } }
#pragma unroll
                for (int i = 0; i < 4; ++i) { const f32x4 v = acc[i] + cb; const float mean = wave_sum((v.x + v.y) + (v.z + v.w)) * (1.0f / 256.0f);
                    const f32x4 d = v - mean; const float var = wave_sum((d.x * d.x + d.y * d.y) + (d.z * d.z + d.w * d.w)) * (1.0f / 256.0f);
                    const float rs = 1.0f / sqrtf(var + EPS); f32x4 y = d * rs * lg + lb;
                    y.x *= sigmoidf_(y.x); y.y *= sigmoidf_(y.y); y.z *= sigmoidf_(y.z); y.w *= sigmoidf_(y.w);
                    u32x2 w; w.x = cvt_pk_bf16(y.x, y.y); w.y = cvt_pk_bf16(y.z, y.w);
                    *(u32x2*)(MC + (size_t)(t0 + tq + i) * KMIX + 4 * lane) = w; }
            }
        }
        __syncthreads();
        SW_STOP(2); SW_START(3);
        {   u32x2 av[10];
#pragma unroll
            for (int q = 0; q < 10; ++q) { const int idx = c.tid + 512 * q, r = idx >> 6, c4 = idx & 63; int s = s0 - 15 + r; s = s < 0 ? 0 : (s > S - 1 ? S - 1 : s);
                av[q] = *(const u32x2*)(Z + (size_t)(b * S + s) * NZ + Z_UP + 4 * c4); }
#pragma unroll
            for (int q = 0; q < 10; ++q) { const int idx = c.tid + 512 * q, r = idx >> 6, c4 = idx & 63, s = s0 - 15 + r; f32x4 u = {0.f, 0.f, 0.f, 0.f};
                if (s >= 0) { const u32x2 a = av[q]; u.x = bflo(a.x); u.y = bfhi(a.x); u.z = bflo(a.y); u.w = bfhi(a.y); }
                if (idx < 79 * 64) *(LAS f32x4*)(U + r * 256 + 4 * c4) = u; }
        }
        __syncthreads();
        f32x4 dv[8];
        {
            const int w = 2 << (lane >> 4);
#pragma unroll
            for (int i = 0; i < 8; ++i) { const int r = 15 + tk0 + i, s = s0 + tk0 + i; f32x4 sum = {0.f, 0.f, 0.f, 0.f};
#pragma unroll
                for (int q = 0; q < 16; ++q) { const f32x4 u = *(const LAS f32x4*)(U + (r - q) * 256 + 4 * lane); if (q < w) sum += u; }
                const float rc = __builtin_amdgcn_rcpf((float)((s + 1) < w ? (s + 1) : w));
                dv[i] = sum * rc - *(const LAS f32x4*)(U + r * 256 + 4 * lane); }
        }
        SW_STOP(3); SW_START(5);
        {
            __syncthreads();
            LAS bf16_t* D16 = (LAS bf16_t*)c.lds;
#pragma unroll
            for (int i = 0; i < 8; ++i) { u32x2 w; w.x = cvt_pk_bf16(dv[i].x, dv[i].y); w.y = cvt_pk_bf16(dv[i].z, dv[i].w); *(LAS u32x2*)(D16 + (tk0 + i) * 264 + 4 * lane) = w; }
            __syncthreads();
            const int mt = c.wave & 3, g0 = (c.wave >> 2) * 2, fr = lane & 15, fq = lane >> 4;
            const bf16_t* PWT = (const bf16_t*)(p.ws + WS_SMALL + SM_PWT) + (size_t)l * 4 * 4096;
#pragma unroll
            for (int gg = 0; gg < 2; ++gg) { const int g = g0 + gg;
                const bf16x8 d0 = *(const LAS bf16x8*)(D16 + (16 * mt + fr) * 264 + 64 * g + 8 * fq), d1 = *(const LAS bf16x8*)(D16 + (16 * mt + fr) * 264 + 64 * g + 32 + 8 * fq);
#pragma unroll
                for (int nt = 0; nt < 4; ++nt) {
                    const bf16_t* wp = PWT + (size_t)g * 4096 + (16 * nt + fr) * 64 + 8 * fq;
                    const bf16x8 w0 = *(const bf16x8*)wp, w1 = *(const bf16x8*)(wp + 32);
                    f32x4 acc = {0.f, 0.f, 0.f, 0.f};
                    acc = __builtin_amdgcn_mfma_f32_16x16x32_bf16(w0, d0, acc, 0, 0, 0); acc = __builtin_amdgcn_mfma_f32_16x16x32_bf16(w1, d1, acc, 0, 0, 0);
                    const int oc = 64 * g + 16 * nt + 4 * fq;
                    const f32x4 ps = *(const f32x4*)(p.in[I_POOLS] + l * 256 + oc); const f32x4 y = acc * ps;
                    u32x2 w; w.x = cvt_pk_bf16(y.x, y.y); w.y = cvt_pk_bf16(y.z, y.w);
                    *(u32x2*)(MC + (size_t)(t0 + 16 * mt + fr) * KMIX + 1280 + oc) = w; } }
        }
        SW_STOP(5); SW_START(6);
        asm volatile("" ::: "memory");
        {
            const float kg0 = p.in[I_KVNG][l * 128 + 2 * lane], kg1 = p.in[I_KVNG][l * 128 + 2 * lane + 1];
            u32x2 qv[8]; unsigned kvv[8];
#pragma unroll
            for (int i = 0; i < 8; ++i) { const bf16_t* zr = Z + (size_t)(t0 + tk0 + i) * NZ; qv[i] = *(const u32x2*)(zr + Z_CQ + 4 * lane); kvv[i] = *(const unsigned*)(zr + Z_CKV + 2 * lane); }
#pragma unroll
            for (int i = 0; i < 8; ++i) { const size_t t = (size_t)(t0 + tk0 + i);
                const u32x2 q = qv[i]; const float q0 = bflo(q.x), q1 = bfhi(q.x), q2 = bflo(q.y), q3 = bfhi(q.y);
                const float rq = 1.0f / sqrtf(wave_sum((q0 * q0 + q1 * q1) + (q2 * q2 + q3 * q3)) * (1.0f / 256.0f) + EPS);
                u32x2 w; w.x = cvt_pk_bf16(q0 * rq, q1 * rq); w.y = cvt_pk_bf16(q2 * rq, q3 * rq); *(u32x2*)(CQR + t * 256 + 4 * lane) = w;
                const unsigned kv = kvv[i]; const float k0 = bflo(kv), k1 = bfhi(kv);
                const float rk = 1.0f / sqrtf(wave_sum(k0 * k0 + k1 * k1) * (1.0f / 128.0f) + EPS);
                *(unsigned*)(KVN + t * 128 + 2 * lane) = cvt_pk_bf16(k0 * rk * kg0, k1 * rk * kg1); }
        }
        SW_STOP(6);
        __syncthreads();
    }
}

__device__ __forceinline__ size_t sc_off(int b, int cq) { return (size_t)b * SC_PER_B + (size_t)2048 * cq * (cq + 1); }
__device__ __forceinline__ void ph_scores(const Params& p, const Ctx& c) {
    const bf16_t* Z = (const bf16_t*)(p.ws + WS_Z); float* SC = (float*)(p.ws + WS_Y);
    const int lane = c.lane, l15 = lane & 15, g = lane >> 4;
    for (int U = c.gw; U < NB * 576; U += c.NGW) {
        const int b = U / 576, u = U % 576;
        int cg = 0; while (8 * (cg + 1) * (cg + 2) <= u) ++cg;
        const int r = u - 8 * cg * (cg + 1), q16 = r / (cg + 1), seg = r % (cg + 1), cq = 4 * cg + (q16 >> 2), q4 = q16 & 3;
        const int n = 64 * (cq + 1), kt0 = seg * 16, kt1 = (kt0 + 16 < 4 * (cq + 1)) ? kt0 + 16 : 4 * (cq + 1);
        SW_START(20);
        const size_t tq = (size_t)b * S + cq * 64 + q4 * 16 + l15;
        const bf16_t* zq = Z + tq * NZ;
        bf16x8 bq[8][2];
#pragma unroll
        for (int h = 0; h < 8; ++h)
#pragma unroll
            for (int s = 0; s < 2; ++s) bq[h][s] = *(const bf16x8*)(zq + Z_QI + h * 64 + 32 * s + 8 * g);
        float wq[8];
        { const u32x4 wv = *(const u32x4*)(zq + Z_WI); const float isc = 0.044194173824159216f;
          wq[0] = bflo(wv.x) * isc; wq[1] = bfhi(wv.x) * isc; wq[2] = bflo(wv.y) * isc; wq[3] = bfhi(wv.y) * isc; wq[4] = bflo(wv.z) * isc; wq[5] = bfhi(wv.z) * isc; wq[6] = bflo(wv.w) * isc; wq[7] = bfhi(wv.w) * isc; }
        float* srow = SC + sc_off(b, cq) + (size_t)(q4 * 16 + l15) * n;
        const bf16_t* zkb = Z + ((size_t)b * S + l15) * NZ + Z_KI + 8 * g;
        bf16x8 nk[2][2];
#pragma unroll
        for (int u2 = 0; u2 < 2; ++u2) { nk[u2][0] = *(const bf16x8*)(zkb + (size_t)(kt0 + u2) * 16 * NZ); nk[u2][1] = *(const bf16x8*)(zkb + (size_t)(kt0 + u2) * 16 * NZ + 32); }
        asm volatile("s_waitcnt vmcnt(0)" ::: "memory"); SW_STOP(20); SW_START(21);
        for (int kt = kt0; kt < kt1; kt += 2) {
            bf16x8 ak[2][2];
#pragma unroll
            for (int u2 = 0; u2 < 2; ++u2) { ak[u2][0] = nk[u2][0]; ak[u2][1] = nk[u2][1]; }
            if (kt + 2 < kt1) {
#pragma unroll
                for (int u2 = 0; u2 < 2; ++u2) { nk[u2][0] = *(const bf16x8*)(zkb + (size_t)(kt + 2 + u2) * 16 * NZ); nk[u2][1] = *(const bf16x8*)(zkb + (size_t)(kt + 2 + u2) * 16 * NZ + 32); } }
            f32x2 s01[2] = {{0.f, 0.f}, {0.f, 0.f}}, s23[2] = {{0.f, 0.f}, {0.f, 0.f}};
#pragma unroll
            for (int h = 0; h < 8; ++h) {
#pragma unroll
                for (int u2 = 0; u2 < 2; ++u2) { f32x4 a = {0.f, 0.f, 0.f, 0.f};
                    a = __builtin_amdgcn_mfma_f32_16x16x32_bf16(ak[u2][0], bq[h][0], a, 0, 0, 0);
                    a = __builtin_amdgcn_mfma_f32_16x16x32_bf16(ak[u2][1], bq[h][1], a, 0, 0, 0);
                    const f32x2 r01 = {__int_as_float(max(__float_as_int(a[0]), 0)), __int_as_float(max(__float_as_int(a[1]), 0))}, r23 = {__int_as_float(max(__float_as_int(a[2]), 0)), __int_as_float(max(__float_as_int(a[3]), 0))};
                    const f32x2 w2 = {wq[h], wq[h]}; s01[u2] = __builtin_elementwise_fma(r01, w2, s01[u2]); s23[u2] = __builtin_elementwise_fma(r23, w2, s23[u2]); } }
#pragma unroll
            for (int u2 = 0; u2 < 2; ++u2) *(f32x4*)(srow + (kt + u2) * 16 + 4 * g) = (f32x4){s01[u2].x, s01[u2].y, s23[u2].x, s23[u2].y};
        }
        SW_STOP(21);
    }
}

__device__ __forceinline__ unsigned off_b(unsigned row, unsigned ch) { return 256u * row + 16u * (ch ^ (((row & 3) << 2) | ((row >> 2) & 3))); }
template <int MODE>
__device__ __forceinline__ void ph_attn(const Params& p, const Ctx& c, int l) {
    const float* SC = (const float*)(p.ws + WS_Y); const bf16_t* QA = (const bf16_t*)(p.ws + WS_H); const bf16_t* KVN = (const bf16_t*)(p.ws + WS_KVN);
    bf16_t* MC = (bf16_t*)p.out;
    const int lane = c.lane, g = lane >> 4, hd = lane & 15;
    LAS unsigned char* tile = c.lds + c.wave * 16384;
    LAS unsigned* lst = (LAS unsigned*)(c.lds + LIST_OFF + c.wave * 1088);
    const unsigned long long ltmask = (1ull << lane) - 1ull;
    const int xg = blockIdx.x & 7, wv = (blockIdx.x >> 3) * 8 + c.wave, nwv = (c.G >> 3) * 8;
    int cxq = 0;
    float svn[32];
#define ATT_PREFETCH(qn_) do { const int bn_ = xg + 8 * ((qn_) / S), sn_ = (qn_) % S, cn_ = sn_ >> 6, nn_ = 64 * (cn_ + 1); \
        const float* srn_ = SC + sc_off(bn_, cn_) + (size_t)(sn_ & 63) * nn_ + lane; \
        _Pragma("unroll") for (int j = 0; j < 32; ++j) svn[j] = srn_[64 * (j <= cn_ ? j : cn_)]; } while (0)
    if ((MODE & 1) && wv < 2 * S) ATT_PREFETCH(wv);
    for (int qi = wv; qi < 2 * S; qi += nwv) {
        const int b = xg + 8 * (qi / S), s = qi % S, cq = s >> 6, n = 64 * (cq + 1), nk = n < 256 ? n : 256;
        const size_t t = (size_t)b * S + s;
        float sv[32];
#pragma unroll
        for (int j = 0; j < 32; ++j) sv[j] = svn[j];
        if ((MODE & 1) && qi + nwv < 2 * S) ATT_PREFETCH(qi + nwv);
        float tv[32]; const int cit = c.gw + c.NGW * cxq; const bool cxv = (MODE & 8) && cit < 3 * 8192;
        if (cxv) cx_issue(p, l, cit, lane, tv);
        SW_START(10);
        if (cq < 4 || !(MODE & 1)) { for (int i = lane; i < nk; i += 64) lst[i] = (unsigned)i * 256u; }
        else {
            unsigned key[32]; unsigned kmin = 0xffffffffu, kmax = 0u;
#pragma unroll
            for (int j = 0; j < 32; ++j) key[j] = 0u;
#pragma unroll
            for (int jb = 0; jb < 4; ++jb) if (8 * jb <= cq) {
#pragma unroll
                for (int j = 8 * jb; j < 8 * jb + 8; ++j) { const unsigned u = __float_as_uint(sv[j] + 0.0f); const unsigned k = (u & 0x80000000u) ? ~u : (u | 0x80000000u);
                    key[j] = (j <= cq) ? k : 0u; kmin = (j <= cq && k < kmin) ? k : kmin; kmax = (j <= cq && k > kmax) ? k : kmax; } }
#define KMM(W) { const unsigned a = lane_xor<W>(kmin), bb = lane_xor<W>(kmax); kmin = a < kmin ? a : kmin; kmax = bb > kmax ? bb : kmax; }
            KMM(1) KMM(2) KMM(4) KMM(8) KMM(16) KMM(32)
#undef KMM
            SW_START(11);
            unsigned lo = __builtin_amdgcn_readfirstlane(kmin), hi = __builtin_amdgcn_readfirstlane(kmax); int c_lo = n, c_hi = 0; int it = 0;
            unsigned thr = 0u; int need = 0; bool done = false;
            while (lo < hi && (c_lo - c_hi) > 64) {
                unsigned mid;
                if (it < 20) {
                    const float lo_v = __uint_as_float((lo & 0x80000000u) ? (lo ^ 0x80000000u) : ~lo), hi_v = __uint_as_float((hi & 0x80000000u) ? (hi ^ 0x80000000u) : ~hi);
                    const float f = (it & 1) ? 0.5f : (float)(c_lo - 256) * __builtin_amdgcn_rcpf((float)(c_lo - c_hi));
                    const float mid_v = lo_v + (hi_v - lo_v) * f + 0.0f;
                    const unsigned mu = __float_as_uint(mid_v); mid = (mu & 0x80000000u) ? ~mu : (mu | 0x80000000u);
                } else mid = lo + ((hi - lo) >> 1) + 1u;
                mid = mid > lo ? mid : lo + 1u; mid = mid < hi ? mid : hi;
                int cnt = 0;
#pragma unroll
                for (int jb = 0; jb < 4; ++jb) if (8 * jb <= cq) {
                    unsigned long long bm[8];
#pragma unroll
                    for (int j = 0; j < 8; ++j) bm[j] = __ballot(key[8 * jb + j] >= mid);
#pragma unroll
                    for (int j = 0; j < 8; ++j) cnt += __builtin_popcountll(bm[j]); }
                if (cnt >= 256) { lo = mid; c_lo = cnt; if (cnt == 256) { thr = mid; need = 1 << 20; done = true; break; } } else { hi = mid - 1u; c_hi = cnt; }
                ++it;
            }
            SW_STOP(11); SW_START(12);
            if (!done) {
                if (lo == hi) {
                    thr = lo; int cgt = 0;
#pragma unroll
                    for (int j = 0; j < 32; ++j) cgt += __builtin_popcountll(__ballot(key[j] > thr));
                    need = 256 - cgt;
                } else {
                    LAS unsigned* cand = (LAS unsigned*)lst; int base = 0;
#pragma unroll
                    for (int jb = 0; jb < 4; ++jb) if (8 * jb <= cq) {
#pragma unroll
                        for (int j = 8 * jb; j < 8 * jb + 8; ++j) { const bool isc = key[j] >= lo && key[j] <= hi; const unsigned long long bc = __ballot(isc);
                            if (isc) cand[base + __builtin_popcountll(bc & ltmask)] = key[j]; base += __builtin_popcountll(bc); } }
                    const int m = base;
                    const unsigned ck = lane < m ? cand[lane] : 0u;
                    int gt = 0, ge = 0;
                    for (int q = 0; q < m; ++q) { const unsigned v = (unsigned)__builtin_amdgcn_readlane((int)ck, q); gt += v > ck; ge += v >= ck; }
                    const int r = 256 - c_hi;
                    const unsigned long long hit = __ballot(lane < m && gt < r && r <= ge);
                    const int src = __builtin_ctzll(hit);
                    thr = __shfl(ck, src); need = r - __shfl(gt, src);
                }
            }
            SW_STOP(12); SW_START(13);
            asm volatile("" ::: "memory");
            {
                int base = 0, tb = 0;
#pragma unroll
                for (int jb = 0; jb < 4; ++jb) if (8 * jb <= cq) {
#pragma unroll
                    for (int j = 8 * jb; j < 8 * jb + 8; ++j) {
                        const bool gt = key[j] > thr, tie = key[j] == thr; const unsigned long long bt = __ballot(tie);
                        const int trank = tb + __builtin_popcountll(bt & ltmask); const bool sel = gt || (tie && trank < need);
                        const unsigned long long bs = __ballot(sel); const int pos = base + __builtin_popcountll(bs & ltmask);
                        if (sel && pos < 256) lst[pos] = (unsigned)(64 * j + lane) * 256u;
                        base += __builtin_popcountll(bs); tb += __builtin_popcountll(bt); } }
            }
        }
        if (cq >= 4 && (MODE & 1)) SW_STOP(13);
        SW_STOP(10); SW_START(14);
        bf16x8 qf[4];
#pragma unroll
        for (int ks = 0; ks < 4; ++ks) { qf[ks] = (bf16x8){0, 0, 0, 0, 0, 0, 0, 0}; if (hd < 8) qf[ks] = *(const bf16x8*)(QA + t * D + hd * 128 + 32 * ks + 8 * g); }
        float m_ref = -INFINITY, l_run = 0.f;
        f32x4 o[8];
#pragma unroll
        for (int ct = 0; ct < 8; ++ct) o[ct] = (f32x4){0.f, 0.f, 0.f, 0.f};
        const char* kvb = (const char*)(KVN + (size_t)b * S * 128);
        const int ntile = nk >> 5;
        LDS_WAIT();
        unsigned choff[4];
#pragma unroll
        for (int i = 0; i < 4; ++i) choff[i] = (((unsigned)hd ^ (unsigned)((g << 2) | i)) * 16u);
#define ATT_ISSUE(kt_, buf_) do { const u32x4 kq0_ = *(const LAS u32x4*)(lst + (kt_) * 32 + 8 * g), kq1_ = *(const LAS u32x4*)(lst + (kt_) * 32 + 8 * g + 4); _Pragma("unroll") for (int i = 0; i < 8; ++i) { \
            const unsigned off_ = (i < 4 ? kq0_[i & 3] : kq1_[i & 3]) + choff[i & 3]; \
            if (MODE & 2) __builtin_amdgcn_global_load_lds((const unsigned*)(kvb + off_), (LAS unsigned*)(tile + (buf_) * 8192 + i * 1024), 16, 0, 0); } } while (0)
        ATT_ISSUE(0, 0);
        for (int kt = 0; kt < ntile; ++kt) {
            LAS unsigned char* tb_ = tile + (kt & 1) * 8192;
            if (kt + 1 < ntile) { ATT_ISSUE(kt + 1, (kt + 1) & 1); asm volatile("s_waitcnt vmcnt(8)" ::: "memory"); }
            else asm volatile("s_waitcnt vmcnt(0)" ::: "memory");
            if (!(MODE & 4)) continue;
            f32x4 sa[2]; bf16x8 af[2][4];
#pragma unroll
            for (int rb = 0; rb < 2; ++rb)
#pragma unroll
                for (int ks = 0; ks < 4; ++ks) af[rb][ks] = *(const LAS bf16x8*)(tb_ + off_b(16 * rb + hd, 4 * ks + g));
#pragma unroll
            for (int rb = 0; rb < 2; ++rb) { sa[rb] = (f32x4){0.f, 0.f, 0.f, 0.f};
#pragma unroll
                for (int ks = 0; ks < 4; ++ks) sa[rb] = __builtin_amdgcn_mfma_f32_16x16x32_bf16(af[rb][ks], qf[ks], sa[rb], 0, 0, 0); }
            float pr[8], ps = 0.f;
#pragma unroll
            for (int j = 0; j < 8; ++j) { pr[j] = __builtin_amdgcn_exp2f(sa[j >> 2][j & 3] - m_ref); ps += pr[j]; }
            if (__ballot(!(ps < 8.0e12f)) != 0ull) {
                float mx = fmaxf(fmaxf(fmaxf(sa[0][0], sa[0][1]), fmaxf(sa[0][2], sa[0][3])), fmaxf(fmaxf(sa[1][0], sa[1][1]), fmaxf(sa[1][2], sa[1][3])));
                mx = fmaxf(mx, lane_xor<16>(mx)); mx = fmaxf(mx, lane_xor<32>(mx));
                const float m_new = fmaxf(m_ref, mx), alpha = __builtin_amdgcn_exp2f(m_ref - m_new);
                l_run *= alpha; m_ref = m_new;
#pragma unroll
                for (int ct = 0; ct < 8; ++ct) o[ct] *= alpha;
                ps = 0.f;
#pragma unroll
                for (int j = 0; j < 8; ++j) { pr[j] = __builtin_amdgcn_exp2f(sa[j >> 2][j & 3] - m_ref); ps += pr[j]; }
            }
            l_run += ps;
            u32x4 pw; pw.x = cvt_pk_bf16(pr[0], pr[1]); pw.y = cvt_pk_bf16(pr[2], pr[3]); pw.z = cvt_pk_bf16(pr[4], pr[5]); pw.w = cvt_pk_bf16(pr[6], pr[7]);
            const bf16x8 pb = __builtin_bit_cast(bf16x8, pw);
            const unsigned q4 = (unsigned)hd >> 2, p4 = (unsigned)hd & 3;
#pragma unroll
            for (int ct = 0; ct < 8; ++ct) {
                const bf16x4 vlo = __builtin_amdgcn_ds_read_tr16_b64_v4i16((LAS bf16x4*)(tb_ + off_b(4 * g + q4, 2 * ct + (p4 >> 1)) + 8 * (p4 & 1)));
                const bf16x4 vhi = __builtin_amdgcn_ds_read_tr16_b64_v4i16((LAS bf16x4*)(tb_ + off_b(16 + 4 * g + q4, 2 * ct + (p4 >> 1)) + 8 * (p4 & 1)));
                const bf16x8 va = __builtin_shufflevector(vlo, vhi, 0, 1, 2, 3, 4, 5, 6, 7);
                o[ct] = __builtin_amdgcn_mfma_f32_16x16x32_bf16(va, pb, o[ct], 0, 0, 0);
            }
            LDS_WAIT();
        }
        SW_STOP(14); SW_START(16);
#undef ATT_ISSUE
        float lt = l_run + lane_xor<16>(l_run); lt += lane_xor<32>(lt);
        const float inv = 1.0f / lt;
        if (hd < 8 && ((MODE & 8) || lt == 12345.678f)) {
#pragma unroll
            for (int ct = 0; ct < 8; ++ct) { const f32x4 v = o[ct] * inv; u32x2 w; w.x = cvt_pk_bf16(v.x, v.y); w.y = cvt_pk_bf16(v.z, v.w);
                *(u32x2*)(MC + t * KMIX + 256 + hd * 128 + 16 * ct + 4 * g) = w; }
        }
        SW_STOP(16); SW_START(15);
        if (cxv) cx_finish(p, cit, lane, tv, (LAS float*)tile);
        SW_STOP(15);
        ++cxq;
    }
#undef ATT_PREFETCH
    for (; (MODE & 8) && c.gw + c.NGW * cxq < 3 * 8192; ++cxq) { float tv[32]; const int cit = c.gw + c.NGW * cxq; cx_issue(p, l, cit, lane, tv); cx_finish(p, cit, lane, tv, (LAS float*)tile); }
}

#ifndef RT_NT
#define RT_NT 2
#endif
__device__ __forceinline__ void ph_router(const Params& p, const Ctx& c, int l) {
    const float* mod = (const float*)(p.ws + WS_MOD); bf16_t* H = (bf16_t*)(p.ws + WS_H);
    int* toke = (int*)(p.ws + WS_SMALL + SM_TOKE); int* rank = (int*)(p.ws + WS_SMALL + SM_RANK);
    LAS int* le = (LAS int*)(c.lds + RT_LE_OFF); LAS int* wcnt = le + 256; LAS float* lg = (LAS float*)(wcnt + 192);
    const int lane = c.lane;
    SW_START(30);
    {
        const f32x4* srcE = (const f32x4*)(p.ws + WS_SMALL + SM_REW2) + (size_t)l * 8192; const f32x4* srcG = (const f32x4*)(p.ws + WS_SMALL + SM_RGW2) + (size_t)l * 1024;
        LAS f32x4* dE = (LAS f32x4*)c.lds; LAS f32x4* dG = (LAS f32x4*)(c.lds + RT_RG_OFF);
#pragma unroll
        for (int hb = 0; hb < 2; ++hb) { f32x4 t[8];
#pragma unroll
            for (int q = 0; q < 8; ++q) t[q] = srcE[c.tid + 512 * (8 * hb + q)];
#pragma unroll
            for (int q = 0; q < 8; ++q) dE[c.tid + 512 * (8 * hb + q)] = t[q]; }
        { const f32x4 t0 = srcG[c.tid], t1 = srcG[c.tid + 512]; dG[c.tid] = t0; dG[c.tid + 512] = t1; }
        __syncthreads();
    }
    SW_STOP(30);
    for (int tile = c.vcu; tile < 256; tile += c.G) {
        SW_START(31);
        constexpr int NT = RT_NT;
        const int b = (tile * 128) >> 11;
        const f32x4* ng = (const f32x4*)(p.in[I_N2G] + l * D) + lane;
        const f32x4* sh = (const f32x4*)(mod + (size_t)(l * NB + b) * 6144 + 3072) + lane; const f32x4* sc = (const f32x4*)(mod + (size_t)(l * NB + b) * 6144 + 4096) + lane;
        const LAS f32x4* rg = (const LAS f32x4*)(c.lds + RT_RG_OFF) + lane;
        f32x4 gm[4], sv[4];
#pragma unroll
        for (int j = 0; j < 4; ++j) { gm[j] = ng[64 * j] * (sc[64 * j] + 1.0f); sv[j] = sh[64 * j]; }
        f32x4 v[NT][4]; u32x2 vn[NT][4];
#pragma unroll
        for (int t = 0; t < NT; ++t)
#pragma unroll
            for (int j = 0; j < 4; ++j) vn[t][j] = ((const u32x2*)((const bf16_t*)(p.ws + WS_X16) + (size_t)(tile * 128 + c.wave * 16 + t) * D) + lane)[64 * j];
        for (int i = 0; i < 16; i += NT) {
            const int tl0 = c.wave * 16 + i, m0 = tile * 128 + tl0;
            float ss[NT], r[NT], gl[NT][4];
#pragma unroll
            for (int t = 0; t < NT; ++t) { ss[t] = 0.f;
#pragma unroll
                for (int j = 0; j < 4; ++j) { v[t][j] = (f32x4){bflo(vn[t][j].x), bfhi(vn[t][j].x), bflo(vn[t][j].y), bfhi(vn[t][j].y)}; ss[t] += (v[t][j].x * v[t][j].x + v[t][j].y * v[t][j].y) + (v[t][j].z * v[t][j].z + v[t][j].w * v[t][j].w); } }
            if (i + NT < 16) {
#pragma unroll
                for (int t = 0; t < NT; ++t)
#pragma unroll
                    for (int j = 0; j < 4; ++j) vn[t][j] = ((const u32x2*)((const bf16_t*)(p.ws + WS_X16) + (size_t)(m0 + NT + t) * D) + lane)[64 * j]; }
#pragma unroll
            for (int t = 0; t < NT; ++t) ss[t] = wave_sum(ss[t]);
            f32x2 gl2[NT][2];
#pragma unroll
            for (int t = 0; t < NT; ++t) { r[t] = 1.0f / sqrtf(ss[t] * (1.0f / D) + EPS); gl2[t][0] = gl2[t][1] = (f32x2){0.f, 0.f}; }
#pragma unroll
            for (int j = 0; j < 4; ++j) {
#pragma unroll
                for (int t = 0; t < NT; ++t) { v[t][j] = v[t][j] * r[t] * gm[j] + sv[j];
                    u32x2 w; w.x = cvt_pk_bf16(v[t][j].x, v[t][j].y); w.y = cvt_pk_bf16(v[t][j].z, v[t][j].w); ((u32x2*)(H + (size_t)(m0 + t) * D) + lane)[64 * j] = w; }
#pragma unroll
                for (int e = 0; e < 4; ++e) { const f32x4 wr = rg[(j * 4 + e) * 64];
#pragma unroll
                    for (int t = 0; t < NT; ++t) { const f32x2 hv2 = {v[t][j][e], v[t][j][e]}; gl2[t][0] = __builtin_elementwise_fma(hv2, (f32x2){wr.x, wr.y}, gl2[t][0]); gl2[t][1] = __builtin_elementwise_fma(hv2, (f32x2){wr.z, wr.w}, gl2[t][1]); } } }
#pragma unroll
            for (int t = 0; t < NT; ++t) { gl[t][0] = gl2[t][0].x; gl[t][1] = gl2[t][0].y; gl[t][2] = gl2[t][1].x; gl[t][3] = gl2[t][1].y; }
            const bool h32 = lane & 32, h16 = lane & 16, h8 = lane & 8;
            float dg[NT];
#pragma unroll
            for (int t = 0; t < NT; ++t) {
                const float c0 = (h16 ? gl[t][2] : gl[t][0]) + lane_xor<16>(h16 ? gl[t][0] : gl[t][2]), c1 = (h16 ? gl[t][3] : gl[t][1]) + lane_xor<16>(h16 ? gl[t][1] : gl[t][3]);
                float d = (h8 ? c1 : c0) + lane_xor<8>(h8 ? c0 : c1);
                d += lane_xor<4>(d); d += lane_xor<2>(d); d += lane_xor<1>(d); d += lane_xor<32>(d); dg[t] = d; }
            int gi[NT]; float gp[NT];
#pragma unroll
            for (int t = 0; t < NT; ++t) { float gq[4]; int g_ = 0; float gmax = -INFINITY;
#pragma unroll
                for (int q = 0; q < 4; ++q) { gq[q] = __shfl(dg[t], 8 * (q & 1) + 16 * (q >> 1)) + p.in[I_RGB][l * 4 + q]; if (gq[q] > gmax) { gmax = gq[q]; g_ = q; } }
                float gden = 0.f;
#pragma unroll
                for (int q = 0; q < 4; ++q) gden += __expf(gq[q] - gmax);
                gp[t] = 1.0f / gden; gi[t] = __builtin_amdgcn_readfirstlane(g_); }
            float el[NT][8]; f32x2 el2[NT][4];
#pragma unroll
            for (int t = 0; t < NT; ++t)
#pragma unroll
                for (int q = 0; q < 4; ++q) el2[t][q] = (f32x2){0.f, 0.f};
#pragma unroll
            for (int j = 0; j < 4; ++j)
#pragma unroll
                for (int e = 0; e < 4; ++e)
#pragma unroll
                    for (int t = 0; t < NT; ++t) { const LAS f32x4* rr = (const LAS f32x4*)c.lds + gi[t] * 2048 + (j * 4 + e) * 128 + lane;
                        const f32x4 w0 = rr[0], w1 = rr[64]; const float hv = v[t][j][e];
                        const f32x2 hv2 = {hv, hv}; el2[t][0] = __builtin_elementwise_fma(hv2, (f32x2){w0.x, w0.y}, el2[t][0]); el2[t][1] = __builtin_elementwise_fma(hv2, (f32x2){w0.z, w0.w}, el2[t][1]);
                        el2[t][2] = __builtin_elementwise_fma(hv2, (f32x2){w1.x, w1.y}, el2[t][2]); el2[t][3] = __builtin_elementwise_fma(hv2, (f32x2){w1.z, w1.w}, el2[t][3]); }
#pragma unroll
            for (int t = 0; t < NT; ++t)
#pragma unroll
                for (int q = 0; q < 4; ++q) { el[t][2 * q] = el2[t][q].x; el[t][2 * q + 1] = el2[t][q].y; }
            float de[NT];
#pragma unroll
            for (int t = 0; t < NT; ++t) {
                const float b0 = (h32 ? el[t][4] : el[t][0]) + lane_xor<32>(h32 ? el[t][0] : el[t][4]), b1 = (h32 ? el[t][5] : el[t][1]) + lane_xor<32>(h32 ? el[t][1] : el[t][5]);
                const float b2 = (h32 ? el[t][6] : el[t][2]) + lane_xor<32>(h32 ? el[t][2] : el[t][6]), b3 = (h32 ? el[t][7] : el[t][3]) + lane_xor<32>(h32 ? el[t][3] : el[t][7]);
                const float c0 = (h16 ? b2 : b0) + lane_xor<16>(h16 ? b0 : b2), c1 = (h16 ? b3 : b1) + lane_xor<16>(h16 ? b1 : b3);
                float d = (h8 ? c1 : c0) + lane_xor<8>(h8 ? c0 : c1);
                d += lane_xor<4>(d); d += lane_xor<2>(d); d += lane_xor<1>(d); de[t] = d; }
#pragma unroll
            for (int t = 0; t < NT; ++t) { float eq[8]; int e0 = 0, e1 = 0; float mx0 = -INFINITY, mx1 = -INFINITY;
#pragma unroll
                for (int q = 0; q < 8; ++q) { eq[q] = __shfl(de[t], 8 * (q & 1) + 16 * ((q >> 1) & 1) + 32 * (q >> 2)) + p.in[I_REB][l * 32 + gi[t] * 8 + q];
                    if (eq[q] > mx0) { mx1 = mx0; e1 = e0; mx0 = eq[q]; e0 = q; } else if (eq[q] > mx1) { mx1 = eq[q]; e1 = q; } }
                const float x1 = __expf(mx1 - mx0), den = 1.0f + x1; const int tl = tl0 + t, m = m0 + t;
                if (lane == 0) { le[2 * tl] = gi[t] * 8 + e0; le[2 * tl + 1] = gi[t] * 8 + e1; toke[2 * m] = gi[t] * 8 + e0; toke[2 * m + 1] = gi[t] * 8 + e1; lg[2 * tl] = gp[t] / den; lg[2 * tl + 1] = gp[t] * x1 / den; } }
        }
        SW_STOP(31);
        __syncthreads();
        SW_START(32);
        int myrank = 0, mye = 0;
        if (c.tid < 256) { mye = le[c.tid]; const unsigned long long ltmask = (1ull << lane) - 1ull;
            for (int ee = 0; ee < 32; ++ee) { const unsigned long long m = __ballot(mye == ee); if (mye == ee) myrank = __builtin_popcountll(m & ltmask); if (lane == 0) wcnt[c.wave * 32 + ee] = __builtin_popcountll(m); } }
        __syncthreads();
        LAS int* ebase = wcnt + 128;
        if (c.tid < 32) { const int tc = wcnt[c.tid] + wcnt[32 + c.tid] + wcnt[64 + c.tid] + wcnt[96 + c.tid];
            ebase[c.tid] = (int)__hip_atomic_fetch_add((unsigned*)(p.ws + WS_CTL) + CW_ECUR + 64 * l + c.tid, (unsigned)tc, __ATOMIC_RELAXED, __HIP_MEMORY_SCOPE_AGENT); }
        __syncthreads();
        if (c.tid < 256) { for (int w = 0; w < c.wave; ++w) myrank += wcnt[w * 32 + mye];
            const int pos = ebase[mye] + myrank; rank[tile * 256 + c.tid] = pos;
            u32x2 ent; ent.x = (unsigned)(tile * 128 + (c.tid >> 1)); ent.y = __float_as_uint(lg[c.tid]);
            ((u32x2*)(p.ws + WS_ELIST))[(size_t)mye * (2 * T) + pos] = ent; }
        __syncthreads();
        SW_STOP(32);
    }
}

__device__ __forceinline__ int moe_tables(const Params& p, const Ctx& c, int l, bool rows, LAS int* lds_tab) {
    LAS int* pst = lds_tab + pg8::MoeOrder::MAXU * 256 + 64; LAS int* cntE = pst + 40;
    if (c.tid < 32) cntE[c.tid] = (int)__hip_atomic_load((unsigned*)(p.ws + WS_CTL) + CW_ECUR + 64 * l + c.tid, __ATOMIC_RELAXED, __HIP_MEMORY_SCOPE_AGENT);
    __syncthreads();
    if (c.tid == 0) { int a = 0; for (int e = 0; e < 32; ++e) { pst[e] = a; a += ((cntE[e] + 255) >> 8) << 8; } pst[32] = a; }
    __syncthreads();
    const int ntl = pst[32] >> 8;
    if (rows) { const int* toke = (const int*)(p.ws + WS_SMALL + SM_TOKE); const int* tpos = (const int*)(p.ws + WS_SMALL + SM_RANK); int* tslot = (int*)(p.ws + WS_SMALL + SM_TSLOT);
        for (int tile = c.vcu; tile < 256; tile += c.G) if (c.tid < 256) { const int a = tile * 256 + c.tid; tslot[a] = pst[toke[a]] + tpos[a]; } }
    float* sgate = (float*)(p.ws + WS_SMALL + SM_SGATE);
    for (int i = 0; i < pg8::MoeOrder::MAXU; ++i) { const int L = i * c.G + c.vcu; if (L >= ntl * 4) break; const int tile = L >> 2;
        int e = 0; while (pst[e + 1] <= (tile << 8)) ++e;
        if (c.tid == 0) lds_tab[pg8::MoeOrder::MAXU * 256 + i] = e;
        if (rows && c.tid < 256) { const int q = (tile << 8) - pst[e] + c.tid; u32x2 ent = {0u, 0u};
            if (q < cntE[e]) ent = ((const u32x2*)(p.ws + WS_ELIST))[(size_t)e * (2 * T) + q];
            lds_tab[i * 256 + c.tid] = (int)ent.x; sgate[(tile << 8) + c.tid] = __uint_as_float(ent.y); } }
    __syncthreads();
    return ntl;
}

#ifndef PH_ONLY
#define PH_ONLY -1
#endif
#define IN(k) ((PH_ONLY < 0 || PH_ONLY == (k)) && lo <= (k) && (k) < hi)
#define SEAM(k) do { if (IN(k) && IN((k) + 1)) xcd_barrier(bar); } while (0)
#ifndef REP_MASK
#define REP_MASK 0
#endif
#define REP(id) (((REP_MASK) >> (id)) & 1)
#define BODY(id, cond, ...) do { __VA_ARGS__ if (REP(id) && (cond)) { xcd_barrier(bar); __VA_ARGS__ } } while (0)
template <int l>
__device__ __forceinline__ void run_layer(const Params& p, const Ctx& c, const XcdBarrier& bar, int lo, int hi) {
    bf16_t* Zb = (bf16_t*)(p.ws + WS_Z); bf16_t* Hb = (bf16_t*)(p.ws + WS_H); bf16_t* MCb = (bf16_t*)p.out;
    const float* mod = (const float*)(p.ws + WS_MOD);
    constexpr int P = 1 + 10 * l;
    if (IN(P)) { if (l == 0) { BODY(1, true, ph_norm1<0>(p, c);); } else { ph_norm1<1>(p, c); } }
    SEAM(P);
    if (IN(P + 1)) { BODY(2, true, { pg8::StaticOrder So; So.init(Hb, (bf16_t*)(p.ws + WS_WIN) + (size_t)l * NZ * D, T, NZ, D, c.G, (int)blockIdx.x);
        pg8::EpiBf16 E{Zb, NZ}; pg8::gemm_phase<pg8::EpiBf16, pg8::StaticOrder, false>(c.lds, So, E); });
        if (l == 0) { constexpr int NU = (T / 256) * (NZ / 256); const int rem = NU % c.G;
            if (rem == 0) ph_prologue_rest(p, c, c.gw, c.NGW); else if ((int)blockIdx.x >= rem) ph_prologue_rest(p, c, ((int)blockIdx.x - rem) * 8 + c.wave, (c.G - rem) * 8); } }
    SEAM(P + 1);
    if (IN(P + 2)) { BODY(3, true, ph_postz(p, c, l);); }
    SEAM(P + 2);
    if (IN(P + 3)) { BODY(4, true, { pg8::StaticOrder So; So.init((bf16_t*)(p.ws + WS_CQR), (bf16_t*)(p.ws + WS_WQA) + (size_t)l * D * 256, T, D, 256, c.G, (int)blockIdx.x);
        pg8::EpiBf16 E{Hb, D}; pg8::gemm_phase<pg8::EpiBf16, pg8::StaticOrder, false>(c.lds, So, E); });
        BODY(5, true, ph_scores(p, c);); }
    SEAM(P + 3);
#ifndef ATT_PROBE
#define ATT_PROBE 0
#endif
    if (IN(P + 4)) { ph_attn<15>(p, c, l); if (ATT_PROBE) { xcd_barrier(bar); ph_attn<ATT_PROBE>(p, c, l); } }
    SEAM(P + 4);
    if (IN(P + 5)) { BODY(7, l == 0, { pg8::StaticOrder So; So.init(MCb, (bf16_t*)(p.ws + WS_WMIX) + (size_t)l * D * KMIX, T, D, KMIX, c.G, (int)blockIdx.x);
        pg8::EpiMix<l == 0> E{l == 0 ? p.in[I_X] : nullptr, (bf16_t*)(p.ws + WS_X16), mod + (size_t)l * NB * 6144 + 2048}; pg8::gemm_phase<pg8::EpiMix<l == 0>, pg8::StaticOrder, false>(c.lds, So, E); }); }
    SEAM(P + 5);
    if (IN(P + 6)) { BODY(8, true, ph_router(p, c, l);); }
    SEAM(P + 6);
    if (IN(P + 8)) { const int ntl = moe_tables(p, c, l, true, (LAS int*)(c.lds + MOE_TAB_OFF));
        pg8::MoeOrder Mo; Mo.init(Hb, p.ws + WS_W13, D, (size_t)1024 * 1024 * 2, true, ntl, c.G, c.vcu, (LAS int*)(c.lds + MOE_TAB_OFF));
        pg8::EpiAct E{Zb}; pg8::gemm_phase<pg8::EpiAct, pg8::MoeOrder, true>(c.lds, Mo, E); }
    SEAM(P + 8);
    if (IN(P + 9)) { const int ntl = moe_tables(p, c, l, false, (LAS int*)(c.lds + MOE_TAB_OFF));
        pg8::MoeOrder Mo; Mo.init(Zb, p.ws + WS_W2, DEXP, (size_t)1024 * 512 * 2, false, ntl, c.G, c.vcu, (LAS int*)(c.lds + MOE_TAB_OFF));
        pg8::EpiY E{(bf16_t*)(p.ws + WS_Y), (const float*)(p.ws + WS_SMALL + SM_SGATE)}; pg8::gemm_phase<pg8::EpiY, pg8::MoeOrder, false>(c.lds, Mo, E); }
    SEAM(P + 9);
}

__global__ void __launch_bounds__(512, 2) fwd(Params p) {
    extern __shared__ __attribute__((aligned(16))) unsigned char lds_raw[];
    Ctx c;
    c.lds = (LAS unsigned char*)lds_raw;
    c.tid = threadIdx.x; c.lane = c.tid & 63; c.wave = __builtin_amdgcn_readfirstlane(c.tid >> 6);
    c.G = gridDim.x; { const int bx = blockIdx.x; c.vcu = (c.G % 8 == 0) ? (bx % 8) * (c.G / 8) + bx / 8 : bx; }
    c.gw = c.vcu * 8 + c.wave; c.NGW = c.G * 8; c.sw_t0 = 0ull; c.sw_sum = 0ull;
    volatile LAS unsigned* MISC = (volatile LAS unsigned*)(c.lds + MISC_OFF);
    if (c.tid < 64) MISC[c.tid] = 0u;
    __syncthreads();
    unsigned* ctl = (unsigned*)(p.ws + WS_CTL);
    XcdBarrier bar; bar.bar = ctl + CW_BAR; bar.x = 0; bar.st = nullptr;
    const bool multi = (p.ph_hi - p.ph_lo) > 1;
    if (multi) bar = xcd_barrier_post(ctl + CW_BAR, MISC + 8);
    const int lo = p.ph_lo, hi = p.ph_hi;
    if (IN(0)) { BODY(0, true, ph_prologue(p, c);); }
    SEAM(0);
    run_layer<0>(p, c, bar, lo, hi);
    run_layer<1>(p, c, bar, lo, hi);
    if (IN(21)) ph_norm1<2>(p, c);
    if (SW_ID) { const unsigned long long t0 = __builtin_amdgcn_s_memrealtime(); while (__builtin_amdgcn_s_memrealtime() - t0 < 8ull * c.sw_sum) __builtin_amdgcn_s_sleep(8); }
#undef IN
#undef SEAM
}

extern "C" void kernel_launch(void* const* d_in, const int* in_sizes, int n_in, void* d_out, int out_size, void* d_ws, size_t ws_size, hipStream_t stream) {
    static int grid = 0;
    if (grid == 0) {
        if (n_in != 27 || out_size != T * D || ws_size < WS_END) { fprintf(stderr, "kernel_launch: unexpected shapes (n_in %d out %d ws %zu, need %zu)\n", n_in, out_size, ws_size, (size_t)WS_END); grid = -1; return; }
        int dev = 0, cus = 0, per_cu = 0;
        if (hipGetDevice(&dev) != hipSuccess || hipDeviceGetAttribute(&cus, hipDeviceAttributeMultiprocessorCount, dev) != hipSuccess) { grid = -1; return; }
        if (hipFuncSetAttribute((const void*)fwd, hipFuncAttributeMaxDynamicSharedMemorySize, LDS_BYTES) != hipSuccess) { fprintf(stderr, "kernel_launch: hipFuncSetAttribute failed\n"); grid = -1; return; }
        if (hipOccupancyMaxActiveBlocksPerMultiprocessor(&per_cu, (const void*)fwd, 512, LDS_BYTES) != hipSuccess || per_cu < 1) { fprintf(stderr, "kernel_launch: occupancy query says %d blocks per CU\n", per_cu); grid = -1; return; }
        (void)hipGetLastError();
        grid = cus >= 256 ? 256 : (cus >= 128 ? 128 : 0);
        if (grid == 0) { fprintf(stderr, "kernel_launch: %d CUs: this kernel needs at least 128\n", cus); grid = -1; return; }
    }
    if (grid <= 0) return;
    (void)hipMemsetAsync((char*)d_ws + WS_CTL, 0, CTL_ZERO_BYTES, stream);
    Params p{};
    for (int i = 0; i < 27; ++i) p.in[i] = (const float*)d_in[i];
    p.out = (float*)d_out; p.ws = (unsigned char*)d_ws;
#if MK_SPLIT
    for (int ph = 0; ph < NPHASE; ++ph) { p.ph_lo = ph; p.ph_hi = ph + 1; hipLaunchKernelGGL(fwd, dim3(grid), dim3(512), LDS_BYTES, stream, p); }
#else
    p.ph_lo = 0; p.ph_hi = NPHASE;
    hipLaunchKernelGGL(fwd, dim3(grid), dim3(512), LDS_BYTES, stream, p);
#endif
}
```

```cpp
#include <hip/hip_runtime.h>
#include <cstdio>
#include <cstdint>

#ifndef MK_SPLIT
#define MK_SPLIT 0
#endif

#define LAS __attribute__((address_space(3)))
typedef unsigned short bf16_t;
typedef short bf16x8 __attribute__((ext_vector_type(8)));
typedef short bf16x4 __attribute__((ext_vector_type(4)));
typedef float f32x4 __attribute__((ext_vector_type(4)));
typedef float f32x2 __attribute__((ext_vector_type(2)));
typedef float f32x16 __attribute__((ext_vector_type(16)));
typedef unsigned u32x4 __attribute__((ext_vector_type(4)));
typedef unsigned u32x2 __attribute__((ext_vector_type(2)));

constexpr int D = 1024, NB = 16, S = 2048, T = NB * S, DEPTH = 2;
constexpr int NZ = 1792;
constexpr int N_IN = 1736;
constexpr int Z_AVAL = 0, Z_AGATE = 256, Z_CQ = 512, Z_CKV = 768, Z_QI = 896, Z_KI = 1408, Z_WI = 1472, Z_UP = 1480;
constexpr int KMIX = 1536;
constexpr int NEXP = 32, DEXP = 512, MAXTILES = 288, PMAX = MAXTILES * 256;
constexpr float EPS = 1e-6f;
constexpr int SC_PER_B = 4096 * 528;

constexpr size_t MiB = 1u << 20;
constexpr size_t WS_CTL = 0, CTL_ZERO_BYTES = 64 * 1024;
constexpr size_t WS_MOD = 1 * MiB;
constexpr size_t WS_WIN = 2 * MiB;
constexpr size_t WS_WQA = 9 * MiB;
constexpr size_t WS_WMIX = 10 * MiB;
constexpr size_t WS_SMALL = 16 * MiB;
constexpr size_t WS_W13 = 20 * MiB;
constexpr size_t WS_W2 = 84 * MiB;
constexpr size_t WS_Z = 116 * MiB;
constexpr size_t WS_X16 = 228 * MiB;
constexpr size_t WS_H = 324 * MiB;
constexpr size_t WS_CQR = 388 * MiB;
constexpr size_t WS_KVN = 404 * MiB;
constexpr size_t WS_Y = 412 * MiB;
constexpr size_t WS_ELIST = 556 * MiB;
constexpr size_t WS_END = 572 * MiB;
constexpr size_t SM_TOKE = 0;
constexpr size_t SM_TOKG = 256 * 1024;
constexpr size_t SM_RANK = 512 * 1024;
constexpr size_t SM_TSLOT = 768 * 1024;
constexpr size_t SM_STOK = 1024 * 1024;
constexpr size_t SM_SGATE = 1024 * 1024 + 512 * 1024;
constexpr size_t SM_CNT = 2 * 1024 * 1024;
constexpr size_t SM_TEXP = 2 * 1024 * 1024 + 64 * 1024;
constexpr size_t SM_REW2 = 2 * 1024 * 1024 + 512 * 1024;
constexpr size_t SM_PWT = 3 * 1024 * 1024 + 64 * 1024;
constexpr size_t SM_WRT = 3 * 1024 * 1024 + 512 * 1024;
constexpr size_t SM_RGW2 = 3 * 1024 * 1024;
constexpr int CW_BAR = 1024;
constexpr int CW_ARR = 12288;
constexpr int CW_ECUR = 8192;

constexpr int LDS_BYTES = 155648;
constexpr int LIST_OFF = 131072;
constexpr int MISC_OFF = 154624;
constexpr int MOE_TAB_OFF = 131072;
constexpr int RT_RG_OFF = 131072, RT_LE_OFF = 147456;
constexpr int NPHASE = 22;

__device__ __forceinline__ unsigned cvt_pk_bf16(float lo, float hi) { unsigned r; asm volatile("v_cvt_pk_bf16_f32 %0, %1, %2" : "=v"(r) : "v"(lo), "v"(hi)); return r; }
__device__ __forceinline__ float bf2f(unsigned short b) { return __uint_as_float(((unsigned)b) << 16); }
__device__ __forceinline__ float bflo(unsigned w) { return __uint_as_float(w << 16); }
__device__ __forceinline__ float bfhi(unsigned w) { return __uint_as_float(w & 0xffff0000u); }
template <int W> __device__ __forceinline__ int lane_xor_i(int iv) {
    int r;
    if constexpr (W == 1) r = __builtin_amdgcn_mov_dpp(iv, 0xB1, 0xF, 0xF, true);
    else if constexpr (W == 2) r = __builtin_amdgcn_mov_dpp(iv, 0x4E, 0xF, 0xF, true);
    else if constexpr (W == 4) { r = __builtin_amdgcn_update_dpp(iv, iv, 0x104, 0xF, 0x5, false);
                                 r = __builtin_amdgcn_update_dpp(r, iv, 0x114, 0xF, 0xA, false); }
    else if constexpr (W == 8) r = __builtin_amdgcn_mov_dpp(iv, 0x128, 0xF, 0xF, true);
    else if constexpr (W == 16) { const auto p = __builtin_amdgcn_permlane16_swap((unsigned)iv, (unsigned)iv, false, false); r = (threadIdx.x & 16) ? (int)p[0] : (int)p[1]; }
    else { const auto p = __builtin_amdgcn_permlane32_swap((unsigned)iv, (unsigned)iv, false, false); r = (threadIdx.x & 32) ? (int)p[0] : (int)p[1]; }
    return r;
}
template <int W> __device__ __forceinline__ float lane_xor(float v) { return __builtin_bit_cast(float, lane_xor_i<W>(__builtin_bit_cast(int, v))); }
template <int W> __device__ __forceinline__ unsigned lane_xor(unsigned v) { return (unsigned)lane_xor_i<W>((int)v); }
__device__ __forceinline__ float wave_sum(float v) {
    v += lane_xor<1>(v); v += lane_xor<2>(v); v += lane_xor<4>(v); v += lane_xor<8>(v); v += lane_xor<16>(v); v += lane_xor<32>(v);
    return v;
}
__device__ __forceinline__ float sigmoidf_(float x) { return __builtin_amdgcn_rcpf(1.0f + __builtin_amdgcn_exp2f(-1.44269504089f * x)); }
#define LDS_WAIT() asm volatile("s_waitcnt lgkmcnt(0)" ::: "memory")
#define VM_WAIT() asm volatile("s_waitcnt vmcnt(0)" ::: "memory")

#define XB_TMO      128
#define XB_XCNT(j)  (256  + 64 * (j))
#define XB_XSUB(j)  (1280 + 64 * (j))
#define XB_XGEN(j)  (2304 + 64 * (j))
#define XB_TOP      3328
#define XB_TOPGEN   3392
#define XCD_BAR_WORDS 3456
#define XB_SPIN_CAP (1u << 22)

__device__ __forceinline__ unsigned xb_ld(unsigned* p)              { return __hip_atomic_load(p, __ATOMIC_RELAXED, __HIP_MEMORY_SCOPE_AGENT); }
__device__ __forceinline__ unsigned xb_add(unsigned* p, unsigned v) { return __hip_atomic_fetch_add(p, v, __ATOMIC_RELAXED, __HIP_MEMORY_SCOPE_AGENT); }
__device__ __forceinline__ unsigned xb_xcc_id() { return (unsigned)__builtin_amdgcn_s_getreg((3 << 11) | 20) & 0xFu; }
#define XB_SPIN(cond, bar) do { unsigned _sp = 0; while (cond) { __builtin_amdgcn_s_sleep(1); \
    if ((++_sp & 255u) == 0u) { if (xb_ld(&(bar)[XB_TMO])) break; if (_sp > XB_SPIN_CAP) { atomicAdd(&(bar)[XB_TMO], 1u); break; } } } } while (0)

struct XcdBarrier {
    unsigned* bar; unsigned x;
    volatile LAS unsigned* st;
};
__device__ __forceinline__ XcdBarrier xcd_barrier_post(unsigned* bar, volatile LAS unsigned* st) {
    XcdBarrier b; b.bar = bar; b.x = xb_xcc_id(); b.st = st;
    if (threadIdx.x == 0) (void)xb_add(&bar[XB_XCNT(b.x)], 1u);
    return b;
}
__device__ __forceinline__ void xcd_barrier_complete(unsigned* bar, unsigned x, unsigned& nloc, unsigned& nx) {
    const unsigned G = gridDim.x * gridDim.y * gridDim.z;
    unsigned sum, cnt, mine, sp = 0u;
    for (;;) {
        sum = 0u; cnt = 0u; mine = 0u;
#pragma unroll
        for (unsigned j = 0; j < 16; ++j) { const unsigned c = xb_ld(&bar[XB_XCNT(j)]); sum += c; cnt += (c > 0u) ? 1u : 0u; mine = (j == x) ? c : mine; }
        if (sum == G) break;
        __builtin_amdgcn_s_sleep(1);
        if ((++sp & 255u) == 0u) { if (xb_ld(&bar[XB_TMO])) break; if (sp > XB_SPIN_CAP) { atomicAdd(&bar[XB_TMO], 1u); break; } }
    }
    nloc = mine > 0u ? mine : 1u; nx = cnt > 0u ? cnt : 1u;
}
__device__ __forceinline__ void xcd_barrier(const XcdBarrier& b) {
    asm volatile("s_waitcnt vmcnt(0)" ::: "memory");
    __syncthreads();
    if (threadIdx.x == 0) {
        unsigned* bar = b.bar;
        __builtin_amdgcn_s_waitcnt(0);
        unsigned nloc = b.st[0], nx = b.st[1];
        if (nloc == 0u) { xcd_barrier_complete(bar, b.x, nloc, nx); b.st[0] = nloc; b.st[1] = nx; }
        const unsigned old = xb_add(&bar[XB_XSUB(b.x)], 1u);
        const unsigned gen = old / nloc;
        if (old + 1u == (gen + 1u) * nloc) {
            __builtin_amdgcn_fence(__ATOMIC_RELEASE, "agent");
            asm volatile("s_waitcnt vmcnt(0)" ::: "memory");
            const unsigned og = xb_add(&bar[XB_TOP], 1u);
            const unsigned tg = og / nx;
            if (og + 1u == (tg + 1u) * nx) xb_add(&bar[XB_TOPGEN], 1u);
            else XB_SPIN(xb_ld(&bar[XB_TOPGEN]) == tg, bar);
            __builtin_amdgcn_fence(__ATOMIC_ACQUIRE, "agent");
            xb_add(&bar[XB_XGEN(b.x)], 1u);
            asm volatile("s_waitcnt vmcnt(0)" ::: "memory");
        } else {
            XB_SPIN(xb_ld(&bar[XB_XGEN(b.x)]) == gen, bar);
            __builtin_amdgcn_fence(__ATOMIC_ACQUIRE, "agent");
            asm volatile("s_waitcnt vmcnt(0)" ::: "memory");
        }
    }
    __syncthreads();
}

namespace pg8 {
constexpr int BM = 256, BK = 64, HALF = 128, HTB = HALF * BK * 2  , STAGE_BYTES = 8 * HTB, NXCD = 8, WGM = 8;
__host__ __device__ __forceinline__ int lds_byte(int r, int c) { const int st = (r >> 4) * 2 + (c >> 5), rr = r & 15, cc = c & 31, ob = rr * 64 + cc * 2; return st * 1024 + (ob ^ (((ob >> 9) & 1) << 5)); }
__host__ __device__ __forceinline__ void stage_rc(int b, int& R, int& C) { const int st = b / 1024, sb = b % 1024, swz = sb ^ (((sb >> 9) & 1) << 5); R = (st >> 1) * 16 + swz / 64; C = (st & 1) * 32 + (swz % 64) / 2; }
__host__ __device__ __forceinline__ int perm32(int rho) { const int n = rho >> 4, i = rho & 15; return 8 * (i >> 2) + 4 * n + (i & 3); }

struct Unit { int pm, pn; const char* a; const char* b; };

struct StaticOrder {
    const char* A; const char* Bt; int K;
    int nM, nN, nwg, G, c;
    __device__ void init(const void* A_, const void* Bt_, int M, int N, int K_, int G_, int c_) { A = (const char*)A_; Bt = (const char*)Bt_; K = K_; nM = M / BM; nN = N / BM; nwg = nM * nN; G = G_; c = c_; }
    __device__ __forceinline__ bool next(int i, Unit& u) const {
        const long L = (long)i * G + c; if (L >= nwg) return false;
        int wgid = (int)L; { const int q = nwg / NXCD, r = nwg % NXCD, xcd = wgid % NXCD, off = wgid / NXCD; wgid = (xcd < r ? xcd * (q + 1) : r * (q + 1) + (xcd - r) * q) + off; }
        const int nig = WGM * nN, gid = wgid / nig, fm = gid * WGM, gsz = (nM - fm) < WGM ? (nM - fm) : WGM;
        u.pm = fm + ((wgid % nig) % gsz); u.pn = (wgid % nig) / gsz;
        u.a = A + (size_t)u.pm * BM * K * 2; u.b = Bt + (size_t)u.pn * BM * K * 2; return true;
    }
    __device__ __forceinline__ int row(int, int) const { return 0; }
};
struct MoeOrder {
    const char* A; const char* Bt; int K; const LAS int* rowtab;
    const LAS int* etab; int nunits, G, c, off; size_t bstride;
    static constexpr int MAXU = 12;
    __device__ __forceinline__ void init(const void* A_, const void* Bt_, int K_, size_t bstride_, bool gather, int ntiles, int G_, int c_, LAS int* lds_tab, int off_ = 0, int slot0 = 0) {
        A = (const char*)A_; Bt = (const char*)Bt_; K = K_; bstride = bstride_; nunits = ntiles * 4; G = G_; c = c_; off = off_;
        rowtab = gather ? lds_tab + slot0 * 256 : nullptr; etab = lds_tab + MAXU * 256 + slot0;
    }
    __device__ __forceinline__ bool next(int i, Unit& u) const {
        const int L = i * G + c + off; if (L >= nunits || i >= MAXU) return false;
        u.pm = L >> 2; u.pn = L & 3; const int e = __builtin_amdgcn_readfirstlane(etab[i]);
        u.a = A + (size_t)u.pm * BM * K * 2; u.b = Bt + (size_t)e * bstride + (size_t)u.pn * BM * K * 2; return true;
    }
    __device__ __forceinline__ int row(int i, int r) const { return rowtab[i * 256 + r]; }
};
struct NoGather { };
struct EpiBf16 {
    static constexpr bool PERM = true;
    bf16_t* O; int ldc;
    __device__ __forceinline__ void operator()(const f32x4 (&acc)[2][2][4][2], const Unit& u, int wr, int wc, int fr, int fq) const {
        const int row0 = u.pm * BM + wr * 64 + fr, col0 = u.pn * BM + wc * 32 + 8 * fq;
#pragma unroll
        for (int ai = 0; ai < 2; ++ai)
#pragma unroll
            for (int m = 0; m < 4; ++m) { bf16_t* rowp = O + (size_t)(row0 + ai * HALF + m * 16) * ldc + col0;
#pragma unroll
                for (int bj = 0; bj < 2; ++bj) { const f32x4 v0 = acc[ai][bj][m][0], v1 = acc[ai][bj][m][1];
                    u32x4 w; w.x = cvt_pk_bf16(v0[0], v0[1]); w.y = cvt_pk_bf16(v0[2], v0[3]); w.z = cvt_pk_bf16(v1[0], v1[1]); w.w = cvt_pk_bf16(v1[2], v1[3]);
                    *(u32x4*)(rowp + bj * HALF) = w; } }
    }
};
template <bool F32IN>
struct EpiMix {
    static constexpr bool PERM = true;
    const float* xin32; bf16_t* x16; const float* gate;
    __device__ __forceinline__ void operator()(const f32x4 (&acc)[2][2][4][2], const Unit& u, int wr, int wc, int fr, int fq) const {
        const int row0 = u.pm * BM + wr * 64 + fr, col0 = u.pn * BM + wc * 32 + 8 * fq;
        const float* gp = gate + (size_t)(u.pm >> 3) * 6144 + col0;
        f32x4 gv[2][2];
#pragma unroll
        for (int bj = 0; bj < 2; ++bj)
#pragma unroll
            for (int n = 0; n < 2; ++n) gv[bj][n] = *(const f32x4*)(gp + bj * HALF + 4 * n);
#pragma unroll
        for (int ai = 0; ai < 2; ++ai)
#pragma unroll
            for (int mh = 0; mh < 2; ++mh) {
                f32x4 xa[2][2][2]; u32x4 xb[2][2];
#pragma unroll
                for (int mm = 0; mm < 2; ++mm) { const size_t off = (size_t)(row0 + ai * HALF + (2 * mh + mm) * 16) * D + col0;
#pragma unroll
                    for (int bj = 0; bj < 2; ++bj) { if (F32IN) { xa[mm][bj][0] = *(const f32x4*)(xin32 + off + bj * HALF); xa[mm][bj][1] = *(const f32x4*)(xin32 + off + bj * HALF + 4); } else xb[mm][bj] = *(const u32x4*)(x16 + off + bj * HALF); } }
#pragma unroll
                for (int mm = 0; mm < 2; ++mm) { const int m = 2 * mh + mm; const size_t off = (size_t)(row0 + ai * HALF + m * 16) * D + col0;
#pragma unroll
                    for (int bj = 0; bj < 2; ++bj) { f32x4 x0, x1;
                        if (F32IN) { x0 = xa[mm][bj][0]; x1 = xa[mm][bj][1]; }
                        else { const u32x4 xv = xb[mm][bj]; x0 = (f32x4){bflo(xv.x), bfhi(xv.x), bflo(xv.y), bfhi(xv.y)}; x1 = (f32x4){bflo(xv.z), bfhi(xv.z), bflo(xv.w), bfhi(xv.w)}; }
                        const f32x4 v0 = x0 + gv[bj][0] * acc[ai][bj][m][0], v1 = x1 + gv[bj][1] * acc[ai][bj][m][1];
                        u32x4 w; w.x = cvt_pk_bf16(v0[0], v0[1]); w.y = cvt_pk_bf16(v0[2], v0[3]); w.z = cvt_pk_bf16(v1[0], v1[1]); w.w = cvt_pk_bf16(v1[2], v1[3]);
                        *(u32x4*)(x16 + off + bj * HALF) = w; } }
                asm volatile("" ::: "memory"); }
    }
};
struct EpiAct {
    static constexpr bool PERM = true;
    bf16_t* O;
    __device__ __forceinline__ void operator()(const f32x4 (&acc)[2][2][4][2], const Unit& u, int wr, int wc, int fr, int fq) const {
        const int row0 = u.pm * BM + wr * 64 + fr, col0 = u.pn * 128 + wc * 16 + 4 * fq;
#pragma unroll
        for (int ai = 0; ai < 2; ++ai)
#pragma unroll
            for (int m = 0; m < 4; ++m) { bf16_t* rowp = O + (size_t)(row0 + ai * HALF + m * 16) * DEXP + col0;
#pragma unroll
                for (int bj = 0; bj < 2; ++bj) { const f32x4 a = acc[ai][bj][m][0], b = acc[ai][bj][m][1]; f32x4 r;
#pragma unroll
                    for (int j = 0; j < 4; ++j) r[j] = a[j] * b[j] * __builtin_amdgcn_rcpf(1.0f + __expf(-a[j]));
                    u32x2 w; w.x = cvt_pk_bf16(r[0], r[1]); w.y = cvt_pk_bf16(r[2], r[3]);
                    *(u32x2*)(rowp + bj * 64) = w; } }
    }
};
struct EpiY {
    static constexpr bool PERM = true;
    bf16_t* O; const float* sgate;
    __device__ __forceinline__ void operator()(const f32x4 (&acc)[2][2][4][2], const Unit& u, int wr, int wc, int fr, int fq) const {
        const int row0 = u.pm * BM + wr * 64 + fr, col0 = u.pn * BM + wc * 32 + 8 * fq;
        float gg[2][4];
#pragma unroll
        for (int ai = 0; ai < 2; ++ai)
#pragma unroll
            for (int m = 0; m < 4; ++m) gg[ai][m] = sgate[row0 + ai * HALF + m * 16];
#pragma unroll
        for (int ai = 0; ai < 2; ++ai)
#pragma unroll
            for (int m = 0; m < 4; ++m) { const int row = row0 + ai * HALF + m * 16; const float g = gg[ai][m]; bf16_t* rowp = O + (size_t)row * D + col0;
#pragma unroll
                for (int bj = 0; bj < 2; ++bj) { const f32x4 v0 = acc[ai][bj][m][0] * g, v1 = acc[ai][bj][m][1] * g;
                    u32x4 w; w.x = cvt_pk_bf16(v0[0], v0[1]); w.y = cvt_pk_bf16(v0[2], v0[3]); w.z = cvt_pk_bf16(v1[0], v1[1]); w.w = cvt_pk_bf16(v1[2], v1[3]);
                    *(u32x4*)(rowp + bj * HALF) = w; } }
    }
};

template <class Epi, class Sched, bool GATHER>
__device__ __forceinline__ void gemm_phase(LAS unsigned char* lds, const Sched& S, const Epi& E) {
    const int tid = threadIdx.x, wid = __builtin_amdgcn_readfirstlane(tid >> 6), lane = tid & 63, wr = wid >> 2, wc = wid & 3, fr = lane & 15, fq = lane >> 4;
    const int K = S.K, nt = K / BK;
    unsigned voffA[2], voffB[2]; int RA[2], CA[2];
#pragma unroll
    for (int i = 0; i < 2; ++i) { int R, C; stage_rc(tid * 16 + i * 8192, R, C); const int Rb = Epi::PERM ? ((R & ~31) + perm32(R & 31)) : R;
        RA[i] = R; CA[i] = C; voffA[i] = (unsigned)(R * K + C) * 2u; voffB[i] = (unsigned)(Rb * K + C) * 2u; }
    const size_t kstep = (size_t)(BK * 2);
    const size_t hstep = (size_t)HALF * K * 2;
    const unsigned ldsw = (unsigned)wid * 1024u;
    const int aoff = lds_byte(wr * 64 + fr, fq * 8), boff = lds_byte(wc * 32 + fr, fq * 8);
#define PG8_SA(b, h) (((b) * 2 + (h)) * HTB)
#define PG8_SB(b, h) ((4 + (b) * 2 + (h)) * HTB)
#define PG8_DMA(bufoff, gptr, i) __builtin_amdgcn_global_load_lds((const unsigned*)(gptr), (LAS unsigned*)(lds + (bufoff) + ldsw + (i) * 8192), 16, 0, 0)
#define PG8_STAGE(bufoff, gbase, voff) do { PG8_DMA(bufoff, (const char*)(gbase) + (voff)[0], 0); PG8_DMA(bufoff, (const char*)(gbase) + (voff)[1], 1); } while (0)
#define PG8_STAGE_A(bufoff, nx, h, kb) do { if constexpr (GATHER) { \
            PG8_DMA(bufoff, S.A + (kb) + ((nx) ? gN[h][0] : gC[h][0]), 0); PG8_DMA(bufoff, S.A + (kb) + ((nx) ? gN[h][1] : gC[h][1]), 1); } \
        else { const char* _b = ((nx) ? nA : cA) + (h) * hstep + (kb); PG8_DMA(bufoff, _b + voffA[0], 0); PG8_DMA(bufoff, _b + voffA[1], 1); } } while (0)
#define PG8_LDA(dst, b, h) do { _Pragma("unroll") for (int m = 0; m < 4; ++m) _Pragma("unroll") for (int k = 0; k < 2; ++k) dst[m][k] = *(const LAS bf16x8*)(lds + PG8_SA(b, h) + aoff + m * 2048 + k * 1024); } while (0)
#define PG8_LDB(dst, b, h) do { _Pragma("unroll") for (int n = 0; n < 2; ++n) _Pragma("unroll") for (int k = 0; k < 2; ++k) dst[n][k] = *(const LAS bf16x8*)(lds + PG8_SB(b, h) + boff + n * 2048 + k * 1024); } while (0)
#define PG8_MMA(ai, bj, At, Bt) do { __builtin_amdgcn_s_setprio(1); _Pragma("unroll") for (int m = 0; m < 4; ++m) _Pragma("unroll") for (int n = 0; n < 2; ++n) _Pragma("unroll") for (int k = 0; k < 2; ++k) \
        acc[ai][bj][m][n] = __builtin_amdgcn_mfma_f32_16x16x32_bf16(Bt[n][k], At[m][k], acc[ai][bj][m][n], 0, 0, 0); __builtin_amdgcn_s_setprio(0); } while (0)
#define PG8_WAIT_V(n) asm volatile("s_waitcnt vmcnt(" #n ")" ::: "memory")
#define PG8_WAIT_L(n) asm volatile("s_waitcnt lgkmcnt(" #n ")" ::: "memory")
#define PG8_BAR __builtin_amdgcn_s_barrier()
#define PG8_SCHED __builtin_amdgcn_sched_barrier(0)
    Unit cur, nxt; int ui = 0;
    if (!S.next(0, cur)) return;
    unsigned gC[2][2] = {{0u, 0u}, {0u, 0u}}, gN[2][2] = {{0u, 0u}, {0u, 0u}};
    if constexpr (GATHER) {
#pragma unroll
        for (int h = 0; h < 2; ++h)
#pragma unroll
            for (int i = 0; i < 2; ++i) gC[h][i] = (unsigned)(S.row(0, h * HALF + RA[i]) * K + CA[i]) * 2u;
    }
    f32x4 acc[2][2][4][2];
#pragma unroll
    for (int a = 0; a < 2; ++a)
#pragma unroll
        for (int b = 0; b < 2; ++b)
#pragma unroll
            for (int m = 0; m < 4; ++m)
#pragma unroll
                for (int n = 0; n < 2; ++n) acc[a][b][m][n] = (f32x4){0.f, 0.f, 0.f, 0.f};
    bf16x8 At[4][2], B0[2][2], B1[2][2];
    const char* cA = cur.a; const char* cB = cur.b; const char* nA = cA; const char* nB = cB;
    PG8_STAGE(PG8_SB(0, 0), cB, voffB); PG8_STAGE(PG8_SB(0, 1), cB + hstep, voffB); PG8_STAGE_A(PG8_SA(0, 0), false, 0, 0); PG8_STAGE_A(PG8_SA(0, 1), false, 1, 0);
    if (wr == 1) PG8_BAR;
    PG8_WAIT_V(2); PG8_BAR;
    PG8_STAGE(PG8_SB(1, 0), cB + kstep, voffB); PG8_STAGE_A(PG8_SA(1, 0), false, 0, kstep); PG8_STAGE(PG8_SB(1, 1), cB + hstep + kstep, voffB);
    PG8_WAIT_V(6); PG8_BAR;
    for (;;) {
        const bool has_next = S.next(ui + 1, nxt);
        nA = has_next ? nxt.a : cA; nB = has_next ? nxt.b : cB;
        if constexpr (GATHER) {
            const int nord = has_next ? ui + 1 : ui;
#pragma unroll
            for (int h = 0; h < 2; ++h)
#pragma unroll
                for (int i = 0; i < 2; ++i) gN[h][i] = (unsigned)(S.row(nord, h * HALF + RA[i]) * K + CA[i]) * 2u;
        }
        for (int t = 0; t < nt; t += 2) {
            const bool last = (t == nt - 2);
            const size_t k1 = (size_t)(t + 1) * kstep;
            const size_t k2 = last ? 0 : (size_t)(t + 2) * kstep, k3 = k2 + kstep;
            const char* b2 = (last ? nB : cB) + k2; const char* b3 = b2 + kstep;
            PG8_LDB(B0, 0, 0); PG8_LDB(B1, 0, 1); PG8_SCHED; PG8_LDA(At, 0, 0); PG8_STAGE_A(PG8_SA(1, 1), false, 1, k1);
            PG8_WAIT_V(8); PG8_WAIT_L(0); PG8_BAR; PG8_MMA(0, 0, At, B0); PG8_MMA(0, 1, At, B1); PG8_BAR; PG8_SCHED;
            PG8_LDA(At, 0, 1); PG8_STAGE(PG8_SB(0, 0), b2, voffB); PG8_STAGE(PG8_SB(0, 1), b2 + hstep, voffB); PG8_STAGE_A(PG8_SA(0, 0), last, 0, k2);
            PG8_WAIT_V(8); PG8_WAIT_L(0); PG8_BAR; PG8_MMA(1, 0, At, B0); PG8_MMA(1, 1, At, B1); PG8_BAR; PG8_SCHED;
            PG8_LDB(B0, 1, 0); PG8_LDB(B1, 1, 1); PG8_SCHED; PG8_LDA(At, 1, 0); PG8_STAGE_A(PG8_SA(0, 1), last, 1, k2);
            PG8_WAIT_V(8); PG8_WAIT_L(0); PG8_BAR; PG8_MMA(0, 0, At, B0); PG8_MMA(0, 1, At, B1); PG8_BAR; PG8_SCHED;
            PG8_LDA(At, 1, 1); PG8_STAGE(PG8_SB(1, 0), b3, voffB); PG8_STAGE(PG8_SB(1, 1), b3 + hstep, voffB); PG8_STAGE_A(PG8_SA(1, 0), last, 0, k3);
            PG8_WAIT_V(8); PG8_WAIT_L(0); PG8_BAR; PG8_MMA(1, 0, At, B0); PG8_MMA(1, 1, At, B1); PG8_BAR; PG8_SCHED;
        }
        if (wr == 0) PG8_BAR;
        E(acc, cur, wr, wc, fr, fq);
        if (!has_next) break;
#pragma unroll
        for (int a = 0; a < 2; ++a)
#pragma unroll
            for (int b = 0; b < 2; ++b)
#pragma unroll
                for (int m = 0; m < 4; ++m)
#pragma unroll
                    for (int n = 0; n < 2; ++n) acc[a][b][m][n] = (f32x4){0.f, 0.f, 0.f, 0.f};
        cur = nxt; cA = nA; cB = nB; ++ui;
        if constexpr (GATHER) {
#pragma unroll
            for (int h = 0; h < 2; ++h)
#pragma unroll
                for (int i = 0; i < 2; ++i) gC[h][i] = gN[h][i];
        }
        if (wr == 1) PG8_BAR;
    }
    PG8_WAIT_V(0);
    PG8_BAR;
#undef PG8_SA
#undef PG8_SB
#undef PG8_DMA
#undef PG8_STAGE
#undef PG8_STAGE_A
#undef PG8_LDA
#undef PG8_LDB
#undef PG8_MMA
#undef PG8_WAIT_V
#undef PG8_WAIT_L
#undef PG8_BAR
#undef PG8_SCHED
}
}

struct Params { const float* in[27]; float* out; unsigned char* ws; int ph_lo, ph_hi; };
struct Ctx { LAS unsigned char* lds; int tid, lane, wave, vcu, G, gw, NGW; mutable unsigned long long sw_t0, sw_sum; };
#ifndef SW_ID
#define SW_ID 0
#endif
#define SW_START(id) do { if (SW_ID == (id)) c.sw_t0 = __builtin_amdgcn_s_memrealtime(); } while (0)
#define SW_STOP(id) do { if (SW_ID == (id)) c.sw_sum += __builtin_amdgcn_s_memrealtime() - c.sw_t0; } while (0)
enum { I_X = 0, I_C, I_MODW, I_MODB, I_N1G, I_WIN, I_CONVK, I_CONVB, I_CLNG, I_CLNB, I_QNG, I_KVNG, I_WUQ, I_WUK, I_WUV, I_POOLW, I_POOLS, I_WOUT, I_N2G, I_RGW, I_RGB, I_REW, I_REB, I_W1, I_W3, I_W2, I_FG };

template <class RowMap>
__device__ __forceinline__ void tr_item(const float* src, int ldn, int k0, int n0, int nvalid, bf16_t* dst, int ldk, int dk0, RowMap rm, LAS float* scr, int lane) {
#pragma unroll 8
    for (int i = 0; i < 32; ++i) { const int kk = 2 * i + (lane >> 5), n = n0 + (lane & 31); scr[kk * 33 + (lane & 31)] = (n < nvalid) ? src[(size_t)(k0 + kk) * ldn + n] : 0.f; }
    LDS_WAIT();
    const int c = lane & 7;
#pragma unroll
    for (int j = 0; j < 4; ++j) { const int n = (lane >> 3) + 8 * j; const LAS float* s = scr + (8 * c) * 33 + n;
        u32x4 o; o.x = cvt_pk_bf16(s[0 * 33], s[1 * 33]); o.y = cvt_pk_bf16(s[2 * 33], s[3 * 33]); o.z = cvt_pk_bf16(s[4 * 33], s[5 * 33]); o.w = cvt_pk_bf16(s[6 * 33], s[7 * 33]);
        *(u32x4*)(dst + (size_t)rm(n0 + n) * ldk + dk0 + k0 + 8 * c) = o; }
    LDS_WAIT();
}

__device__ __forceinline__ void conv_experts(const Params& p, const Ctx& c, int l) {
    LAS float* scr = (LAS float*)(c.lds + c.wave * 8448);
    bf16_t* W13 = (bf16_t*)(p.ws + WS_W13); bf16_t* W2 = (bf16_t*)(p.ws + WS_W2);
    for (int it = c.gw; it < 3 * 8192; it += c.NGW) {
        const int which = it >> 13, r = it & 8191, e = r >> 8;
        if (which < 2) { const int kb = (r >> 4) & 15, nb = r & 15; const float* src = p.in[which ? I_W3 : I_W1] + (size_t)(l * NEXP + e) * 1024 * 512; const int add = which ? 4 : 0;
            tr_item(src, 512, 64 * kb, 32 * nb, 512, W13 + (size_t)e * 1024 * 1024, 1024, 0, [add](int n) { return 8 * (n >> 2) + (n & 3) + add; }, scr, c.lane); }
        else { const int kb = (r >> 5) & 7, nb = r & 31; const float* src = p.in[I_W2] + (size_t)(l * NEXP + e) * 512 * 1024;
            tr_item(src, 1024, 64 * kb, 32 * nb, 1024, W2 + (size_t)e * 1024 * 512, 512, 0, [](int n) { return n; }, scr, c.lane); }
    }
}

__device__ __forceinline__ void cx_issue(const Params& p, int l, int it, int lane, float (&tv)[32]) {
    const int which = it >> 13, r = it & 8191, e = r >> 8;
    const float* src; int ldn, k0, n0;
    if (which < 2) { const int kb = (r >> 4) & 15, nb = r & 15; src = p.in[which ? I_W3 : I_W1] + (size_t)(l * NEXP + e) * 1024 * 512; ldn = 512; k0 = 64 * kb; n0 = 32 * nb; }
    else { const int kb = (r >> 5) & 7, nb = r & 31; src = p.in[I_W2] + (size_t)(l * NEXP + e) * 512 * 1024; ldn = 1024; k0 = 64 * kb; n0 = 32 * nb; }
    const float* s0 = src + (size_t)(k0 + (lane >> 5)) * ldn + n0 + (lane & 31);
#pragma unroll
    for (int i = 0; i < 32; ++i) tv[i] = s0[(size_t)(2 * i) * ldn];
}
__device__ __forceinline__ void cx_finish(const Params& p, int it, int lane, const float (&tv)[32], LAS float* scr) {
    const int which = it >> 13, r = it & 8191, e = r >> 8;
    bf16_t* dst; int ldk, k0, n0, add = 0; bool inter = false;
    if (which < 2) { const int kb = (r >> 4) & 15, nb = r & 15; dst = (bf16_t*)(p.ws + WS_W13) + (size_t)e * 1024 * 1024; ldk = 1024; k0 = 64 * kb; n0 = 32 * nb; add = which ? 4 : 0; inter = true; }
    else { const int kb = (r >> 5) & 7, nb = r & 31; dst = (bf16_t*)(p.ws + WS_W2) + (size_t)e * 1024 * 512; ldk = 512; k0 = 64 * kb; n0 = 32 * nb; }
#pragma unroll
    for (int i = 0; i < 32; ++i) scr[(2 * i + (lane >> 5)) * 33 + (lane & 31)] = tv[i];
    LDS_WAIT();
    const int cc = lane & 7;
#pragma unroll
    for (int j = 0; j < 4; ++j) { const int n = (lane >> 3) + 8 * j; const LAS float* sp = scr + (8 * cc) * 33 + n; const int nn = n0 + n; const int row = inter ? (8 * (nn >> 2) + (nn & 3) + add) : nn;
        u32x4 o; o.x = cvt_pk_bf16(sp[0 * 33], sp[1 * 33]); o.y = cvt_pk_bf16(sp[2 * 33], sp[3 * 33]); o.z = cvt_pk_bf16(sp[4 * 33], sp[5 * 33]); o.w = cvt_pk_bf16(sp[6 * 33], sp[7 * 33]);
        *(u32x4*)(dst + (size_t)row * ldk + k0 + 8 * cc) = o; }
    LDS_WAIT();
}

__device__ __forceinline__ void ph_prologue(const Params& p, const Ctx& c) {
    float* mod = (float*)(p.ws + WS_MOD);
    {
        LAS float* cond = (LAS float*)c.lds; LAS float* part = (LAS float*)(c.lds + 65536);
        bool loaded = false;
        for (int item = c.vcu; item < 192; item += c.G) {
            if (!loaded) { for (int i = c.tid; i < NB * D; i += 512) { const float v = p.in[I_C][i]; cond[i] = v / (1.0f + expf(-v)); } __syncthreads(); loaded = true; }
            const int l = item / 96, n0 = (item % 96) * 64;
            const float* W = p.in[I_MODW] + (size_t)l * D * 6144 + n0 + c.lane;
            float acc[NB];
#pragma unroll
            for (int b = 0; b < NB; ++b) acc[b] = 0.f;
#pragma unroll 8
            for (int k = c.wave * 128; k < c.wave * 128 + 128; ++k) { const float w = W[(size_t)k * 6144];
#pragma unroll
                for (int b = 0; b < NB; ++b) acc[b] += cond[b * D + k] * w; }
#pragma unroll
            for (int b = 0; b < NB; ++b) part[(c.wave * NB + b) * 64 + c.lane] = acc[b];
            __syncthreads();
            for (int o = c.tid; o < NB * 64; o += 512) { const int b = o >> 6, ln = o & 63; float s = 0.f;
#pragma unroll
                for (int w = 0; w < 8; ++w) s += part[(w * NB + b) * 64 + ln];
                mod[(size_t)(l * NB + b) * 6144 + n0 + ln] = s + p.in[I_MODB][l * 6144 + n0 + ln]; }
            __syncthreads();
        }
        __syncthreads();
    }
    {
        LAS float* scr = (LAS float*)(c.lds + c.wave * 8448);
        constexpr int I_IN = 16 * 56;
        for (int it = c.gw; it < 2 * I_IN; it += c.NGW) {
            const int l = it / I_IN, r = it % I_IN, kb = r / 56, nb = r % 56;
            tr_item(p.in[I_WIN] + (size_t)l * D * N_IN, N_IN, 64 * kb, 32 * nb, N_IN, (bf16_t*)(p.ws + WS_WIN) + (size_t)l * NZ * D, D, 0, [](int n) { return n; }, scr, c.lane);
        }
    }
}
__device__ __forceinline__ void ph_prologue_rest(const Params& p, const Ctx& c, int wid, int nw) {
    {
        LAS float* scr = (LAS float*)(c.lds + c.wave * 8448);
        constexpr int I_MX = 4 * 32;
        for (int it = wid; it < 2 * 2 * I_MX; it += nw) {
            const int l = it / (2 * I_MX); int r = it % (2 * I_MX); const int part = r / I_MX; r %= I_MX; const int kb = r / 32, nb = r % 32;
            tr_item(p.in[I_WOUT] + (size_t)l * D * D + (size_t)(part ? 768 : 0) * D, D, 64 * kb, 32 * nb, D, (bf16_t*)(p.ws + WS_WMIX) + (size_t)l * D * KMIX, KMIX, part ? 1280 : 0, [](int n) { return n; }, scr, c.lane);
        }
    }
    for (int it = wid * 64 + c.lane; it < 2 * 131072; it += nw * 64) {
        const int l = it >> 17, r = it & 131071, n = r & 1023, h = (r >> 10) & 7, cb = r >> 13;
        const float* wo = p.in[I_WOUT] + (size_t)l * D * D + (size_t)(256 + 64 * h) * D + n;
        const float* wv = p.in[I_WUV] + (size_t)l * 128 * 512 + (size_t)(8 * cb) * 512 + h * 64;
        float acc[8];
#pragma unroll
        for (int j = 0; j < 8; ++j) acc[j] = 0.f;
        for (int d0 = 0; d0 < 64; d0 += 16) { float w[16];
#pragma unroll
            for (int q = 0; q < 16; ++q) w[q] = wo[(size_t)(d0 + q) * D];
#pragma unroll
            for (int j = 0; j < 8; ++j) { asm volatile("" ::: "memory");
#pragma unroll
                for (int q = 0; q < 16; q += 4) { const f32x4 v4 = *(const f32x4*)(wv + j * 512 + d0 + q); acc[j] += (v4.x * w[q] + v4.y * w[q + 1]) + (v4.z * w[q + 2] + v4.w * w[q + 3]); } } }
        u32x4 o; o.x = cvt_pk_bf16(acc[0], acc[1]); o.y = cvt_pk_bf16(acc[2], acc[3]); o.z = cvt_pk_bf16(acc[4], acc[5]); o.w = cvt_pk_bf16(acc[6], acc[7]);
        *(u32x4*)((bf16_t*)(p.ws + WS_WMIX) + (size_t)l * D * KMIX + (size_t)n * KMIX + 256 + 128 * h + 8 * cb) = o;
    }
    for (int it = wid * 64 + c.lane; it < 2 * 32768; it += nw * 64) {
        const int l = it >> 15, r = it & 32767, cb = r & 31, k = (r >> 5) & 127, h = r >> 12;
        const float* uq = p.in[I_WUQ] + (size_t)l * 256 * 512 + (size_t)(8 * cb) * 512 + h * 64;
        const float* uk = p.in[I_WUK] + (size_t)l * 128 * 512 + (size_t)k * 512 + h * 64;
        float acc[8];
#pragma unroll
        for (int j = 0; j < 8; ++j) acc[j] = 0.f;
        for (int d0 = 0; d0 < 64; d0 += 16) { f32x4 w4[4];
#pragma unroll
            for (int q = 0; q < 4; ++q) w4[q] = *(const f32x4*)(uk + d0 + 4 * q);
#pragma unroll
            for (int j = 0; j < 8; ++j) { asm volatile("" ::: "memory");
#pragma unroll
                for (int q = 0; q < 4; ++q) { const f32x4 v4 = *(const f32x4*)(uq + j * 512 + d0 + 4 * q); acc[j] += (v4.x * w4[q].x + v4.y * w4[q].y) + (v4.z * w4[q].z + v4.w * w4[q].w); } } }
        const float sc = 0.125f * 1.44269504089f;
#pragma unroll
        for (int j = 0; j < 8; ++j) acc[j] *= sc * p.in[I_QNG][l * 256 + 8 * cb + j];
        u32x4 o; o.x = cvt_pk_bf16(acc[0], acc[1]); o.y = cvt_pk_bf16(acc[2], acc[3]); o.z = cvt_pk_bf16(acc[4], acc[5]); o.w = cvt_pk_bf16(acc[6], acc[7]);
        *(u32x4*)((bf16_t*)(p.ws + WS_WQA) + (size_t)l * D * 256 + (size_t)(h * 128 + k) * 256 + 8 * cb) = o;
    }
    for (int it = wid * 64 + c.lane; it < 2 * 36 * 1024; it += nw * 64) {
        const int l = it / 36864, r = it % 36864, R = r >> 10, k = r & 1023;
        float v;
        if (R < 32) { const int g = (R & 15) >> 2, e = (R & 3) + (R >= 16 ? 4 : 0); v = p.in[I_REW][(size_t)l * D * 32 + (size_t)k * 32 + g * 8 + e]; }
        else v = p.in[I_RGW][(size_t)l * D * 4 + (size_t)k * 4 + (R - 32)];
        ((float*)(p.ws + WS_SMALL + SM_WRT))[it] = v;
    }
    for (int it = wid * 64 + c.lane; it < 2 * 4 * 64 * 8; it += nw * 64) {
        const int lg = it >> 9, r = it & 511, o = r >> 3, ib = r & 7; const float* src = p.in[I_POOLW] + (size_t)lg * 4096 + (size_t)(8 * ib) * 64 + o;
        u32x4 w; w.x = cvt_pk_bf16(src[0], src[64]); w.y = cvt_pk_bf16(src[128], src[192]); w.z = cvt_pk_bf16(src[256], src[320]); w.w = cvt_pk_bf16(src[384], src[448]);
        *(u32x4*)((bf16_t*)(p.ws + WS_SMALL + SM_PWT) + (size_t)lg * 4096 + o * 64 + 8 * ib) = w;
    }
}

template <int MODE>
__device__ __forceinline__ void ph_norm1(const Params& p, const Ctx& c) {
    const float* mod = (const float*)(p.ws + WS_MOD);
    const bf16_t* Y = (const bf16_t*)(p.ws + WS_Y); const int* tslot = (const int*)(p.ws + WS_SMALL + SM_TSLOT);
    bf16_t* H = (bf16_t*)(p.ws + WS_H); bf16_t* X16 = (bf16_t*)(p.ws + WS_X16);
    constexpr int NR = (MODE == 0) ? 4 : 2;
    const int nrow = T / c.NGW;
    f32x4 vn[NR][4]; u32x2 xn[NR][4], an[NR][4], bn[NR][4];
    auto load_rows = [&](int r0) {
#pragma unroll
        for (int t = 0; t < NR; ++t) { const int m = c.gw + (r0 + t) * c.NGW;
            if (MODE == 0) {
#pragma unroll
                for (int j = 0; j < 4; ++j) vn[t][j] = ((const f32x4*)(p.in[I_X] + (size_t)m * D) + c.lane)[64 * j];
            } else { const int s0 = tslot[2 * m], s1 = tslot[2 * m + 1];
#pragma unroll
                for (int j = 0; j < 4; ++j) { xn[t][j] = ((const u32x2*)(X16 + (size_t)m * D) + c.lane)[64 * j]; an[t][j] = ((const u32x2*)(Y + (size_t)s0 * D) + c.lane)[64 * j]; bn[t][j] = ((const u32x2*)(Y + (size_t)s1 * D) + c.lane)[64 * j]; } } } };
    load_rows(0);
    for (int r0 = 0; r0 < nrow; r0 += NR) {
        f32x4 v[NR][4]; u32x2 ya[NR][4], yb[NR][4];
#pragma unroll
        for (int t = 0; t < NR; ++t)
#pragma unroll
            for (int j = 0; j < 4; ++j) { if (MODE == 0) v[t][j] = vn[t][j]; else { v[t][j] = (f32x4){bflo(xn[t][j].x), bfhi(xn[t][j].x), bflo(xn[t][j].y), bfhi(xn[t][j].y)}; ya[t][j] = an[t][j]; yb[t][j] = bn[t][j]; } }
        if (r0 + NR < nrow) load_rows(r0 + NR);
#pragma unroll
        for (int t = 0; t < NR; ++t) {
            const int m = c.gw + (r0 + t) * c.NGW, b = m >> 11;
            if (MODE != 0) {
                const f32x4* g2 = (const f32x4*)(mod + (size_t)((MODE - 1) * NB + b) * 6144 + 5120) + c.lane;
#pragma unroll
                for (int j = 0; j < 4; ++j) { const u32x2 a = ya[t][j], bb = yb[t][j]; const f32x4 g = g2[64 * j];
                    v[t][j].x += g.x * (bflo(a.x) + bflo(bb.x)); v[t][j].y += g.y * (bfhi(a.x) + bfhi(bb.x)); v[t][j].z += g.z * (bflo(a.y) + bflo(bb.y)); v[t][j].w += g.w * (bfhi(a.y) + bfhi(bb.y)); }
            }
            float ss = 0.f;
#pragma unroll
            for (int j = 0; j < 4; ++j) ss += (v[t][j].x * v[t][j].x + v[t][j].y * v[t][j].y) + (v[t][j].z * v[t][j].z + v[t][j].w * v[t][j].w);
            const float r = 1.0f / sqrtf(wave_sum(ss) * (1.0f / D) + EPS);
            if (MODE == 2) {
                const f32x4* fg = (const f32x4*)p.in[I_FG] + c.lane; f32x4* o = (f32x4*)(p.out + (size_t)m * D) + c.lane;
#pragma unroll
                for (int j = 0; j < 4; ++j) o[64 * j] = v[t][j] * r * fg[64 * j];
            } else {
                if (MODE == 1) { u32x2* o = (u32x2*)(X16 + (size_t)m * D) + c.lane;
#pragma unroll
                    for (int j = 0; j < 4; ++j) { u32x2 w; w.x = cvt_pk_bf16(v[t][j].x, v[t][j].y); w.y = cvt_pk_bf16(v[t][j].z, v[t][j].w); o[64 * j] = w; } }
                const int l = MODE;
                const f32x4* ng = (const f32x4*)(p.in[I_N1G] + l * D) + c.lane;
                const f32x4* sh = (const f32x4*)(mod + (size_t)(l * NB + b) * 6144) + c.lane; const f32x4* sc = (const f32x4*)(mod + (size_t)(l * NB + b) * 6144 + 1024) + c.lane;
                u32x2* o8 = (u32x2*)(H + (size_t)m * D) + c.lane;
#pragma unroll
                for (int j = 0; j < 4; ++j) { const f32x4 hv = v[t][j] * r * ng[64 * j] * (sc[64 * j] + 1.0f) + sh[64 * j]; u32x2 w; w.x = cvt_pk_bf16(hv.x, hv.y); w.y = cvt_pk_bf16(hv.z, hv.w); o8[64 * j] = w; }
            }
        }
    }
}

__device__ __forceinline__ void ph_postz(const Params& p, const Ctx& c, int l) {
    const bf16_t* Z = (const bf16_t*)(p.ws + WS_Z); bf16_t* MC = (bf16_t*)p.out;
    bf16_t* CQR = (bf16_t*)(p.ws + WS_CQR); bf16_t* KVN = (bf16_t*)(p.ws + WS_KVN);
    LAS float* U = (LAS float*)c.lds;
    const int lane = c.lane, tk0 = c.wave * 8;
    LAS f32x4* CK = (LAS f32x4*)(c.lds + 98304);
    { const f32x4* src = (const f32x4*)(p.in[I_CONVK] + (size_t)l * 31 * 256); f32x4 t[4];
#pragma unroll
      for (int q = 0; q < 4; ++q) { const int i = c.tid + 512 * q; t[q] = src[i < 31 * 64 ? i : 0]; }
#pragma unroll
      for (int q = 0; q < 4; ++q) { const int i = c.tid + 512 * q; if (i < 31 * 64) CK[i] = t[q]; } }
    __syncthreads();
    for (int unit = c.vcu; unit < 512; unit += c.G) {
        const int b = unit >> 5, s0 = (unit & 31) * 64, t0 = b * S + s0;
        SW_START(1);
#pragma unroll
        for (int hb = 0; hb < 2; ++hb) {   u32x2 av[6], gv[6];
#pragma unroll
            for (int q = 0; q < 6; ++q) { const int idx = c.tid + 512 * (6 * hb + q), r = idx >> 6, c4 = idx & 63; int s = s0 - 30 + r; s = s < 0 ? 0 : (s > S - 1 ? S - 1 : s);
                const bf16_t* zr = Z + (size_t)(b * S + s) * NZ + 4 * c4; av[q] = *(const u32x2*)(zr + Z_AVAL); gv[q] = *(const u32x2*)(zr + Z_AGATE); }
#pragma unroll
            for (int q = 0; q < 6; ++q) { const int idx = c.tid + 512 * (6 * hb + q), r = idx >> 6, c4 = idx & 63, s = s0 - 30 + r; f32x4 u = {0.f, 0.f, 0.f, 0.f};
                if (s >= 0) { const u32x2 a = av[q], g = gv[q];
                    u.x = bflo(a.x) * sigmoidf_(bflo(g.x)); u.y = bfhi(a.x) * sigmoidf_(bfhi(g.x)); u.z = bflo(a.y) * sigmoidf_(bflo(g.y)); u.w = bfhi(a.y) * sigmoidf_(bfhi(g.y)); }
                if (idx < 94 * 64) *(LAS f32x4*)(U + r * 256 + 4 * c4) = u; }
            asm volatile("" ::: "memory");
        }
        __syncthreads();
        SW_STOP(1); SW_START(2);
        {
            const LAS f32x4* ck = CK + lane;
            const f32x4 cb = *((const f32x4*)(p.in[I_CONVB] + l * 256) + lane), lg = *((const f32x4*)(p.in[I_CLNG] + l * 256) + lane), lb = *((const f32x4*)(p.in[I_CLNB] + l * 256) + lane);
#pragma unroll 1
            for (int hp = 0; hp < 2; ++hp) {
                const int tq = tk0 + 4 * hp;
                f32x4 acc[4], win[4];
#pragma unroll
                for (int i = 0; i < 4; ++i) { acc[i] = (f32x4){0.f, 0.f, 0.f, 0.f}; win[i] = *(const LAS f32x4*)(U + (tq + i) * 256 + 4 * lane); }
#pragma unroll
                for (int j = 0; j < 31; ++j) { const f32x4 kj = ck[64 * j];
#pragma unroll
                    for (int i = 0; i < 4; ++i) acc[i] += win[i] * kj;
                    if (j < 30) {
#pragma unroll
                        for (int i = 0; i < 3; ++i) win[i] = win[i + 1];
                        win[3] = *(const LAS f32x4*)(U + (tq + 4 + j) * 256 + 4 * lane); } }
#pragma unroll
                for (int i = 0; i < 4; ++i) { const f32x4 v = acc[i] + cb; const float mean = wave_sum((v.x + v.y) + (v.z + v.w)) * (1.0f / 256.0f);
                    const f32x4 d = v - mean; const float var = wave_sum((d.x * d.x + d.y * d.y) + (d.z * d.z + d.w * d.w)) * (1.0f / 256.0f);
                    const float rs = 1.0f / sqrtf(var + EPS); f32x4 y = d * rs * lg + lb;
                    y.x *= sigmoidf_(y.x); y.y *= sigmoidf_(y.y); y.z *= sigmoidf_(y.z); y.w *= sigmoidf_(y.w);
                    u32x2 w; w.x = cvt_pk_bf16(y.x, y.y); w.y = cvt_pk_bf16(y.z, y.w);
                    *(u32x2*)(MC + (size_t)(t0 + tq + i) * KMIX + 4 * lane) = w; }
            }
        }
        __syncthreads();
        SW_STOP(2); SW_START(3);
        {   u32x2 av[10];
#pragma unroll
            for (int q = 0; q < 10; ++q) { const int idx = c.tid + 512 * q, r = idx >> 6, c4 = idx & 63; int s = s0 - 15 + r; s = s < 0 ? 0 : (s > S - 1 ? S - 1 : s);
                av[q] = *(const u32x2*)(Z + (size_t)(b * S + s) * NZ + Z_UP + 4 * c4); }
#pragma unroll
            for (int q = 0; q < 10; ++q) { const int idx = c.tid + 512 * q, r = idx >> 6, c4 = idx & 63, s = s0 - 15 + r; f32x4 u = {0.f, 0.f, 0.f, 0.f};
                if (s >= 0) { const u32x2 a = av[q]; u.x = bflo(a.x); u.y = bfhi(a.x); u.z = bflo(a.y); u.w = bfhi(a.y); }
                if (idx < 79 * 64) *(LAS f32x4*)(U + r * 256 + 4 * c4) = u; }
        }
        __syncthreads();
        f32x4 dv[8];
        {
            const int w = 2 << (lane >> 4);
#pragma unroll
            for (int i = 0; i < 8; ++i) { const int r = 15 + tk0 + i, s = s0 + tk0 + i; f32x4 sum = {0.f, 0.f, 0.f, 0.f};
#pragma unroll
                for (int q = 0; q < 16; ++q) { const f32x4 u = *(const LAS f32x4*)(U + (r - q) * 256 + 4 * lane); if (q < w) sum += u; }
                const float rc = __builtin_amdgcn_rcpf((float)((s + 1) < w ? (s + 1) : w));
                dv[i] = sum * rc - *(const LAS f32x4*)(U + r * 256 + 4 * lane); }
        }
        SW_STOP(3); SW_START(5);
        {
            __syncthreads();
            LAS bf16_t* D16 = (LAS bf16_t*)c.lds;
#pragma unroll
            for (int i = 0; i < 8; ++i) { u32x2 w; w.x = cvt_pk_bf16(dv[i].x, dv[i].y); w.y = cvt_pk_bf16(dv[i].z, dv[i].w); *(LAS u32x2*)(D16 + (tk0 + i) * 264 + 4 * lane) = w; }
            __syncthreads();
            const int mt = c.wave & 3, g0 = (c.wave >> 2) * 2, fr = lane & 15, fq = lane >> 4;
            const bf16_t* PWT = (const bf16_t*)(p.ws + WS_SMALL + SM_PWT) + (size_t)l * 4 * 4096;
#pragma unroll
            for (int gg = 0; gg < 2; ++gg) { const int g = g0 + gg;
                const bf16x8 d0 = *(const LAS bf16x8*)(D16 + (16 * mt + fr) * 264 + 64 * g + 8 * fq), d1 = *(const LAS bf16x8*)(D16 + (16 * mt + fr) * 264 + 64 * g + 32 + 8 * fq);
#pragma unroll
                for (int nt = 0; nt < 4; ++nt) {
                    const bf16_t* wp = PWT + (size_t)g * 4096 + (16 * nt + fr) * 64 + 8 * fq;
                    const bf16x8 w0 = *(const bf16x8*)wp, w1 = *(const bf16x8*)(wp + 32);
                    f32x4 acc = {0.f, 0.f, 0.f, 0.f};
                    acc = __builtin_amdgcn_mfma_f32_16x16x32_bf16(w0, d0, acc, 0, 0, 0); acc = __builtin_amdgcn_mfma_f32_16x16x32_bf16(w1, d1, acc, 0, 0, 0);
                    const int oc = 64 * g + 16 * nt + 4 * fq;
                    const f32x4 ps = *(const f32x4*)(p.in[I_POOLS] + l * 256 + oc); const f32x4 y = acc * ps;
                    u32x2 w; w.x = cvt_pk_bf16(y.x, y.y); w.y = cvt_pk_bf16(y.z, y.w);
                    *(u32x2*)(MC + (size_t)(t0 + 16 * mt + fr) * KMIX + 1280 + oc) = w; } }
        }
        SW_STOP(5); SW_START(6);
        asm volatile("" ::: "memory");
        {
            const float kg0 = p.in[I_KVNG][l * 128 + 2 * lane], kg1 = p.in[I_KVNG][l * 128 + 2 * lane + 1];
            u32x2 qv[8]; unsigned kvv[8];
#pragma unroll
            for (int i = 0; i < 8; ++i) { const bf16_t* zr = Z + (size_t)(t0 + tk0 + i) * NZ; qv[i] = *(const u32x2*)(zr + Z_CQ + 4 * lane); kvv[i] = *(const unsigned*)(zr + Z_CKV + 2 * lane); }
#pragma unroll
            for (int i = 0; i < 8; ++i) { const size_t t = (size_t)(t0 + tk0 + i);
                const u32x2 q = qv[i]; const float q0 = bflo(q.x), q1 = bfhi(q.x), q2 = bflo(q.y), q3 = bfhi(q.y);
                const float rq = 1.0f / sqrtf(wave_sum((q0 * q0 + q1 * q1) + (q2 * q2 + q3 * q3)) * (1.0f / 256.0f) + EPS);
                u32x2 w; w.x = cvt_pk_bf16(q0 * rq, q1 * rq); w.y = cvt_pk_bf16(q2 * rq, q3 * rq); *(u32x2*)(CQR + t * 256 + 4 * lane) = w;
                const unsigned kv = kvv[i]; const float k0 = bflo(kv), k1 = bfhi(kv);
                const float rk = 1.0f / sqrtf(wave_sum(k0 * k0 + k1 * k1) * (1.0f / 128.0f) + EPS);
                *(unsigned*)(KVN + t * 128 + 2 * lane) = cvt_pk_bf16(k0 * rk * kg0, k1 * rk * kg1); }
        }
        SW_STOP(6);
        __syncthreads();
    }
}

__device__ __forceinline__ size_t sc_off(int b, int cq) { return (size_t)b * SC_PER_B + (size_t)2048 * cq * (cq + 1); }
__device__ __forceinline__ void ph_scores(const Params& p, const Ctx& c) {
    const bf16_t* Z = (const bf16_t*)(p.ws + WS_Z); float* SC = (float*)(p.ws + WS_Y);
    const int lane = c.lane, l15 = lane & 15, g = lane >> 4;
    for (int U = c.gw; U < NB * 128; U += c.NGW)
    for (int part = 0; part <= (U & 1); ++part) {
        const int pi = U >> 1, b = pi >> 6, a = (pi & 63) >> 2, q4 = pi & 3;
        const int cq = ((U & 1) && part) ? a : 31 - a;
        const int n = 64 * (cq + 1), kt0 = ((U & 1) && !part) ? 66 : 0, kt1 = (U & 1) ? 4 * (cq + 1) : 66;
        const size_t tq = (size_t)b * S + cq * 64 + q4 * 16 + l15;
        const bf16_t* zq = Z + tq * NZ;
        bf16x8 bq[8][2];
#pragma unroll
        for (int h = 0; h < 8; ++h)
#pragma unroll
            for (int s = 0; s < 2; ++s) bq[h][s] = *(const bf16x8*)(zq + Z_QI + h * 64 + 32 * s + 8 * g);
        float wq[8];
        { const u32x4 wv = *(const u32x4*)(zq + Z_WI); const float isc = 0.044194173824159216f;
          wq[0] = bflo(wv.x) * isc; wq[1] = bfhi(wv.x) * isc; wq[2] = bflo(wv.y) * isc; wq[3] = bfhi(wv.y) * isc; wq[4] = bflo(wv.z) * isc; wq[5] = bfhi(wv.z) * isc; wq[6] = bflo(wv.w) * isc; wq[7] = bfhi(wv.w) * isc; }
        float* srow = SC + sc_off(b, cq) + (size_t)(q4 * 16 + l15) * n;
        const bf16_t* zkb = Z + ((size_t)b * S + l15) * NZ + Z_KI + 8 * g;
        bf16x8 nk[2][2];
#pragma unroll
        for (int u2 = 0; u2 < 2; ++u2) { nk[u2][0] = *(const bf16x8*)(zkb + (size_t)(kt0 + u2) * 16 * NZ); nk[u2][1] = *(const bf16x8*)(zkb + (size_t)(kt0 + u2) * 16 * NZ + 32); }
        for (int kt = kt0; kt < kt1; kt += 2) {
            bf16x8 ak[2][2];
#pragma unroll
            for (int u2 = 0; u2 < 2; ++u2) { ak[u2][0] = nk[u2][0]; ak[u2][1] = nk[u2][1]; }
            if (kt + 2 < kt1) {
#pragma unroll
                for (int u2 = 0; u2 < 2; ++u2) { nk[u2][0] = *(const bf16x8*)(zkb + (size_t)(kt + 2 + u2) * 16 * NZ); nk[u2][1] = *(const bf16x8*)(zkb + (size_t)(kt + 2 + u2) * 16 * NZ + 32); } }
            f32x2 s01[2] = {{0.f, 0.f}, {0.f, 0.f}}, s23[2] = {{0.f, 0.f}, {0.f, 0.f}};
#pragma unroll
            for (int h = 0; h < 8; ++h) {
#pragma unroll
                for (int u2 = 0; u2 < 2; ++u2) { f32x4 a = {0.f, 0.f, 0.f, 0.f};
                    a = __builtin_amdgcn_mfma_f32_16x16x32_bf16(ak[u2][0], bq[h][0], a, 0, 0, 0);
                    a = __builtin_amdgcn_mfma_f32_16x16x32_bf16(ak[u2][1], bq[h][1], a, 0, 0, 0);
                    const f32x2 r01 = {__int_as_float(max(__float_as_int(a[0]), 0)), __int_as_float(max(__float_as_int(a[1]), 0))}, r23 = {__int_as_float(max(__float_as_int(a[2]), 0)), __int_as_float(max(__float_as_int(a[3]), 0))};
                    const f32x2 w2 = {wq[h], wq[h]}; s01[u2] = __builtin_elementwise_fma(r01, w2, s01[u2]); s23[u2] = __builtin_elementwise_fma(r23, w2, s23[u2]); } }
#pragma unroll
            for (int u2 = 0; u2 < 2; ++u2) *(f32x4*)(srow + (kt + u2) * 16 + 4 * g) = (f32x4){s01[u2].x, s01[u2].y, s23[u2].x, s23[u2].y};
        }
    }
}

__device__ __forceinline__ unsigned off_b(unsigned row, unsigned ch) { return 256u * row + 16u * (ch ^ (((row & 3) << 2) | ((row >> 2) & 3))); }
template <int MODE>
__device__ __forceinline__ void ph_attn(const Params& p, const Ctx& c, int l) {
    const float* SC = (const float*)(p.ws + WS_Y); const bf16_t* QA = (const bf16_t*)(p.ws + WS_H); const bf16_t* KVN = (const bf16_t*)(p.ws + WS_KVN);
    bf16_t* MC = (bf16_t*)p.out;
    const int lane = c.lane, g = lane >> 4, hd = lane & 15;
    LAS unsigned char* tile = c.lds + c.wave * 16384;
    LAS unsigned* lst = (LAS unsigned*)(c.lds + LIST_OFF + c.wave * 1088);
    const unsigned long long ltmask = (1ull << lane) - 1ull;
    const int xg = blockIdx.x & 7, wv = (blockIdx.x >> 3) * 8 + c.wave, nwv = (c.G >> 3) * 8;
    int cxq = 0;
    float svn[32];
#define ATT_PREFETCH(qn_) do { const int bn_ = xg + 8 * ((qn_) / S), sn_ = (qn_) % S, cn_ = sn_ >> 6, nn_ = 64 * (cn_ + 1); \
        const float* srn_ = SC + sc_off(bn_, cn_) + (size_t)(sn_ & 63) * nn_ + lane; \
        _Pragma("unroll") for (int j = 0; j < 32; ++j) svn[j] = srn_[64 * (j <= cn_ ? j : cn_)]; } while (0)
    if ((MODE & 1) && wv < 2 * S) ATT_PREFETCH(wv);
    for (int kq = 0; kq * nwv < 2 * S; ++kq) { const int qi = kq * nwv + ((kq & 1) ? nwv - 1 - wv : wv); if (qi >= 2 * S) break;
        const int b = xg + 8 * (qi / S), s = qi % S, cq = s >> 6, n = 64 * (cq + 1), nk = n < 256 ? n : 256;
        const size_t t = (size_t)b * S + s;
        float sv[32];
#pragma unroll
        for (int j = 0; j < 32; ++j) sv[j] = svn[j];
        { const int qn = (kq + 1) * nwv + (((kq + 1) & 1) ? nwv - 1 - wv : wv); if ((MODE & 1) && (kq + 1) * nwv < 2 * S && qn < 2 * S) ATT_PREFETCH(qn); }
        float tv[32]; const int cit = c.gw + c.NGW * cxq; const bool cxv = (MODE & 8) && cit < 3 * 8192;
        if (cxv) cx_issue(p, l, cit, lane, tv);
        SW_START(10);
        if (cq < 4 || !(MODE & 1)) { for (int i = lane; i < nk; i += 64) lst[i] = (unsigned)i * 256u; }
        else {
            unsigned key[32]; unsigned kmin = 0xffffffffu, kmax = 0u;
#pragma unroll
            for (int j = 0; j < 32; ++j) key[j] = 0u;
#pragma unroll
            for (int jb = 0; jb < 4; ++jb) if (8 * jb <= cq) {
#pragma unroll
                for (int j = 8 * jb; j < 8 * jb + 8; ++j) { const unsigned u = __float_as_uint(sv[j] + 0.0f); const unsigned k = (u & 0x80000000u) ? ~u : (u | 0x80000000u);
                    key[j] = (j <= cq) ? k : 0u; kmin = (j <= cq && k < kmin) ? k : kmin; kmax = (j <= cq && k > kmax) ? k : kmax; } }
#define KMM(W) { const unsigned a = lane_xor<W>(kmin), bb = lane_xor<W>(kmax); kmin = a < kmin ? a : kmin; kmax = bb > kmax ? bb : kmax; }
            KMM(1) KMM(2) KMM(4) KMM(8) KMM(16) KMM(32)
#undef KMM
            SW_START(11);
            unsigned lo = __builtin_amdgcn_readfirstlane(kmin), hi = __builtin_amdgcn_readfirstlane(kmax); int c_lo = n, c_hi = 0; int it = 0;
            unsigned thr = 0u; int need = 0; bool done = false;
            while (lo < hi && ((c_lo - c_hi) > 64 || it < 7)) {
                unsigned m1, m2;
                if (it < 12) {
                    const float lo_v = __uint_as_float((lo & 0x80000000u) ? (lo ^ 0x80000000u) : ~lo), hi_v = __uint_as_float((hi & 0x80000000u) ? (hi ^ 0x80000000u) : ~hi);
                    float f1 = 0.45f, f2 = 0.70f;
                    if (it > 0) { const float est = (float)(c_lo - 256) * __builtin_amdgcn_rcpf((float)(c_lo - c_hi)); f1 = est * 0.75f; f2 = est + (1.0f - est) * 0.25f; }
                    const float v1 = lo_v + (hi_v - lo_v) * f1 + 0.0f, v2 = lo_v + (hi_v - lo_v) * f2 + 0.0f;
                    const unsigned u1 = __float_as_uint(v1), u2 = __float_as_uint(v2);
                    m1 = (u1 & 0x80000000u) ? ~u1 : (u1 | 0x80000000u); m2 = (u2 & 0x80000000u) ? ~u2 : (u2 | 0x80000000u);
                } else { const unsigned third = (hi - lo) / 3u; m1 = lo + third + 1u; m2 = hi - third; }
                m1 = m1 > lo ? m1 : lo + 1u; m1 = m1 < hi ? m1 : hi; m2 = m2 > m1 ? m2 : m1; m2 = m2 < hi ? m2 : hi;
                int c1 = 0, c2 = 0;
#pragma unroll
                for (int jb = 0; jb < 8; ++jb) if (4 * jb <= cq) {
                    unsigned long long ba[4], bb[4];
#pragma unroll
                    for (int j = 0; j < 4; ++j) { ba[j] = __ballot(key[4 * jb + j] >= m1); bb[j] = __ballot(key[4 * jb + j] >= m2); }
#pragma unroll
                    for (int j = 0; j < 4; ++j) { c1 += __builtin_popcountll(ba[j]); c2 += __builtin_popcountll(bb[j]); } }
                if (c2 >= 256) { lo = m2; c_lo = c2; if (c2 == 256) { thr = m2; need = 1 << 20; done = true; break; } }
                else if (c1 >= 256) { lo = m1; c_lo = c1; hi = m2 - 1u; c_hi = c2; if (c1 == 256) { thr = m1; need = 1 << 20; done = true; break; } }
                else { hi = m1 - 1u; c_hi = c1; }
                ++it;
            }
            SW_STOP(11); SW_START(12);
            if (!done) {
                if (lo == hi) {
                    thr = lo; int cgt = 0;
#pragma unroll
                    for (int j = 0; j < 32; ++j) cgt += __builtin_popcountll(__ballot(key[j] > thr));
                    need = 256 - cgt;
                } else {
                    LAS unsigned* cand = (LAS unsigned*)lst; int base = 0;
#pragma unroll
                    for (int jb = 0; jb < 4; ++jb) if (8 * jb <= cq) {
#pragma unroll
                        for (int j = 8 * jb; j < 8 * jb + 8; ++j) { const bool isc = key[j] >= lo && key[j] <= hi; const unsigned long long bc = __ballot(isc);
                            if (isc) cand[base + __builtin_popcountll(bc & ltmask)] = key[j]; base += __builtin_popcountll(bc); } }
                    const int m = base;
                    const unsigned ck = lane < m ? cand[lane] : 0u;
                    int gt = 0, ge = 0;
                    for (int q = 0; q < m; ++q) { const unsigned v = (unsigned)__builtin_amdgcn_readlane((int)ck, q); gt += v > ck; ge += v >= ck; }
                    const int r = 256 - c_hi;
                    const unsigned long long hit = __ballot(lane < m && gt < r && r <= ge);
                    const int src = __builtin_ctzll(hit);
                    thr = __shfl(ck, src); need = r - __shfl(gt, src);
                }
            }
            SW_STOP(12); SW_START(13);
            asm volatile("" ::: "memory");
            {
                int base = 0, tb = 0;
#pragma unroll
                for (int jb = 0; jb < 4; ++jb) if (8 * jb <= cq) {
#pragma unroll
                    for (int j = 8 * jb; j < 8 * jb + 8; ++j) {
                        const bool gt = key[j] > thr, tie = key[j] == thr; const unsigned long long bt = __ballot(tie);
                        const int trank = tb + __builtin_popcountll(bt & ltmask); const bool sel = gt || (tie && trank < need);
                        const unsigned long long bs = __ballot(sel); const int pos = base + __builtin_popcountll(bs & ltmask);
                        if (sel && pos < 256) lst[pos] = (unsigned)(64 * j + lane) * 256u;
                        base += __builtin_popcountll(bs); tb += __builtin_popcountll(bt); } }
            }
        }
        if (cq >= 4 && (MODE & 1)) SW_STOP(13);
        SW_STOP(10); SW_START(14);
        bf16x8 qf[4];
#pragma unroll
        for (int ks = 0; ks < 4; ++ks) { qf[ks] = (bf16x8){0, 0, 0, 0, 0, 0, 0, 0}; if (hd < 8) qf[ks] = *(const bf16x8*)(QA + t * D + hd * 128 + 32 * ks + 8 * g); }
        float m_ref = -INFINITY, l_run = 0.f;
        f32x4 o[8];
#pragma unroll
        for (int ct = 0; ct < 8; ++ct) o[ct] = (f32x4){0.f, 0.f, 0.f, 0.f};
        const char* kvb = (const char*)(KVN + (size_t)b * S * 128);
        const int ntile = nk >> 5;
        LDS_WAIT();
        unsigned choff[4];
#pragma unroll
        for (int i = 0; i < 4; ++i) choff[i] = (((unsigned)hd ^ (unsigned)((g << 2) | i)) * 16u);
#define ATT_ISSUE(kt_, buf_) do { const u32x4 kq0_ = *(const LAS u32x4*)(lst + (kt_) * 32 + 8 * g), kq1_ = *(const LAS u32x4*)(lst + (kt_) * 32 + 8 * g + 4); _Pragma("unroll") for (int i = 0; i < 8; ++i) { \
            const unsigned off_ = (i < 4 ? kq0_[i & 3] : kq1_[i & 3]) + choff[i & 3]; \
            if (MODE & 2) __builtin_amdgcn_global_load_lds((const unsigned*)(kvb + off_), (LAS unsigned*)(tile + (buf_) * 8192 + i * 1024), 16, 0, 0); } } while (0)
        ATT_ISSUE(0, 0);
        for (int kt = 0; kt < ntile; ++kt) {
            LAS unsigned char* tb_ = tile + (kt & 1) * 8192;
            if (kt + 1 < ntile) { ATT_ISSUE(kt + 1, (kt + 1) & 1); asm volatile("s_waitcnt vmcnt(8)" ::: "memory"); }
            else asm volatile("s_waitcnt vmcnt(0)" ::: "memory");
            if (!(MODE & 4)) continue;
            f32x4 sa[2]; bf16x8 af[2][4];
#pragma unroll
            for (int rb = 0; rb < 2; ++rb)
#pragma unroll
                for (int ks = 0; ks < 4; ++ks) af[rb][ks] = *(const LAS bf16x8*)(tb_ + off_b(16 * rb + hd, 4 * ks + g));
#pragma unroll
            for (int rb = 0; rb < 2; ++rb) { sa[rb] = (f32x4){0.f, 0.f, 0.f, 0.f};
#pragma unroll
                for (int ks = 0; ks < 4; ++ks) sa[rb] = __builtin_amdgcn_mfma_f32_16x16x32_bf16(af[rb][ks], qf[ks], sa[rb], 0, 0, 0); }
            float pr[8], ps = 0.f;
#pragma unroll
            for (int j = 0; j < 8; ++j) { pr[j] = __builtin_amdgcn_exp2f(sa[j >> 2][j & 3] - m_ref); ps += pr[j]; }
            if (__ballot(!(ps < 8.0e12f)) != 0ull) {
                float mx = fmaxf(fmaxf(fmaxf(sa[0][0], sa[0][1]), fmaxf(sa[0][2], sa[0][3])), fmaxf(fmaxf(sa[1][0], sa[1][1]), fmaxf(sa[1][2], sa[1][3])));
                mx = fmaxf(mx, lane_xor<16>(mx)); mx = fmaxf(mx, lane_xor<32>(mx));
                const float m_new = fmaxf(m_ref, mx), alpha = __builtin_amdgcn_exp2f(m_ref - m_new);
                l_run *= alpha; m_ref = m_new;
#pragma unroll
                for (int ct = 0; ct < 8; ++ct) o[ct] *= alpha;
                ps = 0.f;
#pragma unroll
                for (int j = 0; j < 8; ++j) { pr[j] = __builtin_amdgcn_exp2f(sa[j >> 2][j & 3] - m_ref); ps += pr[j]; }
            }
            l_run += ps;
            u32x4 pw; pw.x = cvt_pk_bf16(pr[0], pr[1]); pw.y = cvt_pk_bf16(pr[2], pr[3]); pw.z = cvt_pk_bf16(pr[4], pr[5]); pw.w = cvt_pk_bf16(pr[6], pr[7]);
            const bf16x8 pb = __builtin_bit_cast(bf16x8, pw);
            const unsigned q4 = (unsigned)hd >> 2, p4 = (unsigned)hd & 3;
#pragma unroll
            for (int ct = 0; ct < 8; ++ct) {
                const bf16x4 vlo = __builtin_amdgcn_ds_read_tr16_b64_v4i16((LAS bf16x4*)(tb_ + off_b(4 * g + q4, 2 * ct + (p4 >> 1)) + 8 * (p4 & 1)));
                const bf16x4 vhi = __builtin_amdgcn_ds_read_tr16_b64_v4i16((LAS bf16x4*)(tb_ + off_b(16 + 4 * g + q4, 2 * ct + (p4 >> 1)) + 8 * (p4 & 1)));
                const bf16x8 va = __builtin_shufflevector(vlo, vhi, 0, 1, 2, 3, 4, 5, 6, 7);
                o[ct] = __builtin_amdgcn_mfma_f32_16x16x32_bf16(va, pb, o[ct], 0, 0, 0);
            }
            LDS_WAIT();
        }
        SW_STOP(14); SW_START(16);
#undef ATT_ISSUE
        float lt = l_run + lane_xor<16>(l_run); lt += lane_xor<32>(lt);
        const float inv = 1.0f / lt;
        if (hd < 8 && ((MODE & 8) || lt == 12345.678f)) {
#pragma unroll
            for (int ct = 0; ct < 8; ++ct) { const f32x4 v = o[ct] * inv; u32x2 w; w.x = cvt_pk_bf16(v.x, v.y); w.y = cvt_pk_bf16(v.z, v.w);
                *(u32x2*)(MC + t * KMIX + 256 + hd * 128 + 16 * ct + 4 * g) = w; }
        }
        SW_STOP(16); SW_START(15);
        if (cxv) cx_finish(p, cit, lane, tv, (LAS float*)tile);
        SW_STOP(15);
        ++cxq;
    }
#undef ATT_PREFETCH
    for (; (MODE & 8) && c.gw + c.NGW * cxq < 3 * 8192; ++cxq) { float tv[32]; const int cit = c.gw + c.NGW * cxq; cx_issue(p, l, cit, lane, tv); cx_finish(p, cit, lane, tv, (LAS float*)tile); }
}

__device__ __forceinline__ void ph_router(const Params& p, const Ctx& c, int l) {
    const float* mod = (const float*)(p.ws + WS_MOD); bf16_t* H = (bf16_t*)(p.ws + WS_H);
    int* toke = (int*)(p.ws + WS_SMALL + SM_TOKE); int* rank = (int*)(p.ws + WS_SMALL + SM_RANK);
    constexpr int RS = 2064, WLO = 36 * RS;
    LAS float* cpart = (LAS float*)(c.lds + 2 * WLO); LAS float* cfin = cpart + 144;
    LAS int* le = (LAS int*)(cfin + 64); LAS int* wcnt = le + 256; LAS float* lg = (LAS float*)(wcnt + 192);
    const int lane = c.lane, t = lane & 15, q = lane >> 4;
    for (int tile = c.vcu; tile < 256; tile += c.G) {
        SW_START(31);
        const int b = (tile * 128) >> 11;
        const int m0 = tile * 128 + c.wave * 16;
        const bf16x8* xr = (const bf16x8*)((const bf16_t*)(p.ws + WS_X16) + (size_t)(m0 + t) * D + q * 8);
        bf16x8 x2[3][8];
#pragma unroll
        for (int i = 0; i < 8; ++i) { x2[0][i] = xr[i * 4]; x2[1][i] = xr[(8 + i) * 4]; }
        const int k4 = c.tid & 255;
        {
            const f32x4 ngv = ((const f32x4*)(p.in[I_N2G] + l * D))[k4];
            const f32x4 scv = ((const f32x4*)(mod + (size_t)(l * NB + b) * 6144 + 4096))[k4], shv = ((const f32x4*)(mod + (size_t)(l * NB + b) * 6144 + 3072))[k4];
            const f32x4 gm = ngv * (scv + 1.0f);
            const int par = c.tid >> 8;
            const f32x4* src = (const f32x4*)(p.ws + WS_SMALL + SM_WRT) + (size_t)l * 36 * 256 + par * 256 + k4;
            int lw = par * RS + k4 * 8, cpo = par * 4 + (k4 >> 6);
            asm volatile("" : "+v"(lw), "+v"(cpo), "+v"(src));
#pragma unroll
            for (int hb = 0; hb < 2; ++hb) { f32x4 w[9];
#pragma unroll
                for (int i = 0; i < 9; ++i) w[i] = src[(9 * hb + i) * 512];
#pragma unroll
                for (int i = 0; i < 9; ++i) { const int j = 9 * hb + i;
                    const f32x4 wp = w[i] * gm;
                    u32x2 hi; hi.x = cvt_pk_bf16(wp.x, wp.y); hi.y = cvt_pk_bf16(wp.z, wp.w);
                    u32x2 lo; lo.x = cvt_pk_bf16(wp.x - bflo(hi.x), wp.y - bfhi(hi.x)); lo.y = cvt_pk_bf16(wp.z - bflo(hi.y), wp.w - bfhi(hi.y));
                    *(LAS u32x2*)(c.lds + lw + j * 2 * RS) = hi; *(LAS u32x2*)(c.lds + lw + WLO + j * 2 * RS) = lo;
                    float d = (w[i].x * shv.x + w[i].y * shv.y) + (w[i].z * shv.z + w[i].w * shv.w); d = wave_sum(d);
                    if (lane == 0) cpart[cpo + j * 8] = d; } }
        }
        __syncthreads();
        if (c.tid < 36) { const int R = c.tid; const float bias = R < 32 ? p.in[I_REB][l * 32 + ((R & 15) >> 2) * 8 + (R & 3) + (R >= 16 ? 4 : 0)] : p.in[I_RGB][l * 4 + (R - 32)];
            cfin[R] = ((cpart[4 * R] + cpart[4 * R + 1]) + (cpart[4 * R + 2] + cpart[4 * R + 3])) + bias; }
        __syncthreads();
        f32x4 a0 = {0.f, 0.f, 0.f, 0.f}, a1 = a0, a2 = a0, aq = a0;
        { const LAS unsigned char* w0p = c.lds + t * RS + q * 16; const LAS unsigned char* w2p = c.lds + (32 + (t & 3)) * RS + q * 16;
#pragma unroll
          for (int ch = 0; ch < 4; ++ch) {
              if (ch < 3) {
#pragma unroll
                  for (int i = 0; i < 8; ++i) x2[(ch + 2) % 3][i] = xr[(8 * ((ch + 2) & 3) + i) * 4]; }
#pragma unroll
              for (int i = 0; i < 8; ++i) { const int ks = 8 * ch + i; if ((i & 1) == 0) asm volatile("" ::: "memory");
                  const bf16x8 xv = x2[ch % 3][i];
                  const bf16x8 h0 = *(const LAS bf16x8*)(w0p + ks * 64), h1 = *(const LAS bf16x8*)(w0p + 16 * RS + ks * 64), h2 = *(const LAS bf16x8*)(w2p + ks * 64);
                  const bf16x8 l0 = *(const LAS bf16x8*)(w0p + WLO + ks * 64), l1 = *(const LAS bf16x8*)(w0p + WLO + 16 * RS + ks * 64), l2 = *(const LAS bf16x8*)(w2p + WLO + ks * 64);
                  a0 = __builtin_amdgcn_mfma_f32_16x16x32_bf16(h0, xv, a0, 0, 0, 0); a1 = __builtin_amdgcn_mfma_f32_16x16x32_bf16(h1, xv, a1, 0, 0, 0);
                  a2 = __builtin_amdgcn_mfma_f32_16x16x32_bf16(h2, xv, a2, 0, 0, 0); aq = __builtin_amdgcn_mfma_f32_16x16x32_bf16(xv, xv, aq, 0, 0, 0);
                  a0 = __builtin_amdgcn_mfma_f32_16x16x32_bf16(l0, xv, a0, 0, 0, 0); a1 = __builtin_amdgcn_mfma_f32_16x16x32_bf16(l1, xv, a1, 0, 0, 0);
                  a2 = __builtin_amdgcn_mfma_f32_16x16x32_bf16(l2, xv, a2, 0, 0, 0); } } }
        float ss = (t & 2) ? ((t & 1) ? aq[3] : aq[2]) : ((t & 1) ? aq[1] : aq[0]);
        ss = (q == (t >> 2)) ? ss : 0.f; ss += lane_xor<16>(ss); ss += lane_xor<32>(ss);
        const float r = 1.0f / sqrtf(ss * (1.0f / D) + EPS);
        {
            __syncthreads();
            if (c.tid < 256) {
                const f32x4 ngv = ((const f32x4*)(p.in[I_N2G] + l * D))[k4], scv = ((const f32x4*)(mod + (size_t)(l * NB + b) * 6144 + 4096))[k4], shv = ((const f32x4*)(mod + (size_t)(l * NB + b) * 6144 + 3072))[k4];
                ((LAS f32x4*)c.lds)[k4] = ngv * (scv + 1.0f); ((LAS f32x4*)c.lds)[256 + k4] = shv; }
            __syncthreads();
            const LAS f32x4* gml = (const LAS f32x4*)c.lds + q * 2;
            u32x4* hrow = (u32x4*)(H + (size_t)(m0 + t) * D + q * 8);
#pragma unroll
            for (int st = 0; st < 4; ++st) { const int ch = (st + 2) & 3;
                if (st == 1) {
#pragma unroll
                    for (int i = 0; i < 8; ++i) x2[2][i] = xr[(8 + i) * 4]; }
#pragma unroll
                for (int i = 0; i < 8; ++i) { const int ks = 8 * ch + i; if ((i & 1) == 0) asm volatile("" ::: "memory");
                    const f32x4 g0 = gml[ks * 8], g1 = gml[ks * 8 + 1], s0 = gml[256 + ks * 8], s1 = gml[256 + ks * 8 + 1];
                    const u32x4 xb = __builtin_bit_cast(u32x4, x2[(st + 2) % 3][i]);
                    f32x4 v0 = {bflo(xb.x), bfhi(xb.x), bflo(xb.y), bfhi(xb.y)}, v1 = {bflo(xb.z), bfhi(xb.z), bflo(xb.w), bfhi(xb.w)};
                    v0 = v0 * r * g0 + s0; v1 = v1 * r * g1 + s1;
                    u32x4 o; o.x = cvt_pk_bf16(v0.x, v0.y); o.y = cvt_pk_bf16(v0.z, v0.w); o.z = cvt_pk_bf16(v1.x, v1.y); o.w = cvt_pk_bf16(v1.z, v1.w);
                    hrow[ks * 4] = o; } }
        }
        {
            float gq[4]; int g_ = 0; float gmax = -INFINITY;
#pragma unroll
            for (int g = 0; g < 4; ++g) { gq[g] = a2[g] * r + cfin[32 + g]; if (gq[g] > gmax) { gmax = gq[g]; g_ = g; } }
            float gden = 0.f;
#pragma unroll
            for (int g = 0; g < 4; ++g) gden += __expf(gq[g] - gmax);
            const float gp = 1.0f / gden;
            float eq[8]; int e0 = 0, e1 = 0; float mx0 = -INFINITY, mx1 = -INFINITY;
#pragma unroll
            for (int e = 0; e < 8; ++e) { eq[e] = (e < 4 ? a0[e & 3] : a1[e & 3]) * r + cfin[(e < 4 ? 0 : 16) + 4 * q + (e & 3)];
                if (eq[e] > mx0) { mx1 = mx0; e1 = e0; mx0 = eq[e]; e0 = e; } else if (eq[e] > mx1) { mx1 = eq[e]; e1 = e; } }
            const float x1 = __expf(mx1 - mx0), den = 1.0f + x1; const int tl = c.wave * 16 + t, m = m0 + t;
            if (q == g_) { le[2 * tl] = q * 8 + e0; le[2 * tl + 1] = q * 8 + e1; toke[2 * m] = q * 8 + e0; toke[2 * m + 1] = q * 8 + e1; lg[2 * tl] = gp / den; lg[2 * tl + 1] = gp * x1 / den; }
        }
        SW_STOP(31);
        __syncthreads();
        SW_START(32);
        int myrank = 0, mye = 0;
        if (c.tid < 256) { mye = le[c.tid]; const unsigned long long ltmask = (1ull << lane) - 1ull;
            for (int ee = 0; ee < 32; ++ee) { const unsigned long long m = __ballot(mye == ee); if (mye == ee) myrank = __builtin_popcountll(m & ltmask); if (lane == 0) wcnt[c.wave * 32 + ee] = __builtin_popcountll(m); } }
        __syncthreads();
        LAS int* ebase = wcnt + 128;
        if (c.tid < 32) { const int tc = wcnt[c.tid] + wcnt[32 + c.tid] + wcnt[64 + c.tid] + wcnt[96 + c.tid];
            ebase[c.tid] = (int)__hip_atomic_fetch_add((unsigned*)(p.ws + WS_CTL) + CW_ECUR + 64 * l + c.tid, (unsigned)tc, __ATOMIC_RELAXED, __HIP_MEMORY_SCOPE_AGENT); }
        __syncthreads();
        if (c.tid < 256) { for (int w = 0; w < c.wave; ++w) myrank += wcnt[w * 32 + mye];
            const int pos = ebase[mye] + myrank; rank[tile * 256 + c.tid] = pos;
            u32x2 ent; ent.x = (unsigned)(tile * 128 + (c.tid >> 1)); ent.y = __float_as_uint(lg[c.tid]);
            ((u32x2*)(p.ws + WS_ELIST))[(size_t)mye * (2 * T) + pos] = ent; }
        __syncthreads();
        SW_STOP(32);
    }
}

__device__ __forceinline__ int moe_tables(const Params& p, const Ctx& c, int l, bool rows, LAS int* lds_tab, bool fuse_ok, int& off, int& n5r) {
    LAS int* pst = lds_tab + pg8::MoeOrder::MAXU * 256 + 64; LAS int* cntE = pst + 40;
    if (c.tid < 32) cntE[c.tid] = (int)__hip_atomic_load((unsigned*)(p.ws + WS_CTL) + CW_ECUR + 64 * l + c.tid, __ATOMIC_RELAXED, __HIP_MEMORY_SCOPE_AGENT);
    __syncthreads();
    if (c.tid == 0) { int a = 0; for (int e = 0; e < 32; ++e) { pst[e] = a; a += ((cntE[e] + 255) >> 8) << 8; } pst[32] = a; }
    __syncthreads();
    const int ntl = pst[32] >> 8;
    { const int n5 = 4 * ntl - 4 * c.G; const bool fuse = fuse_ok && c.G == 256 && n5 > 0 && n5 < c.G; n5r = fuse ? n5 : 0; off = (fuse && !rows) ? 2 * (c.G - n5) : 0; }
    if (rows) { const int* toke = (const int*)(p.ws + WS_SMALL + SM_TOKE); const int* tpos = (const int*)(p.ws + WS_SMALL + SM_RANK); int* tslot = (int*)(p.ws + WS_SMALL + SM_TSLOT);
        for (int tile = c.vcu; tile < 256; tile += c.G) if (c.tid < 256) { const int a = tile * 256 + c.tid; tslot[a] = pst[toke[a]] + tpos[a]; } }
    float* sgate = (float*)(p.ws + WS_SMALL + SM_SGATE);
    for (int i = 0; i < pg8::MoeOrder::MAXU; ++i) { const int L = i * c.G + c.vcu + off; if (L >= ntl * 4) break; const int tile = L >> 2;
        int e = 0; while (pst[e + 1] <= (tile << 8)) ++e;
        if (c.tid == 0) lds_tab[pg8::MoeOrder::MAXU * 256 + i] = e;
        if (rows && c.tid < 256) { const int q = (tile << 8) - pst[e] + c.tid; u32x2 ent = {0u, 0u};
            if (q < cntE[e]) ent = ((const u32x2*)(p.ws + WS_ELIST))[(size_t)e * (2 * T) + q];
            lds_tab[i * 256 + c.tid] = (int)ent.x; sgate[(tile << 8) + c.tid] = __uint_as_float(ent.y); } }
    __syncthreads();
    return ntl;
}

#ifndef PH_ONLY
#define PH_ONLY -1
#endif
#define IN(k) ((PH_ONLY < 0 || PH_ONLY == (k)) && lo <= (k) && (k) < hi)
#define SEAM(k) do { if (IN(k) && IN((k) + 1)) xcd_barrier(bar); } while (0)
#ifndef REP_MASK
#define REP_MASK 0
#endif
#define REP(id) (((REP_MASK) >> (id)) & 1)
#define BODY(id, cond, ...) do { __VA_ARGS__ if (REP(id) && (cond)) { xcd_barrier(bar); __VA_ARGS__ } } while (0)
template <int l>
__device__ __forceinline__ void run_layer(const Params& p, const Ctx& c, const XcdBarrier& bar, int lo, int hi) {
    bf16_t* Zb = (bf16_t*)(p.ws + WS_Z); bf16_t* Hb = (bf16_t*)(p.ws + WS_H); bf16_t* MCb = (bf16_t*)p.out;
    const float* mod = (const float*)(p.ws + WS_MOD);
    constexpr int P = 1 + 10 * l;
    if (IN(P)) { if (l == 0) { BODY(1, true, ph_norm1<0>(p, c);); } else { ph_norm1<1>(p, c); } }
    SEAM(P);
    if (IN(P + 1)) { BODY(2, true, { pg8::StaticOrder So; So.init(Hb, (bf16_t*)(p.ws + WS_WIN) + (size_t)l * NZ * D, T, NZ, D, c.G, (int)blockIdx.x);
        pg8::EpiBf16 E{Zb, NZ}; pg8::gemm_phase<pg8::EpiBf16, pg8::StaticOrder, false>(c.lds, So, E); });
        if (l == 0) { constexpr int NU = (T / 256) * (NZ / 256); const int rem = NU % c.G;
            if (rem == 0) ph_prologue_rest(p, c, c.gw, c.NGW); else if ((int)blockIdx.x >= rem) ph_prologue_rest(p, c, ((int)blockIdx.x - rem) * 8 + c.wave, (c.G - rem) * 8); } }
    SEAM(P + 1);
    if (IN(P + 2)) { BODY(3, true, ph_postz(p, c, l);); }
    SEAM(P + 2);
    if (IN(P + 3)) { BODY(4, true, { pg8::StaticOrder So; So.init((bf16_t*)(p.ws + WS_CQR), (bf16_t*)(p.ws + WS_WQA) + (size_t)l * D * 256, T, D, 256, c.G, (int)blockIdx.x);
        pg8::EpiBf16 E{Hb, D}; pg8::gemm_phase<pg8::EpiBf16, pg8::StaticOrder, false>(c.lds, So, E); });
        BODY(5, true, ph_scores(p, c);); }
    SEAM(P + 3);
#ifndef ATT_PROBE
#define ATT_PROBE 0
#endif
    if (IN(P + 4)) { ph_attn<15>(p, c, l); if (ATT_PROBE) { xcd_barrier(bar); ph_attn<ATT_PROBE>(p, c, l); } }
    SEAM(P + 4);
    if (IN(P + 5)) { BODY(7, l == 0, { pg8::StaticOrder So; So.init(MCb, (bf16_t*)(p.ws + WS_WMIX) + (size_t)l * D * KMIX, T, D, KMIX, c.G, (int)blockIdx.x);
        pg8::EpiMix<l == 0> E{l == 0 ? p.in[I_X] : nullptr, (bf16_t*)(p.ws + WS_X16), mod + (size_t)l * NB * 6144 + 2048}; pg8::gemm_phase<pg8::EpiMix<l == 0>, pg8::StaticOrder, false>(c.lds, So, E); }); }
    SEAM(P + 5);
    if (IN(P + 6)) { BODY(8, true, ph_router(p, c, l);); }
    SEAM(P + 6);
    const bool fuse_ok = IN(P + 8) && IN(P + 9);
    if (IN(P + 8)) { int off, n5; LAS int* tab = (LAS int*)(c.lds + MOE_TAB_OFF); const int ntl = moe_tables(p, c, l, true, tab, fuse_ok, off, n5);
        unsigned* arr = (unsigned*)(p.ws + WS_CTL) + CW_ARR + 64 * l;
        {
            pg8::MoeOrder Mo; Mo.init(Hb, p.ws + WS_W13, D, (size_t)1024 * 1024 * 2, true, n5 > 0 ? c.G : ntl, c.G, c.vcu, tab);
            pg8::EpiAct E{Zb}; pg8::gemm_phase<pg8::EpiAct, pg8::MoeOrder, true>(c.lds, Mo, E); }
        if (n5 > 0) {
            if (c.tid == 0) { __builtin_amdgcn_fence(__ATOMIC_RELEASE, "agent"); asm volatile("s_waitcnt vmcnt(0)" ::: "memory"); (void)xb_add(arr, 1u); }
            if (c.vcu < n5) {
                pg8::MoeOrder Mo; Mo.init(Hb, p.ws + WS_W13, D, (size_t)1024 * 1024 * 2, true, ntl, c.G, c.vcu, tab, 4 * c.G, 4);
                pg8::EpiAct E{Zb}; pg8::gemm_phase<pg8::EpiAct, pg8::MoeOrder, true>(c.lds, Mo, E);
            } else {
                if (c.tid == 0) { XB_SPIN(xb_ld(arr) != (unsigned)c.G, bar.bar); __builtin_amdgcn_fence(__ATOMIC_ACQUIRE, "agent"); asm volatile("s_waitcnt vmcnt(0)" ::: "memory"); }
                __syncthreads();
                const int Lx = c.vcu - n5, nearly = c.G - n5; LAS int* pst = tab + pg8::MoeOrder::MAXU * 256 + 64;
                if (c.tid < 2) { int e = 0; while (pst[e + 1] <= (((Lx + c.tid * nearly) >> 2) << 8)) ++e; tab[pg8::MoeOrder::MAXU * 256 + c.tid] = e; }
                __syncthreads();
                pg8::MoeOrder M2; M2.init(Zb, p.ws + WS_W2, DEXP, (size_t)1024 * 512 * 2, false, nearly / 2, nearly, Lx, tab);
                pg8::EpiY E2{(bf16_t*)(p.ws + WS_Y), (const float*)(p.ws + WS_SMALL + SM_SGATE)}; pg8::gemm_phase<pg8::EpiY, pg8::MoeOrder, false>(c.lds, M2, E2);
            } } }
    SEAM(P + 8);
    if (IN(P + 9)) { int off, n5; const int ntl = moe_tables(p, c, l, false, (LAS int*)(c.lds + MOE_TAB_OFF), fuse_ok, off, n5);
        pg8::MoeOrder Mo; Mo.init(Zb, p.ws + WS_W2, DEXP, (size_t)1024 * 512 * 2, false, ntl, c.G, c.vcu, (LAS int*)(c.lds + MOE_TAB_OFF), off);
        pg8::EpiY E{(bf16_t*)(p.ws + WS_Y), (const float*)(p.ws + WS_SMALL + SM_SGATE)}; pg8::gemm_phase<pg8::EpiY, pg8::MoeOrder, false>(c.lds, Mo, E); }
    SEAM(P + 9);
}

__global__ void __launch_bounds__(512, 2) fwd(Params p) {
    extern __shared__ __attribute__((aligned(16))) unsigned char lds_raw[];
    Ctx c;
    c.lds = (LAS unsigned char*)lds_raw;
    c.tid = threadIdx.x; c.lane = c.tid & 63; c.wave = __builtin_amdgcn_readfirstlane(c.tid >> 6);
    c.G = gridDim.x; { const int bx = blockIdx.x; c.vcu = (c.G % 8 == 0) ? (bx % 8) * (c.G / 8) + bx / 8 : bx; }
    c.gw = c.vcu * 8 + c.wave; c.NGW = c.G * 8; c.sw_t0 = 0ull; c.sw_sum = 0ull;
    volatile LAS unsigned* MISC = (volatile LAS unsigned*)(c.lds + MISC_OFF);
    if (c.tid < 64) MISC[c.tid] = 0u;
    __syncthreads();
    unsigned* ctl = (unsigned*)(p.ws + WS_CTL);
    XcdBarrier bar; bar.bar = ctl + CW_BAR; bar.x = 0; bar.st = nullptr;
    const bool multi = (p.ph_hi - p.ph_lo) > 1;
    if (multi) bar = xcd_barrier_post(ctl + CW_BAR, MISC + 8);
    const int lo = p.ph_lo, hi = p.ph_hi;
    if (IN(0)) { BODY(0, true, ph_prologue(p, c);); }
    SEAM(0);
    run_layer<0>(p, c, bar, lo, hi);
    run_layer<1>(p, c, bar, lo, hi);
    if (IN(21)) ph_norm1<2>(p, c);
    if (SW_ID) { const unsigned long long t0 = __builtin_amdgcn_s_memrealtime(); while (__builtin_amdgcn_s_memrealtime() - t0 < 8ull * c.sw_sum) __builtin_amdgcn_s_sleep(8); }
#undef IN
#undef SEAM
}

extern "C" void kernel_launch(void* const* d_in, const int* in_sizes, int n_in, void* d_out, int out_size, void* d_ws, size_t ws_size, hipStream_t stream) {
    static int grid = 0;
    if (grid == 0) {
        if (n_in != 27 || out_size != T * D || ws_size < WS_END) { fprintf(stderr, "kernel_launch: unexpected shapes (n_in %d out %d ws %zu, need %zu)\n", n_in, out_size, ws_size, (size_t)WS_END); grid = -1; return; }
        int dev = 0, cus = 0, per_cu = 0;
        if (hipGetDevice(&dev) != hipSuccess || hipDeviceGetAttribute(&cus, hipDeviceAttributeMultiprocessorCount, dev) != hipSuccess) { grid = -1; return; }
        if (hipFuncSetAttribute((const void*)fwd, hipFuncAttributeMaxDynamicSharedMemorySize, LDS_BYTES) != hipSuccess) { fprintf(stderr, "kernel_launch: hipFuncSetAttribute failed\n"); grid = -1; return; }
        if (hipOccupancyMaxActiveBlocksPerMultiprocessor(&per_cu, (const void*)fwd, 512, LDS_BYTES) != hipSuccess || per_cu < 1) { fprintf(stderr, "kernel_launch: occupancy query says %d blocks per CU\n", per_cu); grid = -1; return; }
        (void)hipGetLastError();
        grid = cus >= 256 ? 256 : (cus >= 128 ? 128 : 0);
        if (grid == 0) { fprintf(stderr, "kernel_launch: %d CUs: this kernel needs at least 128\n", cus); grid = -1; return; }
    }
    if (grid <= 0) return;
    (void)hipMemsetAsync((char*)d_ws + WS_CTL, 0, CTL_ZERO_BYTES, stream);
    Params p{};
    for (int i = 0; i < 27; ++i) p.in[i] = (const float*)d_in[i];
    p.out = (float*)d_out; p.ws = (unsigned char*)d_ws;
#if MK_SPLIT
    for (int ph = 0; ph < NPHASE; ++ph) { p.ph_lo = ph; p.ph_hi = ph + 1; hipLaunchKernelGGL(fwd, dim3(grid), dim3(512), LDS_BYTES, stream, p); }
#else
    p.ph_lo = 0; p.ph_hi = NPHASE;
    hipLaunchKernelGGL(fwd, dim3(grid), dim3(512), LDS_BYTES, stream, p);
#endif
}
```
